# Optimizing an MI355X kernel written in HIP

```python
import math
import jax
import jax.numpy as jnp
from jax import lax
import numpy as np


D_MODEL = 1024
BATCH = 32
SEQ = 2048
DEPTH = 2

CTX_LEN = 256
GRID_W = 64
HEAD_DIM = 64
ROPE_BASE = 10000.0
EPS = 1e-6
NEG_INF = -1e30
ATTN_SCALE = HEAD_DIM ** -0.5
Q_BLOCK = 128
N_EVEN = (DEPTH + 1) // 2
N_ODD = DEPTH // 2

A_HEADS = 8
A_KV_HEADS = 2
A_GROUP = A_HEADS // A_KV_HEADS
WINDOW = 128
A_WIDTH = A_HEADS * HEAD_DIM
B_HEADS = 4
B_VDIM = 2 * HEAD_DIM
B_WIDTH = B_HEADS * B_VDIM
EVEN_SPLITS = (A_WIDTH, A_KV_HEADS * HEAD_DIM, A_KV_HEADS * HEAD_DIM, A_WIDTH,
               B_HEADS * 2 * HEAD_DIM, B_HEADS * 2 * HEAD_DIM, B_WIDTH, B_WIDTH)
EVEN_IN = sum(EVEN_SPLITS)

G_HEADS = 4
G_DK = (D_MODEL // 2) // G_HEADS
G_DV = D_MODEL // G_HEADS
G_RANK = 16
G_TAU = 16.0
G_CHUNK = 64
ODD_SPLITS = (G_HEADS * G_DK, G_HEADS * G_DK, G_HEADS * G_DV, G_HEADS * G_DV, G_RANK, G_RANK)
ODD_IN = sum(ODD_SPLITS)

kernel_name = 'hybrid_window_diff_gla_prefix_dit'


def rms_norm(x, g):
    xf = x.astype(jnp.float32)
    y = xf * lax.rsqrt(jnp.mean(xf * xf, axis=-1, keepdims=True) + EPS)
    return (y * g.astype(jnp.float32)).astype(x.dtype)


def split_cols(p, sizes):
    out, start = [], 0
    for s in sizes:
        out.append(p[..., start:start + s])
        start += s
    return out


def adaln_params(cond, w, b):
    m = jax.nn.silu(cond) @ w + b
    return jnp.split(m, 3, axis=-1)


def grid_positions(n_rows):
    rows = jnp.repeat(jnp.arange(n_rows, dtype=jnp.int32), GRID_W)
    cols = jnp.tile(jnp.arange(GRID_W, dtype=jnp.int32), n_rows)
    return rows, cols


def rope_1d(x, pos):
    m = x.shape[-1] // 2
    inv = ROPE_BASE ** (-jnp.arange(m, dtype=jnp.float32) / m)
    ang = pos.astype(jnp.float32)[:, None] * inv[None, :]
    cos = jnp.cos(ang)[:, None, :]
    sin = jnp.sin(ang)[:, None, :]
    x1 = x[..., :m].astype(jnp.float32)
    x2 = x[..., m:].astype(jnp.float32)
    return jnp.concatenate([x1 * cos - x2 * sin, x2 * cos + x1 * sin], axis=-1)


def rope_axial(x, rows, cols):
    h = x.shape[-1] // 2
    return jnp.concatenate([rope_1d(x[..., :h], rows), rope_1d(x[..., h:], cols)], axis=-1).astype(x.dtype)


def sink_attention(qg, k, v, sink, valid):
    s = jnp.einsum('bqhgd,bkhd->bhgqk', qg, k).astype(jnp.float32) * ATTN_SCALE
    if valid is not None:
        s = jnp.where(valid, s, NEG_INF)
    sink_col = jnp.broadcast_to(sink.astype(jnp.float32).reshape(1, A_KV_HEADS, A_GROUP, 1, 1),
                                s.shape[:-1] + (1,))
    p = jax.nn.softmax(jnp.concatenate([s, sink_col], axis=-1), axis=-1)[..., :-1]
    return jnp.einsum('bhgqk,bkhd->bqhgd', p, v.astype(jnp.float32))


def window_sink_attention(q, k, v, kc, vc, sink):
    Bn, T = q.shape[:2]
    nb = T // Q_BLOCK
    band = Q_BLOCK + 2 * WINDOW
    qg = q.reshape(Bn, T, A_KV_HEADS, A_GROUP, HEAD_DIM)
    pad = ((0, 0), (WINDOW, WINDOW), (0, 0), (0, 0))
    kp = jnp.pad(k, pad)
    vp = jnp.pad(v, pad)
    ctx_valid = jnp.ones((Q_BLOCK, kc.shape[1]), dtype=bool)

    def block(i):
        start = i * Q_BLOCK
        qb = lax.dynamic_slice_in_dim(qg, start, Q_BLOCK, axis=1)
        kb = lax.dynamic_slice_in_dim(kp, start, band, axis=1)
        vb = lax.dynamic_slice_in_dim(vp, start, band, axis=1)
        qpos = start + jnp.arange(Q_BLOCK)
        kpos = start - WINDOW + jnp.arange(band)
        valid = ((kpos[None, :] >= 0) & (kpos[None, :] < T)
                 & (jnp.abs(qpos[:, None] - kpos[None, :]) <= WINDOW))
        valid = jnp.concatenate([valid, ctx_valid], axis=1)
        return sink_attention(qb, jnp.concatenate([kb, kc], axis=1),
                              jnp.concatenate([vb, vc], axis=1), sink, valid)

    out = lax.map(block, jnp.arange(nb))
    return jnp.moveaxis(out, 0, 1).reshape(Bn, T, A_KV_HEADS, A_GROUP, HEAD_DIM)


def diff_attention(q1, q2, k1, k2, v, lam):
    s1 = jnp.einsum('bqhd,bkhd->bhqk', q1, k1).astype(jnp.float32) * ATTN_SCALE
    s2 = jnp.einsum('bqhd,bkhd->bhqk', q2, k2).astype(jnp.float32) * ATTN_SCALE
    w = jax.nn.softmax(s1, axis=-1) - lam * jax.nn.softmax(s2, axis=-1)
    return jnp.einsum('bhqk,bkhe->bqhe', w, v.astype(jnp.float32))


def blocked_diff_attention(q1, q2, k1, k2, v, lam):
    Bn, T = q1.shape[:2]
    nb = T // Q_BLOCK

    def block(i):
        start = i * Q_BLOCK
        return diff_attention(lax.dynamic_slice_in_dim(q1, start, Q_BLOCK, axis=1),
                              lax.dynamic_slice_in_dim(q2, start, Q_BLOCK, axis=1),
                              k1, k2, v, lam)

    out = lax.map(block, jnp.arange(nb))
    return jnp.moveaxis(out, 0, 1).reshape(Bn, T, B_HEADS, B_VDIM)


def even_mixer(hx, hc, rows, cols, w_in, a_qn, a_kn, a_sink, b_qn, b_kn,
               lq1, lk1, lq2, lk2, b_subln, lambda_init, need_ctx):
    dt = hx.dtype

    def project(h):
        Bn, T = h.shape[:2]
        qa, ka, va, ga, qb, kb, vb, gb = split_cols(h @ w_in, EVEN_SPLITS)
        qa = rms_norm(qa.reshape(Bn, T, A_HEADS, HEAD_DIM), a_qn)
        ka = rms_norm(ka.reshape(Bn, T, A_KV_HEADS, HEAD_DIM), a_kn)
        va = va.reshape(Bn, T, A_KV_HEADS, HEAD_DIM)
        qb = rms_norm(qb.reshape(Bn, T, 2 * B_HEADS, HEAD_DIM), b_qn)
        kb = rms_norm(kb.reshape(Bn, T, 2 * B_HEADS, HEAD_DIM), b_kn)
        vb = vb.reshape(Bn, T, B_HEADS, B_VDIM)
        return qa, ka, va, ga, qb, kb, vb, gb

    def split_pair(t):
        Bn, T = t.shape[:2]
        t = t.reshape(Bn, T, B_HEADS, 2, HEAD_DIM)
        return t[..., 0, :], t[..., 1, :]

    def merge(oa, ga, ob, gb):
        Bn, T = oa.shape[:2]
        ob = rms_norm(ob, b_subln) * (1.0 - lambda_init)
        oa = oa.reshape(Bn, T, A_WIDTH).astype(dt) * jax.nn.silu(ga)
        ob = ob.reshape(Bn, T, B_WIDTH).astype(dt) * jax.nn.silu(gb)
        return jnp.concatenate([oa, ob], axis=-1)

    qa_x, ka_x, va_x, ga_x, qb_x, kb_x, vb_x, gb_x = project(hx)
    qa_c, ka_c, va_c, ga_c, qb_c, kb_c, vb_c, gb_c = project(hc)
    qa_x = rope_axial(qa_x, rows, cols)
    ka_x = rope_axial(ka_x, rows, cols)
    qb_x = rope_axial(qb_x, rows, cols)
    kb_x = rope_axial(kb_x, rows, cols)

    lam = (jnp.exp(jnp.sum(lq1.astype(jnp.float32) * lk1.astype(jnp.float32)))
           - jnp.exp(jnp.sum(lq2.astype(jnp.float32) * lk2.astype(jnp.float32))) + lambda_init)

    q1x, q2x = split_pair(qb_x)
    k1x, k2x = split_pair(kb_x)
    k1c, k2c = split_pair(kb_c)

    oa_x = window_sink_attention(qa_x, ka_x, va_x, ka_c, va_c, a_sink)
    ob_x = blocked_diff_attention(q1x, q2x,
                                  jnp.concatenate([k1x, k1c], axis=1),
                                  jnp.concatenate([k2x, k2c], axis=1),
                                  jnp.concatenate([vb_x, vb_c], axis=1), lam)
    ox = merge(oa_x, ga_x, ob_x, gb_x)
    if not need_ctx:
        return ox, None
    Bn, L = hc.shape[:2]
    oa_c = sink_attention(qa_c.reshape(Bn, L, A_KV_HEADS, A_GROUP, HEAD_DIM), ka_c, va_c, a_sink, None)
    q1c, q2c = split_pair(qb_c)
    ob_c = diff_attention(q1c, q2c, k1c, k2c, vb_c, lam)
    oc = merge(oa_c, ga_c, ob_c, gb_c)
    return ox, oc


def gla_chunked(q, k, v, log_a, s0, with_output):
    Bn, H, T, dk = q.shape
    dv = v.shape[-1]
    n = T // G_CHUNK
    f32 = jnp.float32

    def ch(t):
        return t.astype(f32).reshape(Bn, H, n, G_CHUNK, t.shape[-1])

    q, k, v, la = ch(q), ch(k), ch(v), ch(log_a)
    b = jnp.cumsum(la, axis=3)
    b_last = b[:, :, :, -1:, :]
    d_state = jnp.einsum('bhncd,bhnce->bhnde', k * jnp.exp(b_last - b), v)
    decay = jnp.exp(b_last[:, :, :, 0, :])

    def step(S, inp):
        dec, ds = inp
        return dec[..., None] * S + ds, S

    s_fin, s_prev = lax.scan(step, s0.astype(f32),
                             (jnp.moveaxis(decay, 2, 0), jnp.moveaxis(d_state, 2, 0)))
    if not with_output:
        return None, s_fin
    s_prev = jnp.moveaxis(s_prev, 0, 2)
    qd = q * jnp.exp(b)
    kd = k * jnp.exp(-b)
    tri = jnp.tril(jnp.ones((G_CHUNK, G_CHUNK), dtype=bool))
    att = jnp.where(tri, jnp.einsum('bhncd,bhnsd->bhncs', qd, kd), 0.0)
    o = (jnp.einsum('bhncs,bhnse->bhnce', att, v)
         + jnp.einsum('bhncd,bhnde->bhnce', qd, s_prev))
    return o.reshape(Bn, H, T, dv), s_fin


def gla_mixer(hx, hc, w_in, wa_f, ba_f, wa_b, ba_b, out_norm, need_ctx):
    dt = hx.dtype

    def project(h):
        Bn, T = h.shape[:2]
        q, k, v, g, rf, rb = split_cols(h @ w_in, ODD_SPLITS)

        def heads(t, d):
            return t.reshape(Bn, T, G_HEADS, d).transpose(0, 2, 1, 3)

        la_f = jax.nn.log_sigmoid((rf @ wa_f + ba_f).astype(jnp.float32)) / G_TAU
        la_b = jax.nn.log_sigmoid((rb @ wa_b + ba_b).astype(jnp.float32)) / G_TAU
        return (heads(q, G_DK) * (G_DK ** -0.5), heads(k, G_DK), heads(v, G_DV), g,
                heads(la_f, G_DK), heads(la_b, G_DK))

    def flip(t):
        return jnp.flip(t, axis=2)

    def finish(o, g):
        Bn, H, T, dv = o.shape
        o = rms_norm(o.transpose(0, 2, 1, 3), out_norm).reshape(Bn, T, H * dv)
        return o.astype(dt) * jax.nn.silu(g)

    qx, kx, vx, gx, lfx, lbx = project(hx)
    qc, kc, vc, gc, lfc, lbc = project(hc)
    Bn = hx.shape[0]
    s0 = jnp.zeros((Bn, G_HEADS, G_DK, G_DV), jnp.float32)
    oc_f, sc_f = gla_chunked(qc, kc, vc, lfc, s0, need_ctx)
    oc_b, sc_b = gla_chunked(flip(qc), flip(kc), flip(vc), flip(lbc), s0, need_ctx)
    ox_f, _ = gla_chunked(qx, kx, vx, lfx, sc_f, True)
    ox_b, _ = gla_chunked(flip(qx), flip(kx), flip(vx), flip(lbx), sc_b, True)
    ox = finish(ox_f + flip(ox_b), gx)
    if not need_ctx:
        return ox, None
    oc = finish(oc_f + flip(oc_b), gc)
    return ox, oc


def setup_inputs(seed: int = 0) -> dict:
    key = jax.random.key(seed)
    ks = jax.random.split(key, 32)
    f32 = jnp.float32

    def nrm(k, shape, scale):
        return jax.random.normal(k, shape, f32) * scale

    def gain(k, shape):
        return 1.0 + 0.1 * jax.random.normal(k, shape, f32)

    D = D_MODEL
    return {
        'x': nrm(ks[0], (BATCH, SEQ, D), 1.0),
        'c': nrm(ks[1], (BATCH, D), 1.0),
        'ctx': nrm(ks[2], (BATCH, CTX_LEN, D), 1.0),
        'c_ctx': nrm(ks[3], (D,), 1.0),
        'adaln_w': nrm(ks[4], (DEPTH, D, 3 * D), 0.5 * D ** -0.5),
        'adaln_b': nrm(ks[5], (DEPTH, 3 * D), 0.02),
        'norm_g': gain(ks[6], (DEPTH, D)),
        'w_out': nrm(ks[7], (DEPTH, D, D), D ** -0.5),
        'ab_w_in': nrm(ks[8], (N_EVEN, D, EVEN_IN), D ** -0.5),
        'a_q_norm': gain(ks[9], (N_EVEN, HEAD_DIM)),
        'a_k_norm': gain(ks[10], (N_EVEN, HEAD_DIM)),
        'a_sink': nrm(ks[11], (N_EVEN, A_HEADS), 0.5),
        'b_q_norm': gain(ks[12], (N_EVEN, HEAD_DIM)),
        'b_k_norm': gain(ks[13], (N_EVEN, HEAD_DIM)),
        'b_lambda_q1': nrm(ks[14], (N_EVEN, HEAD_DIM), 0.1),
        'b_lambda_k1': nrm(ks[15], (N_EVEN, HEAD_DIM), 0.1),
        'b_lambda_q2': nrm(ks[16], (N_EVEN, HEAD_DIM), 0.1),
        'b_lambda_k2': nrm(ks[17], (N_EVEN, HEAD_DIM), 0.1),
        'b_subln': gain(ks[18], (N_EVEN, B_VDIM)),
        'gla_w_in': nrm(ks[19], (N_ODD, D, ODD_IN), D ** -0.5),
        'gla_wa_f': nrm(ks[20], (N_ODD, G_RANK, G_HEADS * G_DK), G_RANK ** -0.5),
        'gla_ba_f': nrm(ks[21], (N_ODD, G_HEADS * G_DK), 0.1),
        'gla_wa_b': nrm(ks[22], (N_ODD, G_RANK, G_HEADS * G_DK), G_RANK ** -0.5),
        'gla_ba_b': nrm(ks[23], (N_ODD, G_HEADS * G_DK), 0.1),
        'gla_out_norm': gain(ks[24], (N_ODD, G_DV)),
    }


def reference(x, c, ctx, c_ctx, adaln_w, adaln_b, norm_g, w_out, ab_w_in, a_q_norm, a_k_norm,
              a_sink, b_q_norm, b_k_norm, b_lambda_q1, b_lambda_k1, b_lambda_q2, b_lambda_k2,
              b_subln, gla_w_in, gla_wa_f, gla_ba_f, gla_wa_b, gla_ba_b, gla_out_norm):
    ROWS = x.shape[1] // GRID_W
    rows, cols = grid_positions(ROWS)
    for layer in range(DEPTH):
        need_ctx = layer < DEPTH - 1
        shx, scx, gtx = adaln_params(c, adaln_w[layer], adaln_b[layer])
        shc, scc, gtc = adaln_params(c_ctx, adaln_w[layer], adaln_b[layer])
        hx = rms_norm(x, norm_g[layer]) * (1.0 + scx[:, None, :]) + shx[:, None, :]
        hc = rms_norm(ctx, norm_g[layer]) * (1.0 + scc) + shc
        j = layer // 2
        if layer % 2 == 0:
            lambda_init = 0.8 - 0.6 * math.exp(-0.3 * layer)
            ox, oc = even_mixer(hx, hc, rows, cols, ab_w_in[j], a_q_norm[j], a_k_norm[j], a_sink[j],
                                b_q_norm[j], b_k_norm[j], b_lambda_q1[j], b_lambda_k1[j],
                                b_lambda_q2[j], b_lambda_k2[j], b_subln[j], lambda_init, need_ctx)
        else:
            ox, oc = gla_mixer(hx, hc, gla_w_in[j], gla_wa_f[j], gla_ba_f[j], gla_wa_b[j], gla_ba_b[j],
                               gla_out_norm[j], need_ctx)
        x = x + gtx[:, None, :] * (ox @ w_out[layer])
        if need_ctx:
            ctx = ctx + gtc * (oc @ w_out[layer])
    return x
```

```cpp
#include <hip/hip_runtime.h>
#include <hip/hip_cooperative_groups.h>
#include <cstdint>
#include <cstdio>

namespace {
constexpr int NB = 32, T = 2048, L = 256, D = 1024;
constexpr int ML = NB * T, MC = NB * L, M = ML + MC;
constexpr int N0 = 3328, N1 = 3328, N0R = 3328, N1R = 3104;
constexpr float EPS = 1e-6f;
constexpr float LOG2E = 1.4426950408889634f;
constexpr float QSCALE = 0.125f * LOG2E;
constexpr float LAMBDA_INIT = 0.2f;

typedef unsigned short bf16_t;
typedef short bf16x8 __attribute__((ext_vector_type(8)));
typedef float f32x4 __attribute__((ext_vector_type(4)));
typedef unsigned u32x4 __attribute__((ext_vector_type(4)));
typedef unsigned u32x2 __attribute__((ext_vector_type(2)));

struct Params {
    const float *x, *c, *ctx, *c_ctx, *adaln_w, *adaln_b, *norm_g, *w_out, *ab_w_in, *a_q_norm, *a_k_norm, *a_sink, *b_q_norm, *b_k_norm;
    const float *lq1, *lk1, *lq2, *lk2, *b_subln, *gla_w_in, *wa_f, *ba_f, *wa_b, *ba_b, *gla_out_norm;
    float* out;
    bf16_t *Wt0, *Wt1, *Wo0, *Wo1;
    float *mod, *bias0, *bias1, *rope, *parts;
    bf16_t *A, *O;
    bf16_t *QA, *KA, *VA, *GA, *QB, *KB, *VB, *GB;
    bf16_t *QG, *KG, *VG, *GG; float* RF;
    bf16_t *OD, *A2;
};

__device__ __forceinline__ unsigned f2bf(float f) { unsigned u = __float_as_uint(f); u += 0x7FFFu + ((u >> 16) & 1u); return u >> 16; }
__device__ __forceinline__ unsigned pack2(float lo, float hi) { return f2bf(lo) | (f2bf(hi) << 16); }
__device__ __forceinline__ float bf2f(unsigned h) { return __uint_as_float(h << 16); }
__device__ __forceinline__ float bflo(unsigned w) { return __uint_as_float(w << 16); }
__device__ __forceinline__ float bfhi(unsigned w) { return __uint_as_float(w & 0xFFFF0000u); }
__device__ __forceinline__ float siluf(float v) { return v / (1.0f + __expf(-v)); }

__device__ __forceinline__ int perm_local(int p, bool ropeType) {
    const int bj = p >> 7, wc = (p >> 5) & 3, low = p & 31;
    if (ropeType) return wc * 64 + bj * 32 + low;
    const int n = (low >> 4) & 1, fq = (low >> 2) & 3, e = low & 3;
    return wc * 64 + bj * 32 + fq * 8 + n * 4 + e;
}
__device__ __forceinline__ int src_col(int which, int np) {
    const int p = np & 255, tile = np >> 8;
    bool rope = false;
    if (which == 0) { const int g = tile * 4 + ((p >> 5) & 3); rope = (g < 10) || (g >= 20 && g < 36); }
    const int c = tile * 256 + perm_local(p, rope);
    const int nreal = which == 0 ? N0R : (which == 1 ? N1R : D);
    return c < nreal ? c : -1;
}

__device__ void phase_wt(const Params& P, int vb, int nvb) {
    const long total = (long)(N0 + N1 + D + D) * D;
    for (long idx = (long)vb * blockDim.x + threadIdx.x; idx < total; idx += (long)nvb * blockDim.x) {
        long i = idx; int which; const float* W; bf16_t* dst; int ldw;
        if (i < (long)N0 * D) { which = 0; W = P.ab_w_in; dst = P.Wt0; ldw = N0R; }
        else if ((i -= (long)N0 * D) < (long)N1 * D) { which = 1; W = P.gla_w_in; dst = P.Wt1; ldw = N1R; }
        else if ((i -= (long)N1 * D) < (long)D * D) { which = 2; W = P.w_out; dst = P.Wo0; ldw = D; }
        else { i -= (long)D * D; which = 3; W = P.w_out + (size_t)D * D; dst = P.Wo1; ldw = D; }
        const int np = (int)(i >> 10), k = (int)(i & 1023);
        const int sc = src_col(which, np);
        const float v = sc >= 0 ? W[(size_t)k * ldw + sc] : 0.f;
        dst[i] = (bf16_t)f2bf(v);
    }
}

__device__ void phase_adaln(const Params& P, int vb, int nvb) {
    for (int idx = vb * blockDim.x + threadIdx.x; idx < 2 * 3072; idx += nvb * blockDim.x) {
        const int l = idx / 3072, j = idx % 3072;
        float acc[33];
#pragma unroll
        for (int r = 0; r < 33; ++r) acc[r] = 0.f;
        const float* w = P.adaln_w + (size_t)l * D * 3072 + j;
        for (int k = 0; k < D; ++k) {
            const float wv = w[(size_t)k * 3072];
#pragma unroll
            for (int r = 0; r < 33; ++r) { const float cv = r < 32 ? P.c[r * D + k] : P.c_ctx[k]; acc[r] += siluf(cv) * wv; }
        }
        const float bv = P.adaln_b[l * 3072 + j];
#pragma unroll
        for (int r = 0; r < 33; ++r) P.mod[((size_t)l * 33 + r) * 3072 + j] = acc[r] + bv;
    }
}

__device__ void phase_rope(const Params& P, int vb, int nvb) {
    for (int idx = vb * blockDim.x + threadIdx.x; idx < 64 * 16; idx += nvb * blockDim.x) {
        const int pos = idx >> 4, i = idx & 15;
        const double inv = pow(10000.0, -(double)i / 16.0);
        const double ang = (double)((float)pos * (float)inv);
        P.rope[idx * 2 + 0] = (float)cos(ang);
        P.rope[idx * 2 + 1] = (float)sin(ang);
    }
}

__device__ void phase_bias(const Params& P, int vb, int nvb) {
    for (int idx = vb * blockDim.x + threadIdx.x; idx < N0 + N1; idx += nvb * blockDim.x) {
        const int l = idx >= N0, np = l ? idx - N0 : idx;
        const int sc = src_col(l, np);
        float acc[33];
#pragma unroll
        for (int r = 0; r < 33; ++r) acc[r] = 0.f;
        if (sc >= 0) {
            const float* W = l ? P.gla_w_in : P.ab_w_in; const int ldw = l ? N1R : N0R;
            const float* sh = P.mod + (size_t)l * 33 * 3072;
            for (int k = 0; k < D; ++k) {
                const float wv = W[(size_t)k * ldw + sc];
#pragma unroll
                for (int r = 0; r < 33; ++r) acc[r] += sh[r * 3072 + k] * wv;
            }
        }
        float* dst = l ? P.bias1 : P.bias0;
#pragma unroll
        for (int r = 0; r < 33; ++r) dst[r * 3328 + np] = acc[r];
    }
}

__device__ void phase_a0(const Params& P, int vb, int nvb) {
    const int lane = threadIdx.x & 63, wpb = blockDim.x >> 6, w = threadIdx.x >> 6;
    for (int row = vb * wpb + w; row < M; row += nvb * wpb) {
        const float* xin = row < ML ? P.x + (size_t)row * D : P.ctx + (size_t)(row - ML) * D;
        const int r = row < ML ? row >> 11 : 32;
        const float* sc = P.mod + (size_t)r * 3072 + 1024;
        float ss = 0.f;
#pragma unroll
        for (int i = 0; i < 2; ++i) {
            const int c0 = i * 512 + lane * 8;
            const f32x4 a = *(const f32x4*)(xin + c0), b = *(const f32x4*)(xin + c0 + 4);
            const f32x4 g0 = *(const f32x4*)(P.norm_g + c0), g1 = *(const f32x4*)(P.norm_g + c0 + 4);
            const f32x4 s0 = *(const f32x4*)(sc + c0), s1 = *(const f32x4*)(sc + c0 + 4);
            ss += a[0] * a[0] + a[1] * a[1] + a[2] * a[2] + a[3] * a[3] + b[0] * b[0] + b[1] * b[1] + b[2] * b[2] + b[3] * b[3];
            const f32x4 ya = a * g0 * (1.0f + s0), yb = b * g1 * (1.0f + s1);
            u32x4 o; o.x = pack2(ya[0], ya[1]); o.y = pack2(ya[2], ya[3]); o.z = pack2(yb[0], yb[1]); o.w = pack2(yb[2], yb[3]);
            *(u32x4*)(P.A + (size_t)row * D + c0) = o;
        }
#pragma unroll
        for (int o = 32; o >= 1; o >>= 1) ss += __shfl_xor(ss, o);
        if (lane == 0) P.parts[row] = ss;
    }
}

struct EpiIn0 {
    const float* parts; int nparts; const float* bias;
    const float *aqn, *akn, *bqn, *bkn, *rope;
    bf16_t *QA, *KA, *VA, *GA, *QB, *KB, *VB, *GB;
    __device__ __forceinline__ void operator()(const f32x4 (&acc)[2][2][4][2], int pm, int pn, int wr, int wc, int fr, int fq) const {
        const int g = 4 * pn + wc;
        bf16_t* dst; int ld, col, type; const float* gain = nullptr;
        if (g < 8) { dst = QA; ld = 512; col = g * 64; type = 2; gain = aqn; }
        else if (g < 10) { dst = KA; ld = 128; col = (g - 8) * 64; type = 3; gain = akn; }
        else if (g < 12) { dst = VA; ld = 128; col = (g - 10) * 64; type = 0; }
        else if (g < 20) { dst = GA; ld = 512; col = (g - 12) * 64; type = 1; }
        else if (g < 28) { dst = QB; ld = 512; col = (g - 20) * 64; type = 2; gain = bqn; }
        else if (g < 36) { dst = KB; ld = 512; col = (g - 28) * 64; type = 3; gain = bkn; }
        else if (g < 44) { dst = VB; ld = 512; col = (g - 36) * 64; type = 0; }
        else { dst = GB; ld = 512; col = (g - 44) * 64; type = 1; }
#pragma unroll
        for (int ai = 0; ai < 2; ++ai)
#pragma unroll
            for (int m = 0; m < 4; ++m) {
                const int row = pm * 256 + ai * 128 + wr * 64 + m * 16 + fr;
                float ss = 0.f;
                for (int i = 0; i < nparts; ++i) ss += parts[(size_t)i * M + row];
                const float rstd = rsqrtf(ss * (1.0f / 1024.0f) + EPS);
                const int r = row < ML ? row >> 11 : 32;
                const float* bptr = bias + (size_t)r * 3328 + pn * 256 + wc * 32 + fq * 4;
                f32x4 v[2][2];
#pragma unroll
                for (int bj = 0; bj < 2; ++bj)
#pragma unroll
                    for (int n = 0; n < 2; ++n) v[bj][n] = acc[ai][bj][m][n] * rstd + *(const f32x4*)(bptr + bj * 128 + n * 16);
                if (type >= 2) {
                    float s2 = 0.f;
#pragma unroll
                    for (int bj = 0; bj < 2; ++bj)
#pragma unroll
                        for (int n = 0; n < 2; ++n) s2 += v[bj][n][0] * v[bj][n][0] + v[bj][n][1] * v[bj][n][1] + v[bj][n][2] * v[bj][n][2] + v[bj][n][3] * v[bj][n][3];
                    s2 += __shfl_xor(s2, 16); s2 += __shfl_xor(s2, 32);
                    const float rn = rsqrtf(s2 * (1.0f / 64.0f) + EPS);
#pragma unroll
                    for (int bj = 0; bj < 2; ++bj)
#pragma unroll
                        for (int n = 0; n < 2; ++n) v[bj][n] = v[bj][n] * rn * *(const f32x4*)(gain + bj * 32 + n * 16 + fq * 4);
                    if (row < ML) {
                        const int t = row & 2047;
#pragma unroll
                        for (int bj = 0; bj < 2; ++bj) {
                            const int pos = bj == 0 ? (t >> 6) : (t & 63);
                            const float* cs = rope + (pos * 16 + fq * 4) * 2;
                            const f32x4 c01 = *(const f32x4*)cs, c23 = *(const f32x4*)(cs + 4);
                            const float cc[4] = {c01[0], c01[2], c23[0], c23[2]}, sn[4] = {c01[1], c01[3], c23[1], c23[3]};
#pragma unroll
                            for (int e = 0; e < 4; ++e) { const float x1 = v[bj][0][e], x2 = v[bj][1][e]; v[bj][0][e] = x1 * cc[e] - x2 * sn[e]; v[bj][1][e] = x2 * cc[e] + x1 * sn[e]; }
                        }
                    }
                    if (type == 2) {
#pragma unroll
                        for (int bj = 0; bj < 2; ++bj)
#pragma unroll
                            for (int n = 0; n < 2; ++n) v[bj][n] = v[bj][n] * QSCALE;
                    }
                } else if (type == 1) {
#pragma unroll
                    for (int bj = 0; bj < 2; ++bj)
#pragma unroll
                        for (int n = 0; n < 2; ++n)
#pragma unroll
                            for (int e = 0; e < 4; ++e) v[bj][n][e] = siluf(v[bj][n][e]);
                }
#pragma unroll
                for (int bj = 0; bj < 2; ++bj) {
                    u32x4 o; o.x = pack2(v[bj][0][0], v[bj][0][1]); o.y = pack2(v[bj][0][2], v[bj][0][3]); o.z = pack2(v[bj][1][0], v[bj][1][1]); o.w = pack2(v[bj][1][2], v[bj][1][3]);
                    *(u32x4*)(dst + (size_t)row * ld + col + bj * 32 + fq * 8) = o;
                }
            }
    }
};

struct EpiIn1 {
    const float* parts; int nparts; const float* bias;
    bf16_t *QG, *KG, *VG, *GG; float* RF;
    __device__ __forceinline__ void operator()(const f32x4 (&acc)[2][2][4][2], int pm, int pn, int wr, int wc, int fr, int fq) const {
        const int g = 4 * pn + wc;
        if (g > 48) return;
        bf16_t* dst = nullptr; int ld = 0, col = 0, type;
        if (g < 8) { dst = QG; ld = 512; col = g * 64; type = 2; }
        else if (g < 16) { dst = KG; ld = 512; col = (g - 8) * 64; type = 0; }
        else if (g < 32) { dst = VG; ld = 1024; col = (g - 16) * 64; type = 0; }
        else if (g < 48) { dst = GG; ld = 1024; col = (g - 32) * 64; type = 1; }
        else type = 3;
#pragma unroll
        for (int ai = 0; ai < 2; ++ai)
#pragma unroll
            for (int m = 0; m < 4; ++m) {
                const int row = pm * 256 + ai * 128 + wr * 64 + m * 16 + fr;
                float ss = 0.f;
                for (int i = 0; i < nparts; ++i) ss += parts[(size_t)i * M + row];
                const float rstd = rsqrtf(ss * (1.0f / 1024.0f) + EPS);
                const int r = row < ML ? row >> 11 : 32;
                const float* bptr = bias + (size_t)r * 3328 + pn * 256 + wc * 32 + fq * 4;
                f32x4 v[2][2];
#pragma unroll
                for (int bj = 0; bj < 2; ++bj)
#pragma unroll
                    for (int n = 0; n < 2; ++n) v[bj][n] = acc[ai][bj][m][n] * rstd + *(const f32x4*)(bptr + bj * 128 + n * 16);
                if (type == 3) {
                    *(f32x4*)(RF + (size_t)row * 32 + fq * 8) = v[0][0];
                    *(f32x4*)(RF + (size_t)row * 32 + fq * 8 + 4) = v[0][1];
                    continue;
                }
                if (type == 2) {
#pragma unroll
                    for (int bj = 0; bj < 2; ++bj)
#pragma unroll
                        for (int n = 0; n < 2; ++n) v[bj][n] = v[bj][n] * 0.08838834764831845f;
                } else if (type == 1) {
#pragma unroll
                    for (int bj = 0; bj < 2; ++bj)
#pragma unroll
                        for (int n = 0; n < 2; ++n)
#pragma unroll
                            for (int e = 0; e < 4; ++e) v[bj][n][e] = siluf(v[bj][n][e]);
                }
#pragma unroll
                for (int bj = 0; bj < 2; ++bj) {
                    u32x4 o; o.x = pack2(v[bj][0][0], v[bj][0][1]); o.y = pack2(v[bj][0][2], v[bj][0][3]); o.z = pack2(v[bj][1][0], v[bj][1][1]); o.w = pack2(v[bj][1][2], v[bj][1][3]);
                    *(u32x4*)(dst + (size_t)row * ld + col + bj * 32 + fq * 8) = o;
                }
            }
    }
};

struct EpiOut0 {
    const float *x, *ctx, *mod, *g1; float* out; bf16_t* A1; float* parts;
    __device__ __forceinline__ void operator()(const f32x4 (&acc)[2][2][4][2], int pm, int pn, int wr, int wc, int fr, int fq) const {
#pragma unroll
        for (int ai = 0; ai < 2; ++ai)
#pragma unroll
            for (int m = 0; m < 4; ++m) {
                const int row = pm * 256 + ai * 128 + wr * 64 + m * 16 + fr;
                const int r = row < ML ? row >> 11 : 32;
                const float* xin = row < ML ? x + (size_t)row * D : ctx + (size_t)(row - ML) * D;
                const float* gt = mod + (size_t)r * 3072 + 2048;
                const float* sc = mod + (size_t)(33 + r) * 3072 + 1024;
                float ss = 0.f;
#pragma unroll
                for (int bj = 0; bj < 2; ++bj) {
                    const int c = pn * 256 + wc * 64 + bj * 32 + fq * 8;
                    f32x4 y[2];
#pragma unroll
                    for (int n = 0; n < 2; ++n) {
                        const f32x4 x1 = *(const f32x4*)(xin + c + n * 4) + *(const f32x4*)(gt + c + n * 4) * acc[ai][bj][m][n];
                        ss += x1[0] * x1[0] + x1[1] * x1[1] + x1[2] * x1[2] + x1[3] * x1[3];
                        if (row < ML) *(f32x4*)(out + (size_t)row * D + c + n * 4) = x1;
                        y[n] = x1 * *(const f32x4*)(g1 + c + n * 4) * (1.0f + *(const f32x4*)(sc + c + n * 4));
                    }
                    u32x4 o; o.x = pack2(y[0][0], y[0][1]); o.y = pack2(y[0][2], y[0][3]); o.z = pack2(y[1][0], y[1][1]); o.w = pack2(y[1][2], y[1][3]);
                    *(u32x4*)(A1 + (size_t)row * D + c) = o;
                }
                ss += __shfl_xor(ss, 16); ss += __shfl_xor(ss, 32);
                if (fq == 0) parts[(size_t)(4 * pn + wc) * M + row] = ss;
            }
    }
};

struct EpiOut1 {
    const float* mod; float* out;
    __device__ __forceinline__ void operator()(const f32x4 (&acc)[2][2][4][2], int pm, int pn, int wr, int wc, int fr, int fq) const {
#pragma unroll
        for (int ai = 0; ai < 2; ++ai)
#pragma unroll
            for (int m = 0; m < 4; ++m) {
                const int row = pm * 256 + ai * 128 + wr * 64 + m * 16 + fr;
                const int r = row >> 11;
                const float* gt = mod + (size_t)(33 + r) * 3072 + 2048;
#pragma unroll
                for (int bj = 0; bj < 2; ++bj)
#pragma unroll
                    for (int n = 0; n < 2; ++n) {
                        const int c = pn * 256 + wc * 64 + bj * 32 + fq * 8 + n * 4;
                        float* o = out + (size_t)row * D + c;
                        *(f32x4*)o = *(const f32x4*)o + *(const f32x4*)(gt + c) * acc[ai][bj][m][n];
                    }
            }
    }
};

template <class Epi>
__device__ void gemm_simple(const bf16_t* __restrict__ A, const bf16_t* __restrict__ Bt, int nM, int nN, const Epi& E, unsigned char* lds, int vb, int nvb) {
    const int tid = threadIdx.x, wid = tid >> 6, lane = tid & 63, wr = wid >> 2, wc = wid & 3, fr = lane & 15, fq = lane >> 4;
    unsigned char* ldsA = lds; unsigned char* ldsB = lds + 256 * 80;
    for (int tile = vb; tile < nM * nN; tile += nvb) {
        const int pm = tile / nN, pn = tile % nN;
        f32x4 acc[2][2][4][2];
#pragma unroll
        for (int a = 0; a < 2; ++a)
#pragma unroll
            for (int b = 0; b < 2; ++b)
#pragma unroll
                for (int m = 0; m < 4; ++m)
#pragma unroll
                    for (int n = 0; n < 2; ++n) acc[a][b][m][n] = (f32x4){0.f, 0.f, 0.f, 0.f};
        for (int k0 = 0; k0 < D; k0 += 32) {
            __syncthreads();
#pragma unroll
            for (int i = 0; i < 2; ++i) {
                const int cidx = tid + 512 * i, r = cidx >> 2, kc = cidx & 3;
                *(u32x4*)(ldsA + r * 80 + kc * 16) = *(const u32x4*)(A + (size_t)(pm * 256 + r) * D + k0 + kc * 8);
                *(u32x4*)(ldsB + r * 80 + kc * 16) = *(const u32x4*)(Bt + (size_t)(pn * 256 + r) * D + k0 + kc * 8);
            }
            __syncthreads();
            bf16x8 af[2][4], bfr[2][2];
#pragma unroll
            for (int ai = 0; ai < 2; ++ai)
#pragma unroll
                for (int m = 0; m < 4; ++m) af[ai][m] = *(const bf16x8*)(ldsA + (ai * 128 + wr * 64 + m * 16 + fr) * 80 + fq * 16);
#pragma unroll
            for (int bj = 0; bj < 2; ++bj)
#pragma unroll
                for (int n = 0; n < 2; ++n) bfr[bj][n] = *(const bf16x8*)(ldsB + (bj * 128 + wc * 32 + n * 16 + fr) * 80 + fq * 16);
#pragma unroll
            for (int ai = 0; ai < 2; ++ai)
#pragma unroll
                for (int bj = 0; bj < 2; ++bj)
#pragma unroll
                    for (int m = 0; m < 4; ++m)
#pragma unroll
                        for (int n = 0; n < 2; ++n) acc[ai][bj][m][n] = __builtin_amdgcn_mfma_f32_16x16x32_bf16(bfr[bj][n], af[ai][m], acc[ai][bj][m][n], 0, 0, 0);
        }
        E(acc, pm, pn, wr, wc, fr, fq);
    }
}

__device__ __forceinline__ float maxabs64(const float* g) { float m = 0.f; for (int i = 0; i < 64; ++i) m = fmaxf(m, fabsf(g[i])); return m; }

__device__ void phase_attnA(const Params& P, int vb, int nvb) {
    const float MA = 8.0f * maxabs64(P.a_q_norm) * maxabs64(P.a_k_norm) * LOG2E;
    for (long idx = (long)vb * blockDim.x + threadIdx.x; idx < (long)M * 8; idx += (long)nvb * blockDim.x) {
        const int h = (int)(idx / M), m = (int)(idx % M), kv = h >> 2;
        float q[64], o[64];
        {
            const u32x4* qp = (const u32x4*)(P.QA + (size_t)m * 512 + h * 64);
#pragma unroll
            for (int i = 0; i < 8; ++i) { const u32x4 w = qp[i]; q[8 * i] = bflo(w.x); q[8 * i + 1] = bfhi(w.x); q[8 * i + 2] = bflo(w.y); q[8 * i + 3] = bfhi(w.y); q[8 * i + 4] = bflo(w.z); q[8 * i + 5] = bfhi(w.z); q[8 * i + 6] = bflo(w.w); q[8 * i + 7] = bfhi(w.w); }
        }
#pragma unroll
        for (int i = 0; i < 64; ++i) o[i] = 0.f;
        float l = 0.f;
        int b, nlat = 0, j0 = 0;
        if (m < ML) { b = m >> 11; const int t = m & 2047; j0 = t - 128 < 0 ? 0 : t - 128; const int j1 = t + 128 > 2047 ? 2047 : t + 128; nlat = j1 - j0 + 1; }
        else b = (m - ML) >> 8;
        const int ntot = nlat + 256;
        for (int jj = 0; jj < ntot; ++jj) {
            const int kr = jj < nlat ? b * 2048 + j0 + jj : ML + b * 256 + (jj - nlat);
            const u32x4* kp = (const u32x4*)(P.KA + (size_t)kr * 128 + kv * 64);
            float s = 0.f;
#pragma unroll
            for (int i = 0; i < 8; ++i) { const u32x4 w = kp[i]; s += q[8 * i] * bflo(w.x) + q[8 * i + 1] * bfhi(w.x) + q[8 * i + 2] * bflo(w.y) + q[8 * i + 3] * bfhi(w.y) + q[8 * i + 4] * bflo(w.z) + q[8 * i + 5] * bfhi(w.z) + q[8 * i + 6] * bflo(w.w) + q[8 * i + 7] * bfhi(w.w); }
            const float p = exp2f(s - MA);
            l += p;
            const u32x4* vp = (const u32x4*)(P.VA + (size_t)kr * 128 + kv * 64);
#pragma unroll
            for (int i = 0; i < 8; ++i) { const u32x4 w = vp[i]; o[8 * i] += p * bflo(w.x); o[8 * i + 1] += p * bfhi(w.x); o[8 * i + 2] += p * bflo(w.y); o[8 * i + 3] += p * bfhi(w.y); o[8 * i + 4] += p * bflo(w.z); o[8 * i + 5] += p * bfhi(w.z); o[8 * i + 6] += p * bflo(w.w); o[8 * i + 7] += p * bfhi(w.w); }
        }
        l += exp2f(P.a_sink[h] * LOG2E - MA);
        const float inv = 1.0f / l;
        const u32x4* gp = (const u32x4*)(P.GA + (size_t)m * 512 + h * 64);
        u32x4* op = (u32x4*)(P.O + (size_t)m * 1024 + h * 64);
#pragma unroll
        for (int i = 0; i < 8; ++i) {
            const u32x4 w = gp[i]; u32x4 r;
            r.x = pack2(o[8 * i] * inv * bflo(w.x), o[8 * i + 1] * inv * bfhi(w.x)); r.y = pack2(o[8 * i + 2] * inv * bflo(w.y), o[8 * i + 3] * inv * bfhi(w.y));
            r.z = pack2(o[8 * i + 4] * inv * bflo(w.z), o[8 * i + 5] * inv * bfhi(w.z)); r.w = pack2(o[8 * i + 6] * inv * bflo(w.w), o[8 * i + 7] * inv * bfhi(w.w));
            op[i] = r;
        }
    }
}

__device__ void phase_attnB(const Params& P, int vb, int nvb) {
    const float MB = 8.0f * maxabs64(P.b_q_norm) * maxabs64(P.b_k_norm) * LOG2E;
    float d1 = 0.f, d2 = 0.f;
    for (int i = 0; i < 64; ++i) { d1 += P.lq1[i] * P.lk1[i]; d2 += P.lq2[i] * P.lk2[i]; }
    const float lam = expf(d1) - expf(d2) + LAMBDA_INIT;
    for (long idx = (long)vb * blockDim.x + threadIdx.x; idx < (long)M * 8; idx += (long)nvb * blockDim.x) {
        const int half = (int)(idx & 1); const long hm = idx >> 1; const int h = (int)(hm / M), m = (int)(hm % M);
        int b, nlat;
        if (m < ML) { b = m >> 11; nlat = 2048; } else { b = (m - ML) >> 8; nlat = 0; }
        const int ntot = nlat + 256;
        float rres[64];
        for (int s = 0; s < 2; ++s) {
            const int g = 2 * h + s;
            float q[64], o[64];
            const u32x4* qp = (const u32x4*)(P.QB + (size_t)m * 512 + g * 64);
#pragma unroll
            for (int i = 0; i < 8; ++i) { const u32x4 w = qp[i]; q[8 * i] = bflo(w.x); q[8 * i + 1] = bfhi(w.x); q[8 * i + 2] = bflo(w.y); q[8 * i + 3] = bfhi(w.y); q[8 * i + 4] = bflo(w.z); q[8 * i + 5] = bfhi(w.z); q[8 * i + 6] = bflo(w.w); q[8 * i + 7] = bfhi(w.w); }
#pragma unroll
            for (int i = 0; i < 64; ++i) o[i] = 0.f;
            float l = 0.f;
            for (int jj = 0; jj < ntot; ++jj) {
                const int kr = jj < nlat ? b * 2048 + jj : ML + b * 256 + (jj - nlat);
                const u32x4* kp = (const u32x4*)(P.KB + (size_t)kr * 512 + g * 64);
                float sc = 0.f;
#pragma unroll
                for (int i = 0; i < 8; ++i) { const u32x4 w = kp[i]; sc += q[8 * i] * bflo(w.x) + q[8 * i + 1] * bfhi(w.x) + q[8 * i + 2] * bflo(w.y) + q[8 * i + 3] * bfhi(w.y) + q[8 * i + 4] * bflo(w.z) + q[8 * i + 5] * bfhi(w.z) + q[8 * i + 6] * bflo(w.w) + q[8 * i + 7] * bfhi(w.w); }
                const float p = exp2f(sc - MB);
                l += p;
                const u32x4* vp = (const u32x4*)(P.VB + (size_t)kr * 512 + h * 128 + half * 64);
#pragma unroll
                for (int i = 0; i < 8; ++i) { const u32x4 w = vp[i]; o[8 * i] += p * bflo(w.x); o[8 * i + 1] += p * bfhi(w.x); o[8 * i + 2] += p * bflo(w.y); o[8 * i + 3] += p * bfhi(w.y); o[8 * i + 4] += p * bflo(w.z); o[8 * i + 5] += p * bfhi(w.z); o[8 * i + 6] += p * bflo(w.w); o[8 * i + 7] += p * bfhi(w.w); }
            }
            const float inv = 1.0f / l;
            if (s == 0) {
#pragma unroll
                for (int i = 0; i < 64; ++i) rres[i] = o[i] * inv;
            } else {
#pragma unroll
                for (int i = 0; i < 64; ++i) rres[i] -= lam * o[i] * inv;
            }
        }
        float ss = 0.f;
#pragma unroll
        for (int i = 0; i < 64; ++i) ss += rres[i] * rres[i];
        ss += __shfl_xor(ss, 1);
        const float rn = rsqrtf(ss * (1.0f / 128.0f) + EPS) * (1.0f - LAMBDA_INIT);
        const u32x4* gp = (const u32x4*)(P.GB + (size_t)m * 512 + h * 128 + half * 64);
        const float* sl = P.b_subln + half * 64;
        u32x4* op = (u32x4*)(P.O + (size_t)m * 1024 + 512 + h * 128 + half * 64);
#pragma unroll
        for (int i = 0; i < 8; ++i) {
            const u32x4 w = gp[i]; u32x4 r;
            r.x = pack2(rres[8 * i] * rn * sl[8 * i] * bflo(w.x), rres[8 * i + 1] * rn * sl[8 * i + 1] * bfhi(w.x));
            r.y = pack2(rres[8 * i + 2] * rn * sl[8 * i + 2] * bflo(w.y), rres[8 * i + 3] * rn * sl[8 * i + 3] * bfhi(w.y));
            r.z = pack2(rres[8 * i + 4] * rn * sl[8 * i + 4] * bflo(w.z), rres[8 * i + 5] * rn * sl[8 * i + 5] * bfhi(w.z));
            r.w = pack2(rres[8 * i + 6] * rn * sl[8 * i + 6] * bflo(w.w), rres[8 * i + 7] * rn * sl[8 * i + 7] * bfhi(w.w));
            op[i] = r;
        }
    }
}

__device__ void phase_gla(const Params& P, float* lds, int vb, int nvb) {
    float* sa = lds; float* sk = lds + 128; float* sq = lds + 256;
    const int e = threadIdx.x;
    for (int unit = vb; unit < NB * 4 * 2; unit += nvb) {
        const int dr = unit & 1, h = (unit >> 1) & 3, b = unit >> 3;
        const float* wa = dr ? P.wa_b : P.wa_f; const float* ba = dr ? P.ba_b : P.ba_f;
        float S[128];
#pragma unroll
        for (int d = 0; d < 128; ++d) S[d] = 0.f;
        float war[16], bav = 0.f;
        if (e < 128) {
#pragma unroll
            for (int j = 0; j < 16; ++j) war[j] = wa[j * 512 + h * 128 + e];
            bav = ba[h * 128 + e];
        }
        for (int step = 0; step < L + T; ++step) {
            int m;
            if (step < L) m = ML + b * L + (dr ? L - 1 - step : step);
            else { const int t = step - L; m = b * T + (dr ? T - 1 - t : t); }
            __syncthreads();
            if (e < 128) {
                const float* rf = P.RF + (size_t)m * 32 + dr * 16;
                float z = bav;
#pragma unroll
                for (int j = 0; j < 16; ++j) z += rf[j] * war[j];
                const float ls = fminf(z, 0.f) - log1pf(expf(-fabsf(z)));
                sa[e] = expf(ls * (1.0f / 16.0f));
                sk[e] = bf2f(P.KG[(size_t)m * 512 + h * 128 + e]);
                sq[e] = bf2f(P.QG[(size_t)m * 512 + h * 128 + e]);
            }
            __syncthreads();
            const float v = bf2f(P.VG[(size_t)m * 1024 + h * 256 + e]);
            float o = 0.f;
#pragma unroll
            for (int d = 0; d < 128; ++d) { S[d] = sa[d] * S[d] + sk[d] * v; o += sq[d] * S[d]; }
            if (m < ML) P.OD[((size_t)dr * ML + m) * 1024 + h * 256 + e] = (bf16_t)f2bf(o);
        }
    }
}

__device__ void phase_finish(const Params& P, int vb, int nvb) {
    const int lane = threadIdx.x & 63, wpb = blockDim.x >> 6, w = threadIdx.x >> 6;
    for (int row = vb * wpb + w; row < ML; row += nvb * wpb) {
        const int c0 = lane * 16;
        float v[16];
        const u32x4* pf = (const u32x4*)(P.OD + (size_t)row * 1024 + c0);
        const u32x4* pb = (const u32x4*)(P.OD + ((size_t)ML + row) * 1024 + c0);
        float ss = 0.f;
#pragma unroll
        for (int i = 0; i < 2; ++i) {
            const u32x4 a = pf[i], bq = pb[i];
            v[8 * i] = bflo(a.x) + bflo(bq.x); v[8 * i + 1] = bfhi(a.x) + bfhi(bq.x); v[8 * i + 2] = bflo(a.y) + bflo(bq.y); v[8 * i + 3] = bfhi(a.y) + bfhi(bq.y);
            v[8 * i + 4] = bflo(a.z) + bflo(bq.z); v[8 * i + 5] = bfhi(a.z) + bfhi(bq.z); v[8 * i + 6] = bflo(a.w) + bflo(bq.w); v[8 * i + 7] = bfhi(a.w) + bfhi(bq.w);
        }
#pragma unroll
        for (int i = 0; i < 16; ++i) ss += v[i] * v[i];
        ss += __shfl_xor(ss, 1); ss += __shfl_xor(ss, 2); ss += __shfl_xor(ss, 4); ss += __shfl_xor(ss, 8);
        const float rn = rsqrtf(ss * (1.0f / 256.0f) + EPS);
        const float* gn = P.gla_out_norm + (c0 & 255);
        const u32x4* gp = (const u32x4*)(P.GG + (size_t)row * 1024 + c0);
        u32x4* op = (u32x4*)(P.A2 + (size_t)row * 1024 + c0);
#pragma unroll
        for (int i = 0; i < 2; ++i) {
            const u32x4 g = gp[i]; u32x4 r;
            r.x = pack2(v[8 * i] * rn * gn[8 * i] * bflo(g.x), v[8 * i + 1] * rn * gn[8 * i + 1] * bfhi(g.x));
            r.y = pack2(v[8 * i + 2] * rn * gn[8 * i + 2] * bflo(g.y), v[8 * i + 3] * rn * gn[8 * i + 3] * bfhi(g.y));
            r.z = pack2(v[8 * i + 4] * rn * gn[8 * i + 4] * bflo(g.z), v[8 * i + 5] * rn * gn[8 * i + 5] * bfhi(g.z));
            r.w = pack2(v[8 * i + 6] * rn * gn[8 * i + 6] * bflo(g.w), v[8 * i + 7] * rn * gn[8 * i + 7] * bfhi(g.w));
            op[i] = r;
        }
    }
}

__global__ void __launch_bounds__(256) k_pro0(Params P) { phase_wt(P, blockIdx.x, gridDim.x); phase_adaln(P, blockIdx.x, gridDim.x); phase_rope(P, blockIdx.x, gridDim.x); }
__global__ void __launch_bounds__(256) k_pro1(Params P) { phase_bias(P, blockIdx.x, gridDim.x); phase_a0(P, blockIdx.x, gridDim.x); }
__global__ void __launch_bounds__(512) k_gemm_in0(Params P) {
    __shared__ __attribute__((aligned(16))) unsigned char lds[2 * 256 * 80];
    EpiIn0 E{P.parts, 1, P.bias0, P.a_q_norm, P.a_k_norm, P.b_q_norm, P.b_k_norm, P.rope, P.QA, P.KA, P.VA, P.GA, P.QB, P.KB, P.VB, P.GB};
    gemm_simple(P.A, P.Wt0, M / 256, N0 / 256, E, lds, blockIdx.x, gridDim.x);
}
__global__ void __launch_bounds__(256) k_attnA(Params P) { phase_attnA(P, blockIdx.x, gridDim.x); }
__global__ void __launch_bounds__(256) k_attnB(Params P) { phase_attnB(P, blockIdx.x, gridDim.x); }
__global__ void __launch_bounds__(512) k_gemm_out0(Params P) {
    __shared__ __attribute__((aligned(16))) unsigned char lds[2 * 256 * 80];
    EpiOut0 E{P.x, P.ctx, P.mod, P.norm_g + D, P.out, P.A, P.parts};
    gemm_simple(P.O, P.Wo0, M / 256, D / 256, E, lds, blockIdx.x, gridDim.x);
}
__global__ void __launch_bounds__(512) k_gemm_in1(Params P) {
    __shared__ __attribute__((aligned(16))) unsigned char lds[2 * 256 * 80];
    EpiIn1 E{P.parts, 16, P.bias1, P.QG, P.KG, P.VG, P.GG, P.RF};
    gemm_simple(P.A, P.Wt1, M / 256, N1 / 256, E, lds, blockIdx.x, gridDim.x);
}
__global__ void __launch_bounds__(256) k_gla(Params P) { __shared__ float lds[384]; phase_gla(P, lds, blockIdx.x, gridDim.x); }
__global__ void __launch_bounds__(256) k_finish(Params P) { phase_finish(P, blockIdx.x, gridDim.x); }
__global__ void __launch_bounds__(512) k_gemm_out1(Params P) {
    __shared__ __attribute__((aligned(16))) unsigned char lds[2 * 256 * 80];
    EpiOut1 E{P.mod, P.out};
    gemm_simple(P.A2, P.Wo1, ML / 256, D / 256, E, lds, blockIdx.x, gridDim.x);
}
}

extern "C" void kernel_launch(void* const* d_in, const int* in_sizes, int n_in, void* d_out, int out_size, void* d_ws, size_t ws_size, hipStream_t stream) {
    Params P{};
    const float* const* in = (const float* const*)d_in;
    P.x = in[0]; P.c = in[1]; P.ctx = in[2]; P.c_ctx = in[3]; P.adaln_w = in[4]; P.adaln_b = in[5]; P.norm_g = in[6]; P.w_out = in[7]; P.ab_w_in = in[8];
    P.a_q_norm = in[9]; P.a_k_norm = in[10]; P.a_sink = in[11]; P.b_q_norm = in[12]; P.b_k_norm = in[13]; P.lq1 = in[14]; P.lk1 = in[15]; P.lq2 = in[16]; P.lk2 = in[17];
    P.b_subln = in[18]; P.gla_w_in = in[19]; P.wa_f = in[20]; P.ba_f = in[21]; P.wa_b = in[22]; P.ba_b = in[23]; P.gla_out_norm = in[24];
    P.out = (float*)d_out;
    unsigned char* w = (unsigned char*)d_ws; size_t off = 0;
    auto take = [&](size_t bytes) { unsigned char* p = w + off; off += (bytes + 255) & ~(size_t)255; return p; };
    P.Wt0 = (bf16_t*)take((size_t)N0 * D * 2); P.Wt1 = (bf16_t*)take((size_t)N1 * D * 2); P.Wo0 = (bf16_t*)take((size_t)D * D * 2); P.Wo1 = (bf16_t*)take((size_t)D * D * 2);
    P.mod = (float*)take((size_t)2 * 33 * 3072 * 4); P.bias0 = (float*)take((size_t)33 * 3328 * 4); P.bias1 = (float*)take((size_t)33 * 3328 * 4);
    P.rope = (float*)take(64 * 16 * 2 * 4); P.parts = (float*)take((size_t)16 * M * 4);
    P.A = (bf16_t*)take((size_t)M * D * 2); P.O = (bf16_t*)take((size_t)M * D * 2);
    unsigned char* qkv = take((size_t)M * 3328 * 2);
    {
        unsigned char* q = qkv;
        P.QA = (bf16_t*)q; q += (size_t)M * 512 * 2; P.KA = (bf16_t*)q; q += (size_t)M * 128 * 2; P.VA = (bf16_t*)q; q += (size_t)M * 128 * 2; P.GA = (bf16_t*)q; q += (size_t)M * 512 * 2;
        P.QB = (bf16_t*)q; q += (size_t)M * 512 * 2; P.KB = (bf16_t*)q; q += (size_t)M * 512 * 2; P.VB = (bf16_t*)q; q += (size_t)M * 512 * 2; P.GB = (bf16_t*)q;
        q = qkv;
        P.QG = (bf16_t*)q; q += (size_t)M * 512 * 2; P.KG = (bf16_t*)q; q += (size_t)M * 512 * 2; P.VG = (bf16_t*)q; q += (size_t)M * 1024 * 2; P.GG = (bf16_t*)q; q += (size_t)M * 1024 * 2; P.RF = (float*)q;
        P.A2 = (bf16_t*)qkv;
        P.OD = P.A;
    }
    if (off > ws_size) { fprintf(stderr, "workspace too small: need %zu have %zu\n", off, ws_size); return; }
    k_pro0<<<1024, 256, 0, stream>>>(P);
    k_pro1<<<2048, 256, 0, stream>>>(P);
    k_gemm_in0<<<1024, 512, 0, stream>>>(P);
    k_attnA<<<2304, 256, 0, stream>>>(P);
    k_attnB<<<2304, 256, 0, stream>>>(P);
    k_gemm_out0<<<1152, 512, 0, stream>>>(P);
    k_gemm_in1<<<1024, 512, 0, stream>>>(P);
    k_gla<<<256, 256, 0, stream>>>(P);
    k_finish<<<2048, 256, 0, stream>>>(P);
    k_gemm_out1<<<1024, 512, 0, stream>>>(P);
}
```

```cpp
#include <hip/hip_runtime.h>
#include <hip/hip_cooperative_groups.h>
#include <cstdint>
#include <cstdio>

namespace {
constexpr int NB = 32, T = 2048, L = 256, D = 1024;
constexpr int ML = NB * T, MC = NB * L, M = ML + MC;
constexpr int N0 = 3328, N1 = 3328, N0R = 3328, N1R = 3104;
constexpr float EPS = 1e-6f;
constexpr float LOG2E = 1.4426950408889634f;
constexpr float QSCALE = 0.125f * LOG2E;
constexpr float LAMBDA_INIT = 0.2f;

typedef unsigned short bf16_t;
typedef short bf16x8 __attribute__((ext_vector_type(8)));
typedef float f32x4 __attribute__((ext_vector_type(4)));
typedef unsigned u32x4 __attribute__((ext_vector_type(4)));
typedef unsigned u32x2 __attribute__((ext_vector_type(2)));

struct Params {
    const float *x, *c, *ctx, *c_ctx, *adaln_w, *adaln_b, *norm_g, *w_out, *ab_w_in, *a_q_norm, *a_k_norm, *a_sink, *b_q_norm, *b_k_norm;
    const float *lq1, *lk1, *lq2, *lk2, *b_subln, *gla_w_in, *wa_f, *ba_f, *wa_b, *ba_b, *gla_out_norm;
    float* out;
    bf16_t *Wt0, *Wt1, *Wo0, *Wo1;
    float *mod, *bias0, *bias1, *rope, *parts;
    bf16_t *A, *O;
    bf16_t *QA, *KA, *VA, *GA, *QB, *KB, *VB, *GB;
    bf16_t *QG, *KG, *VG, *GG; float* RF;
    bf16_t *OD, *A2;
};

__device__ __forceinline__ unsigned f2bf(float f) { unsigned u = __float_as_uint(f); u += 0x7FFFu + ((u >> 16) & 1u); return u >> 16; }
__device__ __forceinline__ unsigned pack2(float lo, float hi) { return f2bf(lo) | (f2bf(hi) << 16); }
__device__ __forceinline__ float bf2f(unsigned h) { return __uint_as_float(h << 16); }
__device__ __forceinline__ float bflo(unsigned w) { return __uint_as_float(w << 16); }
__device__ __forceinline__ float bfhi(unsigned w) { return __uint_as_float(w & 0xFFFF0000u); }
__device__ __forceinline__ float siluf(float v) { return v / (1.0f + __expf(-v)); }

__device__ __forceinline__ int perm_local(int p, bool ropeType) {
    const int bj = p >> 7, wc = (p >> 5) & 3, low = p & 31;
    if (ropeType) return wc * 64 + bj * 32 + low;
    const int n = (low >> 4) & 1, fq = (low >> 2) & 3, e = low & 3;
    return wc * 64 + bj * 32 + fq * 8 + n * 4 + e;
}
__device__ __forceinline__ int src_col(int which, int np) {
    const int p = np & 255, tile = np >> 8;
    bool rope = false;
    if (which == 0) { const int g = tile * 4 + ((p >> 5) & 3); rope = (g < 10) || (g >= 20 && g < 36); }
    const int c = tile * 256 + perm_local(p, rope);
    const int nreal = which == 0 ? N0R : (which == 1 ? N1R : D);
    return c < nreal ? c : -1;
}

__device__ void phase_wt(const Params& P, int vb, int nvb) {
    const long total = (long)(N0 + N1 + D + D) * D;
    for (long idx = (long)vb * blockDim.x + threadIdx.x; idx < total; idx += (long)nvb * blockDim.x) {
        long i = idx; int which; const float* W; bf16_t* dst; int ldw;
        if (i < (long)N0 * D) { which = 0; W = P.ab_w_in; dst = P.Wt0; ldw = N0R; }
        else if ((i -= (long)N0 * D) < (long)N1 * D) { which = 1; W = P.gla_w_in; dst = P.Wt1; ldw = N1R; }
        else if ((i -= (long)N1 * D) < (long)D * D) { which = 2; W = P.w_out; dst = P.Wo0; ldw = D; }
        else { i -= (long)D * D; which = 3; W = P.w_out + (size_t)D * D; dst = P.Wo1; ldw = D; }
        const int np = (int)(i >> 10), k = (int)(i & 1023);
        const int sc = src_col(which, np);
        const float v = sc >= 0 ? W[(size_t)k * ldw + sc] : 0.f;
        dst[i] = (bf16_t)f2bf(v);
    }
}

__device__ void phase_adaln(const Params& P, int vb, int nvb) {
    for (int idx = vb * blockDim.x + threadIdx.x; idx < 2 * 3072; idx += nvb * blockDim.x) {
        const int l = idx / 3072, j = idx % 3072;
        float acc[33];
#pragma unroll
        for (int r = 0; r < 33; ++r) acc[r] = 0.f;
        const float* w = P.adaln_w + (size_t)l * D * 3072 + j;
        for (int k = 0; k < D; ++k) {
            const float wv = w[(size_t)k * 3072];
#pragma unroll
            for (int r = 0; r < 33; ++r) { const float cv = r < 32 ? P.c[r * D + k] : P.c_ctx[k]; acc[r] += siluf(cv) * wv; }
        }
        const float bv = P.adaln_b[l * 3072 + j];
#pragma unroll
        for (int r = 0; r < 33; ++r) P.mod[((size_t)l * 33 + r) * 3072 + j] = acc[r] + bv;
    }
}

__device__ void phase_rope(const Params& P, int vb, int nvb) {
    for (int idx = vb * blockDim.x + threadIdx.x; idx < 64 * 16; idx += nvb * blockDim.x) {
        const int pos = idx >> 4, i = idx & 15;
        const double inv = pow(10000.0, -(double)i / 16.0);
        const double ang = (double)((float)pos * (float)inv);
        P.rope[idx * 2 + 0] = (float)cos(ang);
        P.rope[idx * 2 + 1] = (float)sin(ang);
    }
}

__device__ void phase_bias(const Params& P, int vb, int nvb) {
    for (int idx = vb * blockDim.x + threadIdx.x; idx < N0 + N1; idx += nvb * blockDim.x) {
        const int l = idx >= N0, np = l ? idx - N0 : idx;
        const int sc = src_col(l, np);
        float acc[33];
#pragma unroll
        for (int r = 0; r < 33; ++r) acc[r] = 0.f;
        if (sc >= 0) {
            const float* W = l ? P.gla_w_in : P.ab_w_in; const int ldw = l ? N1R : N0R;
            const float* sh = P.mod + (size_t)l * 33 * 3072;
            for (int k = 0; k < D; ++k) {
                const float wv = W[(size_t)k * ldw + sc];
#pragma unroll
                for (int r = 0; r < 33; ++r) acc[r] += sh[r * 3072 + k] * wv;
            }
        }
        float* dst = l ? P.bias1 : P.bias0;
#pragma unroll
        for (int r = 0; r < 33; ++r) dst[r * 3328 + np] = acc[r];
    }
}

__device__ void phase_a0(const Params& P, int vb, int nvb) {
    const int lane = threadIdx.x & 63, wpb = blockDim.x >> 6, w = threadIdx.x >> 6;
    for (int row = vb * wpb + w; row < M; row += nvb * wpb) {
        const float* xin = row < ML ? P.x + (size_t)row * D : P.ctx + (size_t)(row - ML) * D;
        const int r = row < ML ? row >> 11 : 32;
        const float* sc = P.mod + (size_t)r * 3072 + 1024;
        float ss = 0.f;
#pragma unroll
        for (int i = 0; i < 2; ++i) {
            const int c0 = i * 512 + lane * 8;
            const f32x4 a = *(const f32x4*)(xin + c0), b = *(const f32x4*)(xin + c0 + 4);
            const f32x4 g0 = *(const f32x4*)(P.norm_g + c0), g1 = *(const f32x4*)(P.norm_g + c0 + 4);
            const f32x4 s0 = *(const f32x4*)(sc + c0), s1 = *(const f32x4*)(sc + c0 + 4);
            ss += a[0] * a[0] + a[1] * a[1] + a[2] * a[2] + a[3] * a[3] + b[0] * b[0] + b[1] * b[1] + b[2] * b[2] + b[3] * b[3];
            const f32x4 ya = a * g0 * (1.0f + s0), yb = b * g1 * (1.0f + s1);
            u32x4 o; o.x = pack2(ya[0], ya[1]); o.y = pack2(ya[2], ya[3]); o.z = pack2(yb[0], yb[1]); o.w = pack2(yb[2], yb[3]);
            *(u32x4*)(P.A + (size_t)row * D + c0) = o;
        }
#pragma unroll
        for (int o = 32; o >= 1; o >>= 1) ss += __shfl_xor(ss, o);
        if (lane == 0) P.parts[row] = ss;
    }
}

struct EpiIn0 {
    const float* parts; int nparts; const float* bias;
    const float *aqn, *akn, *bqn, *bkn, *rope;
    bf16_t *QA, *KA, *VA, *GA, *QB, *KB, *VB, *GB;
    __device__ __forceinline__ void operator()(const f32x4 (&acc)[2][2][4][2], int pm, int pn, int wr, int wc, int fr, int fq) const {
        const int g = 4 * pn + wc;
        bf16_t* dst; int ld, col, type; const float* gain = nullptr;
        if (g < 8) { dst = QA; ld = 512; col = g * 64; type = 2; gain = aqn; }
        else if (g < 10) { dst = KA; ld = 128; col = (g - 8) * 64; type = 3; gain = akn; }
        else if (g < 12) { dst = VA; ld = 128; col = (g - 10) * 64; type = 0; }
        else if (g < 20) { dst = GA; ld = 512; col = (g - 12) * 64; type = 1; }
        else if (g < 28) { dst = QB; ld = 512; col = (g - 20) * 64; type = 2; gain = bqn; }
        else if (g < 36) { dst = KB; ld = 512; col = (g - 28) * 64; type = 3; gain = bkn; }
        else if (g < 44) { dst = VB; ld = 512; col = (g - 36) * 64; type = 0; }
        else { dst = GB; ld = 512; col = (g - 44) * 64; type = 1; }
#pragma unroll
        for (int ai = 0; ai < 2; ++ai)
#pragma unroll
            for (int m = 0; m < 4; ++m) {
                const int row = pm * 256 + ai * 128 + wr * 64 + m * 16 + fr;
                float ss = 0.f;
                for (int i = 0; i < nparts; ++i) ss += parts[(size_t)i * M + row];
                const float rstd = rsqrtf(ss * (1.0f / 1024.0f) + EPS);
                const int r = row < ML ? row >> 11 : 32;
                const float* bptr = bias + (size_t)r * 3328 + pn * 256 + wc * 32 + fq * 4;
                f32x4 v[2][2];
#pragma unroll
                for (int bj = 0; bj < 2; ++bj)
#pragma unroll
                    for (int n = 0; n < 2; ++n) v[bj][n] = acc[ai][bj][m][n] * rstd + *(const f32x4*)(bptr + bj * 128 + n * 16);
                if (type >= 2) {
                    float s2 = 0.f;
#pragma unroll
                    for (int bj = 0; bj < 2; ++bj)
#pragma unroll
                        for (int n = 0; n < 2; ++n) s2 += v[bj][n][0] * v[bj][n][0] + v[bj][n][1] * v[bj][n][1] + v[bj][n][2] * v[bj][n][2] + v[bj][n][3] * v[bj][n][3];
                    s2 += __shfl_xor(s2, 16); s2 += __shfl_xor(s2, 32);
                    const float rn = rsqrtf(s2 * (1.0f / 64.0f) + EPS);
#pragma unroll
                    for (int bj = 0; bj < 2; ++bj)
#pragma unroll
                        for (int n = 0; n < 2; ++n) v[bj][n] = v[bj][n] * rn * *(const f32x4*)(gain + bj * 32 + n * 16 + fq * 4);
                    if (row < ML) {
                        const int t = row & 2047;
#pragma unroll
                        for (int bj = 0; bj < 2; ++bj) {
                            const int pos = bj == 0 ? (t >> 6) : (t & 63);
                            const float* cs = rope + (pos * 16 + fq * 4) * 2;
                            const f32x4 c01 = *(const f32x4*)cs, c23 = *(const f32x4*)(cs + 4);
                            const float cc[4] = {c01[0], c01[2], c23[0], c23[2]}, sn[4] = {c01[1], c01[3], c23[1], c23[3]};
#pragma unroll
                            for (int e = 0; e < 4; ++e) { const float x1 = v[bj][0][e], x2 = v[bj][1][e]; v[bj][0][e] = x1 * cc[e] - x2 * sn[e]; v[bj][1][e] = x2 * cc[e] + x1 * sn[e]; }
                        }
                    }
                    if (type == 2) {
#pragma unroll
                        for (int bj = 0; bj < 2; ++bj)
#pragma unroll
                            for (int n = 0; n < 2; ++n) v[bj][n] = v[bj][n] * QSCALE;
                    }
                } else if (type == 1) {
#pragma unroll
                    for (int bj = 0; bj < 2; ++bj)
#pragma unroll
                        for (int n = 0; n < 2; ++n)
#pragma unroll
                            for (int e = 0; e < 4; ++e) v[bj][n][e] = siluf(v[bj][n][e]);
                }
#pragma unroll
                for (int bj = 0; bj < 2; ++bj) {
                    u32x4 o; o.x = pack2(v[bj][0][0], v[bj][0][1]); o.y = pack2(v[bj][0][2], v[bj][0][3]); o.z = pack2(v[bj][1][0], v[bj][1][1]); o.w = pack2(v[bj][1][2], v[bj][1][3]);
                    *(u32x4*)(dst + (size_t)row * ld + col + bj * 32 + fq * 8) = o;
                }
            }
    }
};

struct EpiIn1 {
    const float* parts; int nparts; const float* bias;
    bf16_t *QG, *KG, *VG, *GG; float* RF;
    __device__ __forceinline__ void operator()(const f32x4 (&acc)[2][2][4][2], int pm, int pn, int wr, int wc, int fr, int fq) const {
        const int g = 4 * pn + wc;
        if (g > 48) return;
        bf16_t* dst = nullptr; int ld = 0, col = 0, type;
        if (g < 8) { dst = QG; ld = 512; col = g * 64; type = 2; }
        else if (g < 16) { dst = KG; ld = 512; col = (g - 8) * 64; type = 0; }
        else if (g < 32) { dst = VG; ld = 1024; col = (g - 16) * 64; type = 0; }
        else if (g < 48) { dst = GG; ld = 1024; col = (g - 32) * 64; type = 1; }
        else type = 3;
#pragma unroll
        for (int ai = 0; ai < 2; ++ai)
#pragma unroll
            for (int m = 0; m < 4; ++m) {
                const int row = pm * 256 + ai * 128 + wr * 64 + m * 16 + fr;
                float ss = 0.f;
                for (int i = 0; i < nparts; ++i) ss += parts[(size_t)i * M + row];
                const float rstd = rsqrtf(ss * (1.0f / 1024.0f) + EPS);
                const int r = row < ML ? row >> 11 : 32;
                const float* bptr = bias + (size_t)r * 3328 + pn * 256 + wc * 32 + fq * 4;
                f32x4 v[2][2];
#pragma unroll
                for (int bj = 0; bj < 2; ++bj)
#pragma unroll
                    for (int n = 0; n < 2; ++n) v[bj][n] = acc[ai][bj][m][n] * rstd + *(const f32x4*)(bptr + bj * 128 + n * 16);
                if (type == 3) {
                    *(f32x4*)(RF + (size_t)row * 32 + fq * 8) = v[0][0];
                    *(f32x4*)(RF + (size_t)row * 32 + fq * 8 + 4) = v[0][1];
                    continue;
                }
                if (type == 2) {
#pragma unroll
                    for (int bj = 0; bj < 2; ++bj)
#pragma unroll
                        for (int n = 0; n < 2; ++n) v[bj][n] = v[bj][n] * 0.08838834764831845f;
                } else if (type == 1) {
#pragma unroll
                    for (int bj = 0; bj < 2; ++bj)
#pragma unroll
                        for (int n = 0; n < 2; ++n)
#pragma unroll
                            for (int e = 0; e < 4; ++e) v[bj][n][e] = siluf(v[bj][n][e]);
                }
#pragma unroll
                for (int bj = 0; bj < 2; ++bj) {
                    u32x4 o; o.x = pack2(v[bj][0][0], v[bj][0][1]); o.y = pack2(v[bj][0][2], v[bj][0][3]); o.z = pack2(v[bj][1][0], v[bj][1][1]); o.w = pack2(v[bj][1][2], v[bj][1][3]);
                    *(u32x4*)(dst + (size_t)row * ld + col + bj * 32 + fq * 8) = o;
                }
            }
    }
};

struct EpiOut0 {
    const float *x, *ctx, *mod, *g1; float* out; bf16_t* A1; float* parts;
    __device__ __forceinline__ void operator()(const f32x4 (&acc)[2][2][4][2], int pm, int pn, int wr, int wc, int fr, int fq) const {
#pragma unroll
        for (int ai = 0; ai < 2; ++ai)
#pragma unroll
            for (int m = 0; m < 4; ++m) {
                const int row = pm * 256 + ai * 128 + wr * 64 + m * 16 + fr;
                const int r = row < ML ? row >> 11 : 32;
                const float* xin = row < ML ? x + (size_t)row * D : ctx + (size_t)(row - ML) * D;
                const float* gt = mod + (size_t)r * 3072 + 2048;
                const float* sc = mod + (size_t)(33 + r) * 3072 + 1024;
                float ss = 0.f;
#pragma unroll
                for (int bj = 0; bj < 2; ++bj) {
                    const int c = pn * 256 + wc * 64 + bj * 32 + fq * 8;
                    f32x4 y[2];
#pragma unroll
                    for (int n = 0; n < 2; ++n) {
                        const f32x4 x1 = *(const f32x4*)(xin + c + n * 4) + *(const f32x4*)(gt + c + n * 4) * acc[ai][bj][m][n];
                        ss += x1[0] * x1[0] + x1[1] * x1[1] + x1[2] * x1[2] + x1[3] * x1[3];
                        if (row < ML) *(f32x4*)(out + (size_t)row * D + c + n * 4) = x1;
                        y[n] = x1 * *(const f32x4*)(g1 + c + n * 4) * (1.0f + *(const f32x4*)(sc + c + n * 4));
                    }
                    u32x4 o; o.x = pack2(y[0][0], y[0][1]); o.y = pack2(y[0][2], y[0][3]); o.z = pack2(y[1][0], y[1][1]); o.w = pack2(y[1][2], y[1][3]);
                    *(u32x4*)(A1 + (size_t)row * D + c) = o;
                }
                ss += __shfl_xor(ss, 16); ss += __shfl_xor(ss, 32);
                if (fq == 0) parts[(size_t)(4 * pn + wc) * M + row] = ss;
            }
    }
};

struct EpiOut1 {
    const float* mod; float* out;
    __device__ __forceinline__ void operator()(const f32x4 (&acc)[2][2][4][2], int pm, int pn, int wr, int wc, int fr, int fq) const {
#pragma unroll
        for (int ai = 0; ai < 2; ++ai)
#pragma unroll
            for (int m = 0; m < 4; ++m) {
                const int row = pm * 256 + ai * 128 + wr * 64 + m * 16 + fr;
                const int r = row >> 11;
                const float* gt = mod + (size_t)(33 + r) * 3072 + 2048;
#pragma unroll
                for (int bj = 0; bj < 2; ++bj)
#pragma unroll
                    for (int n = 0; n < 2; ++n) {
                        const int c = pn * 256 + wc * 64 + bj * 32 + fq * 8 + n * 4;
                        float* o = out + (size_t)row * D + c;
                        *(f32x4*)o = *(const f32x4*)o + *(const f32x4*)(gt + c) * acc[ai][bj][m][n];
                    }
            }
    }
};

template <class Epi>
__device__ void gemm_simple(const bf16_t* __restrict__ A, const bf16_t* __restrict__ Bt, int nM, int nN, const Epi& E, unsigned char* lds, int vb, int nvb) {
    const int tid = threadIdx.x, wid = tid >> 6, lane = tid & 63, wr = wid >> 2, wc = wid & 3, fr = lane & 15, fq = lane >> 4;
    unsigned char* ldsA = lds; unsigned char* ldsB = lds + 256 * 80;
    for (int tile = vb; tile < nM * nN; tile += nvb) {
        const int pm = tile / nN, pn = tile % nN;
        f32x4 acc[2][2][4][2];
#pragma unroll
        for (int a = 0; a < 2; ++a)
#pragma unroll
            for (int b = 0; b < 2; ++b)
#pragma unroll
                for (int m = 0; m < 4; ++m)
#pragma unroll
                    for (int n = 0; n < 2; ++n) acc[a][b][m][n] = (f32x4){0.f, 0.f, 0.f, 0.f};
        for (int k0 = 0; k0 < D; k0 += 32) {
            __syncthreads();
#pragma unroll
            for (int i = 0; i < 2; ++i) {
                const int cidx = tid + 512 * i, r = cidx >> 2, kc = cidx & 3;
                *(u32x4*)(ldsA + r * 80 + kc * 16) = *(const u32x4*)(A + (size_t)(pm * 256 + r) * D + k0 + kc * 8);
                *(u32x4*)(ldsB + r * 80 + kc * 16) = *(const u32x4*)(Bt + (size_t)(pn * 256 + r) * D + k0 + kc * 8);
            }
            __syncthreads();
            bf16x8 af[2][4], bfr[2][2];
#pragma unroll
            for (int ai = 0; ai < 2; ++ai)
#pragma unroll
                for (int m = 0; m < 4; ++m) af[ai][m] = *(const bf16x8*)(ldsA + (ai * 128 + wr * 64 + m * 16 + fr) * 80 + fq * 16);
#pragma unroll
            for (int bj = 0; bj < 2; ++bj)
#pragma unroll
                for (int n = 0; n < 2; ++n) bfr[bj][n] = *(const bf16x8*)(ldsB + (bj * 128 + wc * 32 + n * 16 + fr) * 80 + fq * 16);
#pragma unroll
            for (int ai = 0; ai < 2; ++ai)
#pragma unroll
                for (int bj = 0; bj < 2; ++bj)
#pragma unroll
                    for (int m = 0; m < 4; ++m)
#pragma unroll
                        for (int n = 0; n < 2; ++n) acc[ai][bj][m][n] = __builtin_amdgcn_mfma_f32_16x16x32_bf16(bfr[bj][n], af[ai][m], acc[ai][bj][m][n], 0, 0, 0);
        }
        E(acc, pm, pn, wr, wc, fr, fq);
    }
}

__device__ __forceinline__ float maxabs64(const float* g) { float m = 0.f; for (int i = 0; i < 64; ++i) m = fmaxf(m, fabsf(g[i])); return m; }

__device__ void phase_attnA(const Params& P, int vb, int nvb) {
    const float MA = 8.0f * maxabs64(P.a_q_norm) * maxabs64(P.a_k_norm) * LOG2E;
    for (long idx = (long)vb * blockDim.x + threadIdx.x; idx < (long)M * 8; idx += (long)nvb * blockDim.x) {
        const int h = (int)(idx / M), m = (int)(idx % M), kv = h >> 2;
        float q[64], o[64];
        {
            const u32x4* qp = (const u32x4*)(P.QA + (size_t)m * 512 + h * 64);
#pragma unroll
            for (int i = 0; i < 8; ++i) { const u32x4 w = qp[i]; q[8 * i] = bflo(w.x); q[8 * i + 1] = bfhi(w.x); q[8 * i + 2] = bflo(w.y); q[8 * i + 3] = bfhi(w.y); q[8 * i + 4] = bflo(w.z); q[8 * i + 5] = bfhi(w.z); q[8 * i + 6] = bflo(w.w); q[8 * i + 7] = bfhi(w.w); }
        }
#pragma unroll
        for (int i = 0; i < 64; ++i) o[i] = 0.f;
        float l = 0.f;
        int b, nlat = 0, j0 = 0;
        if (m < ML) { b = m >> 11; const int t = m & 2047; j0 = t - 128 < 0 ? 0 : t - 128; const int j1 = t + 128 > 2047 ? 2047 : t + 128; nlat = j1 - j0 + 1; }
        else b = (m - ML) >> 8;
        const int ntot = nlat + 256;
        for (int jj = 0; jj < ntot; ++jj) {
            const int kr = jj < nlat ? b * 2048 + j0 + jj : ML + b * 256 + (jj - nlat);
            const u32x4* kp = (const u32x4*)(P.KA + (size_t)kr * 128 + kv * 64);
            float s = 0.f;
#pragma unroll
            for (int i = 0; i < 8; ++i) { const u32x4 w = kp[i]; s += q[8 * i] * bflo(w.x) + q[8 * i + 1] * bfhi(w.x) + q[8 * i + 2] * bflo(w.y) + q[8 * i + 3] * bfhi(w.y) + q[8 * i + 4] * bflo(w.z) + q[8 * i + 5] * bfhi(w.z) + q[8 * i + 6] * bflo(w.w) + q[8 * i + 7] * bfhi(w.w); }
            const float p = exp2f(s - MA);
            l += p;
            const u32x4* vp = (const u32x4*)(P.VA + (size_t)kr * 128 + kv * 64);
#pragma unroll
            for (int i = 0; i < 8; ++i) { const u32x4 w = vp[i]; o[8 * i] += p * bflo(w.x); o[8 * i + 1] += p * bfhi(w.x); o[8 * i + 2] += p * bflo(w.y); o[8 * i + 3] += p * bfhi(w.y); o[8 * i + 4] += p * bflo(w.z); o[8 * i + 5] += p * bfhi(w.z); o[8 * i + 6] += p * bflo(w.w); o[8 * i + 7] += p * bfhi(w.w); }
        }
        l += exp2f(P.a_sink[h] * LOG2E - MA);
        const float inv = 1.0f / l;
        const u32x4* gp = (const u32x4*)(P.GA + (size_t)m * 512 + h * 64);
        u32x4* op = (u32x4*)(P.O + (size_t)m * 1024 + h * 64);
#pragma unroll
        for (int i = 0; i < 8; ++i) {
            const u32x4 w = gp[i]; u32x4 r;
            r.x = pack2(o[8 * i] * inv * bflo(w.x), o[8 * i + 1] * inv * bfhi(w.x)); r.y = pack2(o[8 * i + 2] * inv * bflo(w.y), o[8 * i + 3] * inv * bfhi(w.y));
            r.z = pack2(o[8 * i + 4] * inv * bflo(w.z), o[8 * i + 5] * inv * bfhi(w.z)); r.w = pack2(o[8 * i + 6] * inv * bflo(w.w), o[8 * i + 7] * inv * bfhi(w.w));
            op[i] = r;
        }
    }
}

__device__ void phase_attnB(const Params& P, int vb, int nvb) {
    const float MB = 8.0f * maxabs64(P.b_q_norm) * maxabs64(P.b_k_norm) * LOG2E;
    float d1 = 0.f, d2 = 0.f;
    for (int i = 0; i < 64; ++i) { d1 += P.lq1[i] * P.lk1[i]; d2 += P.lq2[i] * P.lk2[i]; }
    const float lam = expf(d1) - expf(d2) + LAMBDA_INIT;
    for (long idx = (long)vb * blockDim.x + threadIdx.x; idx < (long)M * 16; idx += (long)nvb * blockDim.x) {
        const int qt = (int)(idx & 3); const long hm = idx >> 2; const int h = (int)(hm / M), m = (int)(hm % M);
        int b, nlat;
        if (m < ML) { b = m >> 11; nlat = 2048; } else { b = (m - ML) >> 8; nlat = 0; }
        const int ntot = nlat + 256;
        float rres[32];
        for (int s = 0; s < 2; ++s) {
            const int g = 2 * h + s;
            float q[64], o[32];
            const u32x4* qp = (const u32x4*)(P.QB + (size_t)m * 512 + g * 64);
#pragma unroll
            for (int i = 0; i < 8; ++i) { const u32x4 w = qp[i]; q[8 * i] = bflo(w.x); q[8 * i + 1] = bfhi(w.x); q[8 * i + 2] = bflo(w.y); q[8 * i + 3] = bfhi(w.y); q[8 * i + 4] = bflo(w.z); q[8 * i + 5] = bfhi(w.z); q[8 * i + 6] = bflo(w.w); q[8 * i + 7] = bfhi(w.w); }
#pragma unroll
            for (int i = 0; i < 32; ++i) o[i] = 0.f;
            float l = 0.f;
            for (int jj = 0; jj < ntot; ++jj) {
                const int kr = jj < nlat ? b * 2048 + jj : ML + b * 256 + (jj - nlat);
                const u32x4* kp = (const u32x4*)(P.KB + (size_t)kr * 512 + g * 64);
                float sc = 0.f;
#pragma unroll
                for (int i = 0; i < 8; ++i) { const u32x4 w = kp[i]; sc += q[8 * i] * bflo(w.x) + q[8 * i + 1] * bfhi(w.x) + q[8 * i + 2] * bflo(w.y) + q[8 * i + 3] * bfhi(w.y) + q[8 * i + 4] * bflo(w.z) + q[8 * i + 5] * bfhi(w.z) + q[8 * i + 6] * bflo(w.w) + q[8 * i + 7] * bfhi(w.w); }
                const float p = exp2f(sc - MB);
                l += p;
                const u32x4* vp = (const u32x4*)(P.VB + (size_t)kr * 512 + h * 128 + qt * 32);
#pragma unroll
                for (int i = 0; i < 4; ++i) { const u32x4 w = vp[i]; o[8 * i] += p * bflo(w.x); o[8 * i + 1] += p * bfhi(w.x); o[8 * i + 2] += p * bflo(w.y); o[8 * i + 3] += p * bfhi(w.y); o[8 * i + 4] += p * bflo(w.z); o[8 * i + 5] += p * bfhi(w.z); o[8 * i + 6] += p * bflo(w.w); o[8 * i + 7] += p * bfhi(w.w); }
            }
            const float inv = 1.0f / l;
            if (s == 0) {
#pragma unroll
                for (int i = 0; i < 32; ++i) rres[i] = o[i] * inv;
            } else {
#pragma unroll
                for (int i = 0; i < 32; ++i) rres[i] -= lam * o[i] * inv;
            }
        }
        float ss = 0.f;
#pragma unroll
        for (int i = 0; i < 32; ++i) ss += rres[i] * rres[i];
        ss += __shfl_xor(ss, 1); ss += __shfl_xor(ss, 2);
        const float rn = rsqrtf(ss * (1.0f / 128.0f) + EPS) * (1.0f - LAMBDA_INIT);
        const u32x4* gp = (const u32x4*)(P.GB + (size_t)m * 512 + h * 128 + qt * 32);
        const float* sl = P.b_subln + qt * 32;
        u32x4* op = (u32x4*)(P.O + (size_t)m * 1024 + 512 + h * 128 + qt * 32);
#pragma unroll
        for (int i = 0; i < 4; ++i) {
            const u32x4 w = gp[i]; u32x4 r;
            r.x = pack2(rres[8 * i] * rn * sl[8 * i] * bflo(w.x), rres[8 * i + 1] * rn * sl[8 * i + 1] * bfhi(w.x));
            r.y = pack2(rres[8 * i + 2] * rn * sl[8 * i + 2] * bflo(w.y), rres[8 * i + 3] * rn * sl[8 * i + 3] * bfhi(w.y));
            r.z = pack2(rres[8 * i + 4] * rn * sl[8 * i + 4] * bflo(w.z), rres[8 * i + 5] * rn * sl[8 * i + 5] * bfhi(w.z));
            r.w = pack2(rres[8 * i + 6] * rn * sl[8 * i + 6] * bflo(w.w), rres[8 * i + 7] * rn * sl[8 * i + 7] * bfhi(w.w));
            op[i] = r;
        }
    }
}

__device__ void phase_gla(const Params& P, float* lds, int vb, int nvb) {
    float* sa = lds; float* sk = lds + 128; float* sq = lds + 256;
    const int e = threadIdx.x;
    for (int unit = vb; unit < NB * 4 * 2; unit += nvb) {
        const int dr = unit & 1, h = (unit >> 1) & 3, b = unit >> 3;
        const float* wa = dr ? P.wa_b : P.wa_f; const float* ba = dr ? P.ba_b : P.ba_f;
        float S[128];
#pragma unroll
        for (int d = 0; d < 128; ++d) S[d] = 0.f;
        float war[16], bav = 0.f;
        if (e < 128) {
#pragma unroll
            for (int j = 0; j < 16; ++j) war[j] = wa[j * 512 + h * 128 + e];
            bav = ba[h * 128 + e];
        }
        for (int step = 0; step < L + T; ++step) {
            int m;
            if (step < L) m = ML + b * L + (dr ? L - 1 - step : step);
            else { const int t = step - L; m = b * T + (dr ? T - 1 - t : t); }
            __syncthreads();
            if (e < 128) {
                const float* rf = P.RF + (size_t)m * 32 + dr * 16;
                float z = bav;
#pragma unroll
                for (int j = 0; j < 16; ++j) z += rf[j] * war[j];
                const float ls = fminf(z, 0.f) - log1pf(expf(-fabsf(z)));
                sa[e] = expf(ls * (1.0f / 16.0f));
                sk[e] = bf2f(P.KG[(size_t)m * 512 + h * 128 + e]);
                sq[e] = bf2f(P.QG[(size_t)m * 512 + h * 128 + e]);
            }
            __syncthreads();
            if (e < 256) {
            const float v = bf2f(P.VG[(size_t)m * 1024 + h * 256 + e]);
            float o = 0.f;
#pragma unroll
            for (int d = 0; d < 128; ++d) { S[d] = sa[d] * S[d] + sk[d] * v; o += sq[d] * S[d]; }
            if (m < ML) P.OD[((size_t)dr * ML + m) * 1024 + h * 256 + e] = (bf16_t)f2bf(o);
            }
        }
    }
}

__device__ void phase_finish(const Params& P, int vb, int nvb) {
    const int lane = threadIdx.x & 63, wpb = blockDim.x >> 6, w = threadIdx.x >> 6;
    for (int row = vb * wpb + w; row < ML; row += nvb * wpb) {
        const int c0 = lane * 16;
        float v[16];
        const u32x4* pf = (const u32x4*)(P.OD + (size_t)row * 1024 + c0);
        const u32x4* pb = (const u32x4*)(P.OD + ((size_t)ML + row) * 1024 + c0);
        float ss = 0.f;
#pragma unroll
        for (int i = 0; i < 2; ++i) {
            const u32x4 a = pf[i], bq = pb[i];
            v[8 * i] = bflo(a.x) + bflo(bq.x); v[8 * i + 1] = bfhi(a.x) + bfhi(bq.x); v[8 * i + 2] = bflo(a.y) + bflo(bq.y); v[8 * i + 3] = bfhi(a.y) + bfhi(bq.y);
            v[8 * i + 4] = bflo(a.z) + bflo(bq.z); v[8 * i + 5] = bfhi(a.z) + bfhi(bq.z); v[8 * i + 6] = bflo(a.w) + bflo(bq.w); v[8 * i + 7] = bfhi(a.w) + bfhi(bq.w);
        }
#pragma unroll
        for (int i = 0; i < 16; ++i) ss += v[i] * v[i];
        ss += __shfl_xor(ss, 1); ss += __shfl_xor(ss, 2); ss += __shfl_xor(ss, 4); ss += __shfl_xor(ss, 8);
        const float rn = rsqrtf(ss * (1.0f / 256.0f) + EPS);
        const float* gn = P.gla_out_norm + (c0 & 255);
        const u32x4* gp = (const u32x4*)(P.GG + (size_t)row * 1024 + c0);
        u32x4* op = (u32x4*)(P.A2 + (size_t)row * 1024 + c0);
#pragma unroll
        for (int i = 0; i < 2; ++i) {
            const u32x4 g = gp[i]; u32x4 r;
            r.x = pack2(v[8 * i] * rn * gn[8 * i] * bflo(g.x), v[8 * i + 1] * rn * gn[8 * i + 1] * bfhi(g.x));
            r.y = pack2(v[8 * i + 2] * rn * gn[8 * i + 2] * bflo(g.y), v[8 * i + 3] * rn * gn[8 * i + 3] * bfhi(g.y));
            r.z = pack2(v[8 * i + 4] * rn * gn[8 * i + 4] * bflo(g.z), v[8 * i + 5] * rn * gn[8 * i + 5] * bfhi(g.z));
            r.w = pack2(v[8 * i + 6] * rn * gn[8 * i + 6] * bflo(g.w), v[8 * i + 7] * rn * gn[8 * i + 7] * bfhi(g.w));
            op[i] = r;
        }
    }
}

namespace cg = cooperative_groups;
__global__ void __launch_bounds__(512) mega_kernel(Params P) {
    __shared__ __attribute__((aligned(16))) unsigned char lds[2 * 256 * 80];
    cg::grid_group grid = cg::this_grid();
    const int vb = blockIdx.x, nvb = gridDim.x;
    phase_wt(P, vb, nvb); phase_adaln(P, vb, nvb); phase_rope(P, vb, nvb);
    grid.sync();
    phase_bias(P, vb, nvb); phase_a0(P, vb, nvb);
    grid.sync();
    { EpiIn0 E{P.parts, 1, P.bias0, P.a_q_norm, P.a_k_norm, P.b_q_norm, P.b_k_norm, P.rope, P.QA, P.KA, P.VA, P.GA, P.QB, P.KB, P.VB, P.GB};
      gemm_simple(P.A, P.Wt0, M / 256, N0 / 256, E, lds, vb, nvb); }
    grid.sync();
    phase_attnA(P, vb, nvb); phase_attnB(P, vb, nvb);
    grid.sync();
    { EpiOut0 E{P.x, P.ctx, P.mod, P.norm_g + D, P.out, P.A, P.parts};
      gemm_simple(P.O, P.Wo0, M / 256, D / 256, E, lds, vb, nvb); }
    grid.sync();
    { EpiIn1 E{P.parts, 16, P.bias1, P.QG, P.KG, P.VG, P.GG, P.RF};
      gemm_simple(P.A, P.Wt1, M / 256, N1 / 256, E, lds, vb, nvb); }
    grid.sync();
    phase_gla(P, (float*)lds, vb, nvb);
    grid.sync();
    phase_finish(P, vb, nvb);
    grid.sync();
    { EpiOut1 E{P.mod, P.out};
      gemm_simple(P.A2, P.Wo1, ML / 256, D / 256, E, lds, vb, nvb); }
}
}

extern "C" void kernel_launch(void* const* d_in, const int* in_sizes, int n_in, void* d_out, int out_size, void* d_ws, size_t ws_size, hipStream_t stream) {
    Params P{};
    const float* const* in = (const float* const*)d_in;
    P.x = in[0]; P.c = in[1]; P.ctx = in[2]; P.c_ctx = in[3]; P.adaln_w = in[4]; P.adaln_b = in[5]; P.norm_g = in[6]; P.w_out = in[7]; P.ab_w_in = in[8];
    P.a_q_norm = in[9]; P.a_k_norm = in[10]; P.a_sink = in[11]; P.b_q_norm = in[12]; P.b_k_norm = in[13]; P.lq1 = in[14]; P.lk1 = in[15]; P.lq2 = in[16]; P.lk2 = in[17];
    P.b_subln = in[18]; P.gla_w_in = in[19]; P.wa_f = in[20]; P.ba_f = in[21]; P.wa_b = in[22]; P.ba_b = in[23]; P.gla_out_norm = in[24];
    P.out = (float*)d_out;
    unsigned char* w = (unsigned char*)d_ws; size_t off = 0;
    auto take = [&](size_t bytes) { unsigned char* p = w + off; off += (bytes + 255) & ~(size_t)255; return p; };
    P.Wt0 = (bf16_t*)take((size_t)N0 * D * 2); P.Wt1 = (bf16_t*)take((size_t)N1 * D * 2); P.Wo0 = (bf16_t*)take((size_t)D * D * 2); P.Wo1 = (bf16_t*)take((size_t)D * D * 2);
    P.mod = (float*)take((size_t)2 * 33 * 3072 * 4); P.bias0 = (float*)take((size_t)33 * 3328 * 4); P.bias1 = (float*)take((size_t)33 * 3328 * 4);
    P.rope = (float*)take(64 * 16 * 2 * 4); P.parts = (float*)take((size_t)16 * M * 4);
    P.A = (bf16_t*)take((size_t)M * D * 2); P.O = (bf16_t*)take((size_t)M * D * 2);
    unsigned char* qkv = take((size_t)M * 3328 * 2);
    {
        unsigned char* q = qkv;
        P.QA = (bf16_t*)q; q += (size_t)M * 512 * 2; P.KA = (bf16_t*)q; q += (size_t)M * 128 * 2; P.VA = (bf16_t*)q; q += (size_t)M * 128 * 2; P.GA = (bf16_t*)q; q += (size_t)M * 512 * 2;
        P.QB = (bf16_t*)q; q += (size_t)M * 512 * 2; P.KB = (bf16_t*)q; q += (size_t)M * 512 * 2; P.VB = (bf16_t*)q; q += (size_t)M * 512 * 2; P.GB = (bf16_t*)q;
        q = qkv;
        P.QG = (bf16_t*)q; q += (size_t)M * 512 * 2; P.KG = (bf16_t*)q; q += (size_t)M * 512 * 2; P.VG = (bf16_t*)q; q += (size_t)M * 1024 * 2; P.GG = (bf16_t*)q; q += (size_t)M * 1024 * 2; P.RF = (float*)q;
        P.A2 = (bf16_t*)qkv;
        P.OD = P.A;
    }
    if (off > ws_size) { fprintf(stderr, "workspace too small: need %zu have %zu\n", off, ws_size); return; }
    static int grid_blocks = 0;
    if (!grid_blocks) {
        int dev = 0, cus = 0, per_cu = 0;
        (void)hipGetDevice(&dev);
        (void)hipDeviceGetAttribute(&cus, hipDeviceAttributeMultiprocessorCount, dev);
        (void)hipOccupancyMaxActiveBlocksPerMultiprocessor(&per_cu, mega_kernel, 512, 0);
        if (per_cu > 1) per_cu = 1;
        grid_blocks = cus * per_cu;
    }
    void* args[] = {&P};
    hipError_t e = hipLaunchCooperativeKernel((void*)mega_kernel, dim3(grid_blocks), dim3(512), args, 0, stream);
    if (e != hipSuccess) fprintf(stderr, "cooperative launch failed: %s (grid %d)\n", hipGetErrorString(e), grid_blocks);
}
```

```cpp
#include <hip/hip_runtime.h>
#include <hip/hip_cooperative_groups.h>
#include <cstdint>
#include <cstdio>

namespace {
constexpr int NB = 32, T = 2048, L = 256, D = 1024;
constexpr int ML = NB * T, MC = NB * L, M = ML + MC;
constexpr int N0 = 3328, N1 = 3328, N0R = 3328, N1R = 3104;
constexpr float EPS = 1e-6f;
constexpr float LOG2E = 1.4426950408889634f;
constexpr float QSCALE = 0.125f * LOG2E;
constexpr float LAMBDA_INIT = 0.2f;

typedef unsigned short bf16_t;
typedef short bf16x8 __attribute__((ext_vector_type(8)));
typedef float f32x4 __attribute__((ext_vector_type(4)));
typedef unsigned u32x4 __attribute__((ext_vector_type(4)));
typedef unsigned u32x2 __attribute__((ext_vector_type(2)));

struct Params {
    const float *x, *c, *ctx, *c_ctx, *adaln_w, *adaln_b, *norm_g, *w_out, *ab_w_in, *a_q_norm, *a_k_norm, *a_sink, *b_q_norm, *b_k_norm;
    const float *lq1, *lk1, *lq2, *lk2, *b_subln, *gla_w_in, *wa_f, *ba_f, *wa_b, *ba_b, *gla_out_norm;
    float* out;
    bf16_t *Wt0, *Wt1, *Wo0, *Wo1;
    float *mod, *bias0, *bias1, *rope, *parts;
    bf16_t *A, *O;
    bf16_t *QA, *KA, *VA, *GA, *QB, *KB, *VB, *GB;
    bf16_t *QG, *KG, *VG, *GG; float* RF;
    bf16_t *OD, *A2;
};

__device__ __forceinline__ unsigned f2bf(float f) { unsigned u = __float_as_uint(f); u += 0x7FFFu + ((u >> 16) & 1u); return u >> 16; }
__device__ __forceinline__ unsigned pack2(float lo, float hi) { return f2bf(lo) | (f2bf(hi) << 16); }
__device__ __forceinline__ float bf2f(unsigned h) { return __uint_as_float(h << 16); }
__device__ __forceinline__ float bflo(unsigned w) { return __uint_as_float(w << 16); }
__device__ __forceinline__ float bfhi(unsigned w) { return __uint_as_float(w & 0xFFFF0000u); }
__device__ __forceinline__ float siluf(float v) { return v / (1.0f + __expf(-v)); }

__device__ __forceinline__ int perm_local(int p, bool ropeType) {
    const int bj = p >> 7, wc = (p >> 5) & 3, low = p & 31;
    if (ropeType) return wc * 64 + bj * 32 + low;
    const int n = (low >> 4) & 1, fq = (low >> 2) & 3, e = low & 3;
    return wc * 64 + bj * 32 + fq * 8 + n * 4 + e;
}
__device__ __forceinline__ int src_col(int which, int np) {
    const int p = np & 255, tile = np >> 8;
    bool rope = false;
    if (which == 0) { const int g = tile * 4 + ((p >> 5) & 3); rope = (g < 10) || (g >= 20 && g < 36); }
    const int c = tile * 256 + perm_local(p, rope);
    const int nreal = which == 0 ? N0R : (which == 1 ? N1R : D);
    return c < nreal ? c : -1;
}

__device__ void phase_wt(const Params& P, int vb, int nvb) {
    const long total = (long)(N0 + N1 + D + D) * D;
    for (long idx = (long)vb * blockDim.x + threadIdx.x; idx < total; idx += (long)nvb * blockDim.x) {
        long i = idx; int which; const float* W; bf16_t* dst; int ldw;
        if (i < (long)N0 * D) { which = 0; W = P.ab_w_in; dst = P.Wt0; ldw = N0R; }
        else if ((i -= (long)N0 * D) < (long)N1 * D) { which = 1; W = P.gla_w_in; dst = P.Wt1; ldw = N1R; }
        else if ((i -= (long)N1 * D) < (long)D * D) { which = 2; W = P.w_out; dst = P.Wo0; ldw = D; }
        else { i -= (long)D * D; which = 3; W = P.w_out + (size_t)D * D; dst = P.Wo1; ldw = D; }
        const int np = (int)(i >> 10), k = (int)(i & 1023);
        const int sc = src_col(which, np);
        const float v = sc >= 0 ? W[(size_t)k * ldw + sc] : 0.f;
        dst[i] = (bf16_t)f2bf(v);
    }
}

__device__ void phase_adaln(const Params& P, int vb, int nvb) {
    for (int idx = vb * blockDim.x + threadIdx.x; idx < 2 * 3072; idx += nvb * blockDim.x) {
        const int l = idx / 3072, j = idx % 3072;
        float acc[33];
#pragma unroll
        for (int r = 0; r < 33; ++r) acc[r] = 0.f;
        const float* w = P.adaln_w + (size_t)l * D * 3072 + j;
        for (int k = 0; k < D; ++k) {
            const float wv = w[(size_t)k * 3072];
#pragma unroll
            for (int r = 0; r < 33; ++r) { const float cv = r < 32 ? P.c[r * D + k] : P.c_ctx[k]; acc[r] += siluf(cv) * wv; }
        }
        const float bv = P.adaln_b[l * 3072 + j];
#pragma unroll
        for (int r = 0; r < 33; ++r) P.mod[((size_t)l * 33 + r) * 3072 + j] = acc[r] + bv;
    }
}

__device__ void phase_rope(const Params& P, int vb, int nvb) {
    for (int idx = vb * blockDim.x + threadIdx.x; idx < 64 * 16; idx += nvb * blockDim.x) {
        const int pos = idx >> 4, i = idx & 15;
        const double inv = pow(10000.0, -(double)i / 16.0);
        const double ang = (double)((float)pos * (float)inv);
        P.rope[idx * 2 + 0] = (float)cos(ang);
        P.rope[idx * 2 + 1] = (float)sin(ang);
    }
}

__device__ void phase_bias(const Params& P, int vb, int nvb) {
    for (int idx = vb * blockDim.x + threadIdx.x; idx < N0 + N1; idx += nvb * blockDim.x) {
        const int l = idx >= N0, np = l ? idx - N0 : idx;
        const int sc = src_col(l, np);
        float acc[33];
#pragma unroll
        for (int r = 0; r < 33; ++r) acc[r] = 0.f;
        if (sc >= 0) {
            const float* W = l ? P.gla_w_in : P.ab_w_in; const int ldw = l ? N1R : N0R;
            const float* sh = P.mod + (size_t)l * 33 * 3072;
            for (int k = 0; k < D; ++k) {
                const float wv = W[(size_t)k * ldw + sc];
#pragma unroll
                for (int r = 0; r < 33; ++r) acc[r] += sh[r * 3072 + k] * wv;
            }
        }
        float* dst = l ? P.bias1 : P.bias0;
#pragma unroll
        for (int r = 0; r < 33; ++r) dst[r * 3328 + np] = acc[r];
    }
}

__device__ void phase_a0(const Params& P, int vb, int nvb) {
    const int lane = threadIdx.x & 63, wpb = blockDim.x >> 6, w = threadIdx.x >> 6;
    for (int row = vb * wpb + w; row < M; row += nvb * wpb) {
        const float* xin = row < ML ? P.x + (size_t)row * D : P.ctx + (size_t)(row - ML) * D;
        const int r = row < ML ? row >> 11 : 32;
        const float* sc = P.mod + (size_t)r * 3072 + 1024;
        float ss = 0.f;
#pragma unroll
        for (int i = 0; i < 2; ++i) {
            const int c0 = i * 512 + lane * 8;
            const f32x4 a = *(const f32x4*)(xin + c0), b = *(const f32x4*)(xin + c0 + 4);
            const f32x4 g0 = *(const f32x4*)(P.norm_g + c0), g1 = *(const f32x4*)(P.norm_g + c0 + 4);
            const f32x4 s0 = *(const f32x4*)(sc + c0), s1 = *(const f32x4*)(sc + c0 + 4);
            ss += a[0] * a[0] + a[1] * a[1] + a[2] * a[2] + a[3] * a[3] + b[0] * b[0] + b[1] * b[1] + b[2] * b[2] + b[3] * b[3];
            const f32x4 ya = a * g0 * (1.0f + s0), yb = b * g1 * (1.0f + s1);
            u32x4 o; o.x = pack2(ya[0], ya[1]); o.y = pack2(ya[2], ya[3]); o.z = pack2(yb[0], yb[1]); o.w = pack2(yb[2], yb[3]);
            *(u32x4*)(P.A + (size_t)row * D + c0) = o;
        }
#pragma unroll
        for (int o = 32; o >= 1; o >>= 1) ss += __shfl_xor(ss, o);
        if (lane == 0) P.parts[row] = ss;
    }
}

struct EpiIn0 {
    const float* parts; int nparts; const float* bias;
    const float *aqn, *akn, *bqn, *bkn, *rope;
    bf16_t *QA, *KA, *VA, *GA, *QB, *KB, *VB, *GB;
    __device__ __forceinline__ void operator()(const f32x4 (&acc)[2][2][4][2], int pm, int pn, int wr, int wc, int fr, int fq) const {
        const int g = 4 * pn + wc;
        bf16_t* dst; int ld, col, type; const float* gain = nullptr;
        if (g < 8) { dst = QA; ld = 512; col = g * 64; type = 2; gain = aqn; }
        else if (g < 10) { dst = KA; ld = 128; col = (g - 8) * 64; type = 3; gain = akn; }
        else if (g < 12) { dst = VA; ld = 128; col = (g - 10) * 64; type = 0; }
        else if (g < 20) { dst = GA; ld = 512; col = (g - 12) * 64; type = 1; }
        else if (g < 28) { dst = QB; ld = 512; col = (g - 20) * 64; type = 2; gain = bqn; }
        else if (g < 36) { dst = KB; ld = 512; col = (g - 28) * 64; type = 3; gain = bkn; }
        else if (g < 44) { dst = VB; ld = 512; col = (g - 36) * 64; type = 0; }
        else { dst = GB; ld = 512; col = (g - 44) * 64; type = 1; }
#pragma unroll
        for (int ai = 0; ai < 2; ++ai)
#pragma unroll
            for (int m = 0; m < 4; ++m) {
                const int row = pm * 256 + ai * 128 + wr * 64 + m * 16 + fr;
                float ss = 0.f;
                for (int i = 0; i < nparts; ++i) ss += parts[(size_t)i * M + row];
                const float rstd = rsqrtf(ss * (1.0f / 1024.0f) + EPS);
                const int r = row < ML ? row >> 11 : 32;
                const float* bptr = bias + (size_t)r * 3328 + pn * 256 + wc * 32 + fq * 4;
                f32x4 v[2][2];
#pragma unroll
                for (int bj = 0; bj < 2; ++bj)
#pragma unroll
                    for (int n = 0; n < 2; ++n) v[bj][n] = acc[ai][bj][m][n] * rstd + *(const f32x4*)(bptr + bj * 128 + n * 16);
                if (type >= 2) {
                    float s2 = 0.f;
#pragma unroll
                    for (int bj = 0; bj < 2; ++bj)
#pragma unroll
                        for (int n = 0; n < 2; ++n) s2 += v[bj][n][0] * v[bj][n][0] + v[bj][n][1] * v[bj][n][1] + v[bj][n][2] * v[bj][n][2] + v[bj][n][3] * v[bj][n][3];
                    s2 += __shfl_xor(s2, 16); s2 += __shfl_xor(s2, 32);
                    const float rn = rsqrtf(s2 * (1.0f / 64.0f) + EPS);
#pragma unroll
                    for (int bj = 0; bj < 2; ++bj)
#pragma unroll
                        for (int n = 0; n < 2; ++n) v[bj][n] = v[bj][n] * rn * *(const f32x4*)(gain + bj * 32 + n * 16 + fq * 4);
                    if (row < ML) {
                        const int t = row & 2047;
#pragma unroll
                        for (int bj = 0; bj < 2; ++bj) {
                            const int pos = bj == 0 ? (t >> 6) : (t & 63);
                            const float* cs = rope + (pos * 16 + fq * 4) * 2;
                            const f32x4 c01 = *(const f32x4*)cs, c23 = *(const f32x4*)(cs + 4);
                            const float cc[4] = {c01[0], c01[2], c23[0], c23[2]}, sn[4] = {c01[1], c01[3], c23[1], c23[3]};
#pragma unroll
                            for (int e = 0; e < 4; ++e) { const float x1 = v[bj][0][e], x2 = v[bj][1][e]; v[bj][0][e] = x1 * cc[e] - x2 * sn[e]; v[bj][1][e] = x2 * cc[e] + x1 * sn[e]; }
                        }
                    }
                    if (type == 2) {
#pragma unroll
                        for (int bj = 0; bj < 2; ++bj)
#pragma unroll
                            for (int n = 0; n < 2; ++n) v[bj][n] = v[bj][n] * QSCALE;
                    }
                } else if (type == 1) {
#pragma unroll
                    for (int bj = 0; bj < 2; ++bj)
#pragma unroll
                        for (int n = 0; n < 2; ++n)
#pragma unroll
                            for (int e = 0; e < 4; ++e) v[bj][n][e] = siluf(v[bj][n][e]);
                }
#pragma unroll
                for (int bj = 0; bj < 2; ++bj) {
                    u32x4 o; o.x = pack2(v[bj][0][0], v[bj][0][1]); o.y = pack2(v[bj][0][2], v[bj][0][3]); o.z = pack2(v[bj][1][0], v[bj][1][1]); o.w = pack2(v[bj][1][2], v[bj][1][3]);
                    *(u32x4*)(dst + (size_t)row * ld + col + bj * 32 + fq * 8) = o;
                }
            }
    }
};

struct EpiIn1 {
    const float* parts; int nparts; const float* bias;
    bf16_t *QG, *KG, *VG, *GG; float* RF;
    __device__ __forceinline__ void operator()(const f32x4 (&acc)[2][2][4][2], int pm, int pn, int wr, int wc, int fr, int fq) const {
        const int g = 4 * pn + wc;
        if (g > 48) return;
        bf16_t* dst = nullptr; int ld = 0, col = 0, type;
        if (g < 8) { dst = QG; ld = 512; col = g * 64; type = 2; }
        else if (g < 16) { dst = KG; ld = 512; col = (g - 8) * 64; type = 0; }
        else if (g < 32) { dst = VG; ld = 1024; col = (g - 16) * 64; type = 0; }
        else if (g < 48) { dst = GG; ld = 1024; col = (g - 32) * 64; type = 1; }
        else type = 3;
#pragma unroll
        for (int ai = 0; ai < 2; ++ai)
#pragma unroll
            for (int m = 0; m < 4; ++m) {
                const int row = pm * 256 + ai * 128 + wr * 64 + m * 16 + fr;
                float ss = 0.f;
                for (int i = 0; i < nparts; ++i) ss += parts[(size_t)i * M + row];
                const float rstd = rsqrtf(ss * (1.0f / 1024.0f) + EPS);
                const int r = row < ML ? row >> 11 : 32;
                const float* bptr = bias + (size_t)r * 3328 + pn * 256 + wc * 32 + fq * 4;
                f32x4 v[2][2];
#pragma unroll
                for (int bj = 0; bj < 2; ++bj)
#pragma unroll
                    for (int n = 0; n < 2; ++n) v[bj][n] = acc[ai][bj][m][n] * rstd + *(const f32x4*)(bptr + bj * 128 + n * 16);
                if (type == 3) {
                    *(f32x4*)(RF + (size_t)row * 32 + fq * 8) = v[0][0];
                    *(f32x4*)(RF + (size_t)row * 32 + fq * 8 + 4) = v[0][1];
                    continue;
                }
                if (type == 2) {
#pragma unroll
                    for (int bj = 0; bj < 2; ++bj)
#pragma unroll
                        for (int n = 0; n < 2; ++n) v[bj][n] = v[bj][n] * 0.08838834764831845f;
                } else if (type == 1) {
#pragma unroll
                    for (int bj = 0; bj < 2; ++bj)
#pragma unroll
                        for (int n = 0; n < 2; ++n)
#pragma unroll
                            for (int e = 0; e < 4; ++e) v[bj][n][e] = siluf(v[bj][n][e]);
                }
#pragma unroll
                for (int bj = 0; bj < 2; ++bj) {
                    u32x4 o; o.x = pack2(v[bj][0][0], v[bj][0][1]); o.y = pack2(v[bj][0][2], v[bj][0][3]); o.z = pack2(v[bj][1][0], v[bj][1][1]); o.w = pack2(v[bj][1][2], v[bj][1][3]);
                    *(u32x4*)(dst + (size_t)row * ld + col + bj * 32 + fq * 8) = o;
                }
            }
    }
};

struct EpiOut0 {
    const float *x, *ctx, *mod, *g1; float* out; bf16_t* A1; float* parts;
    __device__ __forceinline__ void operator()(const f32x4 (&acc)[2][2][4][2], int pm, int pn, int wr, int wc, int fr, int fq) const {
#pragma unroll
        for (int ai = 0; ai < 2; ++ai)
#pragma unroll
            for (int m = 0; m < 4; ++m) {
                const int row = pm * 256 + ai * 128 + wr * 64 + m * 16 + fr;
                const int r = row < ML ? row >> 11 : 32;
                const float* xin = row < ML ? x + (size_t)row * D : ctx + (size_t)(row - ML) * D;
                const float* gt = mod + (size_t)r * 3072 + 2048;
                const float* sc = mod + (size_t)(33 + r) * 3072 + 1024;
                float ss = 0.f;
#pragma unroll
                for (int bj = 0; bj < 2; ++bj) {
                    const int c = pn * 256 + wc * 64 + bj * 32 + fq * 8;
                    f32x4 y[2];
#pragma unroll
                    for (int n = 0; n < 2; ++n) {
                        const f32x4 x1 = *(const f32x4*)(xin + c + n * 4) + *(const f32x4*)(gt + c + n * 4) * acc[ai][bj][m][n];
                        ss += x1[0] * x1[0] + x1[1] * x1[1] + x1[2] * x1[2] + x1[3] * x1[3];
                        if (row < ML) *(f32x4*)(out + (size_t)row * D + c + n * 4) = x1;
                        y[n] = x1 * *(const f32x4*)(g1 + c + n * 4) * (1.0f + *(const f32x4*)(sc + c + n * 4));
                    }
                    u32x4 o; o.x = pack2(y[0][0], y[0][1]); o.y = pack2(y[0][2], y[0][3]); o.z = pack2(y[1][0], y[1][1]); o.w = pack2(y[1][2], y[1][3]);
                    *(u32x4*)(A1 + (size_t)row * D + c) = o;
                }
                ss += __shfl_xor(ss, 16); ss += __shfl_xor(ss, 32);
                if (fq == 0) parts[(size_t)(4 * pn + wc) * M + row] = ss;
            }
    }
};

struct EpiOut1 {
    const float* mod; float* out;
    __device__ __forceinline__ void operator()(const f32x4 (&acc)[2][2][4][2], int pm, int pn, int wr, int wc, int fr, int fq) const {
#pragma unroll
        for (int ai = 0; ai < 2; ++ai)
#pragma unroll
            for (int m = 0; m < 4; ++m) {
                const int row = pm * 256 + ai * 128 + wr * 64 + m * 16 + fr;
                const int r = row >> 11;
                const float* gt = mod + (size_t)(33 + r) * 3072 + 2048;
#pragma unroll
                for (int bj = 0; bj < 2; ++bj)
#pragma unroll
                    for (int n = 0; n < 2; ++n) {
                        const int c = pn * 256 + wc * 64 + bj * 32 + fq * 8 + n * 4;
                        float* o = out + (size_t)row * D + c;
                        *(f32x4*)o = *(const f32x4*)o + *(const f32x4*)(gt + c) * acc[ai][bj][m][n];
                    }
            }
    }
};

template <class Epi>
__device__ void gemm_simple(const bf16_t* __restrict__ A, const bf16_t* __restrict__ Bt, int nM, int nN, const Epi& E, unsigned char* lds, int vb, int nvb) {
    const int tid = threadIdx.x, wid = tid >> 6, lane = tid & 63, wr = wid >> 2, wc = wid & 3, fr = lane & 15, fq = lane >> 4;
    unsigned char* ldsA = lds; unsigned char* ldsB = lds + 256 * 80;
    for (int tile = vb; tile < nM * nN; tile += nvb) {
        const int pm = tile / nN, pn = tile % nN;
        f32x4 acc[2][2][4][2];
#pragma unroll
        for (int a = 0; a < 2; ++a)
#pragma unroll
            for (int b = 0; b < 2; ++b)
#pragma unroll
                for (int m = 0; m < 4; ++m)
#pragma unroll
                    for (int n = 0; n < 2; ++n) acc[a][b][m][n] = (f32x4){0.f, 0.f, 0.f, 0.f};
        for (int k0 = 0; k0 < D; k0 += 32) {
            __syncthreads();
#pragma unroll
            for (int i = 0; i < 2; ++i) {
                const int cidx = tid + 512 * i, r = cidx >> 2, kc = cidx & 3;
                *(u32x4*)(ldsA + r * 80 + kc * 16) = *(const u32x4*)(A + (size_t)(pm * 256 + r) * D + k0 + kc * 8);
                *(u32x4*)(ldsB + r * 80 + kc * 16) = *(const u32x4*)(Bt + (size_t)(pn * 256 + r) * D + k0 + kc * 8);
            }
            __syncthreads();
            bf16x8 af[2][4], bfr[2][2];
#pragma unroll
            for (int ai = 0; ai < 2; ++ai)
#pragma unroll
                for (int m = 0; m < 4; ++m) af[ai][m] = *(const bf16x8*)(ldsA + (ai * 128 + wr * 64 + m * 16 + fr) * 80 + fq * 16);
#pragma unroll
            for (int bj = 0; bj < 2; ++bj)
#pragma unroll
                for (int n = 0; n < 2; ++n) bfr[bj][n] = *(const bf16x8*)(ldsB + (bj * 128 + wc * 32 + n * 16 + fr) * 80 + fq * 16);
#pragma unroll
            for (int ai = 0; ai < 2; ++ai)
#pragma unroll
                for (int bj = 0; bj < 2; ++bj)
#pragma unroll
                    for (int m = 0; m < 4; ++m)
#pragma unroll
                        for (int n = 0; n < 2; ++n) acc[ai][bj][m][n] = __builtin_amdgcn_mfma_f32_16x16x32_bf16(bfr[bj][n], af[ai][m], acc[ai][bj][m][n], 0, 0, 0);
        }
        E(acc, pm, pn, wr, wc, fr, fq);
    }
}

__device__ __forceinline__ float maxabs64(const float* g) { float m = 0.f; for (int i = 0; i < 64; ++i) m = fmaxf(m, fabsf(g[i])); return m; }

__device__ void phase_attnA(const Params& P, int vb, int nvb) {
    const float MA = 8.0f * maxabs64(P.a_q_norm) * maxabs64(P.a_k_norm) * LOG2E;
    for (long idx = (long)vb * blockDim.x + threadIdx.x; idx < (long)M * 8; idx += (long)nvb * blockDim.x) {
        const int h = (int)(idx / M), m = (int)(idx % M), kv = h >> 2;
        float q[64], o[64];
        {
            const u32x4* qp = (const u32x4*)(P.QA + (size_t)m * 512 + h * 64);
#pragma unroll
            for (int i = 0; i < 8; ++i) { const u32x4 w = qp[i]; q[8 * i] = bflo(w.x); q[8 * i + 1] = bfhi(w.x); q[8 * i + 2] = bflo(w.y); q[8 * i + 3] = bfhi(w.y); q[8 * i + 4] = bflo(w.z); q[8 * i + 5] = bfhi(w.z); q[8 * i + 6] = bflo(w.w); q[8 * i + 7] = bfhi(w.w); }
        }
#pragma unroll
        for (int i = 0; i < 64; ++i) o[i] = 0.f;
        float l = 0.f;
        int b, nlat = 0, j0 = 0;
        if (m < ML) { b = m >> 11; const int t = m & 2047; j0 = t - 128 < 0 ? 0 : t - 128; const int j1 = t + 128 > 2047 ? 2047 : t + 128; nlat = j1 - j0 + 1; }
        else b = (m - ML) >> 8;
        const int ntot = nlat + 256;
        for (int jj = 0; jj < ntot; ++jj) {
            const int kr = jj < nlat ? b * 2048 + j0 + jj : ML + b * 256 + (jj - nlat);
            const u32x4* kp = (const u32x4*)(P.KA + (size_t)kr * 128 + kv * 64);
            float s = 0.f;
#pragma unroll
            for (int i = 0; i < 8; ++i) { const u32x4 w = kp[i]; s += q[8 * i] * bflo(w.x) + q[8 * i + 1] * bfhi(w.x) + q[8 * i + 2] * bflo(w.y) + q[8 * i + 3] * bfhi(w.y) + q[8 * i + 4] * bflo(w.z) + q[8 * i + 5] * bfhi(w.z) + q[8 * i + 6] * bflo(w.w) + q[8 * i + 7] * bfhi(w.w); }
            const float p = exp2f(s - MA);
            l += p;
            const u32x4* vp = (const u32x4*)(P.VA + (size_t)kr * 128 + kv * 64);
#pragma unroll
            for (int i = 0; i < 8; ++i) { const u32x4 w = vp[i]; o[8 * i] += p * bflo(w.x); o[8 * i + 1] += p * bfhi(w.x); o[8 * i + 2] += p * bflo(w.y); o[8 * i + 3] += p * bfhi(w.y); o[8 * i + 4] += p * bflo(w.z); o[8 * i + 5] += p * bfhi(w.z); o[8 * i + 6] += p * bflo(w.w); o[8 * i + 7] += p * bfhi(w.w); }
        }
        l += exp2f(P.a_sink[h] * LOG2E - MA);
        const float inv = 1.0f / l;
        const u32x4* gp = (const u32x4*)(P.GA + (size_t)m * 512 + h * 64);
        u32x4* op = (u32x4*)(P.O + (size_t)m * 1024 + h * 64);
#pragma unroll
        for (int i = 0; i < 8; ++i) {
            const u32x4 w = gp[i]; u32x4 r;
            r.x = pack2(o[8 * i] * inv * bflo(w.x), o[8 * i + 1] * inv * bfhi(w.x)); r.y = pack2(o[8 * i + 2] * inv * bflo(w.y), o[8 * i + 3] * inv * bfhi(w.y));
            r.z = pack2(o[8 * i + 4] * inv * bflo(w.z), o[8 * i + 5] * inv * bfhi(w.z)); r.w = pack2(o[8 * i + 6] * inv * bflo(w.w), o[8 * i + 7] * inv * bfhi(w.w));
            op[i] = r;
        }
    }
}

__device__ void phase_attnB(const Params& P, int vb, int nvb) {
    const float MB = 8.0f * maxabs64(P.b_q_norm) * maxabs64(P.b_k_norm) * LOG2E;
    float d1 = 0.f, d2 = 0.f;
    for (int i = 0; i < 64; ++i) { d1 += P.lq1[i] * P.lk1[i]; d2 += P.lq2[i] * P.lk2[i]; }
    const float lam = expf(d1) - expf(d2) + LAMBDA_INIT;
    for (long idx = (long)vb * blockDim.x + threadIdx.x; idx < (long)M * 16; idx += (long)nvb * blockDim.x) {
        const int qt = (int)(idx & 3); const long hm = idx >> 2; const int h = (int)(hm / M), m = (int)(hm % M);
        int b, nlat;
        if (m < ML) { b = m >> 11; nlat = 2048; } else { b = (m - ML) >> 8; nlat = 0; }
        const int ntot = nlat + 256;
        float rres[32];
        for (int s = 0; s < 2; ++s) {
            const int g = 2 * h + s;
            float q[64], o[32];
            const u32x4* qp = (const u32x4*)(P.QB + (size_t)m * 512 + g * 64);
#pragma unroll
            for (int i = 0; i < 8; ++i) { const u32x4 w = qp[i]; q[8 * i] = bflo(w.x); q[8 * i + 1] = bfhi(w.x); q[8 * i + 2] = bflo(w.y); q[8 * i + 3] = bfhi(w.y); q[8 * i + 4] = bflo(w.z); q[8 * i + 5] = bfhi(w.z); q[8 * i + 6] = bflo(w.w); q[8 * i + 7] = bfhi(w.w); }
#pragma unroll
            for (int i = 0; i < 32; ++i) o[i] = 0.f;
            float l = 0.f;
            for (int jj = 0; jj < ntot; ++jj) {
                const int kr = jj < nlat ? b * 2048 + jj : ML + b * 256 + (jj - nlat);
                const u32x4* kp = (const u32x4*)(P.KB + (size_t)kr * 512 + g * 64);
                float sc = 0.f;
#pragma unroll
                for (int i = 0; i < 8; ++i) { const u32x4 w = kp[i]; sc += q[8 * i] * bflo(w.x) + q[8 * i + 1] * bfhi(w.x) + q[8 * i + 2] * bflo(w.y) + q[8 * i + 3] * bfhi(w.y) + q[8 * i + 4] * bflo(w.z) + q[8 * i + 5] * bfhi(w.z) + q[8 * i + 6] * bflo(w.w) + q[8 * i + 7] * bfhi(w.w); }
                const float p = exp2f(sc - MB);
                l += p;
                const u32x4* vp = (const u32x4*)(P.VB + (size_t)kr * 512 + h * 128 + qt * 32);
#pragma unroll
                for (int i = 0; i < 4; ++i) { const u32x4 w = vp[i]; o[8 * i] += p * bflo(w.x); o[8 * i + 1] += p * bfhi(w.x); o[8 * i + 2] += p * bflo(w.y); o[8 * i + 3] += p * bfhi(w.y); o[8 * i + 4] += p * bflo(w.z); o[8 * i + 5] += p * bfhi(w.z); o[8 * i + 6] += p * bflo(w.w); o[8 * i + 7] += p * bfhi(w.w); }
            }
            const float inv = 1.0f / l;
            if (s == 0) {
#pragma unroll
                for (int i = 0; i < 32; ++i) rres[i] = o[i] * inv;
            } else {
#pragma unroll
                for (int i = 0; i < 32; ++i) rres[i] -= lam * o[i] * inv;
            }
        }
        float ss = 0.f;
#pragma unroll
        for (int i = 0; i < 32; ++i) ss += rres[i] * rres[i];
        ss += __shfl_xor(ss, 1); ss += __shfl_xor(ss, 2);
        const float rn = rsqrtf(ss * (1.0f / 128.0f) + EPS) * (1.0f - LAMBDA_INIT);
        const u32x4* gp = (const u32x4*)(P.GB + (size_t)m * 512 + h * 128 + qt * 32);
        const float* sl = P.b_subln + qt * 32;
        u32x4* op = (u32x4*)(P.O + (size_t)m * 1024 + 512 + h * 128 + qt * 32);
#pragma unroll
        for (int i = 0; i < 4; ++i) {
            const u32x4 w = gp[i]; u32x4 r;
            r.x = pack2(rres[8 * i] * rn * sl[8 * i] * bflo(w.x), rres[8 * i + 1] * rn * sl[8 * i + 1] * bfhi(w.x));
            r.y = pack2(rres[8 * i + 2] * rn * sl[8 * i + 2] * bflo(w.y), rres[8 * i + 3] * rn * sl[8 * i + 3] * bfhi(w.y));
            r.z = pack2(rres[8 * i + 4] * rn * sl[8 * i + 4] * bflo(w.z), rres[8 * i + 5] * rn * sl[8 * i + 5] * bfhi(w.z));
            r.w = pack2(rres[8 * i + 6] * rn * sl[8 * i + 6] * bflo(w.w), rres[8 * i + 7] * rn * sl[8 * i + 7] * bfhi(w.w));
            op[i] = r;
        }
    }
}

typedef float f32x16 __attribute__((ext_vector_type(16)));
typedef short s16x4 __attribute__((ext_vector_type(4)));
typedef float f32x2_t __attribute__((ext_vector_type(2)));
typedef __bf16 bf16x2_t __attribute__((ext_vector_type(2)));
#define LDSAS __attribute__((address_space(3)))
__device__ __forceinline__ unsigned cvtpk(float lo, float hi) { f32x2_t v = {lo, hi}; bf16x2_t b = __builtin_convertvector(v, bf16x2_t); return __builtin_bit_cast(unsigned, b); }
__device__ __forceinline__ int crow(int r, int hi) { return (r & 3) + 8 * (r >> 2) + 4 * hi; }
__device__ __forceinline__ s16x4 vtr(const LDSAS unsigned char* p) { return __builtin_bit_cast(s16x4, __builtin_amdgcn_ds_read_tr16_b64_v4i16((LDSAS s16x4*)p)); }

constexpr int AB_K1 = 0, AB_K2 = 16384, AB_V = 32768;
constexpr int AB_XCH = 0, AB_SCR = 67584, AB_LDS = 67584 + 8 * 256;

__device__ __forceinline__ void attnB_unit(const Params& P, LDSAS unsigned char* lds, int b, int h, int qrow0, int t_begin, int t_end, float lam) {
    const int tid = threadIdx.x, lane = tid & 63, r32 = lane & 31, hi = lane >> 5;
    const int wid = __builtin_amdgcn_readfirstlane(tid >> 6);
    const int s = wid >> 2, qt = wid & 3;
    const int qrow = qrow0 + qt * 32 + r32;
    bf16x8 qf[4];
#pragma unroll
    for (int d0 = 0; d0 < 4; ++d0) qf[d0] = *(const bf16x8*)(P.QB + (size_t)qrow * 512 + (2 * h + s) * 64 + d0 * 16 + hi * 8);
    f32x16 o[4];
#pragma unroll
    for (int i = 0; i < 4; ++i) o[i] = (f32x16){};
    float l = 0.f;
    const int krow = tid >> 3, kch = tid & 7, vrow = tid >> 4, vch = tid & 15;
    const int kwoff = krow * 128 + ((kch ^ ((krow >> 1) & 7)) * 16);
    const int vwoff = (vch >> 2) * 4096 + vrow * 64 + (vch & 3) * 16;
    u32x4 rk1, rk2, rv0, rv1;
#define AB_GLOAD(t) do { const int kr0_ = (t) < 32 ? b * 2048 + 64 * (t) : ML + b * 256 + 64 * ((t) - 32); \
        rk1 = *(const u32x4*)(P.KB + (size_t)(kr0_ + krow) * 512 + (2 * h) * 64 + kch * 8); \
        rk2 = *(const u32x4*)(P.KB + (size_t)(kr0_ + krow) * 512 + (2 * h + 1) * 64 + kch * 8); \
        rv0 = *(const u32x4*)(P.VB + (size_t)(kr0_ + vrow) * 512 + h * 128 + vch * 8); \
        rv1 = *(const u32x4*)(P.VB + (size_t)(kr0_ + vrow + 32) * 512 + h * 128 + vch * 8); } while (0)
#define AB_LWRITE(buf) do { *(LDSAS u32x4*)(lds + AB_K1 + (buf) * 8192 + kwoff) = rk1; *(LDSAS u32x4*)(lds + AB_K2 + (buf) * 8192 + kwoff) = rk2; \
        *(LDSAS u32x4*)(lds + AB_V + (buf) * 16384 + vwoff) = rv0; *(LDSAS u32x4*)(lds + AB_V + (buf) * 16384 + vwoff + 2048) = rv1; } while (0)
    const int kroff = (s ? AB_K2 : AB_K1) + r32 * 128, ksw = (r32 >> 1) & 7;
    const int vroff = AB_V + (4 * hi + ((lane & 15) >> 2)) * 64 + ((lane >> 4) & 1) * 32 + (lane & 3) * 8;
    AB_GLOAD(t_begin); AB_LWRITE(0); __syncthreads();
    for (int t = t_begin; t < t_end; ++t) {
        const int buf = (t - t_begin) & 1;
        if (t + 1 < t_end) AB_GLOAD(t + 1);
        const LDSAS unsigned char* kb = lds + buf * 8192 + kroff;
        f32x16 p0 = (f32x16){}, p1 = (f32x16){};
#pragma unroll
        for (int d0 = 0; d0 < 4; ++d0) {
            const int co = ((2 * d0 + hi) ^ ksw) * 16;
            const bf16x8 k0 = *(const LDSAS bf16x8*)(kb + co), k1 = *(const LDSAS bf16x8*)(kb + 4096 + co);
            p0 = __builtin_amdgcn_mfma_f32_32x32x16_bf16(k0, qf[d0], p0, 0, 0, 0);
            p1 = __builtin_amdgcn_mfma_f32_32x32x16_bf16(k1, qf[d0], p1, 0, 0, 0);
        }
        float ls = 0.f;
#pragma unroll
        for (int r = 0; r < 16; ++r) { p0[r] = __builtin_amdgcn_exp2f(p0[r]); p1[r] = __builtin_amdgcn_exp2f(p1[r]); ls += p0[r] + p1[r]; }
        l += ls;
        u32x4 pw[4];
        pw[0].x = cvtpk(p0[0], p0[1]); pw[0].y = cvtpk(p0[2], p0[3]); pw[0].z = cvtpk(p0[4], p0[5]); pw[0].w = cvtpk(p0[6], p0[7]);
        pw[1].x = cvtpk(p0[8], p0[9]); pw[1].y = cvtpk(p0[10], p0[11]); pw[1].z = cvtpk(p0[12], p0[13]); pw[1].w = cvtpk(p0[14], p0[15]);
        pw[2].x = cvtpk(p1[0], p1[1]); pw[2].y = cvtpk(p1[2], p1[3]); pw[2].z = cvtpk(p1[4], p1[5]); pw[2].w = cvtpk(p1[6], p1[7]);
        pw[3].x = cvtpk(p1[8], p1[9]); pw[3].y = cvtpk(p1[10], p1[11]); pw[3].z = cvtpk(p1[12], p1[13]); pw[3].w = cvtpk(p1[14], p1[15]);
        const LDSAS unsigned char* vb = lds + buf * 16384 + vroff;
#pragma unroll
        for (int d0 = 0; d0 < 4; ++d0)
#pragma unroll
            for (int ks = 0; ks < 4; ++ks) {
                const s16x4 lo = vtr(vb + d0 * 4096 + ks * 1024), hh = vtr(vb + d0 * 4096 + ks * 1024 + 512);
                const bf16x8 vf = (bf16x8){lo[0], lo[1], lo[2], lo[3], hh[0], hh[1], hh[2], hh[3]};
                o[d0] = __builtin_amdgcn_mfma_f32_32x32x16_bf16(__builtin_bit_cast(bf16x8, pw[ks]), vf, o[d0], 0, 0, 0);
            }
        if (t + 1 < t_end) AB_LWRITE(buf ^ 1);
        __syncthreads();
    }
#undef AB_GLOAD
#undef AB_LWRITE
    l += __shfl_xor(l, 32);
    LDSAS float* scr = (LDSAS float*)(lds + AB_SCR + wid * 256);
    LDSAS float* xch = (LDSAS float*)(lds + AB_XCH + qt * 16896);
    if (hi == 0) scr[r32] = (s ? lam : 1.0f) / l;
    float rl[16];
#pragma unroll
    for (int r = 0; r < 16; ++r) rl[r] = scr[crow(r, hi)];
    if (s == 1) {
#pragma unroll
        for (int d0 = 0; d0 < 4; ++d0)
#pragma unroll
            for (int r = 0; r < 16; ++r) xch[crow(r, hi) * 132 + d0 * 32 + r32] = o[d0][r] * rl[r];
    }
    __syncthreads();
    if (s == 0) {
        float ss[16];
#pragma unroll
        for (int r = 0; r < 16; ++r) {
            float s2 = 0.f;
#pragma unroll
            for (int d0 = 0; d0 < 4; ++d0) { const float v = o[d0][r] * rl[r] - xch[crow(r, hi) * 132 + d0 * 32 + r32]; o[d0][r] = v; s2 += v * v; }
            ss[r] = s2;
        }
#pragma unroll
        for (int r = 0; r < 16; ++r) {
            float s2 = ss[r];
            s2 += __shfl_xor(s2, 1); s2 += __shfl_xor(s2, 2); s2 += __shfl_xor(s2, 4); s2 += __shfl_xor(s2, 8); s2 += __shfl_xor(s2, 16);
            ss[r] = rsqrtf(s2 * (1.0f / 128.0f) + EPS) * (1.0f - LAMBDA_INIT);
        }
#pragma unroll
        for (int d0 = 0; d0 < 4; ++d0) {
            const float sl = P.b_subln[d0 * 32 + r32];
#pragma unroll
            for (int r = 0; r < 16; ++r) xch[crow(r, hi) * 132 + d0 * 32 + r32] = o[d0][r] * ss[r] * sl;
        }
        const int eq = lane >> 1, eseg = lane & 1;
        const size_t grow = (size_t)(qrow0 + qt * 32 + eq);
        const u32x4* gp = (const u32x4*)(P.GB + grow * 512 + h * 128 + eseg * 64);
        u32x4* op = (u32x4*)(P.O + grow * 1024 + 512 + h * 128 + eseg * 64);
#pragma unroll
        for (int i = 0; i < 8; ++i) {
            const f32x4 a = *(const LDSAS f32x4*)(xch + eq * 132 + eseg * 64 + i * 8), c = *(const LDSAS f32x4*)(xch + eq * 132 + eseg * 64 + i * 8 + 4);
            const u32x4 g = gp[i]; u32x4 ov;
            ov.x = cvtpk(a[0] * bflo(g.x), a[1] * bfhi(g.x)); ov.y = cvtpk(a[2] * bflo(g.y), a[3] * bfhi(g.y));
            ov.z = cvtpk(c[0] * bflo(g.z), c[1] * bfhi(g.z)); ov.w = cvtpk(c[2] * bflo(g.w), c[3] * bfhi(g.w));
            op[i] = ov;
        }
    }
    __syncthreads();
}

__device__ void phase_attnB_mfma(const Params& P, LDSAS unsigned char* lds, int vb, int nvb) {
    float d1 = 0.f, d2 = 0.f;
    for (int i = 0; i < 64; ++i) { d1 += P.lq1[i] * P.lk1[i]; d2 += P.lq2[i] * P.lk2[i]; }
    const float lam = expf(d1) - expf(d2) + LAMBDA_INIT;
    for (int u = vb; u < 2048 + 256; u += nvb) {
        if (u < 2048) {
            int pair, qblk;
            if (nvb == 256) { const int round = u >> 8, i = u & 255, xcd = i & 7, slot = i >> 3; pair = round * 16 + xcd * 2 + (slot >> 4); qblk = slot & 15; }
            else { pair = u >> 4; qblk = u & 15; }
            const int b = pair >> 2, h = pair & 3;
            attnB_unit(P, lds, b, h, b * 2048 + qblk * 128, 0, 36, lam);
        } else {
            const int v = u - 2048, pair = v >> 1, qblk = v & 1, b = pair >> 2, h = pair & 3;
            attnB_unit(P, lds, b, h, ML + b * 256 + qblk * 128, 32, 36, lam);
        }
    }
}

__device__ void phase_gla(const Params& P, float* lds, int vb, int nvb) {
    float* sa = lds; float* sk = lds + 128; float* sq = lds + 256;
    const int e = threadIdx.x;
    for (int unit = vb; unit < NB * 4 * 2; unit += nvb) {
        const int dr = unit & 1, h = (unit >> 1) & 3, b = unit >> 3;
        const float* wa = dr ? P.wa_b : P.wa_f; const float* ba = dr ? P.ba_b : P.ba_f;
        float S[128];
#pragma unroll
        for (int d = 0; d < 128; ++d) S[d] = 0.f;
        float war[16], bav = 0.f;
        if (e < 128) {
#pragma unroll
            for (int j = 0; j < 16; ++j) war[j] = wa[j * 512 + h * 128 + e];
            bav = ba[h * 128 + e];
        }
        for (int step = 0; step < L + T; ++step) {
            int m;
            if (step < L) m = ML + b * L + (dr ? L - 1 - step : step);
            else { const int t = step - L; m = b * T + (dr ? T - 1 - t : t); }
            __syncthreads();
            if (e < 128) {
                const float* rf = P.RF + (size_t)m * 32 + dr * 16;
                float z = bav;
#pragma unroll
                for (int j = 0; j < 16; ++j) z += rf[j] * war[j];
                const float ls = fminf(z, 0.f) - log1pf(expf(-fabsf(z)));
                sa[e] = expf(ls * (1.0f / 16.0f));
                sk[e] = bf2f(P.KG[(size_t)m * 512 + h * 128 + e]);
                sq[e] = bf2f(P.QG[(size_t)m * 512 + h * 128 + e]);
            }
            __syncthreads();
            if (e < 256) {
            const float v = bf2f(P.VG[(size_t)m * 1024 + h * 256 + e]);
            float o = 0.f;
#pragma unroll
            for (int d = 0; d < 128; ++d) { S[d] = sa[d] * S[d] + sk[d] * v; o += sq[d] * S[d]; }
            if (m < ML) P.OD[((size_t)dr * ML + m) * 1024 + h * 256 + e] = (bf16_t)f2bf(o);
            }
        }
    }
}

__device__ void phase_finish(const Params& P, int vb, int nvb) {
    const int lane = threadIdx.x & 63, wpb = blockDim.x >> 6, w = threadIdx.x >> 6;
    for (int row = vb * wpb + w; row < ML; row += nvb * wpb) {
        const int c0 = lane * 16;
        float v[16];
        const u32x4* pf = (const u32x4*)(P.OD + (size_t)row * 1024 + c0);
        const u32x4* pb = (const u32x4*)(P.OD + ((size_t)ML + row) * 1024 + c0);
        float ss = 0.f;
#pragma unroll
        for (int i = 0; i < 2; ++i) {
            const u32x4 a = pf[i], bq = pb[i];
            v[8 * i] = bflo(a.x) + bflo(bq.x); v[8 * i + 1] = bfhi(a.x) + bfhi(bq.x); v[8 * i + 2] = bflo(a.y) + bflo(bq.y); v[8 * i + 3] = bfhi(a.y) + bfhi(bq.y);
            v[8 * i + 4] = bflo(a.z) + bflo(bq.z); v[8 * i + 5] = bfhi(a.z) + bfhi(bq.z); v[8 * i + 6] = bflo(a.w) + bflo(bq.w); v[8 * i + 7] = bfhi(a.w) + bfhi(bq.w);
        }
#pragma unroll
        for (int i = 0; i < 16; ++i) ss += v[i] * v[i];
        ss += __shfl_xor(ss, 1); ss += __shfl_xor(ss, 2); ss += __shfl_xor(ss, 4); ss += __shfl_xor(ss, 8);
        const float rn = rsqrtf(ss * (1.0f / 256.0f) + EPS);
        const float* gn = P.gla_out_norm + (c0 & 255);
        const u32x4* gp = (const u32x4*)(P.GG + (size_t)row * 1024 + c0);
        u32x4* op = (u32x4*)(P.A2 + (size_t)row * 1024 + c0);
#pragma unroll
        for (int i = 0; i < 2; ++i) {
            const u32x4 g = gp[i]; u32x4 r;
            r.x = pack2(v[8 * i] * rn * gn[8 * i] * bflo(g.x), v[8 * i + 1] * rn * gn[8 * i + 1] * bfhi(g.x));
            r.y = pack2(v[8 * i + 2] * rn * gn[8 * i + 2] * bflo(g.y), v[8 * i + 3] * rn * gn[8 * i + 3] * bfhi(g.y));
            r.z = pack2(v[8 * i + 4] * rn * gn[8 * i + 4] * bflo(g.z), v[8 * i + 5] * rn * gn[8 * i + 5] * bfhi(g.z));
            r.w = pack2(v[8 * i + 6] * rn * gn[8 * i + 6] * bflo(g.w), v[8 * i + 7] * rn * gn[8 * i + 7] * bfhi(g.w));
            op[i] = r;
        }
    }
}

namespace cg = cooperative_groups;
__global__ void __launch_bounds__(512) mega_kernel(Params P) {
    __shared__ __attribute__((aligned(16))) unsigned char lds[AB_LDS];
    cg::grid_group grid = cg::this_grid();
    const int vb = blockIdx.x, nvb = gridDim.x;
    phase_wt(P, vb, nvb); phase_adaln(P, vb, nvb); phase_rope(P, vb, nvb);
    grid.sync();
    phase_bias(P, vb, nvb); phase_a0(P, vb, nvb);
    grid.sync();
    { EpiIn0 E{P.parts, 1, P.bias0, P.a_q_norm, P.a_k_norm, P.b_q_norm, P.b_k_norm, P.rope, P.QA, P.KA, P.VA, P.GA, P.QB, P.KB, P.VB, P.GB};
      gemm_simple(P.A, P.Wt0, M / 256, N0 / 256, E, lds, vb, nvb); }
    grid.sync();
    phase_attnA(P, vb, nvb); phase_attnB_mfma(P, (LDSAS unsigned char*)lds, vb, nvb);
    grid.sync();
    { EpiOut0 E{P.x, P.ctx, P.mod, P.norm_g + D, P.out, P.A, P.parts};
      gemm_simple(P.O, P.Wo0, M / 256, D / 256, E, lds, vb, nvb); }
    grid.sync();
    { EpiIn1 E{P.parts, 16, P.bias1, P.QG, P.KG, P.VG, P.GG, P.RF};
      gemm_simple(P.A, P.Wt1, M / 256, N1 / 256, E, lds, vb, nvb); }
    grid.sync();
    phase_gla(P, (float*)lds, vb, nvb);
    grid.sync();
    phase_finish(P, vb, nvb);
    grid.sync();
    { EpiOut1 E{P.mod, P.out};
      gemm_simple(P.A2, P.Wo1, ML / 256, D / 256, E, lds, vb, nvb); }
}
}

extern "C" void kernel_launch(void* const* d_in, const int* in_sizes, int n_in, void* d_out, int out_size, void* d_ws, size_t ws_size, hipStream_t stream) {
    Params P{};
    const float* const* in = (const float* const*)d_in;
    P.x = in[0]; P.c = in[1]; P.ctx = in[2]; P.c_ctx = in[3]; P.adaln_w = in[4]; P.adaln_b = in[5]; P.norm_g = in[6]; P.w_out = in[7]; P.ab_w_in = in[8];
    P.a_q_norm = in[9]; P.a_k_norm = in[10]; P.a_sink = in[11]; P.b_q_norm = in[12]; P.b_k_norm = in[13]; P.lq1 = in[14]; P.lk1 = in[15]; P.lq2 = in[16]; P.lk2 = in[17];
    P.b_subln = in[18]; P.gla_w_in = in[19]; P.wa_f = in[20]; P.ba_f = in[21]; P.wa_b = in[22]; P.ba_b = in[23]; P.gla_out_norm = in[24];
    P.out = (float*)d_out;
    unsigned char* w = (unsigned char*)d_ws; size_t off = 0;
    auto take = [&](size_t bytes) { unsigned char* p = w + off; off += (bytes + 255) & ~(size_t)255; return p; };
    P.Wt0 = (bf16_t*)take((size_t)N0 * D * 2); P.Wt1 = (bf16_t*)take((size_t)N1 * D * 2); P.Wo0 = (bf16_t*)take((size_t)D * D * 2); P.Wo1 = (bf16_t*)take((size_t)D * D * 2);
    P.mod = (float*)take((size_t)2 * 33 * 3072 * 4); P.bias0 = (float*)take((size_t)33 * 3328 * 4); P.bias1 = (float*)take((size_t)33 * 3328 * 4);
    P.rope = (float*)take(64 * 16 * 2 * 4); P.parts = (float*)take((size_t)16 * M * 4);
    P.A = (bf16_t*)take((size_t)M * D * 2); P.O = (bf16_t*)take((size_t)M * D * 2);
    unsigned char* qkv = take((size_t)M * 3328 * 2);
    {
        unsigned char* q = qkv;
        P.QA = (bf16_t*)q; q += (size_t)M * 512 * 2; P.KA = (bf16_t*)q; q += (size_t)M * 128 * 2; P.VA = (bf16_t*)q; q += (size_t)M * 128 * 2; P.GA = (bf16_t*)q; q += (size_t)M * 512 * 2;
        P.QB = (bf16_t*)q; q += (size_t)M * 512 * 2; P.KB = (bf16_t*)q; q += (size_t)M * 512 * 2; P.VB = (bf16_t*)q; q += (size_t)M * 512 * 2; P.GB = (bf16_t*)q;
        q = qkv;
        P.QG = (bf16_t*)q; q += (size_t)M * 512 * 2; P.KG = (bf16_t*)q; q += (size_t)M * 512 * 2; P.VG = (bf16_t*)q; q += (size_t)M * 1024 * 2; P.GG = (bf16_t*)q; q += (size_t)M * 1024 * 2; P.RF = (float*)q;
        P.A2 = (bf16_t*)qkv;
        P.OD = P.A;
    }
    if (off > ws_size) { fprintf(stderr, "workspace too small: need %zu have %zu\n", off, ws_size); return; }
    static int grid_blocks = 0;
    if (!grid_blocks) {
        int dev = 0, cus = 0, per_cu = 0;
        (void)hipGetDevice(&dev);
        (void)hipDeviceGetAttribute(&cus, hipDeviceAttributeMultiprocessorCount, dev);
        (void)hipOccupancyMaxActiveBlocksPerMultiprocessor(&per_cu, mega_kernel, 512, 0);
        if (per_cu > 1) per_cu = 1;
        grid_blocks = cus * per_cu;
    }
    void* args[] = {&P};
    hipError_t e = hipLaunchCooperativeKernel((void*)mega_kernel, dim3(grid_blocks), dim3(512), args, 0, stream);
    if (e != hipSuccess) fprintf(stderr, "cooperative launch failed: %s (grid %d)\n", hipGetErrorString(e), grid_blocks);
}
```

```cpp
#include <hip/hip_runtime.h>
#include <hip/hip_cooperative_groups.h>
#include <cstdint>
#include <cstdio>

namespace {
constexpr int NB = 32, T = 2048, L = 256, D = 1024;
constexpr int ML = NB * T, MC = NB * L, M = ML + MC;
constexpr int N0 = 3328, N1 = 3328, N0R = 3328, N1R = 3104;
constexpr float EPS = 1e-6f;
constexpr float LOG2E = 1.4426950408889634f;
constexpr float QSCALE = 0.125f * LOG2E;
constexpr float LAMBDA_INIT = 0.2f;

typedef unsigned short bf16_t;
typedef short bf16x8 __attribute__((ext_vector_type(8)));
typedef float f32x4 __attribute__((ext_vector_type(4)));
typedef unsigned u32x4 __attribute__((ext_vector_type(4)));
typedef unsigned u32x2 __attribute__((ext_vector_type(2)));

struct Params {
    const float *x, *c, *ctx, *c_ctx, *adaln_w, *adaln_b, *norm_g, *w_out, *ab_w_in, *a_q_norm, *a_k_norm, *a_sink, *b_q_norm, *b_k_norm;
    const float *lq1, *lk1, *lq2, *lk2, *b_subln, *gla_w_in, *wa_f, *ba_f, *wa_b, *ba_b, *gla_out_norm;
    float* out;
    bf16_t *Wt0, *Wt1, *Wo0, *Wo1;
    float *mod, *bias0, *bias1, *rope, *parts;
    bf16_t *A, *O;
    bf16_t *QA, *KA, *VA, *GA, *QB, *KB, *VB, *GB;
    bf16_t *QG, *KG, *VG, *GG; float* RF;
    bf16_t *OD, *A2;
};

__device__ __forceinline__ unsigned f2bf(float f) { unsigned u = __float_as_uint(f); u += 0x7FFFu + ((u >> 16) & 1u); return u >> 16; }
__device__ __forceinline__ unsigned pack2(float lo, float hi) { return f2bf(lo) | (f2bf(hi) << 16); }
__device__ __forceinline__ float bf2f(unsigned h) { return __uint_as_float(h << 16); }
__device__ __forceinline__ float bflo(unsigned w) { return __uint_as_float(w << 16); }
__device__ __forceinline__ float bfhi(unsigned w) { return __uint_as_float(w & 0xFFFF0000u); }
__device__ __forceinline__ float siluf(float v) { return v / (1.0f + __expf(-v)); }

__device__ __forceinline__ int perm_local(int p, bool ropeType) {
    const int bj = p >> 7, wc = (p >> 5) & 3, low = p & 31;
    if (ropeType) return wc * 64 + bj * 32 + low;
    const int n = (low >> 4) & 1, fq = (low >> 2) & 3, e = low & 3;
    return wc * 64 + bj * 32 + fq * 8 + n * 4 + e;
}
__device__ __forceinline__ int src_col(int which, int np) {
    const int p = np & 255, tile = np >> 8;
    bool rope = false;
    if (which == 0) { const int g = tile * 4 + ((p >> 5) & 3); rope = (g < 10) || (g >= 20 && g < 36); }
    const int c = tile * 256 + perm_local(p, rope);
    const int nreal = which == 0 ? N0R : (which == 1 ? N1R : D);
    return c < nreal ? c : -1;
}

__device__ void phase_wt(const Params& P, int vb, int nvb) {
    const long total = (long)(N0 + N1 + D + D) * D;
    for (long idx = (long)vb * blockDim.x + threadIdx.x; idx < total; idx += (long)nvb * blockDim.x) {
        long i = idx; int which; const float* W; bf16_t* dst; int ldw;
        if (i < (long)N0 * D) { which = 0; W = P.ab_w_in; dst = P.Wt0; ldw = N0R; }
        else if ((i -= (long)N0 * D) < (long)N1 * D) { which = 1; W = P.gla_w_in; dst = P.Wt1; ldw = N1R; }
        else if ((i -= (long)N1 * D) < (long)D * D) { which = 2; W = P.w_out; dst = P.Wo0; ldw = D; }
        else { i -= (long)D * D; which = 3; W = P.w_out + (size_t)D * D; dst = P.Wo1; ldw = D; }
        const int np = (int)(i >> 10), k = (int)(i & 1023);
        const int sc = src_col(which, np);
        const float v = sc >= 0 ? W[(size_t)k * ldw + sc] : 0.f;
        dst[i] = (bf16_t)f2bf(v);
    }
}

__device__ void phase_adaln(const Params& P, int vb, int nvb) {
    for (int idx = vb * blockDim.x + threadIdx.x; idx < 2 * 3072; idx += nvb * blockDim.x) {
        const int l = idx / 3072, j = idx % 3072;
        float acc[33];
#pragma unroll
        for (int r = 0; r < 33; ++r) acc[r] = 0.f;
        const float* w = P.adaln_w + (size_t)l * D * 3072 + j;
        for (int k = 0; k < D; ++k) {
            const float wv = w[(size_t)k * 3072];
#pragma unroll
            for (int r = 0; r < 33; ++r) { const float cv = r < 32 ? P.c[r * D + k] : P.c_ctx[k]; acc[r] += siluf(cv) * wv; }
        }
        const float bv = P.adaln_b[l * 3072 + j];
#pragma unroll
        for (int r = 0; r < 33; ++r) P.mod[((size_t)l * 33 + r) * 3072 + j] = acc[r] + bv;
    }
}

__device__ void phase_rope(const Params& P, int vb, int nvb) {
    for (int idx = vb * blockDim.x + threadIdx.x; idx < 64 * 16; idx += nvb * blockDim.x) {
        const int pos = idx >> 4, i = idx & 15;
        const double inv = pow(10000.0, -(double)i / 16.0);
        const double ang = (double)((float)pos * (float)inv);
        P.rope[idx * 2 + 0] = (float)cos(ang);
        P.rope[idx * 2 + 1] = (float)sin(ang);
    }
}

__device__ void phase_bias(const Params& P, int vb, int nvb) {
    for (int idx = vb * blockDim.x + threadIdx.x; idx < N0 + N1; idx += nvb * blockDim.x) {
        const int l = idx >= N0, np = l ? idx - N0 : idx;
        const int sc = src_col(l, np);
        float acc[33];
#pragma unroll
        for (int r = 0; r < 33; ++r) acc[r] = 0.f;
        if (sc >= 0) {
            const float* W = l ? P.gla_w_in : P.ab_w_in; const int ldw = l ? N1R : N0R;
            const float* sh = P.mod + (size_t)l * 33 * 3072;
            for (int k = 0; k < D; ++k) {
                const float wv = W[(size_t)k * ldw + sc];
#pragma unroll
                for (int r = 0; r < 33; ++r) acc[r] += sh[r * 3072 + k] * wv;
            }
        }
        float* dst = l ? P.bias1 : P.bias0;
#pragma unroll
        for (int r = 0; r < 33; ++r) dst[r * 3328 + np] = acc[r];
    }
}

__device__ void phase_a0(const Params& P, int vb, int nvb) {
    const int lane = threadIdx.x & 63, wpb = blockDim.x >> 6, w = threadIdx.x >> 6;
    for (int row = vb * wpb + w; row < M; row += nvb * wpb) {
        const float* xin = row < ML ? P.x + (size_t)row * D : P.ctx + (size_t)(row - ML) * D;
        const int r = row < ML ? row >> 11 : 32;
        const float* sc = P.mod + (size_t)r * 3072 + 1024;
        float ss = 0.f;
#pragma unroll
        for (int i = 0; i < 2; ++i) {
            const int c0 = i * 512 + lane * 8;
            const f32x4 a = *(const f32x4*)(xin + c0), b = *(const f32x4*)(xin + c0 + 4);
            const f32x4 g0 = *(const f32x4*)(P.norm_g + c0), g1 = *(const f32x4*)(P.norm_g + c0 + 4);
            const f32x4 s0 = *(const f32x4*)(sc + c0), s1 = *(const f32x4*)(sc + c0 + 4);
            ss += a[0] * a[0] + a[1] * a[1] + a[2] * a[2] + a[3] * a[3] + b[0] * b[0] + b[1] * b[1] + b[2] * b[2] + b[3] * b[3];
            const f32x4 ya = a * g0 * (1.0f + s0), yb = b * g1 * (1.0f + s1);
            u32x4 o; o.x = pack2(ya[0], ya[1]); o.y = pack2(ya[2], ya[3]); o.z = pack2(yb[0], yb[1]); o.w = pack2(yb[2], yb[3]);
            *(u32x4*)(P.A + (size_t)row * D + c0) = o;
        }
#pragma unroll
        for (int o = 32; o >= 1; o >>= 1) ss += __shfl_xor(ss, o);
        if (lane == 0) P.parts[row] = ss;
    }
}

struct EpiIn0 {
    const float* parts; int nparts; const float* bias;
    const float *aqn, *akn, *bqn, *bkn, *rope;
    bf16_t *QA, *KA, *VA, *GA, *QB, *KB, *VB, *GB;
    __device__ __forceinline__ void operator()(const f32x4 (&acc)[2][2][4][2], int pm, int pn, int wr, int wc, int fr, int fq) const {
        const int g = 4 * pn + wc;
        bf16_t* dst; int ld, col, type; const float* gain = nullptr;
        if (g < 8) { dst = QA; ld = 512; col = g * 64; type = 2; gain = aqn; }
        else if (g < 10) { dst = KA; ld = 128; col = (g - 8) * 64; type = 3; gain = akn; }
        else if (g < 12) { dst = VA; ld = 128; col = (g - 10) * 64; type = 0; }
        else if (g < 20) { dst = GA; ld = 512; col = (g - 12) * 64; type = 1; }
        else if (g < 28) { dst = QB; ld = 512; col = (g - 20) * 64; type = 2; gain = bqn; }
        else if (g < 36) { dst = KB; ld = 512; col = (g - 28) * 64; type = 3; gain = bkn; }
        else if (g < 44) { dst = VB; ld = 512; col = (g - 36) * 64; type = 0; }
        else { dst = GB; ld = 512; col = (g - 44) * 64; type = 1; }
#pragma unroll
        for (int ai = 0; ai < 2; ++ai)
#pragma unroll
            for (int m = 0; m < 4; ++m) {
                const int row = pm * 256 + ai * 128 + wr * 64 + m * 16 + fr;
                float ss = 0.f;
                for (int i = 0; i < nparts; ++i) ss += parts[(size_t)i * M + row];
                const float rstd = rsqrtf(ss * (1.0f / 1024.0f) + EPS);
                const int r = row < ML ? row >> 11 : 32;
                const float* bptr = bias + (size_t)r * 3328 + pn * 256 + wc * 32 + fq * 4;
                f32x4 v[2][2];
#pragma unroll
                for (int bj = 0; bj < 2; ++bj)
#pragma unroll
                    for (int n = 0; n < 2; ++n) v[bj][n] = acc[ai][bj][m][n] * rstd + *(const f32x4*)(bptr + bj * 128 + n * 16);
                if (type >= 2) {
                    float s2 = 0.f;
#pragma unroll
                    for (int bj = 0; bj < 2; ++bj)
#pragma unroll
                        for (int n = 0; n < 2; ++n) s2 += v[bj][n][0] * v[bj][n][0] + v[bj][n][1] * v[bj][n][1] + v[bj][n][2] * v[bj][n][2] + v[bj][n][3] * v[bj][n][3];
                    s2 += __shfl_xor(s2, 16); s2 += __shfl_xor(s2, 32);
                    const float rn = rsqrtf(s2 * (1.0f / 64.0f) + EPS);
#pragma unroll
                    for (int bj = 0; bj < 2; ++bj)
#pragma unroll
                        for (int n = 0; n < 2; ++n) v[bj][n] = v[bj][n] * rn * *(const f32x4*)(gain + bj * 32 + n * 16 + fq * 4);
                    if (row < ML) {
                        const int t = row & 2047;
#pragma unroll
                        for (int bj = 0; bj < 2; ++bj) {
                            const int pos = bj == 0 ? (t >> 6) : (t & 63);
                            const float* cs = rope + (pos * 16 + fq * 4) * 2;
                            const f32x4 c01 = *(const f32x4*)cs, c23 = *(const f32x4*)(cs + 4);
                            const float cc[4] = {c01[0], c01[2], c23[0], c23[2]}, sn[4] = {c01[1], c01[3], c23[1], c23[3]};
#pragma unroll
                            for (int e = 0; e < 4; ++e) { const float x1 = v[bj][0][e], x2 = v[bj][1][e]; v[bj][0][e] = x1 * cc[e] - x2 * sn[e]; v[bj][1][e] = x2 * cc[e] + x1 * sn[e]; }
                        }
                    }
                    if (type == 2) {
#pragma unroll
                        for (int bj = 0; bj < 2; ++bj)
#pragma unroll
                            for (int n = 0; n < 2; ++n) v[bj][n] = v[bj][n] * QSCALE;
                    }
                } else if (type == 1) {
#pragma unroll
                    for (int bj = 0; bj < 2; ++bj)
#pragma unroll
                        for (int n = 0; n < 2; ++n)
#pragma unroll
                            for (int e = 0; e < 4; ++e) v[bj][n][e] = siluf(v[bj][n][e]);
                }
#pragma unroll
                for (int bj = 0; bj < 2; ++bj) {
                    u32x4 o; o.x = pack2(v[bj][0][0], v[bj][0][1]); o.y = pack2(v[bj][0][2], v[bj][0][3]); o.z = pack2(v[bj][1][0], v[bj][1][1]); o.w = pack2(v[bj][1][2], v[bj][1][3]);
                    *(u32x4*)(dst + (size_t)row * ld + col + bj * 32 + fq * 8) = o;
                }
            }
    }
};

struct EpiIn1 {
    const float* parts; int nparts; const float* bias;
    bf16_t *QG, *KG, *VG, *GG; float* RF;
    __device__ __forceinline__ void operator()(const f32x4 (&acc)[2][2][4][2], int pm, int pn, int wr, int wc, int fr, int fq) const {
        const int g = 4 * pn + wc;
        if (g > 48) return;
        bf16_t* dst = nullptr; int ld = 0, col = 0, type;
        if (g < 8) { dst = QG; ld = 512; col = g * 64; type = 2; }
        else if (g < 16) { dst = KG; ld = 512; col = (g - 8) * 64; type = 0; }
        else if (g < 32) { dst = VG; ld = 1024; col = (g - 16) * 64; type = 0; }
        else if (g < 48) { dst = GG; ld = 1024; col = (g - 32) * 64; type = 1; }
        else type = 3;
#pragma unroll
        for (int ai = 0; ai < 2; ++ai)
#pragma unroll
            for (int m = 0; m < 4; ++m) {
                const int row = pm * 256 + ai * 128 + wr * 64 + m * 16 + fr;
                float ss = 0.f;
                for (int i = 0; i < nparts; ++i) ss += parts[(size_t)i * M + row];
                const float rstd = rsqrtf(ss * (1.0f / 1024.0f) + EPS);
                const int r = row < ML ? row >> 11 : 32;
                const float* bptr = bias + (size_t)r * 3328 + pn * 256 + wc * 32 + fq * 4;
                f32x4 v[2][2];
#pragma unroll
                for (int bj = 0; bj < 2; ++bj)
#pragma unroll
                    for (int n = 0; n < 2; ++n) v[bj][n] = acc[ai][bj][m][n] * rstd + *(const f32x4*)(bptr + bj * 128 + n * 16);
                if (type == 3) {
                    *(f32x4*)(RF + (size_t)row * 32 + fq * 8) = v[0][0];
                    *(f32x4*)(RF + (size_t)row * 32 + fq * 8 + 4) = v[0][1];
                    continue;
                }
                if (type == 2) {
#pragma unroll
                    for (int bj = 0; bj < 2; ++bj)
#pragma unroll
                        for (int n = 0; n < 2; ++n) v[bj][n] = v[bj][n] * 0.08838834764831845f;
                } else if (type == 1) {
#pragma unroll
                    for (int bj = 0; bj < 2; ++bj)
#pragma unroll
                        for (int n = 0; n < 2; ++n)
#pragma unroll
                            for (int e = 0; e < 4; ++e) v[bj][n][e] = siluf(v[bj][n][e]);
                }
#pragma unroll
                for (int bj = 0; bj < 2; ++bj) {
                    u32x4 o; o.x = pack2(v[bj][0][0], v[bj][0][1]); o.y = pack2(v[bj][0][2], v[bj][0][3]); o.z = pack2(v[bj][1][0], v[bj][1][1]); o.w = pack2(v[bj][1][2], v[bj][1][3]);
                    *(u32x4*)(dst + (size_t)row * ld + col + bj * 32 + fq * 8) = o;
                }
            }
    }
};

struct EpiOut0 {
    const float *x, *ctx, *mod, *g1; float* out; bf16_t* A1; float* parts;
    __device__ __forceinline__ void operator()(const f32x4 (&acc)[2][2][4][2], int pm, int pn, int wr, int wc, int fr, int fq) const {
#pragma unroll
        for (int ai = 0; ai < 2; ++ai)
#pragma unroll
            for (int m = 0; m < 4; ++m) {
                const int row = pm * 256 + ai * 128 + wr * 64 + m * 16 + fr;
                const int r = row < ML ? row >> 11 : 32;
                const float* xin = row < ML ? x + (size_t)row * D : ctx + (size_t)(row - ML) * D;
                const float* gt = mod + (size_t)r * 3072 + 2048;
                const float* sc = mod + (size_t)(33 + r) * 3072 + 1024;
                float ss = 0.f;
#pragma unroll
                for (int bj = 0; bj < 2; ++bj) {
                    const int c = pn * 256 + wc * 64 + bj * 32 + fq * 8;
                    f32x4 y[2];
#pragma unroll
                    for (int n = 0; n < 2; ++n) {
                        const f32x4 x1 = *(const f32x4*)(xin + c + n * 4) + *(const f32x4*)(gt + c + n * 4) * acc[ai][bj][m][n];
                        ss += x1[0] * x1[0] + x1[1] * x1[1] + x1[2] * x1[2] + x1[3] * x1[3];
                        if (row < ML) *(f32x4*)(out + (size_t)row * D + c + n * 4) = x1;
                        y[n] = x1 * *(const f32x4*)(g1 + c + n * 4) * (1.0f + *(const f32x4*)(sc + c + n * 4));
                    }
                    u32x4 o; o.x = pack2(y[0][0], y[0][1]); o.y = pack2(y[0][2], y[0][3]); o.z = pack2(y[1][0], y[1][1]); o.w = pack2(y[1][2], y[1][3]);
                    *(u32x4*)(A1 + (size_t)row * D + c) = o;
                }
                ss += __shfl_xor(ss, 16); ss += __shfl_xor(ss, 32);
                if (fq == 0) parts[(size_t)(4 * pn + wc) * M + row] = ss;
            }
    }
};

struct EpiOut1 {
    const float* mod; float* out;
    __device__ __forceinline__ void operator()(const f32x4 (&acc)[2][2][4][2], int pm, int pn, int wr, int wc, int fr, int fq) const {
#pragma unroll
        for (int ai = 0; ai < 2; ++ai)
#pragma unroll
            for (int m = 0; m < 4; ++m) {
                const int row = pm * 256 + ai * 128 + wr * 64 + m * 16 + fr;
                const int r = row >> 11;
                const float* gt = mod + (size_t)(33 + r) * 3072 + 2048;
#pragma unroll
                for (int bj = 0; bj < 2; ++bj)
#pragma unroll
                    for (int n = 0; n < 2; ++n) {
                        const int c = pn * 256 + wc * 64 + bj * 32 + fq * 8 + n * 4;
                        float* o = out + (size_t)row * D + c;
                        *(f32x4*)o = *(const f32x4*)o + *(const f32x4*)(gt + c) * acc[ai][bj][m][n];
                    }
            }
    }
};

template <class Epi>
__device__ void gemm_simple(const bf16_t* __restrict__ A, const bf16_t* __restrict__ Bt, int nM, int nN, const Epi& E, unsigned char* lds, int vb, int nvb) {
    const int tid = threadIdx.x, wid = tid >> 6, lane = tid & 63, wr = wid >> 2, wc = wid & 3, fr = lane & 15, fq = lane >> 4;
    unsigned char* ldsA = lds; unsigned char* ldsB = lds + 256 * 80;
    for (int tile = vb; tile < nM * nN; tile += nvb) {
        const int pm = tile / nN, pn = tile % nN;
        f32x4 acc[2][2][4][2];
#pragma unroll
        for (int a = 0; a < 2; ++a)
#pragma unroll
            for (int b = 0; b < 2; ++b)
#pragma unroll
                for (int m = 0; m < 4; ++m)
#pragma unroll
                    for (int n = 0; n < 2; ++n) acc[a][b][m][n] = (f32x4){0.f, 0.f, 0.f, 0.f};
        for (int k0 = 0; k0 < D; k0 += 32) {
            __syncthreads();
#pragma unroll
            for (int i = 0; i < 2; ++i) {
                const int cidx = tid + 512 * i, r = cidx >> 2, kc = cidx & 3;
                *(u32x4*)(ldsA + r * 80 + kc * 16) = *(const u32x4*)(A + (size_t)(pm * 256 + r) * D + k0 + kc * 8);
                *(u32x4*)(ldsB + r * 80 + kc * 16) = *(const u32x4*)(Bt + (size_t)(pn * 256 + r) * D + k0 + kc * 8);
            }
            __syncthreads();
            bf16x8 af[2][4], bfr[2][2];
#pragma unroll
            for (int ai = 0; ai < 2; ++ai)
#pragma unroll
                for (int m = 0; m < 4; ++m) af[ai][m] = *(const bf16x8*)(ldsA + (ai * 128 + wr * 64 + m * 16 + fr) * 80 + fq * 16);
#pragma unroll
            for (int bj = 0; bj < 2; ++bj)
#pragma unroll
                for (int n = 0; n < 2; ++n) bfr[bj][n] = *(const bf16x8*)(ldsB + (bj * 128 + wc * 32 + n * 16 + fr) * 80 + fq * 16);
#pragma unroll
            for (int ai = 0; ai < 2; ++ai)
#pragma unroll
                for (int bj = 0; bj < 2; ++bj)
#pragma unroll
                    for (int m = 0; m < 4; ++m)
#pragma unroll
                        for (int n = 0; n < 2; ++n) acc[ai][bj][m][n] = __builtin_amdgcn_mfma_f32_16x16x32_bf16(bfr[bj][n], af[ai][m], acc[ai][bj][m][n], 0, 0, 0);
        }
        E(acc, pm, pn, wr, wc, fr, fq);
    }
}

__device__ __forceinline__ float maxabs64(const float* g) { float m = 0.f; for (int i = 0; i < 64; ++i) m = fmaxf(m, fabsf(g[i])); return m; }

__device__ void phase_attnA(const Params& P, int vb, int nvb) {
    const float MA = 8.0f * maxabs64(P.a_q_norm) * maxabs64(P.a_k_norm) * LOG2E;
    for (long idx = (long)vb * blockDim.x + threadIdx.x; idx < (long)M * 8; idx += (long)nvb * blockDim.x) {
        const int h = (int)(idx / M), m = (int)(idx % M), kv = h >> 2;
        float q[64], o[64];
        {
            const u32x4* qp = (const u32x4*)(P.QA + (size_t)m * 512 + h * 64);
#pragma unroll
            for (int i = 0; i < 8; ++i) { const u32x4 w = qp[i]; q[8 * i] = bflo(w.x); q[8 * i + 1] = bfhi(w.x); q[8 * i + 2] = bflo(w.y); q[8 * i + 3] = bfhi(w.y); q[8 * i + 4] = bflo(w.z); q[8 * i + 5] = bfhi(w.z); q[8 * i + 6] = bflo(w.w); q[8 * i + 7] = bfhi(w.w); }
        }
#pragma unroll
        for (int i = 0; i < 64; ++i) o[i] = 0.f;
        float l = 0.f;
        int b, nlat = 0, j0 = 0;
        if (m < ML) { b = m >> 11; const int t = m & 2047; j0 = t - 128 < 0 ? 0 : t - 128; const int j1 = t + 128 > 2047 ? 2047 : t + 128; nlat = j1 - j0 + 1; }
        else b = (m - ML) >> 8;
        const int ntot = nlat + 256;
        for (int jj = 0; jj < ntot; ++jj) {
            const int kr = jj < nlat ? b * 2048 + j0 + jj : ML + b * 256 + (jj - nlat);
            const u32x4* kp = (const u32x4*)(P.KA + (size_t)kr * 128 + kv * 64);
            float s = 0.f;
#pragma unroll
            for (int i = 0; i < 8; ++i) { const u32x4 w = kp[i]; s += q[8 * i] * bflo(w.x) + q[8 * i + 1] * bfhi(w.x) + q[8 * i + 2] * bflo(w.y) + q[8 * i + 3] * bfhi(w.y) + q[8 * i + 4] * bflo(w.z) + q[8 * i + 5] * bfhi(w.z) + q[8 * i + 6] * bflo(w.w) + q[8 * i + 7] * bfhi(w.w); }
            const float p = exp2f(s - MA);
            l += p;
            const u32x4* vp = (const u32x4*)(P.VA + (size_t)kr * 128 + kv * 64);
#pragma unroll
            for (int i = 0; i < 8; ++i) { const u32x4 w = vp[i]; o[8 * i] += p * bflo(w.x); o[8 * i + 1] += p * bfhi(w.x); o[8 * i + 2] += p * bflo(w.y); o[8 * i + 3] += p * bfhi(w.y); o[8 * i + 4] += p * bflo(w.z); o[8 * i + 5] += p * bfhi(w.z); o[8 * i + 6] += p * bflo(w.w); o[8 * i + 7] += p * bfhi(w.w); }
        }
        l += exp2f(P.a_sink[h] * LOG2E - MA);
        const float inv = 1.0f / l;
        const u32x4* gp = (const u32x4*)(P.GA + (size_t)m * 512 + h * 64);
        u32x4* op = (u32x4*)(P.O + (size_t)m * 1024 + h * 64);
#pragma unroll
        for (int i = 0; i < 8; ++i) {
            const u32x4 w = gp[i]; u32x4 r;
            r.x = pack2(o[8 * i] * inv * bflo(w.x), o[8 * i + 1] * inv * bfhi(w.x)); r.y = pack2(o[8 * i + 2] * inv * bflo(w.y), o[8 * i + 3] * inv * bfhi(w.y));
            r.z = pack2(o[8 * i + 4] * inv * bflo(w.z), o[8 * i + 5] * inv * bfhi(w.z)); r.w = pack2(o[8 * i + 6] * inv * bflo(w.w), o[8 * i + 7] * inv * bfhi(w.w));
            op[i] = r;
        }
    }
}

__device__ void phase_attnB(const Params& P, int vb, int nvb) {
    const float MB = 8.0f * maxabs64(P.b_q_norm) * maxabs64(P.b_k_norm) * LOG2E;
    float d1 = 0.f, d2 = 0.f;
    for (int i = 0; i < 64; ++i) { d1 += P.lq1[i] * P.lk1[i]; d2 += P.lq2[i] * P.lk2[i]; }
    const float lam = expf(d1) - expf(d2) + LAMBDA_INIT;
    for (long idx = (long)vb * blockDim.x + threadIdx.x; idx < (long)M * 16; idx += (long)nvb * blockDim.x) {
        const int qt = (int)(idx & 3); const long hm = idx >> 2; const int h = (int)(hm / M), m = (int)(hm % M);
        int b, nlat;
        if (m < ML) { b = m >> 11; nlat = 2048; } else { b = (m - ML) >> 8; nlat = 0; }
        const int ntot = nlat + 256;
        float rres[32];
        for (int s = 0; s < 2; ++s) {
            const int g = 2 * h + s;
            float q[64], o[32];
            const u32x4* qp = (const u32x4*)(P.QB + (size_t)m * 512 + g * 64);
#pragma unroll
            for (int i = 0; i < 8; ++i) { const u32x4 w = qp[i]; q[8 * i] = bflo(w.x); q[8 * i + 1] = bfhi(w.x); q[8 * i + 2] = bflo(w.y); q[8 * i + 3] = bfhi(w.y); q[8 * i + 4] = bflo(w.z); q[8 * i + 5] = bfhi(w.z); q[8 * i + 6] = bflo(w.w); q[8 * i + 7] = bfhi(w.w); }
#pragma unroll
            for (int i = 0; i < 32; ++i) o[i] = 0.f;
            float l = 0.f;
            for (int jj = 0; jj < ntot; ++jj) {
                const int kr = jj < nlat ? b * 2048 + jj : ML + b * 256 + (jj - nlat);
                const u32x4* kp = (const u32x4*)(P.KB + (size_t)kr * 512 + g * 64);
                float sc = 0.f;
#pragma unroll
                for (int i = 0; i < 8; ++i) { const u32x4 w = kp[i]; sc += q[8 * i] * bflo(w.x) + q[8 * i + 1] * bfhi(w.x) + q[8 * i + 2] * bflo(w.y) + q[8 * i + 3] * bfhi(w.y) + q[8 * i + 4] * bflo(w.z) + q[8 * i + 5] * bfhi(w.z) + q[8 * i + 6] * bflo(w.w) + q[8 * i + 7] * bfhi(w.w); }
                const float p = exp2f(sc - MB);
                l += p;
                const u32x4* vp = (const u32x4*)(P.VB + (size_t)kr * 512 + h * 128 + qt * 32);
#pragma unroll
                for (int i = 0; i < 4; ++i) { const u32x4 w = vp[i]; o[8 * i] += p * bflo(w.x); o[8 * i + 1] += p * bfhi(w.x); o[8 * i + 2] += p * bflo(w.y); o[8 * i + 3] += p * bfhi(w.y); o[8 * i + 4] += p * bflo(w.z); o[8 * i + 5] += p * bfhi(w.z); o[8 * i + 6] += p * bflo(w.w); o[8 * i + 7] += p * bfhi(w.w); }
            }
            const float inv = 1.0f / l;
            if (s == 0) {
#pragma unroll
                for (int i = 0; i < 32; ++i) rres[i] = o[i] * inv;
            } else {
#pragma unroll
                for (int i = 0; i < 32; ++i) rres[i] -= lam * o[i] * inv;
            }
        }
        float ss = 0.f;
#pragma unroll
        for (int i = 0; i < 32; ++i) ss += rres[i] * rres[i];
        ss += __shfl_xor(ss, 1); ss += __shfl_xor(ss, 2);
        const float rn = rsqrtf(ss * (1.0f / 128.0f) + EPS) * (1.0f - LAMBDA_INIT);
        const u32x4* gp = (const u32x4*)(P.GB + (size_t)m * 512 + h * 128 + qt * 32);
        const float* sl = P.b_subln + qt * 32;
        u32x4* op = (u32x4*)(P.O + (size_t)m * 1024 + 512 + h * 128 + qt * 32);
#pragma unroll
        for (int i = 0; i < 4; ++i) {
            const u32x4 w = gp[i]; u32x4 r;
            r.x = pack2(rres[8 * i] * rn * sl[8 * i] * bflo(w.x), rres[8 * i + 1] * rn * sl[8 * i + 1] * bfhi(w.x));
            r.y = pack2(rres[8 * i + 2] * rn * sl[8 * i + 2] * bflo(w.y), rres[8 * i + 3] * rn * sl[8 * i + 3] * bfhi(w.y));
            r.z = pack2(rres[8 * i + 4] * rn * sl[8 * i + 4] * bflo(w.z), rres[8 * i + 5] * rn * sl[8 * i + 5] * bfhi(w.z));
            r.w = pack2(rres[8 * i + 6] * rn * sl[8 * i + 6] * bflo(w.w), rres[8 * i + 7] * rn * sl[8 * i + 7] * bfhi(w.w));
            op[i] = r;
        }
    }
}

typedef float f32x16 __attribute__((ext_vector_type(16)));
typedef short s16x4 __attribute__((ext_vector_type(4)));
typedef float f32x2_t __attribute__((ext_vector_type(2)));
typedef __bf16 bf16x2_t __attribute__((ext_vector_type(2)));
#define LDSAS __attribute__((address_space(3)))
__device__ __forceinline__ unsigned cvtpk(float lo, float hi) { f32x2_t v = {lo, hi}; bf16x2_t b = __builtin_convertvector(v, bf16x2_t); return __builtin_bit_cast(unsigned, b); }
__device__ __forceinline__ int crow(int r, int hi) { return (r & 3) + 8 * (r >> 2) + 4 * hi; }
__device__ __forceinline__ s16x4 vtr(const LDSAS unsigned char* p) { return __builtin_bit_cast(s16x4, __builtin_amdgcn_ds_read_tr16_b64_v4i16((LDSAS s16x4*)p)); }

constexpr int AB_K1 = 0, AB_K2 = 16384, AB_V = 32768;
constexpr int AB_XCH = 0, AB_SCR = 67584, AB_LDS = 67584 + 8 * 256;

__device__ __forceinline__ void attnB_unit(const Params& P, LDSAS unsigned char* lds, int b, int h, int qrow0, int t_begin, int t_end, float lam) {
    const int tid = threadIdx.x, lane = tid & 63, r32 = lane & 31, hi = lane >> 5;
    const int wid = __builtin_amdgcn_readfirstlane(tid >> 6);
    const int s = wid >> 2, qt = wid & 3;
    const int qrow = qrow0 + qt * 32 + r32;
    bf16x8 qf[4];
#pragma unroll
    for (int d0 = 0; d0 < 4; ++d0) qf[d0] = *(const bf16x8*)(P.QB + (size_t)qrow * 512 + (2 * h + s) * 64 + d0 * 16 + hi * 8);
    f32x16 o[4];
#pragma unroll
    for (int i = 0; i < 4; ++i) o[i] = (f32x16){};
    float l = 0.f;
    const int krow = tid >> 3, kch = tid & 7, vrow = tid >> 4, vch = tid & 15;
    const int kwoff = krow * 128 + ((kch ^ ((krow >> 1) & 7)) * 16);
    const int vwoff = (vch >> 2) * 4096 + vrow * 64 + (vch & 3) * 16;
    u32x4 rk1, rk2, rv0, rv1;
#define AB_GLOAD(t) do { const int kr0_ = (t) < 32 ? b * 2048 + 64 * (t) : ML + b * 256 + 64 * ((t) - 32); \
        rk1 = *(const u32x4*)(P.KB + (size_t)(kr0_ + krow) * 512 + (2 * h) * 64 + kch * 8); \
        rk2 = *(const u32x4*)(P.KB + (size_t)(kr0_ + krow) * 512 + (2 * h + 1) * 64 + kch * 8); \
        rv0 = *(const u32x4*)(P.VB + (size_t)(kr0_ + vrow) * 512 + h * 128 + vch * 8); \
        rv1 = *(const u32x4*)(P.VB + (size_t)(kr0_ + vrow + 32) * 512 + h * 128 + vch * 8); } while (0)
#define AB_LWRITE(buf) do { *(LDSAS u32x4*)(lds + AB_K1 + (buf) * 8192 + kwoff) = rk1; *(LDSAS u32x4*)(lds + AB_K2 + (buf) * 8192 + kwoff) = rk2; \
        *(LDSAS u32x4*)(lds + AB_V + (buf) * 16384 + vwoff) = rv0; *(LDSAS u32x4*)(lds + AB_V + (buf) * 16384 + vwoff + 2048) = rv1; } while (0)
    const int kroff = (s ? AB_K2 : AB_K1) + r32 * 128, ksw = (r32 >> 1) & 7;
    const int vroff = AB_V + (4 * hi + ((lane & 15) >> 2)) * 64 + ((lane >> 4) & 1) * 32 + (lane & 3) * 8;
    AB_GLOAD(t_begin); AB_LWRITE(0); __syncthreads();
    for (int t = t_begin; t < t_end; ++t) {
        const int buf = (t - t_begin) & 1;
        if (t + 1 < t_end) AB_GLOAD(t + 1);
        const LDSAS unsigned char* kb = lds + buf * 8192 + kroff;
        f32x16 p0 = (f32x16){}, p1 = (f32x16){};
#pragma unroll
        for (int d0 = 0; d0 < 4; ++d0) {
            const int co = ((2 * d0 + hi) ^ ksw) * 16;
            const bf16x8 k0 = *(const LDSAS bf16x8*)(kb + co), k1 = *(const LDSAS bf16x8*)(kb + 4096 + co);
            p0 = __builtin_amdgcn_mfma_f32_32x32x16_bf16(k0, qf[d0], p0, 0, 0, 0);
            p1 = __builtin_amdgcn_mfma_f32_32x32x16_bf16(k1, qf[d0], p1, 0, 0, 0);
        }
        float ls = 0.f;
#pragma unroll
        for (int r = 0; r < 16; ++r) { p0[r] = __builtin_amdgcn_exp2f(p0[r]); p1[r] = __builtin_amdgcn_exp2f(p1[r]); ls += p0[r] + p1[r]; }
        l += ls;
        u32x4 pw[4];
        pw[0].x = cvtpk(p0[0], p0[1]); pw[0].y = cvtpk(p0[2], p0[3]); pw[0].z = cvtpk(p0[4], p0[5]); pw[0].w = cvtpk(p0[6], p0[7]);
        pw[1].x = cvtpk(p0[8], p0[9]); pw[1].y = cvtpk(p0[10], p0[11]); pw[1].z = cvtpk(p0[12], p0[13]); pw[1].w = cvtpk(p0[14], p0[15]);
        pw[2].x = cvtpk(p1[0], p1[1]); pw[2].y = cvtpk(p1[2], p1[3]); pw[2].z = cvtpk(p1[4], p1[5]); pw[2].w = cvtpk(p1[6], p1[7]);
        pw[3].x = cvtpk(p1[8], p1[9]); pw[3].y = cvtpk(p1[10], p1[11]); pw[3].z = cvtpk(p1[12], p1[13]); pw[3].w = cvtpk(p1[14], p1[15]);
        const LDSAS unsigned char* vb = lds + buf * 16384 + vroff;
#pragma unroll
        for (int d0 = 0; d0 < 4; ++d0)
#pragma unroll
            for (int ks = 0; ks < 4; ++ks) {
                const s16x4 lo = vtr(vb + d0 * 4096 + ks * 1024), hh = vtr(vb + d0 * 4096 + ks * 1024 + 512);
                const bf16x8 vf = (bf16x8){lo[0], lo[1], lo[2], lo[3], hh[0], hh[1], hh[2], hh[3]};
                o[d0] = __builtin_amdgcn_mfma_f32_32x32x16_bf16(__builtin_bit_cast(bf16x8, pw[ks]), vf, o[d0], 0, 0, 0);
            }
        if (t + 1 < t_end) AB_LWRITE(buf ^ 1);
        __syncthreads();
    }
#undef AB_GLOAD
#undef AB_LWRITE
    l += __shfl_xor(l, 32);
    LDSAS float* scr = (LDSAS float*)(lds + AB_SCR + wid * 256);
    LDSAS float* xch = (LDSAS float*)(lds + AB_XCH + qt * 16896);
    if (hi == 0) scr[r32] = (s ? lam : 1.0f) / l;
    float rl[16];
#pragma unroll
    for (int r = 0; r < 16; ++r) rl[r] = scr[crow(r, hi)];
    if (s == 1) {
#pragma unroll
        for (int d0 = 0; d0 < 4; ++d0)
#pragma unroll
            for (int r = 0; r < 16; ++r) xch[crow(r, hi) * 132 + d0 * 32 + r32] = o[d0][r] * rl[r];
    }
    __syncthreads();
    if (s == 0) {
        float ss[16];
#pragma unroll
        for (int r = 0; r < 16; ++r) {
            float s2 = 0.f;
#pragma unroll
            for (int d0 = 0; d0 < 4; ++d0) { const float v = o[d0][r] * rl[r] - xch[crow(r, hi) * 132 + d0 * 32 + r32]; o[d0][r] = v; s2 += v * v; }
            ss[r] = s2;
        }
#pragma unroll
        for (int r = 0; r < 16; ++r) {
            float s2 = ss[r];
            s2 += __shfl_xor(s2, 1); s2 += __shfl_xor(s2, 2); s2 += __shfl_xor(s2, 4); s2 += __shfl_xor(s2, 8); s2 += __shfl_xor(s2, 16);
            ss[r] = rsqrtf(s2 * (1.0f / 128.0f) + EPS) * (1.0f - LAMBDA_INIT);
        }
#pragma unroll
        for (int d0 = 0; d0 < 4; ++d0) {
            const float sl = P.b_subln[d0 * 32 + r32];
#pragma unroll
            for (int r = 0; r < 16; ++r) xch[crow(r, hi) * 132 + d0 * 32 + r32] = o[d0][r] * ss[r] * sl;
        }
        const int eq = lane >> 1, eseg = lane & 1;
        const size_t grow = (size_t)(qrow0 + qt * 32 + eq);
        const u32x4* gp = (const u32x4*)(P.GB + grow * 512 + h * 128 + eseg * 64);
        u32x4* op = (u32x4*)(P.O + grow * 1024 + 512 + h * 128 + eseg * 64);
#pragma unroll
        for (int i = 0; i < 8; ++i) {
            const f32x4 a = *(const LDSAS f32x4*)(xch + eq * 132 + eseg * 64 + i * 8), c = *(const LDSAS f32x4*)(xch + eq * 132 + eseg * 64 + i * 8 + 4);
            const u32x4 g = gp[i]; u32x4 ov;
            ov.x = cvtpk(a[0] * bflo(g.x), a[1] * bfhi(g.x)); ov.y = cvtpk(a[2] * bflo(g.y), a[3] * bfhi(g.y));
            ov.z = cvtpk(c[0] * bflo(g.z), c[1] * bfhi(g.z)); ov.w = cvtpk(c[2] * bflo(g.w), c[3] * bfhi(g.w));
            op[i] = ov;
        }
    }
    __syncthreads();
}

__device__ void phase_attnB_mfma(const Params& P, LDSAS unsigned char* lds, int vb, int nvb) {
    float d1 = 0.f, d2 = 0.f;
    for (int i = 0; i < 64; ++i) { d1 += P.lq1[i] * P.lk1[i]; d2 += P.lq2[i] * P.lk2[i]; }
    const float lam = expf(d1) - expf(d2) + LAMBDA_INIT;
    for (int u = vb; u < 2048 + 256; u += nvb) {
        if (u < 2048) {
            int pair, qblk;
            if (nvb == 256) { const int round = u >> 8, i = u & 255, xcd = i & 7, slot = i >> 3; pair = round * 16 + xcd * 2 + (slot >> 4); qblk = slot & 15; }
            else { pair = u >> 4; qblk = u & 15; }
            const int b = pair >> 2, h = pair & 3;
            attnB_unit(P, lds, b, h, b * 2048 + qblk * 128, 0, 36, lam);
        } else {
            const int v = u - 2048, pair = v >> 1, qblk = v & 1, b = pair >> 2, h = pair & 3;
            attnB_unit(P, lds, b, h, ML + b * 256 + qblk * 128, 32, 36, lam);
        }
    }
}

constexpr int AA_K = 0, AA_V = 16384;
__device__ __forceinline__ void attnA_unit(const Params& P, LDSAS unsigned char* lds, int b, int kvh, int qrow0, int qpos0, int kt0, int nwin) {
    const int tid = threadIdx.x, lane = tid & 63, r32 = lane & 31, hi = lane >> 5;
    const int wid = __builtin_amdgcn_readfirstlane(tid >> 6);
    const int head = kvh * 4 + (wid >> 1), qoff = (wid & 1) * 64;
    bf16x8 qf[2][4];
#pragma unroll
    for (int qq = 0; qq < 2; ++qq)
#pragma unroll
        for (int d0 = 0; d0 < 4; ++d0) qf[qq][d0] = *(const bf16x8*)(P.QA + (size_t)(qrow0 + qoff + qq * 32 + r32) * 512 + head * 64 + d0 * 16 + hi * 8);
    f32x16 o[2][2];
#pragma unroll
    for (int i = 0; i < 2; ++i) { o[i][0] = (f32x16){}; o[i][1] = (f32x16){}; }
    float l[2] = {0.f, 0.f};
    const int krow = tid >> 3, kch = tid & 7;
    const int kwoff = krow * 128 + ((kch ^ ((krow >> 1) & 7)) * 16);
    const int vwoff = (kch >> 2) * 4096 + krow * 64 + (kch & 3) * 16;
    u32x4 rk, rv;
    const int nt = nwin + 4;
#define AA_KR0(i) ((i) < nwin ? b * 2048 + 64 * (kt0 + (i)) : ML + b * 256 + 64 * ((i) - nwin))
#define AA_GLOAD(i) do { const int kr0_ = AA_KR0(i); rk = *(const u32x4*)(P.KA + (size_t)(kr0_ + krow) * 128 + kvh * 64 + kch * 8); rv = *(const u32x4*)(P.VA + (size_t)(kr0_ + krow) * 128 + kvh * 64 + kch * 8); } while (0)
#define AA_LWRITE(buf) do { *(LDSAS u32x4*)(lds + AA_K + (buf) * 8192 + kwoff) = rk; *(LDSAS u32x4*)(lds + AA_V + (buf) * 8192 + vwoff) = rv; } while (0)
    const int kroff = AA_K + r32 * 128, ksw = (r32 >> 1) & 7;
    const int vroff = AA_V + (4 * hi + ((lane & 15) >> 2)) * 64 + ((lane >> 4) & 1) * 32 + (lane & 3) * 8;
    AA_GLOAD(0); AA_LWRITE(0); __syncthreads();
    for (int i = 0; i < nt; ++i) {
        const int buf = i & 1;
        if (i + 1 < nt) AA_GLOAD(i + 1);
        int cls = 1;
        if (i < nwin) { const int delta = 64 * (kt0 + i) - (qpos0 + qoff); cls = delta == -128 ? 2 : (delta == 128 ? 3 : ((delta >= -64 && delta <= 64) ? 1 : 0)); }
        if (cls != 0) {
            const LDSAS unsigned char* kb = lds + buf * 8192 + kroff;
            f32x16 p[2][2];
#pragma unroll
            for (int qq = 0; qq < 2; ++qq) { p[qq][0] = (f32x16){}; p[qq][1] = (f32x16){}; }
#pragma unroll
            for (int d0 = 0; d0 < 4; ++d0) {
                const int co = ((2 * d0 + hi) ^ ksw) * 16;
                const bf16x8 k0 = *(const LDSAS bf16x8*)(kb + co), k1 = *(const LDSAS bf16x8*)(kb + 4096 + co);
#pragma unroll
                for (int qq = 0; qq < 2; ++qq) {
                    p[qq][0] = __builtin_amdgcn_mfma_f32_32x32x16_bf16(k0, qf[qq][d0], p[qq][0], 0, 0, 0);
                    p[qq][1] = __builtin_amdgcn_mfma_f32_32x32x16_bf16(k1, qf[qq][d0], p[qq][1], 0, 0, 0);
                }
            }
            u32x4 pw[2][4];
#pragma unroll
            for (int qq = 0; qq < 2; ++qq) {
                float ls = 0.f;
#pragma unroll
                for (int r = 0; r < 16; ++r) { p[qq][0][r] = __builtin_amdgcn_exp2f(p[qq][0][r]); p[qq][1][r] = __builtin_amdgcn_exp2f(p[qq][1][r]); }
                if (cls >= 2) {
                    const int a = qq * 32 + r32;
#pragma unroll
                    for (int r = 0; r < 16; ++r) {
                        const int c0 = crow(r, hi), c1 = c0 + 32;
                        const bool v0 = cls == 2 ? (c0 >= a) : (c0 <= a), v1 = cls == 2 ? (c1 >= a) : (c1 <= a);
                        p[qq][0][r] = v0 ? p[qq][0][r] : 0.f; p[qq][1][r] = v1 ? p[qq][1][r] : 0.f;
                    }
                }
#pragma unroll
                for (int r = 0; r < 16; ++r) ls += p[qq][0][r] + p[qq][1][r];
                l[qq] += ls;
                const f32x16 &a0 = p[qq][0], &a1 = p[qq][1];
                pw[qq][0].x = cvtpk(a0[0], a0[1]); pw[qq][0].y = cvtpk(a0[2], a0[3]); pw[qq][0].z = cvtpk(a0[4], a0[5]); pw[qq][0].w = cvtpk(a0[6], a0[7]);
                pw[qq][1].x = cvtpk(a0[8], a0[9]); pw[qq][1].y = cvtpk(a0[10], a0[11]); pw[qq][1].z = cvtpk(a0[12], a0[13]); pw[qq][1].w = cvtpk(a0[14], a0[15]);
                pw[qq][2].x = cvtpk(a1[0], a1[1]); pw[qq][2].y = cvtpk(a1[2], a1[3]); pw[qq][2].z = cvtpk(a1[4], a1[5]); pw[qq][2].w = cvtpk(a1[6], a1[7]);
                pw[qq][3].x = cvtpk(a1[8], a1[9]); pw[qq][3].y = cvtpk(a1[10], a1[11]); pw[qq][3].z = cvtpk(a1[12], a1[13]); pw[qq][3].w = cvtpk(a1[14], a1[15]);
            }
            const LDSAS unsigned char* vb = lds + buf * 8192 + vroff;
#pragma unroll
            for (int d0 = 0; d0 < 2; ++d0)
#pragma unroll
                for (int ks = 0; ks < 4; ++ks) {
                    const s16x4 lo = vtr(vb + d0 * 4096 + ks * 1024), hh = vtr(vb + d0 * 4096 + ks * 1024 + 512);
                    const bf16x8 vf = (bf16x8){lo[0], lo[1], lo[2], lo[3], hh[0], hh[1], hh[2], hh[3]};
                    o[0][d0] = __builtin_amdgcn_mfma_f32_32x32x16_bf16(__builtin_bit_cast(bf16x8, pw[0][ks]), vf, o[0][d0], 0, 0, 0);
                    o[1][d0] = __builtin_amdgcn_mfma_f32_32x32x16_bf16(__builtin_bit_cast(bf16x8, pw[1][ks]), vf, o[1][d0], 0, 0, 0);
                }
        }
        if (i + 1 < nt) AA_LWRITE(buf ^ 1);
        __syncthreads();
    }
#undef AA_KR0
#undef AA_GLOAD
#undef AA_LWRITE
    const float sinkp = __builtin_amdgcn_exp2f(P.a_sink[head] * LOG2E);
    LDSAS float* stg = (LDSAS float*)(lds + wid * 8704);
    const int eq = lane >> 1, eseg = lane & 1;
#pragma unroll
    for (int qq = 0; qq < 2; ++qq) {
        float lt = l[qq]; lt += __shfl_xor(lt, 32);
        if (hi == 0) stg[r32] = 1.0f / (lt + sinkp);
        float rl[16];
#pragma unroll
        for (int r = 0; r < 16; ++r) rl[r] = stg[crow(r, hi)];
#pragma unroll
        for (int d0 = 0; d0 < 2; ++d0)
#pragma unroll
            for (int r = 0; r < 16; ++r) stg[crow(r, hi) * 68 + d0 * 32 + r32] = o[qq][d0][r] * rl[r];
        const size_t grow = (size_t)(qrow0 + qoff + qq * 32 + eq);
        const u32x4* gp = (const u32x4*)(P.GA + grow * 512 + head * 64 + eseg * 32);
        u32x4* op = (u32x4*)(P.O + grow * 1024 + head * 64 + eseg * 32);
#pragma unroll
        for (int i = 0; i < 4; ++i) {
            const f32x4 a = *(const LDSAS f32x4*)(stg + eq * 68 + eseg * 32 + i * 8), c = *(const LDSAS f32x4*)(stg + eq * 68 + eseg * 32 + i * 8 + 4);
            const u32x4 g = gp[i]; u32x4 ov;
            ov.x = cvtpk(a[0] * bflo(g.x), a[1] * bfhi(g.x)); ov.y = cvtpk(a[2] * bflo(g.y), a[3] * bfhi(g.y));
            ov.z = cvtpk(c[0] * bflo(g.z), c[1] * bfhi(g.z)); ov.w = cvtpk(c[2] * bflo(g.w), c[3] * bfhi(g.w));
            op[i] = ov;
        }
    }
    __syncthreads();
}

__device__ void phase_attnA_mfma(const Params& P, LDSAS unsigned char* lds, int vb, int nvb) {
    for (int u = vb; u < 1024 + 128; u += nvb) {
        if (u < 1024) {
            const int qblk = u & 15, kvh = (u >> 4) & 1, b = u >> 5;
            const int lo = 2 * qblk - 2 < 0 ? 0 : 2 * qblk - 2, hi_ = 2 * qblk + 3 > 31 ? 31 : 2 * qblk + 3;
            attnA_unit(P, lds, b, kvh, b * 2048 + qblk * 128, qblk * 128, lo, hi_ - lo + 1);
        } else {
            const int v = u - 1024, half = v & 1, kvh = (v >> 1) & 1, b = v >> 2;
            attnA_unit(P, lds, b, kvh, ML + b * 256 + half * 128, 0, 0, 0);
        }
    }
}

__device__ void phase_gla(const Params& P, float* lds, int vb, int nvb) {
    float* sa = lds; float* sk = lds + 128; float* sq = lds + 256;
    const int e = threadIdx.x;
    for (int unit = vb; unit < NB * 4 * 2; unit += nvb) {
        const int dr = unit & 1, h = (unit >> 1) & 3, b = unit >> 3;
        const float* wa = dr ? P.wa_b : P.wa_f; const float* ba = dr ? P.ba_b : P.ba_f;
        float S[128];
#pragma unroll
        for (int d = 0; d < 128; ++d) S[d] = 0.f;
        float war[16], bav = 0.f;
        if (e < 128) {
#pragma unroll
            for (int j = 0; j < 16; ++j) war[j] = wa[j * 512 + h * 128 + e];
            bav = ba[h * 128 + e];
        }
        for (int step = 0; step < L + T; ++step) {
            int m;
            if (step < L) m = ML + b * L + (dr ? L - 1 - step : step);
            else { const int t = step - L; m = b * T + (dr ? T - 1 - t : t); }
            __syncthreads();
            if (e < 128) {
                const float* rf = P.RF + (size_t)m * 32 + dr * 16;
                float z = bav;
#pragma unroll
                for (int j = 0; j < 16; ++j) z += rf[j] * war[j];
                const float ls = fminf(z, 0.f) - log1pf(expf(-fabsf(z)));
                sa[e] = expf(ls * (1.0f / 16.0f));
                sk[e] = bf2f(P.KG[(size_t)m * 512 + h * 128 + e]);
                sq[e] = bf2f(P.QG[(size_t)m * 512 + h * 128 + e]);
            }
            __syncthreads();
            if (e < 256) {
            const float v = bf2f(P.VG[(size_t)m * 1024 + h * 256 + e]);
            float o = 0.f;
#pragma unroll
            for (int d = 0; d < 128; ++d) { S[d] = sa[d] * S[d] + sk[d] * v; o += sq[d] * S[d]; }
            if (m < ML) P.OD[((size_t)dr * ML + m) * 1024 + h * 256 + e] = (bf16_t)f2bf(o);
            }
        }
    }
}

__device__ void phase_finish(const Params& P, int vb, int nvb) {
    const int lane = threadIdx.x & 63, wpb = blockDim.x >> 6, w = threadIdx.x >> 6;
    for (int row = vb * wpb + w; row < ML; row += nvb * wpb) {
        const int c0 = lane * 16;
        float v[16];
        const u32x4* pf = (const u32x4*)(P.OD + (size_t)row * 1024 + c0);
        const u32x4* pb = (const u32x4*)(P.OD + ((size_t)ML + row) * 1024 + c0);
        float ss = 0.f;
#pragma unroll
        for (int i = 0; i < 2; ++i) {
            const u32x4 a = pf[i], bq = pb[i];
            v[8 * i] = bflo(a.x) + bflo(bq.x); v[8 * i + 1] = bfhi(a.x) + bfhi(bq.x); v[8 * i + 2] = bflo(a.y) + bflo(bq.y); v[8 * i + 3] = bfhi(a.y) + bfhi(bq.y);
            v[8 * i + 4] = bflo(a.z) + bflo(bq.z); v[8 * i + 5] = bfhi(a.z) + bfhi(bq.z); v[8 * i + 6] = bflo(a.w) + bflo(bq.w); v[8 * i + 7] = bfhi(a.w) + bfhi(bq.w);
        }
#pragma unroll
        for (int i = 0; i < 16; ++i) ss += v[i] * v[i];
        ss += __shfl_xor(ss, 1); ss += __shfl_xor(ss, 2); ss += __shfl_xor(ss, 4); ss += __shfl_xor(ss, 8);
        const float rn = rsqrtf(ss * (1.0f / 256.0f) + EPS);
        const float* gn = P.gla_out_norm + (c0 & 255);
        const u32x4* gp = (const u32x4*)(P.GG + (size_t)row * 1024 + c0);
        u32x4* op = (u32x4*)(P.A2 + (size_t)row * 1024 + c0);
#pragma unroll
        for (int i = 0; i < 2; ++i) {
            const u32x4 g = gp[i]; u32x4 r;
            r.x = pack2(v[8 * i] * rn * gn[8 * i] * bflo(g.x), v[8 * i + 1] * rn * gn[8 * i + 1] * bfhi(g.x));
            r.y = pack2(v[8 * i + 2] * rn * gn[8 * i + 2] * bflo(g.y), v[8 * i + 3] * rn * gn[8 * i + 3] * bfhi(g.y));
            r.z = pack2(v[8 * i + 4] * rn * gn[8 * i + 4] * bflo(g.z), v[8 * i + 5] * rn * gn[8 * i + 5] * bfhi(g.z));
            r.w = pack2(v[8 * i + 6] * rn * gn[8 * i + 6] * bflo(g.w), v[8 * i + 7] * rn * gn[8 * i + 7] * bfhi(g.w));
            op[i] = r;
        }
    }
}

namespace cg = cooperative_groups;
__global__ void __launch_bounds__(512) mega_kernel(Params P) {
    __shared__ __attribute__((aligned(16))) unsigned char lds[AB_LDS];
    cg::grid_group grid = cg::this_grid();
    const int vb = blockIdx.x, nvb = gridDim.x;
    phase_wt(P, vb, nvb); phase_adaln(P, vb, nvb); phase_rope(P, vb, nvb);
    grid.sync();
    phase_bias(P, vb, nvb); phase_a0(P, vb, nvb);
    grid.sync();
    { EpiIn0 E{P.parts, 1, P.bias0, P.a_q_norm, P.a_k_norm, P.b_q_norm, P.b_k_norm, P.rope, P.QA, P.KA, P.VA, P.GA, P.QB, P.KB, P.VB, P.GB};
      gemm_simple(P.A, P.Wt0, M / 256, N0 / 256, E, lds, vb, nvb); }
    grid.sync();
    phase_attnA_mfma(P, (LDSAS unsigned char*)lds, vb, nvb); phase_attnB_mfma(P, (LDSAS unsigned char*)lds, vb, nvb);
    grid.sync();
    { EpiOut0 E{P.x, P.ctx, P.mod, P.norm_g + D, P.out, P.A, P.parts};
      gemm_simple(P.O, P.Wo0, M / 256, D / 256, E, lds, vb, nvb); }
    grid.sync();
    { EpiIn1 E{P.parts, 16, P.bias1, P.QG, P.KG, P.VG, P.GG, P.RF};
      gemm_simple(P.A, P.Wt1, M / 256, N1 / 256, E, lds, vb, nvb); }
    grid.sync();
    phase_gla(P, (float*)lds, vb, nvb);
    grid.sync();
    phase_finish(P, vb, nvb);
    grid.sync();
    { EpiOut1 E{P.mod, P.out};
      gemm_simple(P.A2, P.Wo1, ML / 256, D / 256, E, lds, vb, nvb); }
}
}

extern "C" void kernel_launch(void* const* d_in, const int* in_sizes, int n_in, void* d_out, int out_size, void* d_ws, size_t ws_size, hipStream_t stream) {
    Params P{};
    const float* const* in = (const float* const*)d_in;
    P.x = in[0]; P.c = in[1]; P.ctx = in[2]; P.c_ctx = in[3]; P.adaln_w = in[4]; P.adaln_b = in[5]; P.norm_g = in[6]; P.w_out = in[7]; P.ab_w_in = in[8];
    P.a_q_norm = in[9]; P.a_k_norm = in[10]; P.a_sink = in[11]; P.b_q_norm = in[12]; P.b_k_norm = in[13]; P.lq1 = in[14]; P.lk1 = in[15]; P.lq2 = in[16]; P.lk2 = in[17];
    P.b_subln = in[18]; P.gla_w_in = in[19]; P.wa_f = in[20]; P.ba_f = in[21]; P.wa_b = in[22]; P.ba_b = in[23]; P.gla_out_norm = in[24];
    P.out = (float*)d_out;
    unsigned char* w = (unsigned char*)d_ws; size_t off = 0;
    auto take = [&](size_t bytes) { unsigned char* p = w + off; off += (bytes + 255) & ~(size_t)255; return p; };
    P.Wt0 = (bf16_t*)take((size_t)N0 * D * 2); P.Wt1 = (bf16_t*)take((size_t)N1 * D * 2); P.Wo0 = (bf16_t*)take((size_t)D * D * 2); P.Wo1 = (bf16_t*)take((size_t)D * D * 2);
    P.mod = (float*)take((size_t)2 * 33 * 3072 * 4); P.bias0 = (float*)take((size_t)33 * 3328 * 4); P.bias1 = (float*)take((size_t)33 * 3328 * 4);
    P.rope = (float*)take(64 * 16 * 2 * 4); P.parts = (float*)take((size_t)16 * M * 4);
    P.A = (bf16_t*)take((size_t)M * D * 2); P.O = (bf16_t*)take((size_t)M * D * 2);
    unsigned char* qkv = take((size_t)M * 3328 * 2);
    {
        unsigned char* q = qkv;
        P.QA = (bf16_t*)q; q += (size_t)M * 512 * 2; P.KA = (bf16_t*)q; q += (size_t)M * 128 * 2; P.VA = (bf16_t*)q; q += (size_t)M * 128 * 2; P.GA = (bf16_t*)q; q += (size_t)M * 512 * 2;
        P.QB = (bf16_t*)q; q += (size_t)M * 512 * 2; P.KB = (bf16_t*)q; q += (size_t)M * 512 * 2; P.VB = (bf16_t*)q; q += (size_t)M * 512 * 2; P.GB = (bf16_t*)q;
        q = qkv;
        P.QG = (bf16_t*)q; q += (size_t)M * 512 * 2; P.KG = (bf16_t*)q; q += (size_t)M * 512 * 2; P.VG = (bf16_t*)q; q += (size_t)M * 1024 * 2; P.GG = (bf16_t*)q; q += (size_t)M * 1024 * 2; P.RF = (float*)q;
        P.A2 = (bf16_t*)qkv;
        P.OD = P.A;
    }
    if (off > ws_size) { fprintf(stderr, "workspace too small: need %zu have %zu\n", off, ws_size); return; }
    static int grid_blocks = 0;
    if (!grid_blocks) {
        int dev = 0, cus = 0, per_cu = 0;
        (void)hipGetDevice(&dev);
        (void)hipDeviceGetAttribute(&cus, hipDeviceAttributeMultiprocessorCount, dev);
        (void)hipOccupancyMaxActiveBlocksPerMultiprocessor(&per_cu, mega_kernel, 512, 0);
        if (per_cu > 1) per_cu = 1;
        grid_blocks = cus * per_cu;
    }
    void* args[] = {&P};
    hipError_t e = hipLaunchCooperativeKernel((void*)mega_kernel, dim3(grid_blocks), dim3(512), args, 0, stream);
    if (e != hipSuccess) fprintf(stderr, "cooperative launch failed: %s (grid %d)\n", hipGetErrorString(e), grid_blocks);
}
```

```cpp
#include <hip/hip_runtime.h>
#include <hip/hip_cooperative_groups.h>
#include <cstdint>
#include <cstdio>

namespace {
constexpr int NB = 32, T = 2048, L = 256, D = 1024;
constexpr int ML = NB * T, MC = NB * L, M = ML + MC;
constexpr int N0 = 3328, N1 = 3328, N0R = 3328, N1R = 3104;
constexpr float EPS = 1e-6f;
constexpr float LOG2E = 1.4426950408889634f;
constexpr float QSCALE = 0.125f * LOG2E;
constexpr float LAMBDA_INIT = 0.2f;

typedef unsigned short bf16_t;
typedef short bf16x8 __attribute__((ext_vector_type(8)));
typedef float f32x4 __attribute__((ext_vector_type(4)));
typedef unsigned u32x4 __attribute__((ext_vector_type(4)));
typedef unsigned u32x2 __attribute__((ext_vector_type(2)));

constexpr size_t al256(size_t x) { return (x + 255) & ~(size_t)255; }
constexpr size_t OFF_WT0 = 0;
constexpr size_t OFF_WT1 = OFF_WT0 + al256((size_t)N0 * D * 2);
constexpr size_t OFF_WO0 = OFF_WT1 + al256((size_t)N1 * D * 2);
constexpr size_t OFF_WO1 = OFF_WO0 + al256((size_t)D * D * 2);
constexpr size_t OFF_MOD = OFF_WO1 + al256((size_t)D * D * 2);
constexpr size_t OFF_BIAS0 = OFF_MOD + al256((size_t)2 * 33 * 3072 * 4);
constexpr size_t OFF_BIAS1 = OFF_BIAS0 + al256((size_t)33 * 3328 * 4);
constexpr size_t OFF_ROPE = OFF_BIAS1 + al256((size_t)33 * 3328 * 4);
constexpr size_t OFF_SCAL = OFF_ROPE + al256(64 * 16 * 2 * 4);
constexpr size_t OFF_PARTS = OFF_SCAL + 256;
constexpr size_t OFF_A = OFF_PARTS + al256((size_t)16 * M * 4);
constexpr size_t OFF_O = OFF_A + (size_t)M * D * 2;
constexpr size_t OFF_QKV = OFF_O + (size_t)M * D * 2;
constexpr size_t WS_NEED = OFF_QKV + (size_t)M * 3328 * 2;
constexpr size_t OFF_QA = OFF_QKV, OFF_KA = OFF_QA + (size_t)M * 512 * 2, OFF_VA = OFF_KA + (size_t)M * 128 * 2, OFF_GA = OFF_VA + (size_t)M * 128 * 2;
constexpr size_t OFF_QB = OFF_GA + (size_t)M * 512 * 2, OFF_KB = OFF_QB + (size_t)M * 512 * 2, OFF_VB = OFF_KB + (size_t)M * 512 * 2, OFF_GB = OFF_VB + (size_t)M * 512 * 2;
constexpr size_t OFF_QG = OFF_QKV, OFF_KG = OFF_QG + (size_t)M * 512 * 2, OFF_VG = OFF_KG + (size_t)M * 512 * 2, OFF_GG = OFF_VG + (size_t)M * 1024 * 2, OFF_RF = OFF_GG + (size_t)M * 1024 * 2;
static_assert(OFF_RF + (size_t)M * 32 * 4 <= WS_NEED, "layer-1 projections fit");
static_assert((size_t)2 * ML * 1024 * 2 <= (size_t)2 * M * D * 2, "OD fits over A + O");

struct Params {
    const float *x, *c, *ctx, *c_ctx, *adaln_w, *adaln_b, *norm_g, *w_out, *ab_w_in, *a_q_norm, *a_k_norm, *a_sink, *b_q_norm, *b_k_norm;
    const float *lq1, *lk1, *lq2, *lk2, *b_subln, *gla_w_in, *wa_f, *ba_f, *wa_b, *ba_b, *gla_out_norm;
    float* out;
    unsigned char* ws;
#define WSPTR(T, name, off) __device__ __forceinline__ T* name() const { return (T*)(ws + (off)); }
    WSPTR(bf16_t, Wt0, OFF_WT0) WSPTR(bf16_t, Wt1, OFF_WT1) WSPTR(bf16_t, Wo0, OFF_WO0) WSPTR(bf16_t, Wo1, OFF_WO1)
    WSPTR(float, mod, OFF_MOD) WSPTR(float, bias0, OFF_BIAS0) WSPTR(float, bias1, OFF_BIAS1) WSPTR(float, rope, OFF_ROPE) WSPTR(float, scal, OFF_SCAL) WSPTR(float, parts, OFF_PARTS)
    WSPTR(bf16_t, A, OFF_A) WSPTR(bf16_t, O, OFF_O)
    WSPTR(bf16_t, QA, OFF_QA) WSPTR(bf16_t, KA, OFF_KA) WSPTR(bf16_t, VA, OFF_VA) WSPTR(bf16_t, GA, OFF_GA)
    WSPTR(bf16_t, QB, OFF_QB) WSPTR(bf16_t, KB, OFF_KB) WSPTR(bf16_t, VB, OFF_VB) WSPTR(bf16_t, GB, OFF_GB)
    WSPTR(bf16_t, QG, OFF_QG) WSPTR(bf16_t, KG, OFF_KG) WSPTR(bf16_t, VG, OFF_VG) WSPTR(bf16_t, GG, OFF_GG) WSPTR(float, RF, OFF_RF)
    WSPTR(bf16_t, OD, OFF_A) WSPTR(bf16_t, A2, OFF_QKV)
#undef WSPTR
};

__device__ __forceinline__ int otid() { int t = threadIdx.x; asm volatile("" : "+v"(t)); return t; }
__device__ __forceinline__ unsigned f2bf(float f) { unsigned u = __float_as_uint(f); u += 0x7FFFu + ((u >> 16) & 1u); return u >> 16; }
__device__ __forceinline__ unsigned pack2(float lo, float hi) { return f2bf(lo) | (f2bf(hi) << 16); }
__device__ __forceinline__ float bf2f(unsigned h) { return __uint_as_float(h << 16); }
__device__ __forceinline__ float bflo(unsigned w) { return __uint_as_float(w << 16); }
__device__ __forceinline__ float bfhi(unsigned w) { return __uint_as_float(w & 0xFFFF0000u); }
__device__ __forceinline__ float siluf(float v) { return v / (1.0f + __expf(-v)); }

__device__ __forceinline__ Params ldparams() {
#if defined(__HIP_DEVICE_COMPILE__)
    const __attribute__((address_space(4))) Params* pp = (const __attribute__((address_space(4))) Params*)__builtin_amdgcn_kernarg_segment_ptr();
    asm volatile("" : "+s"(pp));
    return *pp;
#else
    return Params{};
#endif
}

__device__ __forceinline__ int perm_local(int p, bool ropeType) {
    const int bj = p >> 7, wc = (p >> 5) & 3, low = p & 31;
    if (ropeType) return wc * 64 + bj * 32 + low;
    const int n = (low >> 4) & 1, fq = (low >> 2) & 3, e = low & 3;
    return wc * 64 + bj * 32 + fq * 8 + n * 4 + e;
}
__device__ __forceinline__ int src_col(int which, int np) {
    const int p = np & 255, tile = np >> 8;
    bool rope = false;
    if (which == 0) { const int g = tile * 4 + ((p >> 5) & 3); rope = (g < 10) || (g >= 20 && g < 36); }
    const int c = tile * 256 + perm_local(p, rope);
    const int nreal = which == 0 ? N0R : (which == 1 ? N1R : D);
    return c < nreal ? c : -1;
}

__device__ __forceinline__ void phase_wt(const Params& P, int vb, int nvb) {
    const int tidx = otid();
    const long total = (long)(N0 + N1 + D + D) * D;
    for (long idx = (long)vb * blockDim.x + tidx; idx < total; idx += (long)nvb * blockDim.x) {
        long i = idx; int which; const float* W; bf16_t* dst; int ldw;
        if (i < (long)N0 * D) { which = 0; W = P.ab_w_in; dst = P.Wt0(); ldw = N0R; }
        else if ((i -= (long)N0 * D) < (long)N1 * D) { which = 1; W = P.gla_w_in; dst = P.Wt1(); ldw = N1R; }
        else if ((i -= (long)N1 * D) < (long)D * D) { which = 2; W = P.w_out; dst = P.Wo0(); ldw = D; }
        else { i -= (long)D * D; which = 3; W = P.w_out + (size_t)D * D; dst = P.Wo1(); ldw = D; }
        const int np = (int)(i >> 10), k = (int)(i & 1023);
        const int sc = src_col(which, np);
        const float v = sc >= 0 ? W[(size_t)k * ldw + sc] : 0.f;
        dst[i] = (bf16_t)f2bf(v);
    }
}

__device__ __forceinline__ void phase_adaln(const Params& P, int vb, int nvb) {
    const int tidx = otid();
    for (int idx = vb * blockDim.x + tidx; idx < 2 * 3072; idx += nvb * blockDim.x) {
        const int l = idx / 3072, j = idx % 3072;
        float acc[33];
#pragma unroll
        for (int r = 0; r < 33; ++r) acc[r] = 0.f;
        const float* w = P.adaln_w + (size_t)l * D * 3072 + j;
        for (int k = 0; k < D; ++k) {
            const float wv = w[(size_t)k * 3072];
#pragma unroll
            for (int r = 0; r < 33; ++r) { const float cv = r < 32 ? P.c[r * D + k] : P.c_ctx[k]; acc[r] += siluf(cv) * wv; }
        }
        const float bv = P.adaln_b[l * 3072 + j];
#pragma unroll
        for (int r = 0; r < 33; ++r) P.mod()[((size_t)l * 33 + r) * 3072 + j] = acc[r] + bv;
    }
}

__device__ __forceinline__ void phase_rope(const Params& P, int vb, int nvb) {
    const int tidx = otid();
    for (int idx = vb * blockDim.x + tidx; idx < 64 * 16; idx += nvb * blockDim.x) {
        const int pos = idx >> 4, i = idx & 15;
        const double inv = pow(10000.0, -(double)i / 16.0);
        const double ang = (double)((float)pos * (float)inv);
        P.rope()[idx * 2 + 0] = (float)cos(ang);
        P.rope()[idx * 2 + 1] = (float)sin(ang);
    }
    if (vb == 0 && tidx == 0) {
        float d1 = 0.f, d2 = 0.f;
        for (int i = 0; i < 64; ++i) { d1 += P.lq1[i] * P.lk1[i]; d2 += P.lq2[i] * P.lk2[i]; }
        P.scal()[0] = expf(d1) - expf(d2) + LAMBDA_INIT;
    }
}

__device__ __forceinline__ void phase_bias(const Params& P, int vb, int nvb) {
    const int tidx = otid();
    for (int idx = vb * blockDim.x + tidx; idx < N0 + N1; idx += nvb * blockDim.x) {
        const int l = idx >= N0, np = l ? idx - N0 : idx;
        const int sc = src_col(l, np);
        float acc[33];
#pragma unroll
        for (int r = 0; r < 33; ++r) acc[r] = 0.f;
        if (sc >= 0) {
            const float* W = l ? P.gla_w_in : P.ab_w_in; const int ldw = l ? N1R : N0R;
            const float* sh = P.mod() + (size_t)l * 33 * 3072;
            for (int k = 0; k < D; ++k) {
                const float wv = W[(size_t)k * ldw + sc];
#pragma unroll
                for (int r = 0; r < 33; ++r) acc[r] += sh[r * 3072 + k] * wv;
            }
        }
        float* dst = l ? P.bias1() : P.bias0();
#pragma unroll
        for (int r = 0; r < 33; ++r) dst[r * 3328 + np] = acc[r];
    }
}

__device__ __forceinline__ void phase_a0(const Params& P, int vb, int nvb) {
    const int tidx = otid();
    const int lane = tidx & 63, wpb = blockDim.x >> 6, w = tidx >> 6;
    for (int row = vb * wpb + w; row < M; row += nvb * wpb) {
        const float* xin = row < ML ? P.x + (size_t)row * D : P.ctx + (size_t)(row - ML) * D;
        const int r = row < ML ? row >> 11 : 32;
        const float* sc = P.mod() + (size_t)r * 3072 + 1024;
        float ss = 0.f;
#pragma unroll
        for (int i = 0; i < 2; ++i) {
            const int c0 = i * 512 + lane * 8;
            const f32x4 a = *(const f32x4*)(xin + c0), b = *(const f32x4*)(xin + c0 + 4);
            const f32x4 g0 = *(const f32x4*)(P.norm_g + c0), g1 = *(const f32x4*)(P.norm_g + c0 + 4);
            const f32x4 s0 = *(const f32x4*)(sc + c0), s1 = *(const f32x4*)(sc + c0 + 4);
            ss += a[0] * a[0] + a[1] * a[1] + a[2] * a[2] + a[3] * a[3] + b[0] * b[0] + b[1] * b[1] + b[2] * b[2] + b[3] * b[3];
            const f32x4 ya = a * g0 * (1.0f + s0), yb = b * g1 * (1.0f + s1);
            u32x4 o; o.x = pack2(ya[0], ya[1]); o.y = pack2(ya[2], ya[3]); o.z = pack2(yb[0], yb[1]); o.w = pack2(yb[2], yb[3]);
            *(u32x4*)(P.A() + (size_t)row * D + c0) = o;
        }
#pragma unroll
        for (int o = 32; o >= 1; o >>= 1) ss += __shfl_xor(ss, o);
        if (lane == 0) P.parts()[row] = ss;
    }
}

namespace pg8 {
#define PG8_LAS __attribute__((address_space(3)))
typedef unsigned short bf16_t;
typedef short bf16x8 __attribute__((ext_vector_type(8)));
typedef float f32x4 __attribute__((ext_vector_type(4)));
typedef unsigned u32x4 __attribute__((ext_vector_type(4)));
constexpr int BM = 256, BK = 64, HALF = 128, HTB = HALF * BK * 2  , STAGE_BYTES = 8 * HTB, NXCD = 8, WGM = 8;

__host__ __device__ __forceinline__ int lds_byte(int r, int c) { const int st = (r >> 4) * 2 + (c >> 5), rr = r & 15, cc = c & 31, ob = rr * 64 + cc * 2; return st * 1024 + (ob ^ (((ob >> 9) & 1) << 5)); }
__host__ __device__ __forceinline__ void stage_rc(int b, int& R, int& C) { const int st = b / 1024, sb = b % 1024, swz = sb ^ (((sb >> 9) & 1) << 5); R = (st >> 1) * 16 + swz / 64; C = (st & 1) * 32 + (swz % 64) / 2; }
__host__ __device__ __forceinline__ int perm32(int rho) { const int n = rho >> 4, i = rho & 15; return 8 * (i >> 2) + 4 * n + (i & 3); }

struct Unit { int pm, pn; };
struct Gemm { const bf16_t* A; const bf16_t* Bt; int M, N, K; };

struct StaticOrder {
    int nM, nN, nwg, G, c;
    __host__ __device__ void init(int M, int N, int G_, int c_) { nM = M / BM; nN = N / BM; nwg = nM * nN; G = G_; c = c_; }
    __host__ __device__ bool next(int i, Unit& u) const {
        const long L = (long)i * G + c; if (L >= nwg) return false;
        int wgid = (int)L; { const int q = nwg / NXCD, r = nwg % NXCD, xcd = wgid % NXCD, off = wgid / NXCD; wgid = (xcd < r ? xcd * (q + 1) : r * (q + 1) + (xcd - r) * q) + off; }
        const int nig = WGM * nN, gid = wgid / nig, fm = gid * WGM, gsz = (nM - fm) < WGM ? (nM - fm) : WGM;
        u.pm = fm + ((wgid % nig) % gsz); u.pn = (wgid % nig) / gsz; return true;
    }
    __device__ __forceinline__ void a_ready(const Unit&) const {}
    __device__ __forceinline__ void done(const Unit&) const {}
};
template <class Epi, class Sched, bool ALIGN_EPI = false, bool SP2 = false>
__device__ __forceinline__ void gemm_phase(PG8_LAS unsigned char* lds, const Gemm g, const Sched& S, const Epi& E) {
    const int tid = otid(), wid = __builtin_amdgcn_readfirstlane(tid >> 6), lane = tid & 63, wr = wid >> 2, wc = wid & 3, fr = lane & 15, fq = lane >> 4;
    const int K = g.K, nt = K / BK;
    unsigned voffA[2], voffB[2];
#pragma unroll
    for (int i = 0; i < 2; ++i) { int R, C; stage_rc(tid * 16 + i * 8192, R, C); const int Rb = Epi::PERM ? ((R & ~31) + perm32(R & 31)) : R;
        voffA[i] = (unsigned)(R * K + C) * 2u; voffB[i] = (unsigned)(Rb * K + C) * 2u; }
    const size_t kstep = (size_t)(BK * 2);
    const size_t hstep = (size_t)HALF * K * 2;
    const size_t tstep = 2 * hstep;
    const unsigned ldsw = (unsigned)wid * 1024u;
    const int aoff = lds_byte(wr * 64 + fr, fq * 8), boff = lds_byte(wc * 32 + fr, fq * 8);
#define PG8_SA(b, h) (((b) * 2 + (h)) * HTB)
#define PG8_SB(b, h) ((4 + (b) * 2 + (h)) * HTB)
#define PG8_STAGE(bufoff, gbase, voff) do { _Pragma("unroll") for (int _i = 0; _i < 2; ++_i) \
        __builtin_amdgcn_global_load_lds((const unsigned*)((const char*)(gbase) + (voff)[_i]), (PG8_LAS unsigned*)(lds + (bufoff) + ldsw + _i * 8192), 16, 0, 0); } while (0)
#define PG8_LDA(dst, b, h) do { _Pragma("unroll") for (int m = 0; m < 4; ++m) _Pragma("unroll") for (int k = 0; k < 2; ++k) dst[m][k] = *(const PG8_LAS bf16x8*)(lds + PG8_SA(b, h) + aoff + m * 2048 + k * 1024); } while (0)
#define PG8_LDB(dst, b, h) do { _Pragma("unroll") for (int n = 0; n < 2; ++n) _Pragma("unroll") for (int k = 0; k < 2; ++k) dst[n][k] = *(const PG8_LAS bf16x8*)(lds + PG8_SB(b, h) + boff + n * 2048 + k * 1024); } while (0)
#define PG8_MMA(ai, bj, At, Bt) do { __builtin_amdgcn_s_setprio(1); _Pragma("unroll") for (int m = 0; m < 4; ++m) _Pragma("unroll") for (int n = 0; n < 2; ++n) _Pragma("unroll") for (int k = 0; k < 2; ++k) \
        acc[ai][bj][m][n] = __builtin_amdgcn_mfma_f32_16x16x32_bf16(Bt[n][k], At[m][k], acc[ai][bj][m][n], 0, 0, 0); __builtin_amdgcn_s_setprio(0); } while (0)
#define PG8_WAIT_V(n) asm volatile("s_waitcnt vmcnt(" #n ")" ::: "memory")
#define PG8_WAIT_L(n) asm volatile("s_waitcnt lgkmcnt(" #n ")" ::: "memory")
#define PG8_BAR __builtin_amdgcn_s_barrier()
#define PG8_SCHED __builtin_amdgcn_sched_barrier(0)
    Unit cur, nxt; int ui = 0;
    if (!S.next(0, cur)) return;
    f32x4 acc[2][2][4][2];
#pragma unroll
    for (int a = 0; a < 2; ++a)
#pragma unroll
        for (int b = 0; b < 2; ++b)
#pragma unroll
            for (int m = 0; m < 4; ++m)
#pragma unroll
                for (int n = 0; n < 2; ++n) acc[a][b][m][n] = (f32x4){0.f, 0.f, 0.f, 0.f};
    bf16x8 At[4][2], B0[2][2], B1[2][2];
    const char* cA = (const char*)g.A + (size_t)cur.pm * tstep; const char* cB = (const char*)g.Bt + (size_t)cur.pn * tstep;
    S.a_ready(cur);
    if constexpr (SP2) {
        PG8_STAGE(PG8_SB(0, 0), cB, voffB); PG8_STAGE(PG8_SB(0, 1), cB + hstep, voffB); PG8_STAGE(PG8_SA(0, 0), cA, voffA); PG8_STAGE(PG8_SA(0, 1), cA + hstep, voffA);
        if (wr == 1) PG8_BAR;
        PG8_WAIT_V(2); PG8_BAR;
        PG8_STAGE(PG8_SB(1, 0), cB + kstep, voffB); PG8_STAGE(PG8_SA(1, 0), cA + kstep, voffA); PG8_STAGE(PG8_SB(1, 1), cB + hstep + kstep, voffB);
        PG8_WAIT_V(6); PG8_BAR;
    } else {
        PG8_STAGE(PG8_SB(0, 0), cB, voffB); PG8_STAGE(PG8_SA(0, 0), cA, voffA); PG8_STAGE(PG8_SB(0, 1), cB + hstep, voffB); PG8_STAGE(PG8_SA(0, 1), cA + hstep, voffA);
        if (wr == 1) PG8_BAR;
        PG8_WAIT_V(4); PG8_BAR;
        PG8_STAGE(PG8_SB(1, 0), cB + kstep, voffB); PG8_STAGE(PG8_SA(1, 0), cA + kstep, voffA); PG8_STAGE(PG8_SB(1, 1), cB + hstep + kstep, voffB);
        PG8_WAIT_V(6); PG8_BAR;
    }
    for (;;) {
        const bool has_next = S.next(ui + 1, nxt);
        const char* nA = has_next ? (const char*)g.A + (size_t)nxt.pm * tstep : cA; const char* nB = has_next ? (const char*)g.Bt + (size_t)nxt.pn * tstep : cB;
        for (int t = 0; t < nt; t += 2) {
            const bool last = (t == nt - 2);
            const char* a1 = cA + (size_t)(t + 1) * kstep;
            const char* a2 = last ? nA : cA + (size_t)(t + 2) * kstep; const char* b2 = last ? nB : cB + (size_t)(t + 2) * kstep;
            const char* a3 = a2 + kstep; const char* b3 = b2 + kstep;
            if (last && has_next) S.a_ready(nxt);
            if constexpr (SP2) {
            PG8_LDB(B0, 0, 0); PG8_LDB(B1, 0, 1); PG8_SCHED; PG8_LDA(At, 0, 0); PG8_STAGE(PG8_SA(1, 1), a1 + hstep, voffA);
            PG8_WAIT_V(8); PG8_WAIT_L(0); PG8_BAR; PG8_MMA(0, 0, At, B0); PG8_MMA(0, 1, At, B1); PG8_BAR; PG8_SCHED;
            PG8_LDA(At, 0, 1); PG8_STAGE(PG8_SB(0, 0), b2, voffB); PG8_STAGE(PG8_SB(0, 1), b2 + hstep, voffB); PG8_STAGE(PG8_SA(0, 0), a2, voffA);
            PG8_WAIT_V(8); PG8_WAIT_L(0); PG8_BAR; PG8_MMA(1, 0, At, B0); PG8_MMA(1, 1, At, B1); PG8_BAR; PG8_SCHED;
            PG8_LDB(B0, 1, 0); PG8_LDB(B1, 1, 1); PG8_SCHED; PG8_LDA(At, 1, 0); PG8_STAGE(PG8_SA(0, 1), a2 + hstep, voffA);
            PG8_WAIT_V(8); PG8_WAIT_L(0); PG8_BAR; PG8_MMA(0, 0, At, B0); PG8_MMA(0, 1, At, B1); PG8_BAR; PG8_SCHED;
            PG8_LDA(At, 1, 1); PG8_STAGE(PG8_SB(1, 0), b3, voffB); PG8_STAGE(PG8_SB(1, 1), b3 + hstep, voffB); PG8_STAGE(PG8_SA(1, 0), a3, voffA);
            PG8_WAIT_V(8); PG8_WAIT_L(0); PG8_BAR; PG8_MMA(1, 0, At, B0); PG8_MMA(1, 1, At, B1); PG8_BAR; PG8_SCHED;
            } else {
            PG8_LDB(B0, 0, 0); PG8_SCHED; PG8_LDA(At, 0, 0); PG8_STAGE(PG8_SA(1, 1), a1 + hstep, voffA);
            PG8_WAIT_L(8); PG8_BAR; PG8_WAIT_L(0); PG8_MMA(0, 0, At, B0); PG8_BAR; PG8_SCHED;
            PG8_LDB(B1, 0, 1); PG8_STAGE(PG8_SB(0, 0), b2, voffB);
            PG8_BAR; PG8_WAIT_L(0); PG8_MMA(0, 1, At, B1); PG8_BAR;
            PG8_LDA(At, 0, 1); PG8_STAGE(PG8_SA(0, 0), a2, voffA);
            PG8_BAR; PG8_WAIT_L(0); PG8_MMA(1, 0, At, B0); PG8_BAR; PG8_SCHED;
            PG8_STAGE(PG8_SB(0, 1), b2 + hstep, voffB);
            PG8_WAIT_V(6); PG8_BAR; PG8_MMA(1, 1, At, B1); PG8_BAR;
            PG8_LDB(B0, 1, 0); PG8_SCHED; PG8_LDA(At, 1, 0); PG8_STAGE(PG8_SA(0, 1), a2 + hstep, voffA);
            PG8_WAIT_L(8); PG8_BAR; PG8_WAIT_L(0); PG8_MMA(0, 0, At, B0); PG8_BAR; PG8_SCHED;
            PG8_LDB(B1, 1, 1); PG8_STAGE(PG8_SB(1, 0), b3, voffB);
            PG8_BAR; PG8_WAIT_L(0); PG8_MMA(0, 1, At, B1); PG8_BAR;
            PG8_LDA(At, 1, 1); PG8_STAGE(PG8_SA(1, 0), a3, voffA);
            PG8_BAR; PG8_WAIT_L(0); PG8_MMA(1, 0, At, B0); PG8_BAR; PG8_SCHED;
            PG8_STAGE(PG8_SB(1, 1), b3 + hstep, voffB);
            PG8_WAIT_V(6); PG8_BAR; PG8_MMA(1, 1, At, B1); PG8_BAR;
            }
        }
        if constexpr (ALIGN_EPI) { if (wr == 0) PG8_BAR; }
        if constexpr (!Epi::AFTER_DRAIN) { E(acc, cur, wr, wc, fr, fq); S.done(cur); }
        if (!has_next) break;
#pragma unroll
        for (int a = 0; a < 2; ++a)
#pragma unroll
            for (int b = 0; b < 2; ++b)
#pragma unroll
                for (int m = 0; m < 4; ++m)
#pragma unroll
                    for (int n = 0; n < 2; ++n) acc[a][b][m][n] = (f32x4){0.f, 0.f, 0.f, 0.f};
        cur = nxt; cA = nA; cB = nB; ++ui;
        if constexpr (ALIGN_EPI) { if (wr == 1) PG8_BAR; }
    }
    PG8_WAIT_V(0);
    if constexpr (!ALIGN_EPI) { if (wr == 0) PG8_BAR; }
    PG8_BAR;
    if constexpr (Epi::AFTER_DRAIN) { E.fused(acc, cur, wr, wc, fr, fq, lds, wid, lane); S.done(cur); }
#undef PG8_SA
#undef PG8_SB
#undef PG8_STAGE
#undef PG8_LDA
#undef PG8_LDB
#undef PG8_MMA
#undef PG8_WAIT_V
#undef PG8_WAIT_L
#undef PG8_BAR
#undef PG8_SCHED
}
}

struct EpiIn0 {
    const float* parts; int nparts; const float* bias;
    const float *aqn, *akn, *bqn, *bkn, *rope;
    bf16_t *QA, *KA, *VA, *GA, *QB, *KB, *VB, *GB;
    static constexpr bool PERM = false, AFTER_DRAIN = false;
    __device__ __forceinline__ void operator()(const f32x4 (&acc)[2][2][4][2], const pg8::Unit& u, int wr, int wc, int fr, int fq) const { (*this)(acc, u.pm, u.pn, wr, wc, fr, fq); }
    __device__ __forceinline__ void operator()(const f32x4 (&acc)[2][2][4][2], int pm, int pn, int wr, int wc, int fr, int fq) const {
        const int g = 4 * pn + wc;
        bf16_t* dst; int ld, col, type; const float* gain = nullptr;
        if (g < 8) { dst = QA; ld = 512; col = g * 64; type = 2; gain = aqn; }
        else if (g < 10) { dst = KA; ld = 128; col = (g - 8) * 64; type = 3; gain = akn; }
        else if (g < 12) { dst = VA; ld = 128; col = (g - 10) * 64; type = 0; }
        else if (g < 20) { dst = GA; ld = 512; col = (g - 12) * 64; type = 1; }
        else if (g < 28) { dst = QB; ld = 512; col = (g - 20) * 64; type = 2; gain = bqn; }
        else if (g < 36) { dst = KB; ld = 512; col = (g - 28) * 64; type = 3; gain = bkn; }
        else if (g < 44) { dst = VB; ld = 512; col = (g - 36) * 64; type = 0; }
        else { dst = GB; ld = 512; col = (g - 44) * 64; type = 1; }
#pragma unroll
        for (int ai = 0; ai < 2; ++ai)
#pragma unroll
            for (int m = 0; m < 4; ++m) {
                const int row = pm * 256 + ai * 128 + wr * 64 + m * 16 + fr;
                float ss = 0.f;
                for (int i = 0; i < nparts; ++i) ss += parts[(size_t)i * M + row];
                const float rstd = rsqrtf(ss * (1.0f / 1024.0f) + EPS);
                const int r = row < ML ? row >> 11 : 32;
                const float* bptr = bias + (size_t)r * 3328 + pn * 256 + wc * 32 + fq * 4;
                f32x4 v[2][2];
#pragma unroll
                for (int bj = 0; bj < 2; ++bj)
#pragma unroll
                    for (int n = 0; n < 2; ++n) v[bj][n] = acc[ai][bj][m][n] * rstd + *(const f32x4*)(bptr + bj * 128 + n * 16);
                if (type >= 2) {
                    float s2 = 0.f;
#pragma unroll
                    for (int bj = 0; bj < 2; ++bj)
#pragma unroll
                        for (int n = 0; n < 2; ++n) s2 += v[bj][n][0] * v[bj][n][0] + v[bj][n][1] * v[bj][n][1] + v[bj][n][2] * v[bj][n][2] + v[bj][n][3] * v[bj][n][3];
                    s2 += __shfl_xor(s2, 16); s2 += __shfl_xor(s2, 32);
                    const float rn = rsqrtf(s2 * (1.0f / 64.0f) + EPS);
#pragma unroll
                    for (int bj = 0; bj < 2; ++bj)
#pragma unroll
                        for (int n = 0; n < 2; ++n) v[bj][n] = v[bj][n] * rn * *(const f32x4*)(gain + bj * 32 + n * 16 + fq * 4);
                    if (row < ML) {
                        const int t = row & 2047;
#pragma unroll
                        for (int bj = 0; bj < 2; ++bj) {
                            const int pos = bj == 0 ? (t >> 6) : (t & 63);
                            const float* cs = rope + (pos * 16 + fq * 4) * 2;
                            const f32x4 c01 = *(const f32x4*)cs, c23 = *(const f32x4*)(cs + 4);
                            const float cc[4] = {c01[0], c01[2], c23[0], c23[2]}, sn[4] = {c01[1], c01[3], c23[1], c23[3]};
#pragma unroll
                            for (int e = 0; e < 4; ++e) { const float x1 = v[bj][0][e], x2 = v[bj][1][e]; v[bj][0][e] = x1 * cc[e] - x2 * sn[e]; v[bj][1][e] = x2 * cc[e] + x1 * sn[e]; }
                        }
                    }
                    if (type == 2) {
#pragma unroll
                        for (int bj = 0; bj < 2; ++bj)
#pragma unroll
                            for (int n = 0; n < 2; ++n) v[bj][n] = v[bj][n] * QSCALE;
                    }
                } else if (type == 1) {
#pragma unroll
                    for (int bj = 0; bj < 2; ++bj)
#pragma unroll
                        for (int n = 0; n < 2; ++n)
#pragma unroll
                            for (int e = 0; e < 4; ++e) v[bj][n][e] = siluf(v[bj][n][e]);
                }
#pragma unroll
                for (int bj = 0; bj < 2; ++bj) {
                    u32x4 o; o.x = pack2(v[bj][0][0], v[bj][0][1]); o.y = pack2(v[bj][0][2], v[bj][0][3]); o.z = pack2(v[bj][1][0], v[bj][1][1]); o.w = pack2(v[bj][1][2], v[bj][1][3]);
                    *(u32x4*)(dst + (size_t)row * ld + col + bj * 32 + fq * 8) = o;
                }
            }
    }
};

struct EpiIn1 {
    const float* parts; int nparts; const float* bias;
    bf16_t *QG, *KG, *VG, *GG; float* RF;
    static constexpr bool PERM = false, AFTER_DRAIN = false;
    __device__ __forceinline__ void operator()(const f32x4 (&acc)[2][2][4][2], const pg8::Unit& u, int wr, int wc, int fr, int fq) const { (*this)(acc, u.pm, u.pn, wr, wc, fr, fq); }
    __device__ __forceinline__ void operator()(const f32x4 (&acc)[2][2][4][2], int pm, int pn, int wr, int wc, int fr, int fq) const {
        const int g = 4 * pn + wc;
        if (g > 48) return;
        bf16_t* dst = nullptr; int ld = 0, col = 0, type;
        if (g < 8) { dst = QG; ld = 512; col = g * 64; type = 2; }
        else if (g < 16) { dst = KG; ld = 512; col = (g - 8) * 64; type = 0; }
        else if (g < 32) { dst = VG; ld = 1024; col = (g - 16) * 64; type = 0; }
        else if (g < 48) { dst = GG; ld = 1024; col = (g - 32) * 64; type = 1; }
        else type = 3;
#pragma unroll
        for (int ai = 0; ai < 2; ++ai)
#pragma unroll
            for (int m = 0; m < 4; ++m) {
                const int row = pm * 256 + ai * 128 + wr * 64 + m * 16 + fr;
                float ss = 0.f;
                for (int i = 0; i < nparts; ++i) ss += parts[(size_t)i * M + row];
                const float rstd = rsqrtf(ss * (1.0f / 1024.0f) + EPS);
                const int r = row < ML ? row >> 11 : 32;
                const float* bptr = bias + (size_t)r * 3328 + pn * 256 + wc * 32 + fq * 4;
                f32x4 v[2][2];
#pragma unroll
                for (int bj = 0; bj < 2; ++bj)
#pragma unroll
                    for (int n = 0; n < 2; ++n) v[bj][n] = acc[ai][bj][m][n] * rstd + *(const f32x4*)(bptr + bj * 128 + n * 16);
                if (type == 3) {
                    *(f32x4*)(RF + (size_t)row * 32 + fq * 8) = v[0][0];
                    *(f32x4*)(RF + (size_t)row * 32 + fq * 8 + 4) = v[0][1];
                    continue;
                }
                if (type == 2) {
#pragma unroll
                    for (int bj = 0; bj < 2; ++bj)
#pragma unroll
                        for (int n = 0; n < 2; ++n) v[bj][n] = v[bj][n] * 0.08838834764831845f;
                } else if (type == 1) {
#pragma unroll
                    for (int bj = 0; bj < 2; ++bj)
#pragma unroll
                        for (int n = 0; n < 2; ++n)
#pragma unroll
                            for (int e = 0; e < 4; ++e) v[bj][n][e] = siluf(v[bj][n][e]);
                }
#pragma unroll
                for (int bj = 0; bj < 2; ++bj) {
                    u32x4 o; o.x = pack2(v[bj][0][0], v[bj][0][1]); o.y = pack2(v[bj][0][2], v[bj][0][3]); o.z = pack2(v[bj][1][0], v[bj][1][1]); o.w = pack2(v[bj][1][2], v[bj][1][3]);
                    *(u32x4*)(dst + (size_t)row * ld + col + bj * 32 + fq * 8) = o;
                }
            }
    }
};

struct EpiOut0 {
    const float *x, *ctx, *mod, *g1; float* out; bf16_t* A1; float* parts;
    static constexpr bool PERM = false, AFTER_DRAIN = false;
    __device__ __forceinline__ void operator()(const f32x4 (&acc)[2][2][4][2], const pg8::Unit& u, int wr, int wc, int fr, int fq) const { (*this)(acc, u.pm, u.pn, wr, wc, fr, fq); }
    __device__ __forceinline__ void operator()(const f32x4 (&acc)[2][2][4][2], int pm, int pn, int wr, int wc, int fr, int fq) const {
#pragma unroll
        for (int ai = 0; ai < 2; ++ai)
#pragma unroll
            for (int m = 0; m < 4; ++m) {
                const int row = pm * 256 + ai * 128 + wr * 64 + m * 16 + fr;
                const int r = row < ML ? row >> 11 : 32;
                const float* xin = row < ML ? x + (size_t)row * D : ctx + (size_t)(row - ML) * D;
                const float* gt = mod + (size_t)r * 3072 + 2048;
                const float* sc = mod + (size_t)(33 + r) * 3072 + 1024;
                float ss = 0.f;
#pragma unroll
                for (int bj = 0; bj < 2; ++bj) {
                    const int c = pn * 256 + wc * 64 + bj * 32 + fq * 8;
                    f32x4 y[2];
#pragma unroll
                    for (int n = 0; n < 2; ++n) {
                        const f32x4 x1 = *(const f32x4*)(xin + c + n * 4) + *(const f32x4*)(gt + c + n * 4) * acc[ai][bj][m][n];
                        ss += x1[0] * x1[0] + x1[1] * x1[1] + x1[2] * x1[2] + x1[3] * x1[3];
                        if (row < ML) *(f32x4*)(out + (size_t)row * D + c + n * 4) = x1;
                        y[n] = x1 * *(const f32x4*)(g1 + c + n * 4) * (1.0f + *(const f32x4*)(sc + c + n * 4));
                    }
                    u32x4 o; o.x = pack2(y[0][0], y[0][1]); o.y = pack2(y[0][2], y[0][3]); o.z = pack2(y[1][0], y[1][1]); o.w = pack2(y[1][2], y[1][3]);
                    *(u32x4*)(A1 + (size_t)row * D + c) = o;
                }
                ss += __shfl_xor(ss, 16); ss += __shfl_xor(ss, 32);
                if (fq == 0) parts[(size_t)(4 * pn + wc) * M + row] = ss;
            }
    }
};

struct EpiOut1 {
    const float* mod; float* out;
    static constexpr bool PERM = false, AFTER_DRAIN = false;
    __device__ __forceinline__ void operator()(const f32x4 (&acc)[2][2][4][2], const pg8::Unit& u, int wr, int wc, int fr, int fq) const { (*this)(acc, u.pm, u.pn, wr, wc, fr, fq); }
    __device__ __forceinline__ void operator()(const f32x4 (&acc)[2][2][4][2], int pm, int pn, int wr, int wc, int fr, int fq) const {
#pragma unroll
        for (int ai = 0; ai < 2; ++ai)
#pragma unroll
            for (int m = 0; m < 4; ++m) {
                const int row = pm * 256 + ai * 128 + wr * 64 + m * 16 + fr;
                const int r = row >> 11;
                const float* gt = mod + (size_t)(33 + r) * 3072 + 2048;
#pragma unroll
                for (int bj = 0; bj < 2; ++bj)
#pragma unroll
                    for (int n = 0; n < 2; ++n) {
                        const int c = pn * 256 + wc * 64 + bj * 32 + fq * 8 + n * 4;
                        float* o = out + (size_t)row * D + c;
                        *(f32x4*)o = *(const f32x4*)o + *(const f32x4*)(gt + c) * acc[ai][bj][m][n];
                    }
            }
    }
};

template <class Epi>
__device__ void gemm_simple(const bf16_t* __restrict__ A, const bf16_t* __restrict__ Bt, int nM, int nN, const Epi& E, unsigned char* lds, int vb, int nvb) {
    const int tid = threadIdx.x, wid = tid >> 6, lane = tid & 63, wr = wid >> 2, wc = wid & 3, fr = lane & 15, fq = lane >> 4;
    unsigned char* ldsA = lds; unsigned char* ldsB = lds + 256 * 80;
    for (int tile = vb; tile < nM * nN; tile += nvb) {
        const int pm = tile / nN, pn = tile % nN;
        f32x4 acc[2][2][4][2];
#pragma unroll
        for (int a = 0; a < 2; ++a)
#pragma unroll
            for (int b = 0; b < 2; ++b)
#pragma unroll
                for (int m = 0; m < 4; ++m)
#pragma unroll
                    for (int n = 0; n < 2; ++n) acc[a][b][m][n] = (f32x4){0.f, 0.f, 0.f, 0.f};
        for (int k0 = 0; k0 < D; k0 += 32) {
            __syncthreads();
#pragma unroll
            for (int i = 0; i < 2; ++i) {
                const int cidx = tid + 512 * i, r = cidx >> 2, kc = cidx & 3;
                *(u32x4*)(ldsA + r * 80 + kc * 16) = *(const u32x4*)(A + (size_t)(pm * 256 + r) * D + k0 + kc * 8);
                *(u32x4*)(ldsB + r * 80 + kc * 16) = *(const u32x4*)(Bt + (size_t)(pn * 256 + r) * D + k0 + kc * 8);
            }
            __syncthreads();
            bf16x8 af[2][4], bfr[2][2];
#pragma unroll
            for (int ai = 0; ai < 2; ++ai)
#pragma unroll
                for (int m = 0; m < 4; ++m) af[ai][m] = *(const bf16x8*)(ldsA + (ai * 128 + wr * 64 + m * 16 + fr) * 80 + fq * 16);
#pragma unroll
            for (int bj = 0; bj < 2; ++bj)
#pragma unroll
                for (int n = 0; n < 2; ++n) bfr[bj][n] = *(const bf16x8*)(ldsB + (bj * 128 + wc * 32 + n * 16 + fr) * 80 + fq * 16);
#pragma unroll
            for (int ai = 0; ai < 2; ++ai)
#pragma unroll
                for (int bj = 0; bj < 2; ++bj)
#pragma unroll
                    for (int m = 0; m < 4; ++m)
#pragma unroll
                        for (int n = 0; n < 2; ++n) acc[ai][bj][m][n] = __builtin_amdgcn_mfma_f32_16x16x32_bf16(bfr[bj][n], af[ai][m], acc[ai][bj][m][n], 0, 0, 0);
        }
        E(acc, pm, pn, wr, wc, fr, fq);
    }
}

__device__ __forceinline__ float maxabs64(const float* g) { float m = 0.f; for (int i = 0; i < 64; ++i) m = fmaxf(m, fabsf(g[i])); return m; }

__device__ __forceinline__ void phase_attnA(const Params& P, int vb, int nvb) {
    const float MA = 8.0f * maxabs64(P.a_q_norm) * maxabs64(P.a_k_norm) * LOG2E;
    for (long idx = (long)vb * blockDim.x + threadIdx.x; idx < (long)M * 8; idx += (long)nvb * blockDim.x) {
        const int h = (int)(idx / M), m = (int)(idx % M), kv = h >> 2;
        float q[64], o[64];
        {
            const u32x4* qp = (const u32x4*)(P.QA() + (size_t)m * 512 + h * 64);
#pragma unroll
            for (int i = 0; i < 8; ++i) { const u32x4 w = qp[i]; q[8 * i] = bflo(w.x); q[8 * i + 1] = bfhi(w.x); q[8 * i + 2] = bflo(w.y); q[8 * i + 3] = bfhi(w.y); q[8 * i + 4] = bflo(w.z); q[8 * i + 5] = bfhi(w.z); q[8 * i + 6] = bflo(w.w); q[8 * i + 7] = bfhi(w.w); }
        }
#pragma unroll
        for (int i = 0; i < 64; ++i) o[i] = 0.f;
        float l = 0.f;
        int b, nlat = 0, j0 = 0;
        if (m < ML) { b = m >> 11; const int t = m & 2047; j0 = t - 128 < 0 ? 0 : t - 128; const int j1 = t + 128 > 2047 ? 2047 : t + 128; nlat = j1 - j0 + 1; }
        else b = (m - ML) >> 8;
        const int ntot = nlat + 256;
        for (int jj = 0; jj < ntot; ++jj) {
            const int kr = jj < nlat ? b * 2048 + j0 + jj : ML + b * 256 + (jj - nlat);
            const u32x4* kp = (const u32x4*)(P.KA() + (size_t)kr * 128 + kv * 64);
            float s = 0.f;
#pragma unroll
            for (int i = 0; i < 8; ++i) { const u32x4 w = kp[i]; s += q[8 * i] * bflo(w.x) + q[8 * i + 1] * bfhi(w.x) + q[8 * i + 2] * bflo(w.y) + q[8 * i + 3] * bfhi(w.y) + q[8 * i + 4] * bflo(w.z) + q[8 * i + 5] * bfhi(w.z) + q[8 * i + 6] * bflo(w.w) + q[8 * i + 7] * bfhi(w.w); }
            const float p = exp2f(s - MA);
            l += p;
            const u32x4* vp = (const u32x4*)(P.VA() + (size_t)kr * 128 + kv * 64);
#pragma unroll
            for (int i = 0; i < 8; ++i) { const u32x4 w = vp[i]; o[8 * i] += p * bflo(w.x); o[8 * i + 1] += p * bfhi(w.x); o[8 * i + 2] += p * bflo(w.y); o[8 * i + 3] += p * bfhi(w.y); o[8 * i + 4] += p * bflo(w.z); o[8 * i + 5] += p * bfhi(w.z); o[8 * i + 6] += p * bflo(w.w); o[8 * i + 7] += p * bfhi(w.w); }
        }
        l += exp2f(P.a_sink[h] * LOG2E - MA);
        const float inv = 1.0f / l;
        const u32x4* gp = (const u32x4*)(P.GA() + (size_t)m * 512 + h * 64);
        u32x4* op = (u32x4*)(P.O() + (size_t)m * 1024 + h * 64);
#pragma unroll
        for (int i = 0; i < 8; ++i) {
            const u32x4 w = gp[i]; u32x4 r;
            r.x = pack2(o[8 * i] * inv * bflo(w.x), o[8 * i + 1] * inv * bfhi(w.x)); r.y = pack2(o[8 * i + 2] * inv * bflo(w.y), o[8 * i + 3] * inv * bfhi(w.y));
            r.z = pack2(o[8 * i + 4] * inv * bflo(w.z), o[8 * i + 5] * inv * bfhi(w.z)); r.w = pack2(o[8 * i + 6] * inv * bflo(w.w), o[8 * i + 7] * inv * bfhi(w.w));
            op[i] = r;
        }
    }
}

__device__ __forceinline__ void phase_attnB(const Params& P, int vb, int nvb) {
    const float MB = 8.0f * maxabs64(P.b_q_norm) * maxabs64(P.b_k_norm) * LOG2E;
    float d1 = 0.f, d2 = 0.f;
    for (int i = 0; i < 64; ++i) { d1 += P.lq1[i] * P.lk1[i]; d2 += P.lq2[i] * P.lk2[i]; }
    const float lam = expf(d1) - expf(d2) + LAMBDA_INIT;
    for (long idx = (long)vb * blockDim.x + threadIdx.x; idx < (long)M * 16; idx += (long)nvb * blockDim.x) {
        const int qt = (int)(idx & 3); const long hm = idx >> 2; const int h = (int)(hm / M), m = (int)(hm % M);
        int b, nlat;
        if (m < ML) { b = m >> 11; nlat = 2048; } else { b = (m - ML) >> 8; nlat = 0; }
        const int ntot = nlat + 256;
        float rres[32];
        for (int s = 0; s < 2; ++s) {
            const int g = 2 * h + s;
            float q[64], o[32];
            const u32x4* qp = (const u32x4*)(P.QB() + (size_t)m * 512 + g * 64);
#pragma unroll
            for (int i = 0; i < 8; ++i) { const u32x4 w = qp[i]; q[8 * i] = bflo(w.x); q[8 * i + 1] = bfhi(w.x); q[8 * i + 2] = bflo(w.y); q[8 * i + 3] = bfhi(w.y); q[8 * i + 4] = bflo(w.z); q[8 * i + 5] = bfhi(w.z); q[8 * i + 6] = bflo(w.w); q[8 * i + 7] = bfhi(w.w); }
#pragma unroll
            for (int i = 0; i < 32; ++i) o[i] = 0.f;
            float l = 0.f;
            for (int jj = 0; jj < ntot; ++jj) {
                const int kr = jj < nlat ? b * 2048 + jj : ML + b * 256 + (jj - nlat);
                const u32x4* kp = (const u32x4*)(P.KB() + (size_t)kr * 512 + g * 64);
                float sc = 0.f;
#pragma unroll
                for (int i = 0; i < 8; ++i) { const u32x4 w = kp[i]; sc += q[8 * i] * bflo(w.x) + q[8 * i + 1] * bfhi(w.x) + q[8 * i + 2] * bflo(w.y) + q[8 * i + 3] * bfhi(w.y) + q[8 * i + 4] * bflo(w.z) + q[8 * i + 5] * bfhi(w.z) + q[8 * i + 6] * bflo(w.w) + q[8 * i + 7] * bfhi(w.w); }
                const float p = exp2f(sc - MB);
                l += p;
                const u32x4* vp = (const u32x4*)(P.VB() + (size_t)kr * 512 + h * 128 + qt * 32);
#pragma unroll
                for (int i = 0; i < 4; ++i) { const u32x4 w = vp[i]; o[8 * i] += p * bflo(w.x); o[8 * i + 1] += p * bfhi(w.x); o[8 * i + 2] += p * bflo(w.y); o[8 * i + 3] += p * bfhi(w.y); o[8 * i + 4] += p * bflo(w.z); o[8 * i + 5] += p * bfhi(w.z); o[8 * i + 6] += p * bflo(w.w); o[8 * i + 7] += p * bfhi(w.w); }
            }
            const float inv = 1.0f / l;
            if (s == 0) {
#pragma unroll
                for (int i = 0; i < 32; ++i) rres[i] = o[i] * inv;
            } else {
#pragma unroll
                for (int i = 0; i < 32; ++i) rres[i] -= lam * o[i] * inv;
            }
        }
        float ss = 0.f;
#pragma unroll
        for (int i = 0; i < 32; ++i) ss += rres[i] * rres[i];
        ss += __shfl_xor(ss, 1); ss += __shfl_xor(ss, 2);
        const float rn = rsqrtf(ss * (1.0f / 128.0f) + EPS) * (1.0f - LAMBDA_INIT);
        const u32x4* gp = (const u32x4*)(P.GB() + (size_t)m * 512 + h * 128 + qt * 32);
        const float* sl = P.b_subln + qt * 32;
        u32x4* op = (u32x4*)(P.O() + (size_t)m * 1024 + 512 + h * 128 + qt * 32);
#pragma unroll
        for (int i = 0; i < 4; ++i) {
            const u32x4 w = gp[i]; u32x4 r;
            r.x = pack2(rres[8 * i] * rn * sl[8 * i] * bflo(w.x), rres[8 * i + 1] * rn * sl[8 * i + 1] * bfhi(w.x));
            r.y = pack2(rres[8 * i + 2] * rn * sl[8 * i + 2] * bflo(w.y), rres[8 * i + 3] * rn * sl[8 * i + 3] * bfhi(w.y));
            r.z = pack2(rres[8 * i + 4] * rn * sl[8 * i + 4] * bflo(w.z), rres[8 * i + 5] * rn * sl[8 * i + 5] * bfhi(w.z));
            r.w = pack2(rres[8 * i + 6] * rn * sl[8 * i + 6] * bflo(w.w), rres[8 * i + 7] * rn * sl[8 * i + 7] * bfhi(w.w));
            op[i] = r;
        }
    }
}

typedef float f32x16 __attribute__((ext_vector_type(16)));
typedef short s16x4 __attribute__((ext_vector_type(4)));
typedef float f32x2_t __attribute__((ext_vector_type(2)));
typedef __bf16 bf16x2_t __attribute__((ext_vector_type(2)));
#define LDSAS __attribute__((address_space(3)))
__device__ __forceinline__ unsigned cvtpk(float lo, float hi) { f32x2_t v = {lo, hi}; bf16x2_t b = __builtin_convertvector(v, bf16x2_t); return __builtin_bit_cast(unsigned, b); }
__device__ __forceinline__ int crow(int r, int hi) { return (r & 3) + 8 * (r >> 2) + 4 * hi; }
__device__ __forceinline__ s16x4 vtr(const LDSAS unsigned char* p) { return __builtin_bit_cast(s16x4, __builtin_amdgcn_ds_read_tr16_b64_v4i16((LDSAS s16x4*)p)); }

constexpr int AB_K1 = 0, AB_K2 = 16384, AB_V = 32768;
constexpr int AB_XCH = 0, AB_SCR = 67584, AB_LDS = 67584 + 8 * 256;

__device__ __forceinline__ void attnB_unit(const Params& P, LDSAS unsigned char* lds, int b, int h, int qrow0, int t_begin, int t_end) {
    const int tid = otid(), lane = tid & 63, r32 = lane & 31, hi = lane >> 5;
    const int wid = __builtin_amdgcn_readfirstlane(tid >> 6);
    const int s = wid >> 2, qt = wid & 3;
    const int qrow = qrow0 + qt * 32 + r32;
    bf16x8 qf[4];
#pragma unroll
    for (int d0 = 0; d0 < 4; ++d0) qf[d0] = *(const bf16x8*)(P.QB() + (size_t)qrow * 512 + (2 * h + s) * 64 + d0 * 16 + hi * 8);
    f32x16 o[4];
#pragma unroll
    for (int i = 0; i < 4; ++i) o[i] = (f32x16){};
    float l = 0.f;
    const int krow = tid >> 3, kch = tid & 7, vrow = tid >> 4, vch = tid & 15;
    const int kwoff = krow * 128 + ((kch ^ ((krow >> 1) & 7)) * 16);
    const int vwoff = (vch >> 2) * 4096 + vrow * 64 + (vch & 3) * 16;
    u32x4 rk1, rk2, rv0, rv1;
#define AB_GLOAD(t) do { const int kr0_ = (t) < 32 ? b * 2048 + 64 * (t) : ML + b * 256 + 64 * ((t) - 32); \
        rk1 = *(const u32x4*)(P.KB() + (size_t)(kr0_ + krow) * 512 + (2 * h) * 64 + kch * 8); \
        rk2 = *(const u32x4*)(P.KB() + (size_t)(kr0_ + krow) * 512 + (2 * h + 1) * 64 + kch * 8); \
        rv0 = *(const u32x4*)(P.VB() + (size_t)(kr0_ + vrow) * 512 + h * 128 + vch * 8); \
        rv1 = *(const u32x4*)(P.VB() + (size_t)(kr0_ + vrow + 32) * 512 + h * 128 + vch * 8); } while (0)
#define AB_LWRITE(buf) do { *(LDSAS u32x4*)(lds + AB_K1 + (buf) * 8192 + kwoff) = rk1; *(LDSAS u32x4*)(lds + AB_K2 + (buf) * 8192 + kwoff) = rk2; \
        *(LDSAS u32x4*)(lds + AB_V + (buf) * 16384 + vwoff) = rv0; *(LDSAS u32x4*)(lds + AB_V + (buf) * 16384 + vwoff + 2048) = rv1; } while (0)
    const int kroff = (s ? AB_K2 : AB_K1) + r32 * 128, ksw = (r32 >> 1) & 7;
    const int vroff = AB_V + (4 * hi + ((lane & 15) >> 2)) * 64 + ((lane >> 4) & 1) * 32 + (lane & 3) * 8;
    AB_GLOAD(t_begin); AB_LWRITE(0); __syncthreads();
    for (int t = t_begin; t < t_end; ++t) {
        const int buf = (t - t_begin) & 1;
        const LDSAS unsigned char* kb = lds + buf * 8192 + kroff;
        f32x16 p0 = (f32x16){}, p1 = (f32x16){};
#pragma unroll
        for (int d0 = 0; d0 < 4; ++d0) {
            const int co = ((2 * d0 + hi) ^ ksw) * 16;
            const bf16x8 k0 = *(const LDSAS bf16x8*)(kb + co), k1 = *(const LDSAS bf16x8*)(kb + 4096 + co);
            p0 = __builtin_amdgcn_mfma_f32_32x32x16_bf16(k0, qf[d0], p0, 0, 0, 0);
            p1 = __builtin_amdgcn_mfma_f32_32x32x16_bf16(k1, qf[d0], p1, 0, 0, 0);
        }
        float ls = 0.f;
#pragma unroll
        for (int r = 0; r < 16; ++r) { p0[r] = __builtin_amdgcn_exp2f(p0[r]); p1[r] = __builtin_amdgcn_exp2f(p1[r]); ls += p0[r] + p1[r]; }
        l += ls;
        u32x4 pw[4];
        pw[0].x = cvtpk(p0[0], p0[1]); pw[0].y = cvtpk(p0[2], p0[3]); pw[0].z = cvtpk(p0[4], p0[5]); pw[0].w = cvtpk(p0[6], p0[7]);
        pw[1].x = cvtpk(p0[8], p0[9]); pw[1].y = cvtpk(p0[10], p0[11]); pw[1].z = cvtpk(p0[12], p0[13]); pw[1].w = cvtpk(p0[14], p0[15]);
        pw[2].x = cvtpk(p1[0], p1[1]); pw[2].y = cvtpk(p1[2], p1[3]); pw[2].z = cvtpk(p1[4], p1[5]); pw[2].w = cvtpk(p1[6], p1[7]);
        pw[3].x = cvtpk(p1[8], p1[9]); pw[3].y = cvtpk(p1[10], p1[11]); pw[3].z = cvtpk(p1[12], p1[13]); pw[3].w = cvtpk(p1[14], p1[15]);
        if (t + 1 < t_end) AB_GLOAD(t + 1);
        const LDSAS unsigned char* vb = lds + buf * 16384 + vroff;
#pragma unroll
        for (int d0 = 0; d0 < 4; ++d0)
#pragma unroll
            for (int ks = 0; ks < 4; ++ks) {
                const s16x4 lo = vtr(vb + d0 * 4096 + ks * 1024), hh = vtr(vb + d0 * 4096 + ks * 1024 + 512);
                const bf16x8 vf = (bf16x8){lo[0], lo[1], lo[2], lo[3], hh[0], hh[1], hh[2], hh[3]};
                o[d0] = __builtin_amdgcn_mfma_f32_32x32x16_bf16(__builtin_bit_cast(bf16x8, pw[ks]), vf, o[d0], 0, 0, 0);
                if (ks == 3) __builtin_amdgcn_sched_barrier(0);
            }
        if (t + 1 < t_end) AB_LWRITE(buf ^ 1);
        __syncthreads();
    }
#undef AB_GLOAD
#undef AB_LWRITE
    l += __shfl_xor(l, 32);
    LDSAS float* scr = (LDSAS float*)(lds + AB_SCR + wid * 256);
    LDSAS float* xch = (LDSAS float*)(lds + AB_XCH + qt * 16896);
    if (hi == 0) scr[r32] = (s ? P.scal()[0] : 1.0f) / l;
    float rl[16];
#pragma unroll
    for (int r = 0; r < 16; ++r) rl[r] = scr[crow(r, hi)];
    if (s == 1) {
#pragma unroll
        for (int d0 = 0; d0 < 4; ++d0)
#pragma unroll
            for (int r = 0; r < 16; ++r) xch[crow(r, hi) * 132 + d0 * 32 + r32] = o[d0][r] * rl[r];
    }
    __syncthreads();
    if (s == 0) {
        float ss[16];
#pragma unroll
        for (int r = 0; r < 16; ++r) {
            float s2 = 0.f;
#pragma unroll
            for (int d0 = 0; d0 < 4; ++d0) { const float v = o[d0][r] * rl[r] - xch[crow(r, hi) * 132 + d0 * 32 + r32]; o[d0][r] = v; s2 += v * v; }
            ss[r] = s2;
        }
#pragma unroll
        for (int r = 0; r < 16; ++r) {
            float s2 = ss[r];
            s2 += __shfl_xor(s2, 1); s2 += __shfl_xor(s2, 2); s2 += __shfl_xor(s2, 4); s2 += __shfl_xor(s2, 8); s2 += __shfl_xor(s2, 16);
            ss[r] = rsqrtf(s2 * (1.0f / 128.0f) + EPS) * (1.0f - LAMBDA_INIT);
        }
#pragma unroll
        for (int d0 = 0; d0 < 4; ++d0) {
            const float sl = P.b_subln[d0 * 32 + r32];
#pragma unroll
            for (int r = 0; r < 16; ++r) xch[crow(r, hi) * 132 + d0 * 32 + r32] = o[d0][r] * ss[r] * sl;
        }
        const int eq = lane >> 1, eseg = lane & 1;
        const size_t grow = (size_t)(qrow0 + qt * 32 + eq);
        const u32x4* gp = (const u32x4*)(P.GB() + grow * 512 + h * 128 + eseg * 64);
        u32x4* op = (u32x4*)(P.O() + grow * 1024 + 512 + h * 128 + eseg * 64);
#pragma unroll
        for (int i = 0; i < 8; ++i) {
            const f32x4 a = *(const LDSAS f32x4*)(xch + eq * 132 + eseg * 64 + i * 8), c = *(const LDSAS f32x4*)(xch + eq * 132 + eseg * 64 + i * 8 + 4);
            const u32x4 g = gp[i]; u32x4 ov;
            ov.x = cvtpk(a[0] * bflo(g.x), a[1] * bfhi(g.x)); ov.y = cvtpk(a[2] * bflo(g.y), a[3] * bfhi(g.y));
            ov.z = cvtpk(c[0] * bflo(g.z), c[1] * bfhi(g.z)); ov.w = cvtpk(c[2] * bflo(g.w), c[3] * bfhi(g.w));
            op[i] = ov;
        }
    }
    __syncthreads();
}

__device__ __forceinline__ void phase_attnB_mfma(const Params& P, LDSAS unsigned char* lds, int vb, int nvb) {
    for (int u = vb; u < 2048 + 256; u += nvb) {
        if (u < 2048) {
            int pair, qblk;
            if (nvb == 256) { const int round = u >> 8, i = u & 255, xcd = i & 7, slot = i >> 3; pair = round * 16 + xcd * 2 + (slot >> 4); qblk = slot & 15; }
            else { pair = u >> 4; qblk = u & 15; }
            const int b = pair >> 2, h = pair & 3;
            attnB_unit(P, lds, b, h, b * 2048 + qblk * 128, 0, 36);
        } else {
            const int v = u - 2048, pair = v >> 1, qblk = v & 1, b = pair >> 2, h = pair & 3;
            attnB_unit(P, lds, b, h, ML + b * 256 + qblk * 128, 32, 36);
        }
    }
}

constexpr int AA_K = 0, AA_V = 16384;
__device__ __forceinline__ void attnA_unit(const Params& P, LDSAS unsigned char* lds, int b, int kvh, int qrow0, int qpos0, int kt0, int nwin) {
    const int tid = otid(), lane = tid & 63, r32 = lane & 31, hi = lane >> 5;
    const int wid = __builtin_amdgcn_readfirstlane(tid >> 6);
    const int head = kvh * 4 + (wid >> 1), qoff = (wid & 1) * 64;
    bf16x8 qf[2][4];
#pragma unroll
    for (int qq = 0; qq < 2; ++qq)
#pragma unroll
        for (int d0 = 0; d0 < 4; ++d0) qf[qq][d0] = *(const bf16x8*)(P.QA() + (size_t)(qrow0 + qoff + qq * 32 + r32) * 512 + head * 64 + d0 * 16 + hi * 8);
    f32x16 o[2][2];
#pragma unroll
    for (int i = 0; i < 2; ++i) { o[i][0] = (f32x16){}; o[i][1] = (f32x16){}; }
    float l[2] = {0.f, 0.f};
    const int krow = tid >> 3, kch = tid & 7;
    const int kwoff = krow * 128 + ((kch ^ ((krow >> 1) & 7)) * 16);
    const int vwoff = (kch >> 2) * 4096 + krow * 64 + (kch & 3) * 16;
    u32x4 rk, rv;
    const int nt = nwin + 4;
#define AA_KR0(i) ((i) < nwin ? b * 2048 + 64 * (kt0 + (i)) : ML + b * 256 + 64 * ((i) - nwin))
#define AA_GLOAD(i) do { const int kr0_ = AA_KR0(i); rk = *(const u32x4*)(P.KA() + (size_t)(kr0_ + krow) * 128 + kvh * 64 + kch * 8); rv = *(const u32x4*)(P.VA() + (size_t)(kr0_ + krow) * 128 + kvh * 64 + kch * 8); } while (0)
#define AA_LWRITE(buf) do { *(LDSAS u32x4*)(lds + AA_K + (buf) * 8192 + kwoff) = rk; *(LDSAS u32x4*)(lds + AA_V + (buf) * 8192 + vwoff) = rv; } while (0)
    const int kroff = AA_K + r32 * 128, ksw = (r32 >> 1) & 7;
    const int vroff = AA_V + (4 * hi + ((lane & 15) >> 2)) * 64 + ((lane >> 4) & 1) * 32 + (lane & 3) * 8;
    AA_GLOAD(0); AA_LWRITE(0); __syncthreads();
    for (int i = 0; i < nt; ++i) {
        const int buf = i & 1;
        if (i + 1 < nt) AA_GLOAD(i + 1);
        int cls = 1;
        if (i < nwin) { const int delta = 64 * (kt0 + i) - (qpos0 + qoff); cls = delta == -128 ? 2 : (delta == 128 ? 3 : ((delta >= -64 && delta <= 64) ? 1 : 0)); }
        if (cls != 0) {
            const LDSAS unsigned char* kb = lds + buf * 8192 + kroff;
            f32x16 p[2][2];
#pragma unroll
            for (int qq = 0; qq < 2; ++qq) { p[qq][0] = (f32x16){}; p[qq][1] = (f32x16){}; }
#pragma unroll
            for (int d0 = 0; d0 < 4; ++d0) {
                const int co = ((2 * d0 + hi) ^ ksw) * 16;
                const bf16x8 k0 = *(const LDSAS bf16x8*)(kb + co), k1 = *(const LDSAS bf16x8*)(kb + 4096 + co);
#pragma unroll
                for (int qq = 0; qq < 2; ++qq) {
                    p[qq][0] = __builtin_amdgcn_mfma_f32_32x32x16_bf16(k0, qf[qq][d0], p[qq][0], 0, 0, 0);
                    p[qq][1] = __builtin_amdgcn_mfma_f32_32x32x16_bf16(k1, qf[qq][d0], p[qq][1], 0, 0, 0);
                }
            }
            u32x4 pw[2][4];
#pragma unroll
            for (int qq = 0; qq < 2; ++qq) {
                float ls = 0.f;
#pragma unroll
                for (int r = 0; r < 16; ++r) { p[qq][0][r] = __builtin_amdgcn_exp2f(p[qq][0][r]); p[qq][1][r] = __builtin_amdgcn_exp2f(p[qq][1][r]); }
                if (cls >= 2) {
                    const int a = qq * 32 + r32;
#pragma unroll
                    for (int r = 0; r < 16; ++r) {
                        const int c0 = crow(r, hi), c1 = c0 + 32;
                        const bool v0 = cls == 2 ? (c0 >= a) : (c0 <= a), v1 = cls == 2 ? (c1 >= a) : (c1 <= a);
                        p[qq][0][r] = v0 ? p[qq][0][r] : 0.f; p[qq][1][r] = v1 ? p[qq][1][r] : 0.f;
                    }
                }
#pragma unroll
                for (int r = 0; r < 16; ++r) ls += p[qq][0][r] + p[qq][1][r];
                l[qq] += ls;
                const f32x16 &a0 = p[qq][0], &a1 = p[qq][1];
                pw[qq][0].x = cvtpk(a0[0], a0[1]); pw[qq][0].y = cvtpk(a0[2], a0[3]); pw[qq][0].z = cvtpk(a0[4], a0[5]); pw[qq][0].w = cvtpk(a0[6], a0[7]);
                pw[qq][1].x = cvtpk(a0[8], a0[9]); pw[qq][1].y = cvtpk(a0[10], a0[11]); pw[qq][1].z = cvtpk(a0[12], a0[13]); pw[qq][1].w = cvtpk(a0[14], a0[15]);
                pw[qq][2].x = cvtpk(a1[0], a1[1]); pw[qq][2].y = cvtpk(a1[2], a1[3]); pw[qq][2].z = cvtpk(a1[4], a1[5]); pw[qq][2].w = cvtpk(a1[6], a1[7]);
                pw[qq][3].x = cvtpk(a1[8], a1[9]); pw[qq][3].y = cvtpk(a1[10], a1[11]); pw[qq][3].z = cvtpk(a1[12], a1[13]); pw[qq][3].w = cvtpk(a1[14], a1[15]);
            }
            const LDSAS unsigned char* vb = lds + buf * 8192 + vroff;
#pragma unroll
            for (int d0 = 0; d0 < 2; ++d0)
#pragma unroll
                for (int ks = 0; ks < 4; ++ks) {
                    const s16x4 lo = vtr(vb + d0 * 4096 + ks * 1024), hh = vtr(vb + d0 * 4096 + ks * 1024 + 512);
                    const bf16x8 vf = (bf16x8){lo[0], lo[1], lo[2], lo[3], hh[0], hh[1], hh[2], hh[3]};
                    o[0][d0] = __builtin_amdgcn_mfma_f32_32x32x16_bf16(__builtin_bit_cast(bf16x8, pw[0][ks]), vf, o[0][d0], 0, 0, 0);
                    o[1][d0] = __builtin_amdgcn_mfma_f32_32x32x16_bf16(__builtin_bit_cast(bf16x8, pw[1][ks]), vf, o[1][d0], 0, 0, 0);
                }
        }
        if (i + 1 < nt) AA_LWRITE(buf ^ 1);
        __syncthreads();
    }
#undef AA_KR0
#undef AA_GLOAD
#undef AA_LWRITE
    const float sinkp = __builtin_amdgcn_exp2f(P.a_sink[head] * LOG2E);
    LDSAS float* stg = (LDSAS float*)(lds + wid * 8704);
    const int eq = lane >> 1, eseg = lane & 1;
#pragma unroll
    for (int qq = 0; qq < 2; ++qq) {
        float lt = l[qq]; lt += __shfl_xor(lt, 32);
        if (hi == 0) stg[r32] = 1.0f / (lt + sinkp);
        float rl[16];
#pragma unroll
        for (int r = 0; r < 16; ++r) rl[r] = stg[crow(r, hi)];
#pragma unroll
        for (int d0 = 0; d0 < 2; ++d0)
#pragma unroll
            for (int r = 0; r < 16; ++r) stg[crow(r, hi) * 68 + d0 * 32 + r32] = o[qq][d0][r] * rl[r];
        const size_t grow = (size_t)(qrow0 + qoff + qq * 32 + eq);
        const u32x4* gp = (const u32x4*)(P.GA() + grow * 512 + head * 64 + eseg * 32);
        u32x4* op = (u32x4*)(P.O() + grow * 1024 + head * 64 + eseg * 32);
#pragma unroll
        for (int i = 0; i < 4; ++i) {
            const f32x4 a = *(const LDSAS f32x4*)(stg + eq * 68 + eseg * 32 + i * 8), c = *(const LDSAS f32x4*)(stg + eq * 68 + eseg * 32 + i * 8 + 4);
            const u32x4 g = gp[i]; u32x4 ov;
            ov.x = cvtpk(a[0] * bflo(g.x), a[1] * bfhi(g.x)); ov.y = cvtpk(a[2] * bflo(g.y), a[3] * bfhi(g.y));
            ov.z = cvtpk(c[0] * bflo(g.z), c[1] * bfhi(g.z)); ov.w = cvtpk(c[2] * bflo(g.w), c[3] * bfhi(g.w));
            op[i] = ov;
        }
    }
    __syncthreads();
}

__device__ __forceinline__ void phase_attnA_mfma(const Params& P, LDSAS unsigned char* lds, int vb, int nvb) {
    for (int u = vb; u < 1024 + 128; u += nvb) {
        if (u < 1024) {
            const int qblk = u & 15, kvh = (u >> 4) & 1, b = u >> 5;
            const int lo = 2 * qblk - 2 < 0 ? 0 : 2 * qblk - 2, hi_ = 2 * qblk + 3 > 31 ? 31 : 2 * qblk + 3;
            attnA_unit(P, lds, b, kvh, b * 2048 + qblk * 128, qblk * 128, lo, hi_ - lo + 1);
        } else {
            const int v = u - 1024, half = v & 1, kvh = (v >> 1) & 1, b = v >> 2;
            attnA_unit(P, lds, b, kvh, ML + b * 256 + half * 128, 0, 0, 0);
        }
    }
}

__device__ __forceinline__ void phase_gla(const Params& P, float* lds, int vb, int nvb) {
    const int tidx = otid();
    float* sa = lds; float* sk = lds + 128; float* sq = lds + 256;
    const int e = tidx;
    for (int unit = vb; unit < NB * 4 * 2; unit += nvb) {
        const int dr = unit & 1, h = (unit >> 1) & 3, b = unit >> 3;
        const float* wa = dr ? P.wa_b : P.wa_f; const float* ba = dr ? P.ba_b : P.ba_f;
        float S[128];
#pragma unroll
        for (int d = 0; d < 128; ++d) S[d] = 0.f;
        float war[16], bav = 0.f;
        if (e < 128) {
#pragma unroll
            for (int j = 0; j < 16; ++j) war[j] = wa[j * 512 + h * 128 + e];
            bav = ba[h * 128 + e];
        }
        for (int step = 0; step < L + T; ++step) {
            int m;
            if (step < L) m = ML + b * L + (dr ? L - 1 - step : step);
            else { const int t = step - L; m = b * T + (dr ? T - 1 - t : t); }
            __syncthreads();
            if (e < 128) {
                const float* rf = P.RF() + (size_t)m * 32 + dr * 16;
                float z = bav;
#pragma unroll
                for (int j = 0; j < 16; ++j) z += rf[j] * war[j];
                const float ls = fminf(z, 0.f) - log1pf(expf(-fabsf(z)));
                sa[e] = expf(ls * (1.0f / 16.0f));
                sk[e] = bf2f(P.KG()[(size_t)m * 512 + h * 128 + e]);
                sq[e] = bf2f(P.QG()[(size_t)m * 512 + h * 128 + e]);
            }
            __syncthreads();
            if (e < 256) {
            const float v = bf2f(P.VG()[(size_t)m * 1024 + h * 256 + e]);
            float o = 0.f;
#pragma unroll
            for (int d = 0; d < 128; ++d) { S[d] = sa[d] * S[d] + sk[d] * v; o += sq[d] * S[d]; }
            if (m < ML) P.OD()[((size_t)dr * ML + m) * 1024 + h * 256 + e] = (bf16_t)f2bf(o);
            }
        }
    }
}

__device__ __forceinline__ void phase_finish(const Params& P, int vb, int nvb) {
    const int tidx = otid();
    const int lane = tidx & 63, wpb = blockDim.x >> 6, w = tidx >> 6;
    for (int row = vb * wpb + w; row < ML; row += nvb * wpb) {
        const int c0 = lane * 16;
        float v[16];
        const u32x4* pf = (const u32x4*)(P.OD() + (size_t)row * 1024 + c0);
        const u32x4* pb = (const u32x4*)(P.OD() + ((size_t)ML + row) * 1024 + c0);
        float ss = 0.f;
#pragma unroll
        for (int i = 0; i < 2; ++i) {
            const u32x4 a = pf[i], bq = pb[i];
            v[8 * i] = bflo(a.x) + bflo(bq.x); v[8 * i + 1] = bfhi(a.x) + bfhi(bq.x); v[8 * i + 2] = bflo(a.y) + bflo(bq.y); v[8 * i + 3] = bfhi(a.y) + bfhi(bq.y);
            v[8 * i + 4] = bflo(a.z) + bflo(bq.z); v[8 * i + 5] = bfhi(a.z) + bfhi(bq.z); v[8 * i + 6] = bflo(a.w) + bflo(bq.w); v[8 * i + 7] = bfhi(a.w) + bfhi(bq.w);
        }
#pragma unroll
        for (int i = 0; i < 16; ++i) ss += v[i] * v[i];
        ss += __shfl_xor(ss, 1); ss += __shfl_xor(ss, 2); ss += __shfl_xor(ss, 4); ss += __shfl_xor(ss, 8);
        const float rn = rsqrtf(ss * (1.0f / 256.0f) + EPS);
        const float* gn = P.gla_out_norm + (c0 & 255);
        const u32x4* gp = (const u32x4*)(P.GG() + (size_t)row * 1024 + c0);
        u32x4* op = (u32x4*)(P.A2() + (size_t)row * 1024 + c0);
#pragma unroll
        for (int i = 0; i < 2; ++i) {
            const u32x4 g = gp[i]; u32x4 r;
            r.x = pack2(v[8 * i] * rn * gn[8 * i] * bflo(g.x), v[8 * i + 1] * rn * gn[8 * i + 1] * bfhi(g.x));
            r.y = pack2(v[8 * i + 2] * rn * gn[8 * i + 2] * bflo(g.y), v[8 * i + 3] * rn * gn[8 * i + 3] * bfhi(g.y));
            r.z = pack2(v[8 * i + 4] * rn * gn[8 * i + 4] * bflo(g.z), v[8 * i + 5] * rn * gn[8 * i + 5] * bfhi(g.z));
            r.w = pack2(v[8 * i + 6] * rn * gn[8 * i + 6] * bflo(g.w), v[8 * i + 7] * rn * gn[8 * i + 7] * bfhi(g.w));
            op[i] = r;
        }
    }
}

namespace cg = cooperative_groups;
__global__ void __launch_bounds__(512) mega_kernel(Params Pk) {
    __shared__ __attribute__((aligned(16))) unsigned char lds[pg8::STAGE_BYTES];
    cg::grid_group grid = cg::this_grid();
    const int vb = blockIdx.x, nvb = gridDim.x;
    { const Params P = ldparams(); phase_wt(P, vb, nvb); phase_adaln(P, vb, nvb); phase_rope(P, vb, nvb); }
    grid.sync();
    { const Params P = ldparams(); phase_bias(P, vb, nvb); phase_a0(P, vb, nvb); }
    grid.sync();
    { const Params P = ldparams();
      EpiIn0 E{P.parts(), 1, P.bias0(), P.a_q_norm, P.a_k_norm, P.b_q_norm, P.b_k_norm, P.rope(), P.QA(), P.KA(), P.VA(), P.GA(), P.QB(), P.KB(), P.VB(), P.GB()};
      pg8::Gemm g{P.A(), P.Wt0(), M, N0, D}; pg8::StaticOrder S; S.init(M, N0, nvb, vb); pg8::gemm_phase<EpiIn0, pg8::StaticOrder, true, true>((LDSAS unsigned char*)lds, g, S, E); }
    grid.sync();
    { const Params P = ldparams(); phase_attnA_mfma(P, (LDSAS unsigned char*)lds, vb, nvb); }
    { const Params P = ldparams(); phase_attnB_mfma(P, (LDSAS unsigned char*)lds, vb, nvb); }
    grid.sync();
    { const Params P = ldparams();
      EpiOut0 E{P.x, P.ctx, P.mod(), P.norm_g + D, P.out, P.A(), P.parts()};
      pg8::Gemm g{P.O(), P.Wo0(), M, D, D}; pg8::StaticOrder S; S.init(M, D, nvb, vb); pg8::gemm_phase<EpiOut0, pg8::StaticOrder, true, true>((LDSAS unsigned char*)lds, g, S, E); }
    grid.sync();
    { const Params P = ldparams();
      EpiIn1 E{P.parts(), 16, P.bias1(), P.QG(), P.KG(), P.VG(), P.GG(), P.RF()};
      pg8::Gemm g{P.A(), P.Wt1(), M, N1, D}; pg8::StaticOrder S; S.init(M, N1, nvb, vb); pg8::gemm_phase<EpiIn1, pg8::StaticOrder, true, true>((LDSAS unsigned char*)lds, g, S, E); }
    grid.sync();
    { const Params P = ldparams(); phase_gla(P, (float*)lds, vb, nvb); }
    grid.sync();
    { const Params P = ldparams(); phase_finish(P, vb, nvb); }
    grid.sync();
    { const Params P = ldparams();
      EpiOut1 E{P.mod(), P.out};
      pg8::Gemm g{P.A2(), P.Wo1(), ML, D, D}; pg8::StaticOrder S; S.init(ML, D, nvb, vb); pg8::gemm_phase<EpiOut1, pg8::StaticOrder, true, true>((LDSAS unsigned char*)lds, g, S, E); }
}
}

extern "C" void kernel_launch(void* const* d_in, const int* in_sizes, int n_in, void* d_out, int out_size, void* d_ws, size_t ws_size, hipStream_t stream) {
    Params P{};
    const float* const* in = (const float* const*)d_in;
    P.x = in[0]; P.c = in[1]; P.ctx = in[2]; P.c_ctx = in[3]; P.adaln_w = in[4]; P.adaln_b = in[5]; P.norm_g = in[6]; P.w_out = in[7]; P.ab_w_in = in[8];
    P.a_q_norm = in[9]; P.a_k_norm = in[10]; P.a_sink = in[11]; P.b_q_norm = in[12]; P.b_k_norm = in[13]; P.lq1 = in[14]; P.lk1 = in[15]; P.lq2 = in[16]; P.lk2 = in[17];
    P.b_subln = in[18]; P.gla_w_in = in[19]; P.wa_f = in[20]; P.ba_f = in[21]; P.wa_b = in[22]; P.ba_b = in[23]; P.gla_out_norm = in[24];
    P.out = (float*)d_out;
    P.ws = (unsigned char*)d_ws;
    if (WS_NEED > ws_size) { fprintf(stderr, "workspace too small: need %zu have %zu\n", (size_t)WS_NEED, ws_size); return; }
    static int grid_blocks = 0;
    if (!grid_blocks) {
        int dev = 0, cus = 0, per_cu = 0;
        (void)hipGetDevice(&dev);
        (void)hipDeviceGetAttribute(&cus, hipDeviceAttributeMultiprocessorCount, dev);
        (void)hipOccupancyMaxActiveBlocksPerMultiprocessor(&per_cu, mega_kernel, 512, 0);
        if (per_cu > 1) per_cu = 1;
        grid_blocks = cus * per_cu;
    }
    void* args[] = {&P};
    hipError_t e = hipLaunchCooperativeKernel((void*)mega_kernel, dim3(grid_blocks), dim3(512), args, 0, stream);
    if (e != hipSuccess) fprintf(stderr, "cooperative launch failed: %s (grid %d)\n", hipGetErrorString(e), grid_blocks);
}
```

```cpp
#include <hip/hip_runtime.h>
#include <hip/hip_cooperative_groups.h>
#include <cstdint>
#include <cstdio>

namespace {
constexpr int NB = 32, T = 2048, L = 256, D = 1024;
constexpr int ML = NB * T, MC = NB * L, M = ML + MC;
constexpr int N0 = 3328, N1 = 3328, N0R = 3328, N1R = 3104;
constexpr float EPS = 1e-6f;
constexpr float LOG2E = 1.4426950408889634f;
constexpr float QSCALE = 0.125f * LOG2E;
constexpr float LAMBDA_INIT = 0.2f;

typedef unsigned short bf16_t;
typedef short bf16x8 __attribute__((ext_vector_type(8)));
typedef float f32x4 __attribute__((ext_vector_type(4)));
typedef unsigned u32x4 __attribute__((ext_vector_type(4)));
typedef unsigned u32x2 __attribute__((ext_vector_type(2)));

constexpr size_t al256(size_t x) { return (x + 255) & ~(size_t)255; }
constexpr size_t OFF_WT0 = 0;
constexpr size_t OFF_WT1 = OFF_WT0 + al256((size_t)N0 * D * 2);
constexpr size_t OFF_WO0 = OFF_WT1 + al256((size_t)N1 * D * 2);
constexpr size_t OFF_WO1 = OFF_WO0 + al256((size_t)D * D * 2);
constexpr size_t OFF_MOD = OFF_WO1 + al256((size_t)D * D * 2);
constexpr size_t OFF_BIAS0 = OFF_MOD + al256((size_t)2 * 33 * 3072 * 4);
constexpr size_t OFF_BIAS1 = OFF_BIAS0 + al256((size_t)33 * 3328 * 4);
constexpr size_t OFF_ROPE = OFF_BIAS1 + al256((size_t)33 * 3328 * 4);
constexpr size_t OFF_SCAL = OFF_ROPE + al256(64 * 16 * 2 * 4);
constexpr size_t OFF_PARTS = OFF_SCAL + 256;
constexpr size_t OFF_A = OFF_PARTS + al256((size_t)16 * M * 4);
constexpr size_t OFF_O = OFF_A + (size_t)M * D * 2;
constexpr size_t OFF_QKV = OFF_O + (size_t)M * D * 2;
constexpr size_t WS_NEED = OFF_QKV + (size_t)M * 3328 * 2;
constexpr size_t OFF_QA = OFF_QKV, OFF_KA = OFF_QA + (size_t)M * 512 * 2, OFF_VA = OFF_KA + (size_t)M * 128 * 2, OFF_GA = OFF_VA + (size_t)M * 128 * 2;
constexpr size_t OFF_QB = OFF_GA + (size_t)M * 512 * 2, OFF_KB = OFF_QB + (size_t)M * 512 * 2, OFF_VB = OFF_KB + (size_t)M * 512 * 2, OFF_GB = OFF_VB + (size_t)M * 512 * 2;
constexpr size_t OFF_QG = OFF_QKV, OFF_KG = OFF_QG + (size_t)M * 512 * 2, OFF_VG = OFF_KG + (size_t)M * 512 * 2, OFF_GG = OFF_VG + (size_t)M * 1024 * 2, OFF_RF = OFF_GG + (size_t)M * 1024 * 2;
static_assert(OFF_RF + (size_t)M * 32 * 4 <= WS_NEED, "layer-1 projections fit");
static_assert((size_t)2 * ML * 1024 * 2 <= (size_t)2 * M * D * 2, "OD fits over A + O");

struct Params {
    const float *x, *c, *ctx, *c_ctx, *adaln_w, *adaln_b, *norm_g, *w_out, *ab_w_in, *a_q_norm, *a_k_norm, *a_sink, *b_q_norm, *b_k_norm;
    const float *lq1, *lk1, *lq2, *lk2, *b_subln, *gla_w_in, *wa_f, *ba_f, *wa_b, *ba_b, *gla_out_norm;
    float* out;
    unsigned char* ws;
#define WSPTR(T, name, off) __device__ __forceinline__ T* name() const { return (T*)(ws + (off)); }
    WSPTR(bf16_t, Wt0, OFF_WT0) WSPTR(bf16_t, Wt1, OFF_WT1) WSPTR(bf16_t, Wo0, OFF_WO0) WSPTR(bf16_t, Wo1, OFF_WO1)
    WSPTR(float, mod, OFF_MOD) WSPTR(float, bias0, OFF_BIAS0) WSPTR(float, bias1, OFF_BIAS1) WSPTR(float, rope, OFF_ROPE) WSPTR(float, scal, OFF_SCAL) WSPTR(float, parts, OFF_PARTS)
    WSPTR(bf16_t, A, OFF_A) WSPTR(bf16_t, O, OFF_O)
    WSPTR(bf16_t, QA, OFF_QA) WSPTR(bf16_t, KA, OFF_KA) WSPTR(bf16_t, VA, OFF_VA) WSPTR(bf16_t, GA, OFF_GA)
    WSPTR(bf16_t, QB, OFF_QB) WSPTR(bf16_t, KB, OFF_KB) WSPTR(bf16_t, VB, OFF_VB) WSPTR(bf16_t, GB, OFF_GB)
    WSPTR(bf16_t, QG, OFF_QG) WSPTR(bf16_t, KG, OFF_KG) WSPTR(bf16_t, VG, OFF_VG) WSPTR(bf16_t, GG, OFF_GG) WSPTR(float, RF, OFF_RF)
    WSPTR(bf16_t, OD, OFF_A) WSPTR(bf16_t, A2, OFF_QKV)
#undef WSPTR
};

__device__ __forceinline__ int otid() { int t = threadIdx.x; asm volatile("" : "+v"(t)); return t; }
__device__ __forceinline__ unsigned f2bf(float f) { unsigned u = __float_as_uint(f); u += 0x7FFFu + ((u >> 16) & 1u); return u >> 16; }
__device__ __forceinline__ unsigned pack2(float lo, float hi) { return f2bf(lo) | (f2bf(hi) << 16); }
__device__ __forceinline__ float bf2f(unsigned h) { return __uint_as_float(h << 16); }
__device__ __forceinline__ float bflo(unsigned w) { return __uint_as_float(w << 16); }
__device__ __forceinline__ float bfhi(unsigned w) { return __uint_as_float(w & 0xFFFF0000u); }
__device__ __forceinline__ float siluf(float v) { return v / (1.0f + __expf(-v)); }

__device__ __forceinline__ Params ldparams() {
#if defined(__HIP_DEVICE_COMPILE__)
    const __attribute__((address_space(4))) Params* pp = (const __attribute__((address_space(4))) Params*)__builtin_amdgcn_kernarg_segment_ptr();
    asm volatile("" : "+s"(pp));
    return *pp;
#else
    return Params{};
#endif
}

__device__ __forceinline__ int perm_local(int p, bool ropeType) {
    const int bj = p >> 7, wc = (p >> 5) & 3, low = p & 31;
    if (ropeType) return wc * 64 + bj * 32 + low;
    const int n = (low >> 4) & 1, fq = (low >> 2) & 3, e = low & 3;
    return wc * 64 + bj * 32 + fq * 8 + n * 4 + e;
}
__device__ __forceinline__ int src_col(int which, int np) {
    const int p = np & 255, tile = np >> 8;
    bool rope = false;
    if (which == 0) { const int g = tile * 4 + ((p >> 5) & 3); rope = (g < 10) || (g >= 20 && g < 36); }
    const int c = tile * 256 + perm_local(p, rope);
    const int nreal = which == 0 ? N0R : (which == 1 ? N1R : D);
    return c < nreal ? c : -1;
}

__device__ __forceinline__ int dst_row(int which, int c) {
    const int tile = c >> 8, cl = c & 255, wc = cl >> 6, bj = (cl >> 5) & 1, low = cl & 31;
    bool rope = false;
    if (which == 0) { const int g = tile * 4 + wc; rope = (g < 10) || (g >= 20 && g < 36); }
    int lo5 = low;
    if (!rope) { const int fq = low >> 3, n = (low >> 2) & 1, e = low & 3; lo5 = n * 16 + fq * 4 + e; }
    return tile * 256 + bj * 128 + wc * 32 + lo5;
}

__device__ __forceinline__ void wt_tile(const float* __restrict__ W, int ldw, int nreal, int which, bf16_t* __restrict__ dst, int c0, int k0, unsigned char* lds, int tid) {
    bf16_t* t = (bf16_t*)lds;
    __syncthreads();
#pragma unroll
    for (int i = 0; i < 2; ++i) {
        const int idx = tid + 512 * i, r = idx >> 4, c4 = (idx & 15) * 4;
        f32x4 v = (f32x4){0.f, 0.f, 0.f, 0.f};
        if (c0 + c4 < nreal) v = *(const f32x4*)(W + (size_t)(k0 + r) * ldw + c0 + c4);
#pragma unroll
        for (int j = 0; j < 4; ++j) t[(c4 + j) * 66 + r] = (bf16_t)f2bf(v[j]);
    }
    __syncthreads();
    const int c = tid >> 3, kc = tid & 7;
    const unsigned* tr = (const unsigned*)(t + c * 66 + kc * 8);
    u32x4 o; o.x = tr[0]; o.y = tr[1]; o.z = tr[2]; o.w = tr[3];
    *(u32x4*)(dst + (size_t)dst_row(which, c0 + c) * D + k0 + kc * 8) = o;
}

template <int MODE>
__device__ __forceinline__ void skinny_unit(const Params& P, int l, int c0, unsigned char* lds, int tid) {
    float* tab = (float*)lds;
    const int lane = tid & 63, w = tid >> 6;
    const float* W; int ldw, nreal;
    if (MODE == 0) { W = P.adaln_w + (size_t)l * D * 3072; ldw = 3072; nreal = 3072; }
    else { W = l ? P.gla_w_in : P.ab_w_in; ldw = l ? N1R : N0R; nreal = ldw; }
    const bool colok = c0 + lane < nreal;
    float acc[33];
#pragma unroll
    for (int r = 0; r < 33; ++r) acc[r] = 0.f;
    for (int half = 0; half < 2; ++half) {
        __syncthreads();
        for (int r = 0; r < 33; ++r) {
            float v;
            if (MODE == 0) v = siluf(r < 32 ? P.c[r * D + half * 512 + tid] : P.c_ctx[half * 512 + tid]);
            else v = P.mod()[((size_t)l * 33 + r) * 3072 + half * 512 + tid];
            tab[tid * 36 + r] = v;
        }
        __syncthreads();
        for (int kk = 0; kk < 64; ++kk) {
            const int k = w * 64 + kk;
            const float wv = colok ? W[(size_t)(half * 512 + k) * ldw + c0 + lane] : 0.f;
#pragma unroll
            for (int r4 = 0; r4 < 8; ++r4) { const f32x4 s = *(const f32x4*)(tab + k * 36 + r4 * 4); acc[r4 * 4] += s[0] * wv; acc[r4 * 4 + 1] += s[1] * wv; acc[r4 * 4 + 2] += s[2] * wv; acc[r4 * 4 + 3] += s[3] * wv; }
            acc[32] += tab[k * 36 + 32] * wv;
        }
    }
    __syncthreads();
#pragma unroll
    for (int r = 0; r < 33; ++r) tab[(w * 33 + r) * 64 + lane] = acc[r];
    __syncthreads();
    for (int idx = tid; idx < 33 * 64; idx += 512) {
        const int r = idx >> 6, col = idx & 63;
        float s = 0.f;
#pragma unroll
        for (int ww = 0; ww < 8; ++ww) s += tab[(ww * 33 + r) * 64 + col];
        if (MODE == 0) { const int j = c0 + col; P.mod()[((size_t)l * 33 + r) * 3072 + j] = s + P.adaln_b[l * 3072 + j]; }
        else { const int c = c0 + col; (l ? P.bias1() : P.bias0())[r * 3328 + dst_row(l, c)] = c < nreal ? s : 0.f; }
    }
}

__device__ __forceinline__ void phase_pro0(const Params& P, unsigned char* lds, int vb, int nvb) {
    const int tidx = otid();
    for (int item = vb; item < 96 + 2176; item += nvb) {
        if (item < 96) { skinny_unit<0>(P, item / 48, (item % 48) * 64, lds, tidx); continue; }
        int t = item - 96; int which; const float* W; bf16_t* dst; int ldw, nreal;
        if (t < 832) { which = 0; W = P.ab_w_in; dst = P.Wt0(); ldw = N0R; nreal = N0R; }
        else if ((t -= 832) < 832) { which = 1; W = P.gla_w_in; dst = P.Wt1(); ldw = N1R; nreal = N1R; }
        else if ((t -= 832) < 256) { which = 2; W = P.w_out; dst = P.Wo0(); ldw = D; nreal = D; }
        else { t -= 256; which = 3; W = P.w_out + (size_t)D * D; dst = P.Wo1(); ldw = D; nreal = D; }
        wt_tile(W, ldw, nreal, which, dst, (t >> 4) * 64, (t & 15) * 64, lds, tidx);
    }
    for (int idx = vb * 512 + tidx; idx < 64 * 16; idx += nvb * 512) {
        const int pos = idx >> 4, i = idx & 15;
        const double inv = pow(10000.0, -(double)i / 16.0);
        const double ang = (double)((float)pos * (float)inv);
        P.rope()[idx * 2 + 0] = (float)cos(ang);
        P.rope()[idx * 2 + 1] = (float)sin(ang);
    }
    if (vb == nvb - 1 && tidx == 0) {
        float d1 = 0.f, d2 = 0.f;
        for (int i = 0; i < 64; ++i) { d1 += P.lq1[i] * P.lk1[i]; d2 += P.lq2[i] * P.lk2[i]; }
        P.scal()[0] = expf(d1) - expf(d2) + LAMBDA_INIT;
    }
}

__device__ __forceinline__ void phase_bias(const Params& P, unsigned char* lds, int vb, int nvb) {
    const int tidx = otid();
    for (int item = vb; item < 104; item += nvb) skinny_unit<1>(P, item / 52, (item % 52) * 64, lds, tidx);
}

__device__ __forceinline__ void phase_a0(const Params& P, int vb, int nvb) {
    const int tidx = otid();
    const int lane = tidx & 63, wpb = blockDim.x >> 6, w = tidx >> 6;
    for (int row = vb * wpb + w; row < M; row += nvb * wpb) {
        const float* xin = row < ML ? P.x + (size_t)row * D : P.ctx + (size_t)(row - ML) * D;
        const int r = row < ML ? row >> 11 : 32;
        const float* sc = P.mod() + (size_t)r * 3072 + 1024;
        float ss = 0.f;
#pragma unroll
        for (int i = 0; i < 2; ++i) {
            const int c0 = i * 512 + lane * 8;
            const f32x4 a = *(const f32x4*)(xin + c0), b = *(const f32x4*)(xin + c0 + 4);
            const f32x4 g0 = *(const f32x4*)(P.norm_g + c0), g1 = *(const f32x4*)(P.norm_g + c0 + 4);
            const f32x4 s0 = *(const f32x4*)(sc + c0), s1 = *(const f32x4*)(sc + c0 + 4);
            ss += a[0] * a[0] + a[1] * a[1] + a[2] * a[2] + a[3] * a[3] + b[0] * b[0] + b[1] * b[1] + b[2] * b[2] + b[3] * b[3];
            const f32x4 ya = a * g0 * (1.0f + s0), yb = b * g1 * (1.0f + s1);
            u32x4 o; o.x = pack2(ya[0], ya[1]); o.y = pack2(ya[2], ya[3]); o.z = pack2(yb[0], yb[1]); o.w = pack2(yb[2], yb[3]);
            *(u32x4*)(P.A() + (size_t)row * D + c0) = o;
        }
#pragma unroll
        for (int o = 32; o >= 1; o >>= 1) ss += __shfl_xor(ss, o);
        if (lane == 0) P.parts()[row] = ss;
    }
}

namespace pg8 {
#define PG8_LAS __attribute__((address_space(3)))
typedef unsigned short bf16_t;
typedef short bf16x8 __attribute__((ext_vector_type(8)));
typedef float f32x4 __attribute__((ext_vector_type(4)));
typedef unsigned u32x4 __attribute__((ext_vector_type(4)));
constexpr int BM = 256, BK = 64, HALF = 128, HTB = HALF * BK * 2  , STAGE_BYTES = 8 * HTB, NXCD = 8, WGM = 8;

__host__ __device__ __forceinline__ int lds_byte(int r, int c) { const int st = (r >> 4) * 2 + (c >> 5), rr = r & 15, cc = c & 31, ob = rr * 64 + cc * 2; return st * 1024 + (ob ^ (((ob >> 9) & 1) << 5)); }
__host__ __device__ __forceinline__ void stage_rc(int b, int& R, int& C) { const int st = b / 1024, sb = b % 1024, swz = sb ^ (((sb >> 9) & 1) << 5); R = (st >> 1) * 16 + swz / 64; C = (st & 1) * 32 + (swz % 64) / 2; }
__host__ __device__ __forceinline__ int perm32(int rho) { const int n = rho >> 4, i = rho & 15; return 8 * (i >> 2) + 4 * n + (i & 3); }

struct Unit { int pm, pn; };
struct Gemm { const bf16_t* A; const bf16_t* Bt; int M, N, K; };

struct StaticOrder {
    int nM, nN, nwg, G, c;
    __host__ __device__ void init(int M, int N, int G_, int c_) { nM = M / BM; nN = N / BM; nwg = nM * nN; G = G_; c = c_; }
    __host__ __device__ bool next(int i, Unit& u) const {
        const long L = (long)i * G + c; if (L >= nwg) return false;
        int wgid = (int)L; { const int q = nwg / NXCD, r = nwg % NXCD, xcd = wgid % NXCD, off = wgid / NXCD; wgid = (xcd < r ? xcd * (q + 1) : r * (q + 1) + (xcd - r) * q) + off; }
        const int nig = WGM * nN, gid = wgid / nig, fm = gid * WGM, gsz = (nM - fm) < WGM ? (nM - fm) : WGM;
        u.pm = fm + ((wgid % nig) % gsz); u.pn = (wgid % nig) / gsz; return true;
    }
    __device__ __forceinline__ void a_ready(const Unit&) const {}
    __device__ __forceinline__ void done(const Unit&) const {}
};
template <class Epi, class Sched, bool ALIGN_EPI = false, bool SP2 = false>
__device__ __forceinline__ void gemm_phase(PG8_LAS unsigned char* lds, const Gemm g, const Sched& S, const Epi& E) {
    const int tid = otid(), wid = __builtin_amdgcn_readfirstlane(tid >> 6), lane = tid & 63, wr = wid >> 2, wc = wid & 3, fr = lane & 15, fq = lane >> 4;
    const int K = g.K, nt = K / BK;
    unsigned voffA[2], voffB[2];
#pragma unroll
    for (int i = 0; i < 2; ++i) { int R, C; stage_rc(tid * 16 + i * 8192, R, C); const int Rb = Epi::PERM ? ((R & ~31) + perm32(R & 31)) : R;
        voffA[i] = (unsigned)(R * K + C) * 2u; voffB[i] = (unsigned)(Rb * K + C) * 2u; }
    const size_t kstep = (size_t)(BK * 2);
    const size_t hstep = (size_t)HALF * K * 2;
    const size_t tstep = 2 * hstep;
    const unsigned ldsw = (unsigned)wid * 1024u;
    const int aoff = lds_byte(wr * 64 + fr, fq * 8), boff = lds_byte(wc * 32 + fr, fq * 8);
#define PG8_SA(b, h) (((b) * 2 + (h)) * HTB)
#define PG8_SB(b, h) ((4 + (b) * 2 + (h)) * HTB)
#define PG8_STAGE(bufoff, gbase, voff) do { _Pragma("unroll") for (int _i = 0; _i < 2; ++_i) \
        __builtin_amdgcn_global_load_lds((const unsigned*)((const char*)(gbase) + (voff)[_i]), (PG8_LAS unsigned*)(lds + (bufoff) + ldsw + _i * 8192), 16, 0, 0); } while (0)
#define PG8_LDA(dst, b, h) do { _Pragma("unroll") for (int m = 0; m < 4; ++m) _Pragma("unroll") for (int k = 0; k < 2; ++k) dst[m][k] = *(const PG8_LAS bf16x8*)(lds + PG8_SA(b, h) + aoff + m * 2048 + k * 1024); } while (0)
#define PG8_LDB(dst, b, h) do { _Pragma("unroll") for (int n = 0; n < 2; ++n) _Pragma("unroll") for (int k = 0; k < 2; ++k) dst[n][k] = *(const PG8_LAS bf16x8*)(lds + PG8_SB(b, h) + boff + n * 2048 + k * 1024); } while (0)
#define PG8_MMA(ai, bj, At, Bt) do { __builtin_amdgcn_s_setprio(1); _Pragma("unroll") for (int m = 0; m < 4; ++m) _Pragma("unroll") for (int n = 0; n < 2; ++n) _Pragma("unroll") for (int k = 0; k < 2; ++k) \
        acc[ai][bj][m][n] = __builtin_amdgcn_mfma_f32_16x16x32_bf16(Bt[n][k], At[m][k], acc[ai][bj][m][n], 0, 0, 0); __builtin_amdgcn_s_setprio(0); } while (0)
#define PG8_WAIT_V(n) asm volatile("s_waitcnt vmcnt(" #n ")" ::: "memory")
#define PG8_WAIT_L(n) asm volatile("s_waitcnt lgkmcnt(" #n ")" ::: "memory")
#define PG8_BAR __builtin_amdgcn_s_barrier()
#define PG8_SCHED __builtin_amdgcn_sched_barrier(0)
    Unit cur, nxt; int ui = 0;
    if (!S.next(0, cur)) return;
    f32x4 acc[2][2][4][2];
#pragma unroll
    for (int a = 0; a < 2; ++a)
#pragma unroll
        for (int b = 0; b < 2; ++b)
#pragma unroll
            for (int m = 0; m < 4; ++m)
#pragma unroll
                for (int n = 0; n < 2; ++n) acc[a][b][m][n] = (f32x4){0.f, 0.f, 0.f, 0.f};
    bf16x8 At[4][2], B0[2][2], B1[2][2];
    const char* cA = (const char*)g.A + (size_t)cur.pm * tstep; const char* cB = (const char*)g.Bt + (size_t)cur.pn * tstep;
    S.a_ready(cur);
    if constexpr (SP2) {
        PG8_STAGE(PG8_SB(0, 0), cB, voffB); PG8_STAGE(PG8_SB(0, 1), cB + hstep, voffB); PG8_STAGE(PG8_SA(0, 0), cA, voffA); PG8_STAGE(PG8_SA(0, 1), cA + hstep, voffA);
        if (wr == 1) PG8_BAR;
        PG8_WAIT_V(2); PG8_BAR;
        PG8_STAGE(PG8_SB(1, 0), cB + kstep, voffB); PG8_STAGE(PG8_SA(1, 0), cA + kstep, voffA); PG8_STAGE(PG8_SB(1, 1), cB + hstep + kstep, voffB);
        PG8_WAIT_V(6); PG8_BAR;
    } else {
        PG8_STAGE(PG8_SB(0, 0), cB, voffB); PG8_STAGE(PG8_SA(0, 0), cA, voffA); PG8_STAGE(PG8_SB(0, 1), cB + hstep, voffB); PG8_STAGE(PG8_SA(0, 1), cA + hstep, voffA);
        if (wr == 1) PG8_BAR;
        PG8_WAIT_V(4); PG8_BAR;
        PG8_STAGE(PG8_SB(1, 0), cB + kstep, voffB); PG8_STAGE(PG8_SA(1, 0), cA + kstep, voffA); PG8_STAGE(PG8_SB(1, 1), cB + hstep + kstep, voffB);
        PG8_WAIT_V(6); PG8_BAR;
    }
    for (;;) {
        const bool has_next = S.next(ui + 1, nxt);
        const char* nA = has_next ? (const char*)g.A + (size_t)nxt.pm * tstep : cA; const char* nB = has_next ? (const char*)g.Bt + (size_t)nxt.pn * tstep : cB;
        for (int t = 0; t < nt; t += 2) {
            const bool last = (t == nt - 2);
            const char* a1 = cA + (size_t)(t + 1) * kstep;
            const char* a2 = last ? nA : cA + (size_t)(t + 2) * kstep; const char* b2 = last ? nB : cB + (size_t)(t + 2) * kstep;
            const char* a3 = a2 + kstep; const char* b3 = b2 + kstep;
            if (last && has_next) S.a_ready(nxt);
            if constexpr (SP2) {
            PG8_LDB(B0, 0, 0); PG8_LDB(B1, 0, 1); PG8_SCHED; PG8_LDA(At, 0, 0); PG8_STAGE(PG8_SA(1, 1), a1 + hstep, voffA);
            PG8_WAIT_V(8); PG8_WAIT_L(0); PG8_BAR; PG8_MMA(0, 0, At, B0); PG8_MMA(0, 1, At, B1); PG8_BAR; PG8_SCHED;
            PG8_LDA(At, 0, 1); PG8_STAGE(PG8_SB(0, 0), b2, voffB); PG8_STAGE(PG8_SB(0, 1), b2 + hstep, voffB); PG8_STAGE(PG8_SA(0, 0), a2, voffA);
            PG8_WAIT_V(8); PG8_WAIT_L(0); PG8_BAR; PG8_MMA(1, 0, At, B0); PG8_MMA(1, 1, At, B1); PG8_BAR; PG8_SCHED;
            PG8_LDB(B0, 1, 0); PG8_LDB(B1, 1, 1); PG8_SCHED; PG8_LDA(At, 1, 0); PG8_STAGE(PG8_SA(0, 1), a2 + hstep, voffA);
            PG8_WAIT_V(8); PG8_WAIT_L(0); PG8_BAR; PG8_MMA(0, 0, At, B0); PG8_MMA(0, 1, At, B1); PG8_BAR; PG8_SCHED;
            PG8_LDA(At, 1, 1); PG8_STAGE(PG8_SB(1, 0), b3, voffB); PG8_STAGE(PG8_SB(1, 1), b3 + hstep, voffB); PG8_STAGE(PG8_SA(1, 0), a3, voffA);
            PG8_WAIT_V(8); PG8_WAIT_L(0); PG8_BAR; PG8_MMA(1, 0, At, B0); PG8_MMA(1, 1, At, B1); PG8_BAR; PG8_SCHED;
            } else {
            PG8_LDB(B0, 0, 0); PG8_SCHED; PG8_LDA(At, 0, 0); PG8_STAGE(PG8_SA(1, 1), a1 + hstep, voffA);
            PG8_WAIT_L(8); PG8_BAR; PG8_WAIT_L(0); PG8_MMA(0, 0, At, B0); PG8_BAR; PG8_SCHED;
            PG8_LDB(B1, 0, 1); PG8_STAGE(PG8_SB(0, 0), b2, voffB);
            PG8_BAR; PG8_WAIT_L(0); PG8_MMA(0, 1, At, B1); PG8_BAR;
            PG8_LDA(At, 0, 1); PG8_STAGE(PG8_SA(0, 0), a2, voffA);
            PG8_BAR; PG8_WAIT_L(0); PG8_MMA(1, 0, At, B0); PG8_BAR; PG8_SCHED;
            PG8_STAGE(PG8_SB(0, 1), b2 + hstep, voffB);
            PG8_WAIT_V(6); PG8_BAR; PG8_MMA(1, 1, At, B1); PG8_BAR;
            PG8_LDB(B0, 1, 0); PG8_SCHED; PG8_LDA(At, 1, 0); PG8_STAGE(PG8_SA(0, 1), a2 + hstep, voffA);
            PG8_WAIT_L(8); PG8_BAR; PG8_WAIT_L(0); PG8_MMA(0, 0, At, B0); PG8_BAR; PG8_SCHED;
            PG8_LDB(B1, 1, 1); PG8_STAGE(PG8_SB(1, 0), b3, voffB);
            PG8_BAR; PG8_WAIT_L(0); PG8_MMA(0, 1, At, B1); PG8_BAR;
            PG8_LDA(At, 1, 1); PG8_STAGE(PG8_SA(1, 0), a3, voffA);
            PG8_BAR; PG8_WAIT_L(0); PG8_MMA(1, 0, At, B0); PG8_BAR; PG8_SCHED;
            PG8_STAGE(PG8_SB(1, 1), b3 + hstep, voffB);
            PG8_WAIT_V(6); PG8_BAR; PG8_MMA(1, 1, At, B1); PG8_BAR;
            }
        }
        if constexpr (ALIGN_EPI) { if (wr == 0) PG8_BAR; }
        if constexpr (!Epi::AFTER_DRAIN) { E(acc, cur, wr, wc, fr, fq); S.done(cur); }
        if (!has_next) break;
#pragma unroll
        for (int a = 0; a < 2; ++a)
#pragma unroll
            for (int b = 0; b < 2; ++b)
#pragma unroll
                for (int m = 0; m < 4; ++m)
#pragma unroll
                    for (int n = 0; n < 2; ++n) acc[a][b][m][n] = (f32x4){0.f, 0.f, 0.f, 0.f};
        cur = nxt; cA = nA; cB = nB; ++ui;
        if constexpr (ALIGN_EPI) { if (wr == 1) PG8_BAR; }
    }
    PG8_WAIT_V(0);
    if constexpr (!ALIGN_EPI) { if (wr == 0) PG8_BAR; }
    PG8_BAR;
    if constexpr (Epi::AFTER_DRAIN) { E.fused(acc, cur, wr, wc, fr, fq, lds, wid, lane); S.done(cur); }
#undef PG8_SA
#undef PG8_SB
#undef PG8_STAGE
#undef PG8_LDA
#undef PG8_LDB
#undef PG8_MMA
#undef PG8_WAIT_V
#undef PG8_WAIT_L
#undef PG8_BAR
#undef PG8_SCHED
}
}

struct EpiIn0 {
    const float* parts; int nparts; const float* bias;
    const float *aqn, *akn, *bqn, *bkn, *rope;
    bf16_t *QA, *KA, *VA, *GA, *QB, *KB, *VB, *GB;
    static constexpr bool PERM = false, AFTER_DRAIN = false;
    __device__ __forceinline__ void operator()(const f32x4 (&acc)[2][2][4][2], const pg8::Unit& u, int wr, int wc, int fr, int fq) const { (*this)(acc, u.pm, u.pn, wr, wc, fr, fq); }
    __device__ __forceinline__ void operator()(const f32x4 (&acc)[2][2][4][2], int pm, int pn, int wr, int wc, int fr, int fq) const {
        const int g = 4 * pn + wc;
        bf16_t* dst; int ld, col, type; const float* gain = nullptr;
        if (g < 8) { dst = QA; ld = 512; col = g * 64; type = 2; gain = aqn; }
        else if (g < 10) { dst = KA; ld = 128; col = (g - 8) * 64; type = 3; gain = akn; }
        else if (g < 12) { dst = VA; ld = 128; col = (g - 10) * 64; type = 0; }
        else if (g < 20) { dst = GA; ld = 512; col = (g - 12) * 64; type = 1; }
        else if (g < 28) { dst = QB; ld = 512; col = (g - 20) * 64; type = 2; gain = bqn; }
        else if (g < 36) { dst = KB; ld = 512; col = (g - 28) * 64; type = 3; gain = bkn; }
        else if (g < 44) { dst = VB; ld = 512; col = (g - 36) * 64; type = 0; }
        else { dst = GB; ld = 512; col = (g - 44) * 64; type = 1; }
#pragma unroll
        for (int ai = 0; ai < 2; ++ai)
#pragma unroll
            for (int m = 0; m < 4; ++m) {
                const int row = pm * 256 + ai * 128 + wr * 64 + m * 16 + fr;
                float ss = 0.f;
                for (int i = 0; i < nparts; ++i) ss += parts[(size_t)i * M + row];
                const float rstd = rsqrtf(ss * (1.0f / 1024.0f) + EPS);
                const int r = row < ML ? row >> 11 : 32;
                const float* bptr = bias + (size_t)r * 3328 + pn * 256 + wc * 32 + fq * 4;
                f32x4 v[2][2];
#pragma unroll
                for (int bj = 0; bj < 2; ++bj)
#pragma unroll
                    for (int n = 0; n < 2; ++n) v[bj][n] = acc[ai][bj][m][n] * rstd + *(const f32x4*)(bptr + bj * 128 + n * 16);
                if (type >= 2) {
                    float s2 = 0.f;
#pragma unroll
                    for (int bj = 0; bj < 2; ++bj)
#pragma unroll
                        for (int n = 0; n < 2; ++n) s2 += v[bj][n][0] * v[bj][n][0] + v[bj][n][1] * v[bj][n][1] + v[bj][n][2] * v[bj][n][2] + v[bj][n][3] * v[bj][n][3];
                    s2 += __shfl_xor(s2, 16); s2 += __shfl_xor(s2, 32);
                    const float rn = rsqrtf(s2 * (1.0f / 64.0f) + EPS);
#pragma unroll
                    for (int bj = 0; bj < 2; ++bj)
#pragma unroll
                        for (int n = 0; n < 2; ++n) v[bj][n] = v[bj][n] * rn * *(const f32x4*)(gain + bj * 32 + n * 16 + fq * 4);
                    if (row < ML) {
                        const int t = row & 2047;
#pragma unroll
                        for (int bj = 0; bj < 2; ++bj) {
                            const int pos = bj == 0 ? (t >> 6) : (t & 63);
                            const float* cs = rope + (pos * 16 + fq * 4) * 2;
                            const f32x4 c01 = *(const f32x4*)cs, c23 = *(const f32x4*)(cs + 4);
                            const float cc[4] = {c01[0], c01[2], c23[0], c23[2]}, sn[4] = {c01[1], c01[3], c23[1], c23[3]};
#pragma unroll
                            for (int e = 0; e < 4; ++e) { const float x1 = v[bj][0][e], x2 = v[bj][1][e]; v[bj][0][e] = x1 * cc[e] - x2 * sn[e]; v[bj][1][e] = x2 * cc[e] + x1 * sn[e]; }
                        }
                    }
                    if (type == 2) {
#pragma unroll
                        for (int bj = 0; bj < 2; ++bj)
#pragma unroll
                            for (int n = 0; n < 2; ++n) v[bj][n] = v[bj][n] * QSCALE;
                    }
                } else if (type == 1) {
#pragma unroll
                    for (int bj = 0; bj < 2; ++bj)
#pragma unroll
                        for (int n = 0; n < 2; ++n)
#pragma unroll
                            for (int e = 0; e < 4; ++e) v[bj][n][e] = siluf(v[bj][n][e]);
                }
#pragma unroll
                for (int bj = 0; bj < 2; ++bj) {
                    u32x4 o; o.x = pack2(v[bj][0][0], v[bj][0][1]); o.y = pack2(v[bj][0][2], v[bj][0][3]); o.z = pack2(v[bj][1][0], v[bj][1][1]); o.w = pack2(v[bj][1][2], v[bj][1][3]);
                    *(u32x4*)(dst + (size_t)row * ld + col + bj * 32 + fq * 8) = o;
                }
            }
    }
};

struct EpiIn1 {
    const float* parts; int nparts; const float* bias;
    bf16_t *QG, *KG, *VG, *GG; float* RF;
    static constexpr bool PERM = false, AFTER_DRAIN = false;
    __device__ __forceinline__ void operator()(const f32x4 (&acc)[2][2][4][2], const pg8::Unit& u, int wr, int wc, int fr, int fq) const { (*this)(acc, u.pm, u.pn, wr, wc, fr, fq); }
    __device__ __forceinline__ void operator()(const f32x4 (&acc)[2][2][4][2], int pm, int pn, int wr, int wc, int fr, int fq) const {
        const int g = 4 * pn + wc;
        if (g > 48) return;
        bf16_t* dst = nullptr; int ld = 0, col = 0, type;
        if (g < 8) { dst = QG; ld = 512; col = g * 64; type = 2; }
        else if (g < 16) { dst = KG; ld = 512; col = (g - 8) * 64; type = 0; }
        else if (g < 32) { dst = VG; ld = 1024; col = (g - 16) * 64; type = 0; }
        else if (g < 48) { dst = GG; ld = 1024; col = (g - 32) * 64; type = 1; }
        else type = 3;
#pragma unroll
        for (int ai = 0; ai < 2; ++ai)
#pragma unroll
            for (int m = 0; m < 4; ++m) {
                const int row = pm * 256 + ai * 128 + wr * 64 + m * 16 + fr;
                float ss = 0.f;
                for (int i = 0; i < nparts; ++i) ss += parts[(size_t)i * M + row];
                const float rstd = rsqrtf(ss * (1.0f / 1024.0f) + EPS);
                const int r = row < ML ? row >> 11 : 32;
                const float* bptr = bias + (size_t)r * 3328 + pn * 256 + wc * 32 + fq * 4;
                f32x4 v[2][2];
#pragma unroll
                for (int bj = 0; bj < 2; ++bj)
#pragma unroll
                    for (int n = 0; n < 2; ++n) v[bj][n] = acc[ai][bj][m][n] * rstd + *(const f32x4*)(bptr + bj * 128 + n * 16);
                if (type == 3) {
                    *(f32x4*)(RF + (size_t)row * 32 + fq * 8) = v[0][0];
                    *(f32x4*)(RF + (size_t)row * 32 + fq * 8 + 4) = v[0][1];
                    continue;
                }
                if (type == 2) {
#pragma unroll
                    for (int bj = 0; bj < 2; ++bj)
#pragma unroll
                        for (int n = 0; n < 2; ++n) v[bj][n] = v[bj][n] * 0.08838834764831845f;
                } else if (type == 1) {
#pragma unroll
                    for (int bj = 0; bj < 2; ++bj)
#pragma unroll
                        for (int n = 0; n < 2; ++n)
#pragma unroll
                            for (int e = 0; e < 4; ++e) v[bj][n][e] = siluf(v[bj][n][e]);
                }
#pragma unroll
                for (int bj = 0; bj < 2; ++bj) {
                    u32x4 o; o.x = pack2(v[bj][0][0], v[bj][0][1]); o.y = pack2(v[bj][0][2], v[bj][0][3]); o.z = pack2(v[bj][1][0], v[bj][1][1]); o.w = pack2(v[bj][1][2], v[bj][1][3]);
                    *(u32x4*)(dst + (size_t)row * ld + col + bj * 32 + fq * 8) = o;
                }
            }
    }
};

struct EpiOut0 {
    const float *x, *ctx, *mod, *g1; float* out; bf16_t* A1; float* parts;
    static constexpr bool PERM = false, AFTER_DRAIN = false;
    __device__ __forceinline__ void operator()(const f32x4 (&acc)[2][2][4][2], const pg8::Unit& u, int wr, int wc, int fr, int fq) const { (*this)(acc, u.pm, u.pn, wr, wc, fr, fq); }
    __device__ __forceinline__ void operator()(const f32x4 (&acc)[2][2][4][2], int pm, int pn, int wr, int wc, int fr, int fq) const {
#pragma unroll
        for (int ai = 0; ai < 2; ++ai)
#pragma unroll
            for (int m = 0; m < 4; ++m) {
                const int row = pm * 256 + ai * 128 + wr * 64 + m * 16 + fr;
                const int r = row < ML ? row >> 11 : 32;
                const float* xin = row < ML ? x + (size_t)row * D : ctx + (size_t)(row - ML) * D;
                const float* gt = mod + (size_t)r * 3072 + 2048;
                const float* sc = mod + (size_t)(33 + r) * 3072 + 1024;
                float ss = 0.f;
#pragma unroll
                for (int bj = 0; bj < 2; ++bj) {
                    const int c = pn * 256 + wc * 64 + bj * 32 + fq * 8;
                    f32x4 y[2];
#pragma unroll
                    for (int n = 0; n < 2; ++n) {
                        const f32x4 x1 = *(const f32x4*)(xin + c + n * 4) + *(const f32x4*)(gt + c + n * 4) * acc[ai][bj][m][n];
                        ss += x1[0] * x1[0] + x1[1] * x1[1] + x1[2] * x1[2] + x1[3] * x1[3];
                        if (row < ML) *(f32x4*)(out + (size_t)row * D + c + n * 4) = x1;
                        y[n] = x1 * *(const f32x4*)(g1 + c + n * 4) * (1.0f + *(const f32x4*)(sc + c + n * 4));
                    }
                    u32x4 o; o.x = pack2(y[0][0], y[0][1]); o.y = pack2(y[0][2], y[0][3]); o.z = pack2(y[1][0], y[1][1]); o.w = pack2(y[1][2], y[1][3]);
                    *(u32x4*)(A1 + (size_t)row * D + c) = o;
                }
                ss += __shfl_xor(ss, 16); ss += __shfl_xor(ss, 32);
                if (fq == 0) parts[(size_t)(4 * pn + wc) * M + row] = ss;
            }
    }
};

struct EpiOut1 {
    const float* mod; float* out;
    static constexpr bool PERM = false, AFTER_DRAIN = false;
    __device__ __forceinline__ void operator()(const f32x4 (&acc)[2][2][4][2], const pg8::Unit& u, int wr, int wc, int fr, int fq) const { (*this)(acc, u.pm, u.pn, wr, wc, fr, fq); }
    __device__ __forceinline__ void operator()(const f32x4 (&acc)[2][2][4][2], int pm, int pn, int wr, int wc, int fr, int fq) const {
#pragma unroll
        for (int ai = 0; ai < 2; ++ai)
#pragma unroll
            for (int m = 0; m < 4; ++m) {
                const int row = pm * 256 + ai * 128 + wr * 64 + m * 16 + fr;
                const int r = row >> 11;
                const float* gt = mod + (size_t)(33 + r) * 3072 + 2048;
#pragma unroll
                for (int bj = 0; bj < 2; ++bj)
#pragma unroll
                    for (int n = 0; n < 2; ++n) {
                        const int c = pn * 256 + wc * 64 + bj * 32 + fq * 8 + n * 4;
                        float* o = out + (size_t)row * D + c;
                        *(f32x4*)o = *(const f32x4*)o + *(const f32x4*)(gt + c) * acc[ai][bj][m][n];
                    }
            }
    }
};

template <class Epi>
__device__ void gemm_simple(const bf16_t* __restrict__ A, const bf16_t* __restrict__ Bt, int nM, int nN, const Epi& E, unsigned char* lds, int vb, int nvb) {
    const int tid = threadIdx.x, wid = tid >> 6, lane = tid & 63, wr = wid >> 2, wc = wid & 3, fr = lane & 15, fq = lane >> 4;
    unsigned char* ldsA = lds; unsigned char* ldsB = lds + 256 * 80;
    for (int tile = vb; tile < nM * nN; tile += nvb) {
        const int pm = tile / nN, pn = tile % nN;
        f32x4 acc[2][2][4][2];
#pragma unroll
        for (int a = 0; a < 2; ++a)
#pragma unroll
            for (int b = 0; b < 2; ++b)
#pragma unroll
                for (int m = 0; m < 4; ++m)
#pragma unroll
                    for (int n = 0; n < 2; ++n) acc[a][b][m][n] = (f32x4){0.f, 0.f, 0.f, 0.f};
        for (int k0 = 0; k0 < D; k0 += 32) {
            __syncthreads();
#pragma unroll
            for (int i = 0; i < 2; ++i) {
                const int cidx = tid + 512 * i, r = cidx >> 2, kc = cidx & 3;
                *(u32x4*)(ldsA + r * 80 + kc * 16) = *(const u32x4*)(A + (size_t)(pm * 256 + r) * D + k0 + kc * 8);
                *(u32x4*)(ldsB + r * 80 + kc * 16) = *(const u32x4*)(Bt + (size_t)(pn * 256 + r) * D + k0 + kc * 8);
            }
            __syncthreads();
            bf16x8 af[2][4], bfr[2][2];
#pragma unroll
            for (int ai = 0; ai < 2; ++ai)
#pragma unroll
                for (int m = 0; m < 4; ++m) af[ai][m] = *(const bf16x8*)(ldsA + (ai * 128 + wr * 64 + m * 16 + fr) * 80 + fq * 16);
#pragma unroll
            for (int bj = 0; bj < 2; ++bj)
#pragma unroll
                for (int n = 0; n < 2; ++n) bfr[bj][n] = *(const bf16x8*)(ldsB + (bj * 128 + wc * 32 + n * 16 + fr) * 80 + fq * 16);
#pragma unroll
            for (int ai = 0; ai < 2; ++ai)
#pragma unroll
                for (int bj = 0; bj < 2; ++bj)
#pragma unroll
                    for (int m = 0; m < 4; ++m)
#pragma unroll
                        for (int n = 0; n < 2; ++n) acc[ai][bj][m][n] = __builtin_amdgcn_mfma_f32_16x16x32_bf16(bfr[bj][n], af[ai][m], acc[ai][bj][m][n], 0, 0, 0);
        }
        E(acc, pm, pn, wr, wc, fr, fq);
    }
}

__device__ __forceinline__ float maxabs64(const float* g) { float m = 0.f; for (int i = 0; i < 64; ++i) m = fmaxf(m, fabsf(g[i])); return m; }

__device__ __forceinline__ void phase_attnA(const Params& P, int vb, int nvb) {
    const float MA = 8.0f * maxabs64(P.a_q_norm) * maxabs64(P.a_k_norm) * LOG2E;
    for (long idx = (long)vb * blockDim.x + threadIdx.x; idx < (long)M * 8; idx += (long)nvb * blockDim.x) {
        const int h = (int)(idx / M), m = (int)(idx % M), kv = h >> 2;
        float q[64], o[64];
        {
            const u32x4* qp = (const u32x4*)(P.QA() + (size_t)m * 512 + h * 64);
#pragma unroll
            for (int i = 0; i < 8; ++i) { const u32x4 w = qp[i]; q[8 * i] = bflo(w.x); q[8 * i + 1] = bfhi(w.x); q[8 * i + 2] = bflo(w.y); q[8 * i + 3] = bfhi(w.y); q[8 * i + 4] = bflo(w.z); q[8 * i + 5] = bfhi(w.z); q[8 * i + 6] = bflo(w.w); q[8 * i + 7] = bfhi(w.w); }
        }
#pragma unroll
        for (int i = 0; i < 64; ++i) o[i] = 0.f;
        float l = 0.f;
        int b, nlat = 0, j0 = 0;
        if (m < ML) { b = m >> 11; const int t = m & 2047; j0 = t - 128 < 0 ? 0 : t - 128; const int j1 = t + 128 > 2047 ? 2047 : t + 128; nlat = j1 - j0 + 1; }
        else b = (m - ML) >> 8;
        const int ntot = nlat + 256;
        for (int jj = 0; jj < ntot; ++jj) {
            const int kr = jj < nlat ? b * 2048 + j0 + jj : ML + b * 256 + (jj - nlat);
            const u32x4* kp = (const u32x4*)(P.KA() + (size_t)kr * 128 + kv * 64);
            float s = 0.f;
#pragma unroll
            for (int i = 0; i < 8; ++i) { const u32x4 w = kp[i]; s += q[8 * i] * bflo(w.x) + q[8 * i + 1] * bfhi(w.x) + q[8 * i + 2] * bflo(w.y) + q[8 * i + 3] * bfhi(w.y) + q[8 * i + 4] * bflo(w.z) + q[8 * i + 5] * bfhi(w.z) + q[8 * i + 6] * bflo(w.w) + q[8 * i + 7] * bfhi(w.w); }
            const float p = exp2f(s - MA);
            l += p;
            const u32x4* vp = (const u32x4*)(P.VA() + (size_t)kr * 128 + kv * 64);
#pragma unroll
            for (int i = 0; i < 8; ++i) { const u32x4 w = vp[i]; o[8 * i] += p * bflo(w.x); o[8 * i + 1] += p * bfhi(w.x); o[8 * i + 2] += p * bflo(w.y); o[8 * i + 3] += p * bfhi(w.y); o[8 * i + 4] += p * bflo(w.z); o[8 * i + 5] += p * bfhi(w.z); o[8 * i + 6] += p * bflo(w.w); o[8 * i + 7] += p * bfhi(w.w); }
        }
        l += exp2f(P.a_sink[h] * LOG2E - MA);
        const float inv = 1.0f / l;
        const u32x4* gp = (const u32x4*)(P.GA() + (size_t)m * 512 + h * 64);
        u32x4* op = (u32x4*)(P.O() + (size_t)m * 1024 + h * 64);
#pragma unroll
        for (int i = 0; i < 8; ++i) {
            const u32x4 w = gp[i]; u32x4 r;
            r.x = pack2(o[8 * i] * inv * bflo(w.x), o[8 * i + 1] * inv * bfhi(w.x)); r.y = pack2(o[8 * i + 2] * inv * bflo(w.y), o[8 * i + 3] * inv * bfhi(w.y));
            r.z = pack2(o[8 * i + 4] * inv * bflo(w.z), o[8 * i + 5] * inv * bfhi(w.z)); r.w = pack2(o[8 * i + 6] * inv * bflo(w.w), o[8 * i + 7] * inv * bfhi(w.w));
            op[i] = r;
        }
    }
}

__device__ __forceinline__ void phase_attnB(const Params& P, int vb, int nvb) {
    const float MB = 8.0f * maxabs64(P.b_q_norm) * maxabs64(P.b_k_norm) * LOG2E;
    float d1 = 0.f, d2 = 0.f;
    for (int i = 0; i < 64; ++i) { d1 += P.lq1[i] * P.lk1[i]; d2 += P.lq2[i] * P.lk2[i]; }
    const float lam = expf(d1) - expf(d2) + LAMBDA_INIT;
    for (long idx = (long)vb * blockDim.x + threadIdx.x; idx < (long)M * 16; idx += (long)nvb * blockDim.x) {
        const int qt = (int)(idx & 3); const long hm = idx >> 2; const int h = (int)(hm / M), m = (int)(hm % M);
        int b, nlat;
        if (m < ML) { b = m >> 11; nlat = 2048; } else { b = (m - ML) >> 8; nlat = 0; }
        const int ntot = nlat + 256;
        float rres[32];
        for (int s = 0; s < 2; ++s) {
            const int g = 2 * h + s;
            float q[64], o[32];
            const u32x4* qp = (const u32x4*)(P.QB() + (size_t)m * 512 + g * 64);
#pragma unroll
            for (int i = 0; i < 8; ++i) { const u32x4 w = qp[i]; q[8 * i] = bflo(w.x); q[8 * i + 1] = bfhi(w.x); q[8 * i + 2] = bflo(w.y); q[8 * i + 3] = bfhi(w.y); q[8 * i + 4] = bflo(w.z); q[8 * i + 5] = bfhi(w.z); q[8 * i + 6] = bflo(w.w); q[8 * i + 7] = bfhi(w.w); }
#pragma unroll
            for (int i = 0; i < 32; ++i) o[i] = 0.f;
            float l = 0.f;
            for (int jj = 0; jj < ntot; ++jj) {
                const int kr = jj < nlat ? b * 2048 + jj : ML + b * 256 + (jj - nlat);
                const u32x4* kp = (const u32x4*)(P.KB() + (size_t)kr * 512 + g * 64);
                float sc = 0.f;
#pragma unroll
                for (int i = 0; i < 8; ++i) { const u32x4 w = kp[i]; sc += q[8 * i] * bflo(w.x) + q[8 * i + 1] * bfhi(w.x) + q[8 * i + 2] * bflo(w.y) + q[8 * i + 3] * bfhi(w.y) + q[8 * i + 4] * bflo(w.z) + q[8 * i + 5] * bfhi(w.z) + q[8 * i + 6] * bflo(w.w) + q[8 * i + 7] * bfhi(w.w); }
                const float p = exp2f(sc - MB);
                l += p;
                const u32x4* vp = (const u32x4*)(P.VB() + (size_t)kr * 512 + h * 128 + qt * 32);
#pragma unroll
                for (int i = 0; i < 4; ++i) { const u32x4 w = vp[i]; o[8 * i] += p * bflo(w.x); o[8 * i + 1] += p * bfhi(w.x); o[8 * i + 2] += p * bflo(w.y); o[8 * i + 3] += p * bfhi(w.y); o[8 * i + 4] += p * bflo(w.z); o[8 * i + 5] += p * bfhi(w.z); o[8 * i + 6] += p * bflo(w.w); o[8 * i + 7] += p * bfhi(w.w); }
            }
            const float inv = 1.0f / l;
            if (s == 0) {
#pragma unroll
                for (int i = 0; i < 32; ++i) rres[i] = o[i] * inv;
            } else {
#pragma unroll
                for (int i = 0; i < 32; ++i) rres[i] -= lam * o[i] * inv;
            }
        }
        float ss = 0.f;
#pragma unroll
        for (int i = 0; i < 32; ++i) ss += rres[i] * rres[i];
        ss += __shfl_xor(ss, 1); ss += __shfl_xor(ss, 2);
        const float rn = rsqrtf(ss * (1.0f / 128.0f) + EPS) * (1.0f - LAMBDA_INIT);
        const u32x4* gp = (const u32x4*)(P.GB() + (size_t)m * 512 + h * 128 + qt * 32);
        const float* sl = P.b_subln + qt * 32;
        u32x4* op = (u32x4*)(P.O() + (size_t)m * 1024 + 512 + h * 128 + qt * 32);
#pragma unroll
        for (int i = 0; i < 4; ++i) {
            const u32x4 w = gp[i]; u32x4 r;
            r.x = pack2(rres[8 * i] * rn * sl[8 * i] * bflo(w.x), rres[8 * i + 1] * rn * sl[8 * i + 1] * bfhi(w.x));
            r.y = pack2(rres[8 * i + 2] * rn * sl[8 * i + 2] * bflo(w.y), rres[8 * i + 3] * rn * sl[8 * i + 3] * bfhi(w.y));
            r.z = pack2(rres[8 * i + 4] * rn * sl[8 * i + 4] * bflo(w.z), rres[8 * i + 5] * rn * sl[8 * i + 5] * bfhi(w.z));
            r.w = pack2(rres[8 * i + 6] * rn * sl[8 * i + 6] * bflo(w.w), rres[8 * i + 7] * rn * sl[8 * i + 7] * bfhi(w.w));
            op[i] = r;
        }
    }
}

typedef float f32x16 __attribute__((ext_vector_type(16)));
typedef short s16x4 __attribute__((ext_vector_type(4)));
typedef float f32x2_t __attribute__((ext_vector_type(2)));
typedef __bf16 bf16x2_t __attribute__((ext_vector_type(2)));
#define LDSAS __attribute__((address_space(3)))
__device__ __forceinline__ unsigned cvtpk(float lo, float hi) { f32x2_t v = {lo, hi}; bf16x2_t b = __builtin_convertvector(v, bf16x2_t); return __builtin_bit_cast(unsigned, b); }
__device__ __forceinline__ int crow(int r, int hi) { return (r & 3) + 8 * (r >> 2) + 4 * hi; }
__device__ __forceinline__ s16x4 vtr(const LDSAS unsigned char* p) { return __builtin_bit_cast(s16x4, __builtin_amdgcn_ds_read_tr16_b64_v4i16((LDSAS s16x4*)p)); }

constexpr int AB_K1 = 0, AB_K2 = 16384, AB_V = 32768;
constexpr int AB_XCH = 0, AB_SCR = 67584, AB_LDS = 67584 + 8 * 256;

__device__ __forceinline__ void attnB_unit(const Params& P, LDSAS unsigned char* lds, int b, int h, int qrow0, int t_begin, int t_end) {
    const int tid = otid(), lane = tid & 63, r32 = lane & 31, hi = lane >> 5;
    const int wid = __builtin_amdgcn_readfirstlane(tid >> 6);
    const int s = wid >> 2, qt = wid & 3;
    const int qrow = qrow0 + qt * 32 + r32;
    bf16x8 qf[4];
#pragma unroll
    for (int d0 = 0; d0 < 4; ++d0) qf[d0] = *(const bf16x8*)(P.QB() + (size_t)qrow * 512 + (2 * h + s) * 64 + d0 * 16 + hi * 8);
    f32x16 o[4];
#pragma unroll
    for (int i = 0; i < 4; ++i) o[i] = (f32x16){};
    float l = 0.f;
    const int krow = tid >> 3, kch = tid & 7, vrow = tid >> 4, vch = tid & 15;
    const int kwoff = krow * 128 + ((kch ^ ((krow >> 1) & 7)) * 16);
    const int vwoff = (vch >> 2) * 4096 + vrow * 64 + (vch & 3) * 16;
    u32x4 rk1, rk2, rv0, rv1;
#define AB_GLOAD(t) do { const int kr0_ = (t) < 32 ? b * 2048 + 64 * (t) : ML + b * 256 + 64 * ((t) - 32); \
        rk1 = *(const u32x4*)(P.KB() + (size_t)(kr0_ + krow) * 512 + (2 * h) * 64 + kch * 8); \
        rk2 = *(const u32x4*)(P.KB() + (size_t)(kr0_ + krow) * 512 + (2 * h + 1) * 64 + kch * 8); \
        rv0 = *(const u32x4*)(P.VB() + (size_t)(kr0_ + vrow) * 512 + h * 128 + vch * 8); \
        rv1 = *(const u32x4*)(P.VB() + (size_t)(kr0_ + vrow + 32) * 512 + h * 128 + vch * 8); } while (0)
#define AB_LWRITE(buf) do { *(LDSAS u32x4*)(lds + AB_K1 + (buf) * 8192 + kwoff) = rk1; *(LDSAS u32x4*)(lds + AB_K2 + (buf) * 8192 + kwoff) = rk2; \
        *(LDSAS u32x4*)(lds + AB_V + (buf) * 16384 + vwoff) = rv0; *(LDSAS u32x4*)(lds + AB_V + (buf) * 16384 + vwoff + 2048) = rv1; } while (0)
    const int kroff = (s ? AB_K2 : AB_K1) + r32 * 128, ksw = (r32 >> 1) & 7;
    const int vroff = AB_V + (4 * hi + ((lane & 15) >> 2)) * 64 + ((lane >> 4) & 1) * 32 + (lane & 3) * 8;
    AB_GLOAD(t_begin); AB_LWRITE(0); __syncthreads();
    for (int t = t_begin; t < t_end; ++t) {
        const int buf = (t - t_begin) & 1;
        const LDSAS unsigned char* kb = lds + buf * 8192 + kroff;
        f32x16 p0 = (f32x16){}, p1 = (f32x16){};
#pragma unroll
        for (int d0 = 0; d0 < 4; ++d0) {
            const int co = ((2 * d0 + hi) ^ ksw) * 16;
            const bf16x8 k0 = *(const LDSAS bf16x8*)(kb + co), k1 = *(const LDSAS bf16x8*)(kb + 4096 + co);
            p0 = __builtin_amdgcn_mfma_f32_32x32x16_bf16(k0, qf[d0], p0, 0, 0, 0);
            p1 = __builtin_amdgcn_mfma_f32_32x32x16_bf16(k1, qf[d0], p1, 0, 0, 0);
        }
        float ls = 0.f;
#pragma unroll
        for (int r = 0; r < 16; ++r) { p0[r] = __builtin_amdgcn_exp2f(p0[r]); p1[r] = __builtin_amdgcn_exp2f(p1[r]); ls += p0[r] + p1[r]; }
        l += ls;
        u32x4 pw[4];
        pw[0].x = cvtpk(p0[0], p0[1]); pw[0].y = cvtpk(p0[2], p0[3]); pw[0].z = cvtpk(p0[4], p0[5]); pw[0].w = cvtpk(p0[6], p0[7]);
        pw[1].x = cvtpk(p0[8], p0[9]); pw[1].y = cvtpk(p0[10], p0[11]); pw[1].z = cvtpk(p0[12], p0[13]); pw[1].w = cvtpk(p0[14], p0[15]);
        pw[2].x = cvtpk(p1[0], p1[1]); pw[2].y = cvtpk(p1[2], p1[3]); pw[2].z = cvtpk(p1[4], p1[5]); pw[2].w = cvtpk(p1[6], p1[7]);
        pw[3].x = cvtpk(p1[8], p1[9]); pw[3].y = cvtpk(p1[10], p1[11]); pw[3].z = cvtpk(p1[12], p1[13]); pw[3].w = cvtpk(p1[14], p1[15]);
        if (t + 1 < t_end) AB_GLOAD(t + 1);
        const LDSAS unsigned char* vb = lds + buf * 16384 + vroff;
#pragma unroll
        for (int d0 = 0; d0 < 4; ++d0)
#pragma unroll
            for (int ks = 0; ks < 4; ++ks) {
                const s16x4 lo = vtr(vb + d0 * 4096 + ks * 1024), hh = vtr(vb + d0 * 4096 + ks * 1024 + 512);
                const bf16x8 vf = (bf16x8){lo[0], lo[1], lo[2], lo[3], hh[0], hh[1], hh[2], hh[3]};
                o[d0] = __builtin_amdgcn_mfma_f32_32x32x16_bf16(__builtin_bit_cast(bf16x8, pw[ks]), vf, o[d0], 0, 0, 0);
                if (ks == 3) __builtin_amdgcn_sched_barrier(0);
            }
        if (t + 1 < t_end) AB_LWRITE(buf ^ 1);
        __syncthreads();
    }
#undef AB_GLOAD
#undef AB_LWRITE
    l += __shfl_xor(l, 32);
    LDSAS float* scr = (LDSAS float*)(lds + AB_SCR + wid * 256);
    LDSAS float* xch = (LDSAS float*)(lds + AB_XCH + qt * 16896);
    if (hi == 0) scr[r32] = (s ? P.scal()[0] : 1.0f) / l;
    float rl[16];
#pragma unroll
    for (int r = 0; r < 16; ++r) rl[r] = scr[crow(r, hi)];
    if (s == 1) {
#pragma unroll
        for (int d0 = 0; d0 < 4; ++d0)
#pragma unroll
            for (int r = 0; r < 16; ++r) xch[crow(r, hi) * 132 + d0 * 32 + r32] = o[d0][r] * rl[r];
    }
    __syncthreads();
    if (s == 0) {
        float ss[16];
#pragma unroll
        for (int r = 0; r < 16; ++r) {
            float s2 = 0.f;
#pragma unroll
            for (int d0 = 0; d0 < 4; ++d0) { const float v = o[d0][r] * rl[r] - xch[crow(r, hi) * 132 + d0 * 32 + r32]; o[d0][r] = v; s2 += v * v; }
            ss[r] = s2;
        }
#pragma unroll
        for (int r = 0; r < 16; ++r) {
            float s2 = ss[r];
            s2 += __shfl_xor(s2, 1); s2 += __shfl_xor(s2, 2); s2 += __shfl_xor(s2, 4); s2 += __shfl_xor(s2, 8); s2 += __shfl_xor(s2, 16);
            ss[r] = rsqrtf(s2 * (1.0f / 128.0f) + EPS) * (1.0f - LAMBDA_INIT);
        }
#pragma unroll
        for (int d0 = 0; d0 < 4; ++d0) {
            const float sl = P.b_subln[d0 * 32 + r32];
#pragma unroll
            for (int r = 0; r < 16; ++r) xch[crow(r, hi) * 132 + d0 * 32 + r32] = o[d0][r] * ss[r] * sl;
        }
        const int eq = lane >> 1, eseg = lane & 1;
        const size_t grow = (size_t)(qrow0 + qt * 32 + eq);
        const u32x4* gp = (const u32x4*)(P.GB() + grow * 512 + h * 128 + eseg * 64);
        u32x4* op = (u32x4*)(P.O() + grow * 1024 + 512 + h * 128 + eseg * 64);
#pragma unroll
        for (int i = 0; i < 8; ++i) {
            const f32x4 a = *(const LDSAS f32x4*)(xch + eq * 132 + eseg * 64 + i * 8), c = *(const LDSAS f32x4*)(xch + eq * 132 + eseg * 64 + i * 8 + 4);
            const u32x4 g = gp[i]; u32x4 ov;
            ov.x = cvtpk(a[0] * bflo(g.x), a[1] * bfhi(g.x)); ov.y = cvtpk(a[2] * bflo(g.y), a[3] * bfhi(g.y));
            ov.z = cvtpk(c[0] * bflo(g.z), c[1] * bfhi(g.z)); ov.w = cvtpk(c[2] * bflo(g.w), c[3] * bfhi(g.w));
            op[i] = ov;
        }
    }
    __syncthreads();
}

__device__ __forceinline__ void phase_attnB_mfma(const Params& P, LDSAS unsigned char* lds, int vb, int nvb) {
    for (int u = vb; u < 2048 + 256; u += nvb) {
        if (u < 2048) {
            int pair, qblk;
            if (nvb == 256) { const int round = u >> 8, i = u & 255, xcd = i & 7, slot = i >> 3; pair = round * 16 + xcd * 2 + (slot >> 4); qblk = slot & 15; }
            else { pair = u >> 4; qblk = u & 15; }
            const int b = pair >> 2, h = pair & 3;
            attnB_unit(P, lds, b, h, b * 2048 + qblk * 128, 0, 36);
        } else {
            const int v = u - 2048, pair = v >> 1, qblk = v & 1, b = pair >> 2, h = pair & 3;
            attnB_unit(P, lds, b, h, ML + b * 256 + qblk * 128, 32, 36);
        }
    }
}

constexpr int AA_K = 0, AA_V = 16384;
__device__ __forceinline__ void attnA_unit(const Params& P, LDSAS unsigned char* lds, int b, int kvh, int qrow0, int qpos0, int kt0, int nwin) {
    const int tid = otid(), lane = tid & 63, r32 = lane & 31, hi = lane >> 5;
    const int wid = __builtin_amdgcn_readfirstlane(tid >> 6);
    const int head = kvh * 4 + (wid >> 1), qoff = (wid & 1) * 64;
    bf16x8 qf[2][4];
#pragma unroll
    for (int qq = 0; qq < 2; ++qq)
#pragma unroll
        for (int d0 = 0; d0 < 4; ++d0) qf[qq][d0] = *(const bf16x8*)(P.QA() + (size_t)(qrow0 + qoff + qq * 32 + r32) * 512 + head * 64 + d0 * 16 + hi * 8);
    f32x16 o[2][2];
#pragma unroll
    for (int i = 0; i < 2; ++i) { o[i][0] = (f32x16){}; o[i][1] = (f32x16){}; }
    float l[2] = {0.f, 0.f};
    const int krow = tid >> 3, kch = tid & 7;
    const int kwoff = krow * 128 + ((kch ^ ((krow >> 1) & 7)) * 16);
    const int vwoff = (kch >> 2) * 4096 + krow * 64 + (kch & 3) * 16;
    u32x4 rk, rv;
    const int nt = nwin + 4;
#define AA_KR0(i) ((i) < nwin ? b * 2048 + 64 * (kt0 + (i)) : ML + b * 256 + 64 * ((i) - nwin))
#define AA_GLOAD(i) do { const int kr0_ = AA_KR0(i); rk = *(const u32x4*)(P.KA() + (size_t)(kr0_ + krow) * 128 + kvh * 64 + kch * 8); rv = *(const u32x4*)(P.VA() + (size_t)(kr0_ + krow) * 128 + kvh * 64 + kch * 8); } while (0)
#define AA_LWRITE(buf) do { *(LDSAS u32x4*)(lds + AA_K + (buf) * 8192 + kwoff) = rk; *(LDSAS u32x4*)(lds + AA_V + (buf) * 8192 + vwoff) = rv; } while (0)
    const int kroff = AA_K + r32 * 128, ksw = (r32 >> 1) & 7;
    const int vroff = AA_V + (4 * hi + ((lane & 15) >> 2)) * 64 + ((lane >> 4) & 1) * 32 + (lane & 3) * 8;
    AA_GLOAD(0); AA_LWRITE(0); __syncthreads();
    for (int i = 0; i < nt; ++i) {
        const int buf = i & 1;
        if (i + 1 < nt) AA_GLOAD(i + 1);
        int cls = 1;
        if (i < nwin) { const int delta = 64 * (kt0 + i) - (qpos0 + qoff); cls = delta == -128 ? 2 : (delta == 128 ? 3 : ((delta >= -64 && delta <= 64) ? 1 : 0)); }
        if (cls != 0) {
            const LDSAS unsigned char* kb = lds + buf * 8192 + kroff;
            f32x16 p[2][2];
#pragma unroll
            for (int qq = 0; qq < 2; ++qq) { p[qq][0] = (f32x16){}; p[qq][1] = (f32x16){}; }
#pragma unroll
            for (int d0 = 0; d0 < 4; ++d0) {
                const int co = ((2 * d0 + hi) ^ ksw) * 16;
                const bf16x8 k0 = *(const LDSAS bf16x8*)(kb + co), k1 = *(const LDSAS bf16x8*)(kb + 4096 + co);
#pragma unroll
                for (int qq = 0; qq < 2; ++qq) {
                    p[qq][0] = __builtin_amdgcn_mfma_f32_32x32x16_bf16(k0, qf[qq][d0], p[qq][0], 0, 0, 0);
                    p[qq][1] = __builtin_amdgcn_mfma_f32_32x32x16_bf16(k1, qf[qq][d0], p[qq][1], 0, 0, 0);
                }
            }
            u32x4 pw[2][4];
#pragma unroll
            for (int qq = 0; qq < 2; ++qq) {
                float ls = 0.f;
#pragma unroll
                for (int r = 0; r < 16; ++r) { p[qq][0][r] = __builtin_amdgcn_exp2f(p[qq][0][r]); p[qq][1][r] = __builtin_amdgcn_exp2f(p[qq][1][r]); }
                if (cls >= 2) {
                    const int a = qq * 32 + r32;
#pragma unroll
                    for (int r = 0; r < 16; ++r) {
                        const int c0 = crow(r, hi), c1 = c0 + 32;
                        const bool v0 = cls == 2 ? (c0 >= a) : (c0 <= a), v1 = cls == 2 ? (c1 >= a) : (c1 <= a);
                        p[qq][0][r] = v0 ? p[qq][0][r] : 0.f; p[qq][1][r] = v1 ? p[qq][1][r] : 0.f;
                    }
                }
#pragma unroll
                for (int r = 0; r < 16; ++r) ls += p[qq][0][r] + p[qq][1][r];
                l[qq] += ls;
                const f32x16 &a0 = p[qq][0], &a1 = p[qq][1];
                pw[qq][0].x = cvtpk(a0[0], a0[1]); pw[qq][0].y = cvtpk(a0[2], a0[3]); pw[qq][0].z = cvtpk(a0[4], a0[5]); pw[qq][0].w = cvtpk(a0[6], a0[7]);
                pw[qq][1].x = cvtpk(a0[8], a0[9]); pw[qq][1].y = cvtpk(a0[10], a0[11]); pw[qq][1].z = cvtpk(a0[12], a0[13]); pw[qq][1].w = cvtpk(a0[14], a0[15]);
                pw[qq][2].x = cvtpk(a1[0], a1[1]); pw[qq][2].y = cvtpk(a1[2], a1[3]); pw[qq][2].z = cvtpk(a1[4], a1[5]); pw[qq][2].w = cvtpk(a1[6], a1[7]);
                pw[qq][3].x = cvtpk(a1[8], a1[9]); pw[qq][3].y = cvtpk(a1[10], a1[11]); pw[qq][3].z = cvtpk(a1[12], a1[13]); pw[qq][3].w = cvtpk(a1[14], a1[15]);
            }
            const LDSAS unsigned char* vb = lds + buf * 8192 + vroff;
#pragma unroll
            for (int d0 = 0; d0 < 2; ++d0)
#pragma unroll
                for (int ks = 0; ks < 4; ++ks) {
                    const s16x4 lo = vtr(vb + d0 * 4096 + ks * 1024), hh = vtr(vb + d0 * 4096 + ks * 1024 + 512);
                    const bf16x8 vf = (bf16x8){lo[0], lo[1], lo[2], lo[3], hh[0], hh[1], hh[2], hh[3]};
                    o[0][d0] = __builtin_amdgcn_mfma_f32_32x32x16_bf16(__builtin_bit_cast(bf16x8, pw[0][ks]), vf, o[0][d0], 0, 0, 0);
                    o[1][d0] = __builtin_amdgcn_mfma_f32_32x32x16_bf16(__builtin_bit_cast(bf16x8, pw[1][ks]), vf, o[1][d0], 0, 0, 0);
                }
        }
        if (i + 1 < nt) AA_LWRITE(buf ^ 1);
        __syncthreads();
    }
#undef AA_KR0
#undef AA_GLOAD
#undef AA_LWRITE
    const float sinkp = __builtin_amdgcn_exp2f(P.a_sink[head] * LOG2E);
    LDSAS float* stg = (LDSAS float*)(lds + wid * 8704);
    const int eq = lane >> 1, eseg = lane & 1;
#pragma unroll
    for (int qq = 0; qq < 2; ++qq) {
        float lt = l[qq]; lt += __shfl_xor(lt, 32);
        if (hi == 0) stg[r32] = 1.0f / (lt + sinkp);
        float rl[16];
#pragma unroll
        for (int r = 0; r < 16; ++r) rl[r] = stg[crow(r, hi)];
#pragma unroll
        for (int d0 = 0; d0 < 2; ++d0)
#pragma unroll
            for (int r = 0; r < 16; ++r) stg[crow(r, hi) * 68 + d0 * 32 + r32] = o[qq][d0][r] * rl[r];
        const size_t grow = (size_t)(qrow0 + qoff + qq * 32 + eq);
        const u32x4* gp = (const u32x4*)(P.GA() + grow * 512 + head * 64 + eseg * 32);
        u32x4* op = (u32x4*)(P.O() + grow * 1024 + head * 64 + eseg * 32);
#pragma unroll
        for (int i = 0; i < 4; ++i) {
            const f32x4 a = *(const LDSAS f32x4*)(stg + eq * 68 + eseg * 32 + i * 8), c = *(const LDSAS f32x4*)(stg + eq * 68 + eseg * 32 + i * 8 + 4);
            const u32x4 g = gp[i]; u32x4 ov;
            ov.x = cvtpk(a[0] * bflo(g.x), a[1] * bfhi(g.x)); ov.y = cvtpk(a[2] * bflo(g.y), a[3] * bfhi(g.y));
            ov.z = cvtpk(c[0] * bflo(g.z), c[1] * bfhi(g.z)); ov.w = cvtpk(c[2] * bflo(g.w), c[3] * bfhi(g.w));
            op[i] = ov;
        }
    }
    __syncthreads();
}

__device__ __forceinline__ void phase_attnA_mfma(const Params& P, LDSAS unsigned char* lds, int vb, int nvb) {
    for (int u = vb; u < 1024 + 128; u += nvb) {
        if (u < 1024) {
            const int qblk = u & 15, kvh = (u >> 4) & 1, b = u >> 5;
            const int lo = 2 * qblk - 2 < 0 ? 0 : 2 * qblk - 2, hi_ = 2 * qblk + 3 > 31 ? 31 : 2 * qblk + 3;
            attnA_unit(P, lds, b, kvh, b * 2048 + qblk * 128, qblk * 128, lo, hi_ - lo + 1);
        } else {
            const int v = u - 1024, half = v & 1, kvh = (v >> 1) & 1, b = v >> 2;
            attnA_unit(P, lds, b, kvh, ML + b * 256 + half * 128, 0, 0, 0);
        }
    }
}

__device__ __forceinline__ void phase_gla(const Params& P, float* lds, int vb, int nvb) {
    const int tidx = otid();
    float* sa = lds; float* sk = lds + 128; float* sq = lds + 256;
    const int e = tidx;
    for (int unit = vb; unit < NB * 4 * 2; unit += nvb) {
        const int dr = unit & 1, h = (unit >> 1) & 3, b = unit >> 3;
        const float* wa = dr ? P.wa_b : P.wa_f; const float* ba = dr ? P.ba_b : P.ba_f;
        float S[128];
#pragma unroll
        for (int d = 0; d < 128; ++d) S[d] = 0.f;
        float war[16], bav = 0.f;
        if (e < 128) {
#pragma unroll
            for (int j = 0; j < 16; ++j) war[j] = wa[j * 512 + h * 128 + e];
            bav = ba[h * 128 + e];
        }
        for (int step = 0; step < L + T; ++step) {
            int m;
            if (step < L) m = ML + b * L + (dr ? L - 1 - step : step);
            else { const int t = step - L; m = b * T + (dr ? T - 1 - t : t); }
            __syncthreads();
            if (e < 128) {
                const float* rf = P.RF() + (size_t)m * 32 + dr * 16;
                float z = bav;
#pragma unroll
                for (int j = 0; j < 16; ++j) z += rf[j] * war[j];
                const float ls = fminf(z, 0.f) - log1pf(expf(-fabsf(z)));
                sa[e] = expf(ls * (1.0f / 16.0f));
                sk[e] = bf2f(P.KG()[(size_t)m * 512 + h * 128 + e]);
                sq[e] = bf2f(P.QG()[(size_t)m * 512 + h * 128 + e]);
            }
            __syncthreads();
            if (e < 256) {
            const float v = bf2f(P.VG()[(size_t)m * 1024 + h * 256 + e]);
            float o = 0.f;
#pragma unroll
            for (int d = 0; d < 128; ++d) { S[d] = sa[d] * S[d] + sk[d] * v; o += sq[d] * S[d]; }
            if (m < ML) P.OD()[((size_t)dr * ML + m) * 1024 + h * 256 + e] = (bf16_t)f2bf(o);
            }
        }
    }
}

__device__ __forceinline__ void phase_finish(const Params& P, int vb, int nvb) {
    const int tidx = otid();
    const int lane = tidx & 63, wpb = blockDim.x >> 6, w = tidx >> 6;
    for (int row = vb * wpb + w; row < ML; row += nvb * wpb) {
        const int c0 = lane * 16;
        float v[16];
        const u32x4* pf = (const u32x4*)(P.OD() + (size_t)row * 1024 + c0);
        const u32x4* pb = (const u32x4*)(P.OD() + ((size_t)ML + row) * 1024 + c0);
        float ss = 0.f;
#pragma unroll
        for (int i = 0; i < 2; ++i) {
            const u32x4 a = pf[i], bq = pb[i];
            v[8 * i] = bflo(a.x) + bflo(bq.x); v[8 * i + 1] = bfhi(a.x) + bfhi(bq.x); v[8 * i + 2] = bflo(a.y) + bflo(bq.y); v[8 * i + 3] = bfhi(a.y) + bfhi(bq.y);
            v[8 * i + 4] = bflo(a.z) + bflo(bq.z); v[8 * i + 5] = bfhi(a.z) + bfhi(bq.z); v[8 * i + 6] = bflo(a.w) + bflo(bq.w); v[8 * i + 7] = bfhi(a.w) + bfhi(bq.w);
        }
#pragma unroll
        for (int i = 0; i < 16; ++i) ss += v[i] * v[i];
        ss += __shfl_xor(ss, 1); ss += __shfl_xor(ss, 2); ss += __shfl_xor(ss, 4); ss += __shfl_xor(ss, 8);
        const float rn = rsqrtf(ss * (1.0f / 256.0f) + EPS);
        const float* gn = P.gla_out_norm + (c0 & 255);
        const u32x4* gp = (const u32x4*)(P.GG() + (size_t)row * 1024 + c0);
        u32x4* op = (u32x4*)(P.A2() + (size_t)row * 1024 + c0);
#pragma unroll
        for (int i = 0; i < 2; ++i) {
            const u32x4 g = gp[i]; u32x4 r;
            r.x = pack2(v[8 * i] * rn * gn[8 * i] * bflo(g.x), v[8 * i + 1] * rn * gn[8 * i + 1] * bfhi(g.x));
            r.y = pack2(v[8 * i + 2] * rn * gn[8 * i + 2] * bflo(g.y), v[8 * i + 3] * rn * gn[8 * i + 3] * bfhi(g.y));
            r.z = pack2(v[8 * i + 4] * rn * gn[8 * i + 4] * bflo(g.z), v[8 * i + 5] * rn * gn[8 * i + 5] * bfhi(g.z));
            r.w = pack2(v[8 * i + 6] * rn * gn[8 * i + 6] * bflo(g.w), v[8 * i + 7] * rn * gn[8 * i + 7] * bfhi(g.w));
            op[i] = r;
        }
    }
}

namespace cg = cooperative_groups;
__global__ void __launch_bounds__(512) mega_kernel(Params Pk) {
    __shared__ __attribute__((aligned(16))) unsigned char lds[pg8::STAGE_BYTES];
    cg::grid_group grid = cg::this_grid();
    const int vb = blockIdx.x, nvb = gridDim.x;
    { const Params P = ldparams(); phase_pro0(P, lds, vb, nvb); }
    grid.sync();
    { const Params P = ldparams(); phase_bias(P, lds, vb, nvb); phase_a0(P, vb, nvb); }
    grid.sync();
    { const Params P = ldparams();
      EpiIn0 E{P.parts(), 1, P.bias0(), P.a_q_norm, P.a_k_norm, P.b_q_norm, P.b_k_norm, P.rope(), P.QA(), P.KA(), P.VA(), P.GA(), P.QB(), P.KB(), P.VB(), P.GB()};
      pg8::Gemm g{P.A(), P.Wt0(), M, N0, D}; pg8::StaticOrder S; S.init(M, N0, nvb, vb); pg8::gemm_phase<EpiIn0, pg8::StaticOrder, true, true>((LDSAS unsigned char*)lds, g, S, E); }
    grid.sync();
    { const Params P = ldparams(); phase_attnA_mfma(P, (LDSAS unsigned char*)lds, vb, nvb); }
    { const Params P = ldparams(); phase_attnB_mfma(P, (LDSAS unsigned char*)lds, vb, nvb); }
    grid.sync();
    { const Params P = ldparams();
      EpiOut0 E{P.x, P.ctx, P.mod(), P.norm_g + D, P.out, P.A(), P.parts()};
      pg8::Gemm g{P.O(), P.Wo0(), M, D, D}; pg8::StaticOrder S; S.init(M, D, nvb, vb); pg8::gemm_phase<EpiOut0, pg8::StaticOrder, true, true>((LDSAS unsigned char*)lds, g, S, E); }
    grid.sync();
    { const Params P = ldparams();
      EpiIn1 E{P.parts(), 16, P.bias1(), P.QG(), P.KG(), P.VG(), P.GG(), P.RF()};
      pg8::Gemm g{P.A(), P.Wt1(), M, N1, D}; pg8::StaticOrder S; S.init(M, N1, nvb, vb); pg8::gemm_phase<EpiIn1, pg8::StaticOrder, true, true>((LDSAS unsigned char*)lds, g, S, E); }
    grid.sync();
    { const Params P = ldparams(); phase_gla(P, (float*)lds, vb, nvb); }
    grid.sync();
    { const Params P = ldparams(); phase_finish(P, vb, nvb); }
    grid.sync();
    { const Params P = ldparams();
      EpiOut1 E{P.mod(), P.out};
      pg8::Gemm g{P.A2(), P.Wo1(), ML, D, D}; pg8::StaticOrder S; S.init(ML, D, nvb, vb); pg8::gemm_phase<EpiOut1, pg8::StaticOrder, true, true>((LDSAS unsigned char*)lds, g, S, E); }
}
}

extern "C" void kernel_launch(void* const* d_in, const int* in_sizes, int n_in, void* d_out, int out_size, void* d_ws, size_t ws_size, hipStream_t stream) {
    Params P{};
    const float* const* in = (const float* const*)d_in;
    P.x = in[0]; P.c = in[1]; P.ctx = in[2]; P.c_ctx = in[3]; P.adaln_w = in[4]; P.adaln_b = in[5]; P.norm_g = in[6]; P.w_out = in[7]; P.ab_w_in = in[8];
    P.a_q_norm = in[9]; P.a_k_norm = in[10]; P.a_sink = in[11]; P.b_q_norm = in[12]; P.b_k_norm = in[13]; P.lq1 = in[14]; P.lk1 = in[15]; P.lq2 = in[16]; P.lk2 = in[17];
    P.b_subln = in[18]; P.gla_w_in = in[19]; P.wa_f = in[20]; P.ba_f = in[21]; P.wa_b = in[22]; P.ba_b = in[23]; P.gla_out_norm = in[24];
    P.out = (float*)d_out;
    P.ws = (unsigned char*)d_ws;
    if (WS_NEED > ws_size) { fprintf(stderr, "workspace too small: need %zu have %zu\n", (size_t)WS_NEED, ws_size); return; }
    static int grid_blocks = 0;
    if (!grid_blocks) {
        int dev = 0, cus = 0, per_cu = 0;
        (void)hipGetDevice(&dev);
        (void)hipDeviceGetAttribute(&cus, hipDeviceAttributeMultiprocessorCount, dev);
        (void)hipOccupancyMaxActiveBlocksPerMultiprocessor(&per_cu, mega_kernel, 512, 0);
        if (per_cu > 1) per_cu = 1;
        grid_blocks = cus * per_cu;
    }
    void* args[] = {&P};
    hipError_t e = hipLaunchCooperativeKernel((void*)mega_kernel, dim3(grid_blocks), dim3(512), args, 0, stream);
    if (e != hipSuccess) fprintf(stderr, "cooperative launch failed: %s (grid %d)\n", hipGetErrorString(e), grid_blocks);
}
```

```cpp
#include <hip/hip_runtime.h>
#include <hip/hip_cooperative_groups.h>
#include <cstdint>
#include <cstdio>

namespace {
constexpr int NB = 32, T = 2048, L = 256, D = 1024;
constexpr int ML = NB * T, MC = NB * L, M = ML + MC;
constexpr int N0 = 3328, N1 = 3328, N0R = 3328, N1R = 3104;
constexpr float EPS = 1e-6f;
constexpr float LOG2E = 1.4426950408889634f;
constexpr float QSCALE = 0.125f * LOG2E;
constexpr float LAMBDA_INIT = 0.2f;

typedef unsigned short bf16_t;
typedef short bf16x8 __attribute__((ext_vector_type(8)));
typedef float f32x4 __attribute__((ext_vector_type(4)));
typedef unsigned u32x4 __attribute__((ext_vector_type(4)));
typedef unsigned u32x2 __attribute__((ext_vector_type(2)));

constexpr size_t al256(size_t x) { return (x + 255) & ~(size_t)255; }
constexpr size_t OFF_WT0 = 0;
constexpr size_t OFF_WT1 = OFF_WT0 + al256((size_t)N0 * D * 2);
constexpr size_t OFF_WO0 = OFF_WT1 + al256((size_t)N1 * D * 2);
constexpr size_t OFF_WO1 = OFF_WO0 + al256((size_t)D * D * 2);
constexpr size_t OFF_MOD = OFF_WO1 + al256((size_t)D * D * 2);
constexpr size_t OFF_BIAS0 = OFF_MOD + al256((size_t)2 * 33 * 3072 * 4);
constexpr size_t OFF_BIAS1 = OFF_BIAS0 + al256((size_t)33 * 3328 * 4);
constexpr size_t OFF_ROPE = OFF_BIAS1 + al256((size_t)33 * 3328 * 4);
constexpr size_t OFF_SCAL = OFF_ROPE + al256(64 * 16 * 2 * 4);
constexpr size_t OFF_PARTS = OFF_SCAL + 256;
constexpr size_t OFF_A = OFF_PARTS + al256((size_t)16 * M * 4);
constexpr size_t OFF_O = OFF_A + (size_t)M * D * 2;
constexpr size_t OFF_QKV = OFF_O + (size_t)M * D * 2;
constexpr size_t WS_NEED = OFF_QKV + (size_t)M * 3328 * 2;
constexpr size_t OFF_QA = OFF_QKV, OFF_KA = OFF_QA + (size_t)M * 512 * 2, OFF_VA = OFF_KA + (size_t)M * 128 * 2, OFF_GA = OFF_VA + (size_t)M * 128 * 2;
constexpr size_t OFF_QB = OFF_GA + (size_t)M * 512 * 2, OFF_KB = OFF_QB + (size_t)M * 512 * 2, OFF_VB = OFF_KB + (size_t)M * 512 * 2, OFF_GB = OFF_VB + (size_t)M * 512 * 2;
constexpr size_t OFF_QG = OFF_QKV, OFF_KG = OFF_QG + (size_t)M * 512 * 2, OFF_VG = OFF_KG + (size_t)M * 512 * 2, OFF_GG = OFF_VG + (size_t)M * 1024 * 2, OFF_RF = OFF_GG + (size_t)M * 1024 * 2;
static_assert(OFF_RF + (size_t)M * 32 * 4 <= WS_NEED, "layer-1 projections fit");
static_assert((size_t)2 * ML * 1024 * 2 <= (size_t)2 * M * D * 2, "OD fits over A + O");

struct Params {
    const float *x, *c, *ctx, *c_ctx, *adaln_w, *adaln_b, *norm_g, *w_out, *ab_w_in, *a_q_norm, *a_k_norm, *a_sink, *b_q_norm, *b_k_norm;
    const float *lq1, *lk1, *lq2, *lk2, *b_subln, *gla_w_in, *wa_f, *ba_f, *wa_b, *ba_b, *gla_out_norm;
    float* out;
    unsigned char* ws;
#define WSPTR(T, name, off) __device__ __forceinline__ T* name() const { return (T*)(ws + (off)); }
    WSPTR(bf16_t, Wt0, OFF_WT0) WSPTR(bf16_t, Wt1, OFF_WT1) WSPTR(bf16_t, Wo0, OFF_WO0) WSPTR(bf16_t, Wo1, OFF_WO1)
    WSPTR(float, mod, OFF_MOD) WSPTR(float, bias0, OFF_BIAS0) WSPTR(float, bias1, OFF_BIAS1) WSPTR(float, rope, OFF_ROPE) WSPTR(float, scal, OFF_SCAL) WSPTR(float, parts, OFF_PARTS)
    WSPTR(bf16_t, A, OFF_A) WSPTR(bf16_t, O, OFF_O)
    WSPTR(bf16_t, QA, OFF_QA) WSPTR(bf16_t, KA, OFF_KA) WSPTR(bf16_t, VA, OFF_VA) WSPTR(bf16_t, GA, OFF_GA)
    WSPTR(bf16_t, QB, OFF_QB) WSPTR(bf16_t, KB, OFF_KB) WSPTR(bf16_t, VB, OFF_VB) WSPTR(bf16_t, GB, OFF_GB)
    WSPTR(bf16_t, QG, OFF_QG) WSPTR(bf16_t, KG, OFF_KG) WSPTR(bf16_t, VG, OFF_VG) WSPTR(bf16_t, GG, OFF_GG) WSPTR(float, RF, OFF_RF)
    WSPTR(bf16_t, OD, OFF_A) WSPTR(bf16_t, A2, OFF_QKV)
#undef WSPTR
};

__device__ __forceinline__ int otid() { int t = threadIdx.x; asm volatile("" : "+v"(t)); return t; }
__device__ __forceinline__ unsigned f2bf(float f) { unsigned u = __float_as_uint(f); u += 0x7FFFu + ((u >> 16) & 1u); return u >> 16; }
__device__ __forceinline__ unsigned pack2(float lo, float hi) { return f2bf(lo) | (f2bf(hi) << 16); }
__device__ __forceinline__ float bf2f(unsigned h) { return __uint_as_float(h << 16); }
__device__ __forceinline__ float bflo(unsigned w) { return __uint_as_float(w << 16); }
__device__ __forceinline__ float bfhi(unsigned w) { return __uint_as_float(w & 0xFFFF0000u); }
__device__ __forceinline__ float siluf(float v) { return v / (1.0f + __expf(-v)); }

__device__ __forceinline__ Params ldparams() {
#if defined(__HIP_DEVICE_COMPILE__)
    const __attribute__((address_space(4))) Params* pp = (const __attribute__((address_space(4))) Params*)__builtin_amdgcn_kernarg_segment_ptr();
    asm volatile("" : "+s"(pp));
    return *pp;
#else
    return Params{};
#endif
}

__device__ __forceinline__ int perm_local(int p, bool ropeType) {
    const int bj = p >> 7, wc = (p >> 5) & 3, low = p & 31;
    if (ropeType) return wc * 64 + bj * 32 + low;
    const int n = (low >> 4) & 1, fq = (low >> 2) & 3, e = low & 3;
    return wc * 64 + bj * 32 + fq * 8 + n * 4 + e;
}
__device__ __forceinline__ int src_col(int which, int np) {
    const int p = np & 255, tile = np >> 8;
    bool rope = false;
    if (which == 0) { const int g = tile * 4 + ((p >> 5) & 3); rope = (g < 10) || (g >= 20 && g < 36); }
    const int c = tile * 256 + perm_local(p, rope);
    const int nreal = which == 0 ? N0R : (which == 1 ? N1R : D);
    return c < nreal ? c : -1;
}

__device__ __forceinline__ int dst_row(int which, int c) {
    const int tile = c >> 8, cl = c & 255, wc = cl >> 6, bj = (cl >> 5) & 1, low = cl & 31;
    bool rope = false;
    if (which == 0) { const int g = tile * 4 + wc; rope = (g < 10) || (g >= 20 && g < 36); }
    int lo5 = low;
    if (!rope) { const int fq = low >> 3, n = (low >> 2) & 1, e = low & 3; lo5 = n * 16 + fq * 4 + e; }
    return tile * 256 + bj * 128 + wc * 32 + lo5;
}

__device__ __forceinline__ void wt_tile(const float* __restrict__ W, int ldw, int nreal, int which, bf16_t* __restrict__ dst, int c0, int k0, unsigned char* lds, int tid) {
    bf16_t* t = (bf16_t*)lds;
    __syncthreads();
#pragma unroll
    for (int i = 0; i < 2; ++i) {
        const int idx = tid + 512 * i, r = idx >> 4, c4 = (idx & 15) * 4;
        f32x4 v = (f32x4){0.f, 0.f, 0.f, 0.f};
        if (c0 + c4 < nreal) v = *(const f32x4*)(W + (size_t)(k0 + r) * ldw + c0 + c4);
#pragma unroll
        for (int j = 0; j < 4; ++j) t[(c4 + j) * 66 + r] = (bf16_t)f2bf(v[j]);
    }
    __syncthreads();
    const int c = tid >> 3, kc = tid & 7;
    const unsigned* tr = (const unsigned*)(t + c * 66 + kc * 8);
    u32x4 o; o.x = tr[0]; o.y = tr[1]; o.z = tr[2]; o.w = tr[3];
    *(u32x4*)(dst + (size_t)dst_row(which, c0 + c) * D + k0 + kc * 8) = o;
}

template <int MODE>
__device__ __forceinline__ void skinny_unit(const Params& P, int l, int c0, unsigned char* lds, int tid) {
    float* tab = (float*)lds;
    const int lane = tid & 63, w = tid >> 6;
    const float* W; int ldw, nreal;
    if (MODE == 0) { W = P.adaln_w + (size_t)l * D * 3072; ldw = 3072; nreal = 3072; }
    else { W = l ? P.gla_w_in : P.ab_w_in; ldw = l ? N1R : N0R; nreal = ldw; }
    const bool colok = c0 + lane < nreal;
    float acc[33];
#pragma unroll
    for (int r = 0; r < 33; ++r) acc[r] = 0.f;
    for (int half = 0; half < 2; ++half) {
        __syncthreads();
        for (int r = 0; r < 33; ++r) {
            float v;
            if (MODE == 0) v = siluf(r < 32 ? P.c[r * D + half * 512 + tid] : P.c_ctx[half * 512 + tid]);
            else v = P.mod()[((size_t)l * 33 + r) * 3072 + half * 512 + tid];
            tab[tid * 36 + r] = v;
        }
        __syncthreads();
        for (int kk = 0; kk < 64; ++kk) {
            const int k = w * 64 + kk;
            const float wv = colok ? W[(size_t)(half * 512 + k) * ldw + c0 + lane] : 0.f;
#pragma unroll
            for (int r4 = 0; r4 < 8; ++r4) { const f32x4 s = *(const f32x4*)(tab + k * 36 + r4 * 4); acc[r4 * 4] += s[0] * wv; acc[r4 * 4 + 1] += s[1] * wv; acc[r4 * 4 + 2] += s[2] * wv; acc[r4 * 4 + 3] += s[3] * wv; }
            acc[32] += tab[k * 36 + 32] * wv;
        }
    }
    __syncthreads();
#pragma unroll
    for (int r = 0; r < 33; ++r) tab[(w * 33 + r) * 64 + lane] = acc[r];
    __syncthreads();
    for (int idx = tid; idx < 33 * 64; idx += 512) {
        const int r = idx >> 6, col = idx & 63;
        float s = 0.f;
#pragma unroll
        for (int ww = 0; ww < 8; ++ww) s += tab[(ww * 33 + r) * 64 + col];
        if (MODE == 0) { const int j = c0 + col; P.mod()[((size_t)l * 33 + r) * 3072 + j] = s + P.adaln_b[l * 3072 + j]; }
        else { const int c = c0 + col; (l ? P.bias1() : P.bias0())[r * 3328 + dst_row(l, c)] = c < nreal ? s : 0.f; }
    }
}

__device__ __forceinline__ void phase_pro0(const Params& P, unsigned char* lds, int vb, int nvb) {
    const int tidx = otid();
    for (int item = vb; item < 96 + 2176; item += nvb) {
        if (item < 96) { skinny_unit<0>(P, item / 48, (item % 48) * 64, lds, tidx); continue; }
        int t = item - 96; int which; const float* W; bf16_t* dst; int ldw, nreal;
        if (t < 832) { which = 0; W = P.ab_w_in; dst = P.Wt0(); ldw = N0R; nreal = N0R; }
        else if ((t -= 832) < 832) { which = 1; W = P.gla_w_in; dst = P.Wt1(); ldw = N1R; nreal = N1R; }
        else if ((t -= 832) < 256) { which = 2; W = P.w_out; dst = P.Wo0(); ldw = D; nreal = D; }
        else { t -= 256; which = 3; W = P.w_out + (size_t)D * D; dst = P.Wo1(); ldw = D; nreal = D; }
        wt_tile(W, ldw, nreal, which, dst, (t >> 4) * 64, (t & 15) * 64, lds, tidx);
    }
    for (int idx = vb * 512 + tidx; idx < 64 * 16; idx += nvb * 512) {
        const int pos = idx >> 4, i = idx & 15;
        const double inv = pow(10000.0, -(double)i / 16.0);
        const double ang = (double)((float)pos * (float)inv);
        P.rope()[idx * 2 + 0] = (float)cos(ang);
        P.rope()[idx * 2 + 1] = (float)sin(ang);
    }
    if (vb == nvb - 1 && tidx == 0) {
        float d1 = 0.f, d2 = 0.f;
        for (int i = 0; i < 64; ++i) { d1 += P.lq1[i] * P.lk1[i]; d2 += P.lq2[i] * P.lk2[i]; }
        P.scal()[0] = expf(d1) - expf(d2) + LAMBDA_INIT;
    }
}

__device__ __forceinline__ void phase_bias(const Params& P, unsigned char* lds, int vb, int nvb) {
    const int tidx = otid();
    for (int item = vb; item < 104; item += nvb) skinny_unit<1>(P, item / 52, (item % 52) * 64, lds, tidx);
}

__device__ __forceinline__ void phase_a0(const Params& P, int vb, int nvb) {
    const int tidx = otid();
    const int lane = tidx & 63, wpb = blockDim.x >> 6, w = tidx >> 6;
    for (int row = vb * wpb + w; row < M; row += nvb * wpb) {
        const float* xin = row < ML ? P.x + (size_t)row * D : P.ctx + (size_t)(row - ML) * D;
        const int r = row < ML ? row >> 11 : 32;
        const float* sc = P.mod() + (size_t)r * 3072 + 1024;
        float ss = 0.f;
#pragma unroll
        for (int i = 0; i < 2; ++i) {
            const int c0 = i * 512 + lane * 8;
            const f32x4 a = *(const f32x4*)(xin + c0), b = *(const f32x4*)(xin + c0 + 4);
            const f32x4 g0 = *(const f32x4*)(P.norm_g + c0), g1 = *(const f32x4*)(P.norm_g + c0 + 4);
            const f32x4 s0 = *(const f32x4*)(sc + c0), s1 = *(const f32x4*)(sc + c0 + 4);
            ss += a[0] * a[0] + a[1] * a[1] + a[2] * a[2] + a[3] * a[3] + b[0] * b[0] + b[1] * b[1] + b[2] * b[2] + b[3] * b[3];
            const f32x4 ya = a * g0 * (1.0f + s0), yb = b * g1 * (1.0f + s1);
            u32x4 o; o.x = pack2(ya[0], ya[1]); o.y = pack2(ya[2], ya[3]); o.z = pack2(yb[0], yb[1]); o.w = pack2(yb[2], yb[3]);
            *(u32x4*)(P.A() + (size_t)row * D + c0) = o;
        }
#pragma unroll
        for (int o = 32; o >= 1; o >>= 1) ss += __shfl_xor(ss, o);
        if (lane == 0) P.parts()[row] = ss;
    }
}

namespace pg8 {
#define PG8_LAS __attribute__((address_space(3)))
typedef unsigned short bf16_t;
typedef short bf16x8 __attribute__((ext_vector_type(8)));
typedef float f32x4 __attribute__((ext_vector_type(4)));
typedef unsigned u32x4 __attribute__((ext_vector_type(4)));
constexpr int BM = 256, BK = 64, HALF = 128, HTB = HALF * BK * 2  , STAGE_BYTES = 8 * HTB, NXCD = 8, WGM = 8;

__host__ __device__ __forceinline__ int lds_byte(int r, int c) { const int st = (r >> 4) * 2 + (c >> 5), rr = r & 15, cc = c & 31, ob = rr * 64 + cc * 2; return st * 1024 + (ob ^ (((ob >> 9) & 1) << 5)); }
__host__ __device__ __forceinline__ void stage_rc(int b, int& R, int& C) { const int st = b / 1024, sb = b % 1024, swz = sb ^ (((sb >> 9) & 1) << 5); R = (st >> 1) * 16 + swz / 64; C = (st & 1) * 32 + (swz % 64) / 2; }
__host__ __device__ __forceinline__ int perm32(int rho) { const int n = rho >> 4, i = rho & 15; return 8 * (i >> 2) + 4 * n + (i & 3); }

struct Unit { int pm, pn; };
struct Gemm { const bf16_t* A; const bf16_t* Bt; int M, N, K; };

struct StaticOrder {
    int nM, nN, nwg, G, c;
    __host__ __device__ void init(int M, int N, int G_, int c_) { nM = M / BM; nN = N / BM; nwg = nM * nN; G = G_; c = c_; }
    __host__ __device__ bool next(int i, Unit& u) const {
        const long L = (long)i * G + c; if (L >= nwg) return false;
        int wgid = (int)L; { const int q = nwg / NXCD, r = nwg % NXCD, xcd = wgid % NXCD, off = wgid / NXCD; wgid = (xcd < r ? xcd * (q + 1) : r * (q + 1) + (xcd - r) * q) + off; }
        const int nig = WGM * nN, gid = wgid / nig, fm = gid * WGM, gsz = (nM - fm) < WGM ? (nM - fm) : WGM;
        u.pm = fm + ((wgid % nig) % gsz); u.pn = (wgid % nig) / gsz; return true;
    }
    __device__ __forceinline__ void a_ready(const Unit&) const {}
    __device__ __forceinline__ void done(const Unit&) const {}
};
template <class Epi, class Sched, bool ALIGN_EPI = false, bool SP2 = false>
__device__ __forceinline__ void gemm_phase(PG8_LAS unsigned char* lds, const Gemm g, const Sched& S, const Epi& E) {
    const int tid = otid(), wid = __builtin_amdgcn_readfirstlane(tid >> 6), lane = tid & 63, wr = wid >> 2, wc = wid & 3, fr = lane & 15, fq = lane >> 4;
    const int K = g.K, nt = K / BK;
    unsigned voffA[2], voffB[2];
#pragma unroll
    for (int i = 0; i < 2; ++i) { int R, C; stage_rc(tid * 16 + i * 8192, R, C); const int Rb = Epi::PERM ? ((R & ~31) + perm32(R & 31)) : R;
        voffA[i] = (unsigned)(R * K + C) * 2u; voffB[i] = (unsigned)(Rb * K + C) * 2u; }
    const size_t kstep = (size_t)(BK * 2);
    const size_t hstep = (size_t)HALF * K * 2;
    const size_t tstep = 2 * hstep;
    const unsigned ldsw = (unsigned)wid * 1024u;
    const int aoff = lds_byte(wr * 64 + fr, fq * 8), boff = lds_byte(wc * 32 + fr, fq * 8);
#define PG8_SA(b, h) (((b) * 2 + (h)) * HTB)
#define PG8_SB(b, h) ((4 + (b) * 2 + (h)) * HTB)
#define PG8_STAGE(bufoff, gbase, voff) do { _Pragma("unroll") for (int _i = 0; _i < 2; ++_i) \
        __builtin_amdgcn_global_load_lds((const unsigned*)((const char*)(gbase) + (voff)[_i]), (PG8_LAS unsigned*)(lds + (bufoff) + ldsw + _i * 8192), 16, 0, 0); } while (0)
#define PG8_LDA(dst, b, h) do { _Pragma("unroll") for (int m = 0; m < 4; ++m) _Pragma("unroll") for (int k = 0; k < 2; ++k) dst[m][k] = *(const PG8_LAS bf16x8*)(lds + PG8_SA(b, h) + aoff + m * 2048 + k * 1024); } while (0)
#define PG8_LDB(dst, b, h) do { _Pragma("unroll") for (int n = 0; n < 2; ++n) _Pragma("unroll") for (int k = 0; k < 2; ++k) dst[n][k] = *(const PG8_LAS bf16x8*)(lds + PG8_SB(b, h) + boff + n * 2048 + k * 1024); } while (0)
#define PG8_MMA(ai, bj, At, Bt) do { __builtin_amdgcn_s_setprio(1); _Pragma("unroll") for (int m = 0; m < 4; ++m) _Pragma("unroll") for (int n = 0; n < 2; ++n) _Pragma("unroll") for (int k = 0; k < 2; ++k) \
        acc[ai][bj][m][n] = __builtin_amdgcn_mfma_f32_16x16x32_bf16(Bt[n][k], At[m][k], acc[ai][bj][m][n], 0, 0, 0); __builtin_amdgcn_s_setprio(0); } while (0)
#define PG8_WAIT_V(n) asm volatile("s_waitcnt vmcnt(" #n ")" ::: "memory")
#define PG8_WAIT_L(n) asm volatile("s_waitcnt lgkmcnt(" #n ")" ::: "memory")
#define PG8_BAR __builtin_amdgcn_s_barrier()
#define PG8_SCHED __builtin_amdgcn_sched_barrier(0)
    Unit cur, nxt; int ui = 0;
    if (!S.next(0, cur)) return;
    f32x4 acc[2][2][4][2];
#pragma unroll
    for (int a = 0; a < 2; ++a)
#pragma unroll
        for (int b = 0; b < 2; ++b)
#pragma unroll
            for (int m = 0; m < 4; ++m)
#pragma unroll
                for (int n = 0; n < 2; ++n) acc[a][b][m][n] = (f32x4){0.f, 0.f, 0.f, 0.f};
    bf16x8 At[4][2], B0[2][2], B1[2][2];
    const char* cA = (const char*)g.A + (size_t)cur.pm * tstep; const char* cB = (const char*)g.Bt + (size_t)cur.pn * tstep;
    S.a_ready(cur);
    if constexpr (SP2) {
        PG8_STAGE(PG8_SB(0, 0), cB, voffB); PG8_STAGE(PG8_SB(0, 1), cB + hstep, voffB); PG8_STAGE(PG8_SA(0, 0), cA, voffA); PG8_STAGE(PG8_SA(0, 1), cA + hstep, voffA);
        if (wr == 1) PG8_BAR;
        PG8_WAIT_V(2); PG8_BAR;
        PG8_STAGE(PG8_SB(1, 0), cB + kstep, voffB); PG8_STAGE(PG8_SA(1, 0), cA + kstep, voffA); PG8_STAGE(PG8_SB(1, 1), cB + hstep + kstep, voffB);
        PG8_WAIT_V(6); PG8_BAR;
    } else {
        PG8_STAGE(PG8_SB(0, 0), cB, voffB); PG8_STAGE(PG8_SA(0, 0), cA, voffA); PG8_STAGE(PG8_SB(0, 1), cB + hstep, voffB); PG8_STAGE(PG8_SA(0, 1), cA + hstep, voffA);
        if (wr == 1) PG8_BAR;
        PG8_WAIT_V(4); PG8_BAR;
        PG8_STAGE(PG8_SB(1, 0), cB + kstep, voffB); PG8_STAGE(PG8_SA(1, 0), cA + kstep, voffA); PG8_STAGE(PG8_SB(1, 1), cB + hstep + kstep, voffB);
        PG8_WAIT_V(6); PG8_BAR;
    }
    for (;;) {
        const bool has_next = S.next(ui + 1, nxt);
        const char* nA = has_next ? (const char*)g.A + (size_t)nxt.pm * tstep : cA; const char* nB = has_next ? (const char*)g.Bt + (size_t)nxt.pn * tstep : cB;
        for (int t = 0; t < nt; t += 2) {
            const bool last = (t == nt - 2);
            const char* a1 = cA + (size_t)(t + 1) * kstep;
            const char* a2 = last ? nA : cA + (size_t)(t + 2) * kstep; const char* b2 = last ? nB : cB + (size_t)(t + 2) * kstep;
            const char* a3 = a2 + kstep; const char* b3 = b2 + kstep;
            if (last && has_next) S.a_ready(nxt);
            if constexpr (SP2) {
            PG8_LDB(B0, 0, 0); PG8_LDB(B1, 0, 1); PG8_SCHED; PG8_LDA(At, 0, 0); PG8_STAGE(PG8_SA(1, 1), a1 + hstep, voffA);
            PG8_WAIT_V(8); PG8_WAIT_L(0); PG8_BAR; PG8_MMA(0, 0, At, B0); PG8_MMA(0, 1, At, B1); PG8_BAR; PG8_SCHED;
            PG8_LDA(At, 0, 1); PG8_STAGE(PG8_SB(0, 0), b2, voffB); PG8_STAGE(PG8_SB(0, 1), b2 + hstep, voffB); PG8_STAGE(PG8_SA(0, 0), a2, voffA);
            PG8_WAIT_V(8); PG8_WAIT_L(0); PG8_BAR; PG8_MMA(1, 0, At, B0); PG8_MMA(1, 1, At, B1); PG8_BAR; PG8_SCHED;
            PG8_LDB(B0, 1, 0); PG8_LDB(B1, 1, 1); PG8_SCHED; PG8_LDA(At, 1, 0); PG8_STAGE(PG8_SA(0, 1), a2 + hstep, voffA);
            PG8_WAIT_V(8); PG8_WAIT_L(0); PG8_BAR; PG8_MMA(0, 0, At, B0); PG8_MMA(0, 1, At, B1); PG8_BAR; PG8_SCHED;
            PG8_LDA(At, 1, 1); PG8_STAGE(PG8_SB(1, 0), b3, voffB); PG8_STAGE(PG8_SB(1, 1), b3 + hstep, voffB); PG8_STAGE(PG8_SA(1, 0), a3, voffA);
            PG8_WAIT_V(8); PG8_WAIT_L(0); PG8_BAR; PG8_MMA(1, 0, At, B0); PG8_MMA(1, 1, At, B1); PG8_BAR; PG8_SCHED;
            } else {
            PG8_LDB(B0, 0, 0); PG8_SCHED; PG8_LDA(At, 0, 0); PG8_STAGE(PG8_SA(1, 1), a1 + hstep, voffA);
            PG8_WAIT_L(8); PG8_BAR; PG8_WAIT_L(0); PG8_MMA(0, 0, At, B0); PG8_BAR; PG8_SCHED;
            PG8_LDB(B1, 0, 1); PG8_STAGE(PG8_SB(0, 0), b2, voffB);
            PG8_BAR; PG8_WAIT_L(0); PG8_MMA(0, 1, At, B1); PG8_BAR;
            PG8_LDA(At, 0, 1); PG8_STAGE(PG8_SA(0, 0), a2, voffA);
            PG8_BAR; PG8_WAIT_L(0); PG8_MMA(1, 0, At, B0); PG8_BAR; PG8_SCHED;
            PG8_STAGE(PG8_SB(0, 1), b2 + hstep, voffB);
            PG8_WAIT_V(6); PG8_BAR; PG8_MMA(1, 1, At, B1); PG8_BAR;
            PG8_LDB(B0, 1, 0); PG8_SCHED; PG8_LDA(At, 1, 0); PG8_STAGE(PG8_SA(0, 1), a2 + hstep, voffA);
            PG8_WAIT_L(8); PG8_BAR; PG8_WAIT_L(0); PG8_MMA(0, 0, At, B0); PG8_BAR; PG8_SCHED;
            PG8_LDB(B1, 1, 1); PG8_STAGE(PG8_SB(1, 0), b3, voffB);
            PG8_BAR; PG8_WAIT_L(0); PG8_MMA(0, 1, At, B1); PG8_BAR;
            PG8_LDA(At, 1, 1); PG8_STAGE(PG8_SA(1, 0), a3, voffA);
            PG8_BAR; PG8_WAIT_L(0); PG8_MMA(1, 0, At, B0); PG8_BAR; PG8_SCHED;
            PG8_STAGE(PG8_SB(1, 1), b3 + hstep, voffB);
            PG8_WAIT_V(6); PG8_BAR; PG8_MMA(1, 1, At, B1); PG8_BAR;
            }
        }
        if constexpr (ALIGN_EPI) { if (wr == 0) PG8_BAR; }
        if constexpr (!Epi::AFTER_DRAIN) { E(acc, cur, wr, wc, fr, fq); S.done(cur); }
        if (!has_next) break;
#pragma unroll
        for (int a = 0; a < 2; ++a)
#pragma unroll
            for (int b = 0; b < 2; ++b)
#pragma unroll
                for (int m = 0; m < 4; ++m)
#pragma unroll
                    for (int n = 0; n < 2; ++n) acc[a][b][m][n] = (f32x4){0.f, 0.f, 0.f, 0.f};
        cur = nxt; cA = nA; cB = nB; ++ui;
        if constexpr (ALIGN_EPI) { if (wr == 1) PG8_BAR; }
    }
    PG8_WAIT_V(0);
    if constexpr (!ALIGN_EPI) { if (wr == 0) PG8_BAR; }
    PG8_BAR;
    if constexpr (Epi::AFTER_DRAIN) { E.fused(acc, cur, wr, wc, fr, fq, lds, wid, lane); S.done(cur); }
#undef PG8_SA
#undef PG8_SB
#undef PG8_STAGE
#undef PG8_LDA
#undef PG8_LDB
#undef PG8_MMA
#undef PG8_WAIT_V
#undef PG8_WAIT_L
#undef PG8_BAR
#undef PG8_SCHED
}
}

struct EpiIn0 {
    unsigned char* ws; int nparts;
    const float *aqn, *akn, *bqn, *bkn;
    static constexpr bool PERM = false, AFTER_DRAIN = false;
    __device__ __forceinline__ void operator()(const f32x4 (&acc)[2][2][4][2], const pg8::Unit& u, int wr, int wc, int fr, int fq) const { (*this)(acc, u.pm, u.pn, wr, wc, fr, fq); }
    __device__ __forceinline__ void operator()(const f32x4 (&acc)[2][2][4][2], int pm, int pn, int wr, int wc, int fr, int fq) const {
        const int g = 4 * pn + wc;
        const float* parts = (const float*)(ws + OFF_PARTS); const float* bias = (const float*)(ws + OFF_BIAS0); const float* rope = (const float*)(ws + OFF_ROPE);
        size_t doff; int ld, col, type; const float* gain = nullptr;
        if (g < 8) { doff = OFF_QA; ld = 512; col = g * 64; type = 2; gain = aqn; }
        else if (g < 10) { doff = OFF_KA; ld = 128; col = (g - 8) * 64; type = 3; gain = akn; }
        else if (g < 12) { doff = OFF_VA; ld = 128; col = (g - 10) * 64; type = 0; }
        else if (g < 20) { doff = OFF_GA; ld = 512; col = (g - 12) * 64; type = 1; }
        else if (g < 28) { doff = OFF_QB; ld = 512; col = (g - 20) * 64; type = 2; gain = bqn; }
        else if (g < 36) { doff = OFF_KB; ld = 512; col = (g - 28) * 64; type = 3; gain = bkn; }
        else if (g < 44) { doff = OFF_VB; ld = 512; col = (g - 36) * 64; type = 0; }
        else { doff = OFF_GB; ld = 512; col = (g - 44) * 64; type = 1; }
        bf16_t* dst = (bf16_t*)(ws + doff);
#pragma unroll
        for (int ai = 0; ai < 2; ++ai)
#pragma unroll
            for (int m = 0; m < 4; ++m) {
                const int row = pm * 256 + ai * 128 + wr * 64 + m * 16 + fr;
                float ss = 0.f;
                for (int i = 0; i < nparts; ++i) ss += parts[(size_t)i * M + row];
                const float rstd = rsqrtf(ss * (1.0f / 1024.0f) + EPS);
                const int r = row < ML ? row >> 11 : 32;
                const float* bptr = bias + (size_t)r * 3328 + pn * 256 + wc * 32 + fq * 4;
                f32x4 v[2][2];
#pragma unroll
                for (int bj = 0; bj < 2; ++bj)
#pragma unroll
                    for (int n = 0; n < 2; ++n) v[bj][n] = acc[ai][bj][m][n] * rstd + *(const f32x4*)(bptr + bj * 128 + n * 16);
                if (type >= 2) {
                    float s2 = 0.f;
#pragma unroll
                    for (int bj = 0; bj < 2; ++bj)
#pragma unroll
                        for (int n = 0; n < 2; ++n) s2 += v[bj][n][0] * v[bj][n][0] + v[bj][n][1] * v[bj][n][1] + v[bj][n][2] * v[bj][n][2] + v[bj][n][3] * v[bj][n][3];
                    s2 += __shfl_xor(s2, 16); s2 += __shfl_xor(s2, 32);
                    const float rn = rsqrtf(s2 * (1.0f / 64.0f) + EPS);
#pragma unroll
                    for (int bj = 0; bj < 2; ++bj)
#pragma unroll
                        for (int n = 0; n < 2; ++n) v[bj][n] = v[bj][n] * rn * *(const f32x4*)(gain + bj * 32 + n * 16 + fq * 4);
                    if (row < ML) {
                        const int t = row & 2047;
#pragma unroll
                        for (int bj = 0; bj < 2; ++bj) {
                            const int pos = bj == 0 ? (t >> 6) : (t & 63);
                            const float* cs = rope + (pos * 16 + fq * 4) * 2;
                            const f32x4 c01 = *(const f32x4*)cs, c23 = *(const f32x4*)(cs + 4);
                            const float cc[4] = {c01[0], c01[2], c23[0], c23[2]}, sn[4] = {c01[1], c01[3], c23[1], c23[3]};
#pragma unroll
                            for (int e = 0; e < 4; ++e) { const float x1 = v[bj][0][e], x2 = v[bj][1][e]; v[bj][0][e] = x1 * cc[e] - x2 * sn[e]; v[bj][1][e] = x2 * cc[e] + x1 * sn[e]; }
                        }
                    }
                    if (type == 2) {
#pragma unroll
                        for (int bj = 0; bj < 2; ++bj)
#pragma unroll
                            for (int n = 0; n < 2; ++n) v[bj][n] = v[bj][n] * QSCALE;
                    }
                } else if (type == 1) {
#pragma unroll
                    for (int bj = 0; bj < 2; ++bj)
#pragma unroll
                        for (int n = 0; n < 2; ++n)
#pragma unroll
                            for (int e = 0; e < 4; ++e) v[bj][n][e] = siluf(v[bj][n][e]);
                }
#pragma unroll
                for (int bj = 0; bj < 2; ++bj) {
                    u32x4 o; o.x = pack2(v[bj][0][0], v[bj][0][1]); o.y = pack2(v[bj][0][2], v[bj][0][3]); o.z = pack2(v[bj][1][0], v[bj][1][1]); o.w = pack2(v[bj][1][2], v[bj][1][3]);
                    *(u32x4*)(dst + (size_t)row * ld + col + bj * 32 + fq * 8) = o;
                }
            }
    }
};

struct EpiIn1 {
    unsigned char* ws; int nparts;
    static constexpr bool PERM = false, AFTER_DRAIN = false;
    __device__ __forceinline__ void operator()(const f32x4 (&acc)[2][2][4][2], const pg8::Unit& u, int wr, int wc, int fr, int fq) const { (*this)(acc, u.pm, u.pn, wr, wc, fr, fq); }
    __device__ __forceinline__ void operator()(const f32x4 (&acc)[2][2][4][2], int pm, int pn, int wr, int wc, int fr, int fq) const {
        const int g = 4 * pn + wc;
        if (g > 48) return;
        const float* parts = (const float*)(ws + OFF_PARTS); const float* bias = (const float*)(ws + OFF_BIAS1); float* RF = (float*)(ws + OFF_RF);
        size_t doff = OFF_QG; int ld = 0, col = 0, type;
        if (g < 8) { doff = OFF_QG; ld = 512; col = g * 64; type = 2; }
        else if (g < 16) { doff = OFF_KG; ld = 512; col = (g - 8) * 64; type = 0; }
        else if (g < 32) { doff = OFF_VG; ld = 1024; col = (g - 16) * 64; type = 0; }
        else if (g < 48) { doff = OFF_GG; ld = 1024; col = (g - 32) * 64; type = 1; }
        else type = 3;
        bf16_t* dst = (bf16_t*)(ws + doff);
#pragma unroll
        for (int ai = 0; ai < 2; ++ai)
#pragma unroll
            for (int m = 0; m < 4; ++m) {
                const int row = pm * 256 + ai * 128 + wr * 64 + m * 16 + fr;
                float ss = 0.f;
                for (int i = 0; i < nparts; ++i) ss += parts[(size_t)i * M + row];
                const float rstd = rsqrtf(ss * (1.0f / 1024.0f) + EPS);
                const int r = row < ML ? row >> 11 : 32;
                const float* bptr = bias + (size_t)r * 3328 + pn * 256 + wc * 32 + fq * 4;
                f32x4 v[2][2];
#pragma unroll
                for (int bj = 0; bj < 2; ++bj)
#pragma unroll
                    for (int n = 0; n < 2; ++n) v[bj][n] = acc[ai][bj][m][n] * rstd + *(const f32x4*)(bptr + bj * 128 + n * 16);
                if (type == 3) {
                    *(f32x4*)(RF + (size_t)row * 32 + fq * 8) = v[0][0];
                    *(f32x4*)(RF + (size_t)row * 32 + fq * 8 + 4) = v[0][1];
                    continue;
                }
                if (type == 2) {
#pragma unroll
                    for (int bj = 0; bj < 2; ++bj)
#pragma unroll
                        for (int n = 0; n < 2; ++n) v[bj][n] = v[bj][n] * 0.08838834764831845f;
                } else if (type == 1) {
#pragma unroll
                    for (int bj = 0; bj < 2; ++bj)
#pragma unroll
                        for (int n = 0; n < 2; ++n)
#pragma unroll
                            for (int e = 0; e < 4; ++e) v[bj][n][e] = siluf(v[bj][n][e]);
                }
#pragma unroll
                for (int bj = 0; bj < 2; ++bj) {
                    u32x4 o; o.x = pack2(v[bj][0][0], v[bj][0][1]); o.y = pack2(v[bj][0][2], v[bj][0][3]); o.z = pack2(v[bj][1][0], v[bj][1][1]); o.w = pack2(v[bj][1][2], v[bj][1][3]);
                    *(u32x4*)(dst + (size_t)row * ld + col + bj * 32 + fq * 8) = o;
                }
            }
    }
};

struct EpiOut0 {
    const float *x, *ctx, *g1; float* out; unsigned char* ws;
    static constexpr bool PERM = false, AFTER_DRAIN = false;
    __device__ __forceinline__ void operator()(const f32x4 (&acc)[2][2][4][2], const pg8::Unit& u, int wr, int wc, int fr, int fq) const { (*this)(acc, u.pm, u.pn, wr, wc, fr, fq); }
    __device__ __forceinline__ void operator()(const f32x4 (&acc)[2][2][4][2], int pm, int pn, int wr, int wc, int fr, int fq) const {
        const float* mod = (const float*)(ws + OFF_MOD); bf16_t* A1 = (bf16_t*)(ws + OFF_A); float* parts = (float*)(ws + OFF_PARTS);
#pragma unroll
        for (int ai = 0; ai < 2; ++ai)
#pragma unroll
            for (int m = 0; m < 4; ++m) {
                const int row = pm * 256 + ai * 128 + wr * 64 + m * 16 + fr;
                const int r = row < ML ? row >> 11 : 32;
                const float* xin = row < ML ? x + (size_t)row * D : ctx + (size_t)(row - ML) * D;
                const float* gt = mod + (size_t)r * 3072 + 2048;
                const float* sc = mod + (size_t)(33 + r) * 3072 + 1024;
                float ss = 0.f;
#pragma unroll
                for (int bj = 0; bj < 2; ++bj) {
                    const int c = pn * 256 + wc * 64 + bj * 32 + fq * 8;
                    f32x4 y[2];
#pragma unroll
                    for (int n = 0; n < 2; ++n) {
                        const f32x4 x1 = *(const f32x4*)(xin + c + n * 4) + *(const f32x4*)(gt + c + n * 4) * acc[ai][bj][m][n];
                        ss += x1[0] * x1[0] + x1[1] * x1[1] + x1[2] * x1[2] + x1[3] * x1[3];
                        if (row < ML) *(f32x4*)(out + (size_t)row * D + c + n * 4) = x1;
                        y[n] = x1 * *(const f32x4*)(g1 + c + n * 4) * (1.0f + *(const f32x4*)(sc + c + n * 4));
                    }
                    u32x4 o; o.x = pack2(y[0][0], y[0][1]); o.y = pack2(y[0][2], y[0][3]); o.z = pack2(y[1][0], y[1][1]); o.w = pack2(y[1][2], y[1][3]);
                    *(u32x4*)(A1 + (size_t)row * D + c) = o;
                }
                ss += __shfl_xor(ss, 16); ss += __shfl_xor(ss, 32);
                if (fq == 0) parts[(size_t)(4 * pn + wc) * M + row] = ss;
            }
    }
};

struct EpiOut1 {
    unsigned char* ws; float* out;
    static constexpr bool PERM = false, AFTER_DRAIN = false;
    __device__ __forceinline__ void operator()(const f32x4 (&acc)[2][2][4][2], const pg8::Unit& u, int wr, int wc, int fr, int fq) const { (*this)(acc, u.pm, u.pn, wr, wc, fr, fq); }
    __device__ __forceinline__ void operator()(const f32x4 (&acc)[2][2][4][2], int pm, int pn, int wr, int wc, int fr, int fq) const {
#pragma unroll
        for (int ai = 0; ai < 2; ++ai)
#pragma unroll
            for (int m = 0; m < 4; ++m) {
                const int row = pm * 256 + ai * 128 + wr * 64 + m * 16 + fr;
                const int r = row >> 11;
                const float* gt = (const float*)(ws + OFF_MOD) + (size_t)(33 + r) * 3072 + 2048;
#pragma unroll
                for (int bj = 0; bj < 2; ++bj)
#pragma unroll
                    for (int n = 0; n < 2; ++n) {
                        const int c = pn * 256 + wc * 64 + bj * 32 + fq * 8 + n * 4;
                        float* o = out + (size_t)row * D + c;
                        *(f32x4*)o = *(const f32x4*)o + *(const f32x4*)(gt + c) * acc[ai][bj][m][n];
                    }
            }
    }
};

template <class Epi>
__device__ void gemm_simple(const bf16_t* __restrict__ A, const bf16_t* __restrict__ Bt, int nM, int nN, const Epi& E, unsigned char* lds, int vb, int nvb) {
    const int tid = threadIdx.x, wid = tid >> 6, lane = tid & 63, wr = wid >> 2, wc = wid & 3, fr = lane & 15, fq = lane >> 4;
    unsigned char* ldsA = lds; unsigned char* ldsB = lds + 256 * 80;
    for (int tile = vb; tile < nM * nN; tile += nvb) {
        const int pm = tile / nN, pn = tile % nN;
        f32x4 acc[2][2][4][2];
#pragma unroll
        for (int a = 0; a < 2; ++a)
#pragma unroll
            for (int b = 0; b < 2; ++b)
#pragma unroll
                for (int m = 0; m < 4; ++m)
#pragma unroll
                    for (int n = 0; n < 2; ++n) acc[a][b][m][n] = (f32x4){0.f, 0.f, 0.f, 0.f};
        for (int k0 = 0; k0 < D; k0 += 32) {
            __syncthreads();
#pragma unroll
            for (int i = 0; i < 2; ++i) {
                const int cidx = tid + 512 * i, r = cidx >> 2, kc = cidx & 3;
                *(u32x4*)(ldsA + r * 80 + kc * 16) = *(const u32x4*)(A + (size_t)(pm * 256 + r) * D + k0 + kc * 8);
                *(u32x4*)(ldsB + r * 80 + kc * 16) = *(const u32x4*)(Bt + (size_t)(pn * 256 + r) * D + k0 + kc * 8);
            }
            __syncthreads();
            bf16x8 af[2][4], bfr[2][2];
#pragma unroll
            for (int ai = 0; ai < 2; ++ai)
#pragma unroll
                for (int m = 0; m < 4; ++m) af[ai][m] = *(const bf16x8*)(ldsA + (ai * 128 + wr * 64 + m * 16 + fr) * 80 + fq * 16);
#pragma unroll
            for (int bj = 0; bj < 2; ++bj)
#pragma unroll
                for (int n = 0; n < 2; ++n) bfr[bj][n] = *(const bf16x8*)(ldsB + (bj * 128 + wc * 32 + n * 16 + fr) * 80 + fq * 16);
#pragma unroll
            for (int ai = 0; ai < 2; ++ai)
#pragma unroll
                for (int bj = 0; bj < 2; ++bj)
#pragma unroll
                    for (int m = 0; m < 4; ++m)
#pragma unroll
                        for (int n = 0; n < 2; ++n) acc[ai][bj][m][n] = __builtin_amdgcn_mfma_f32_16x16x32_bf16(bfr[bj][n], af[ai][m], acc[ai][bj][m][n], 0, 0, 0);
        }
        E(acc, pm, pn, wr, wc, fr, fq);
    }
}

__device__ __forceinline__ float maxabs64(const float* g) { float m = 0.f; for (int i = 0; i < 64; ++i) m = fmaxf(m, fabsf(g[i])); return m; }

__device__ __forceinline__ void phase_attnA(const Params& P, int vb, int nvb) {
    const float MA = 8.0f * maxabs64(P.a_q_norm) * maxabs64(P.a_k_norm) * LOG2E;
    for (long idx = (long)vb * blockDim.x + threadIdx.x; idx < (long)M * 8; idx += (long)nvb * blockDim.x) {
        const int h = (int)(idx / M), m = (int)(idx % M), kv = h >> 2;
        float q[64], o[64];
        {
            const u32x4* qp = (const u32x4*)(P.QA() + (size_t)m * 512 + h * 64);
#pragma unroll
            for (int i = 0; i < 8; ++i) { const u32x4 w = qp[i]; q[8 * i] = bflo(w.x); q[8 * i + 1] = bfhi(w.x); q[8 * i + 2] = bflo(w.y); q[8 * i + 3] = bfhi(w.y); q[8 * i + 4] = bflo(w.z); q[8 * i + 5] = bfhi(w.z); q[8 * i + 6] = bflo(w.w); q[8 * i + 7] = bfhi(w.w); }
        }
#pragma unroll
        for (int i = 0; i < 64; ++i) o[i] = 0.f;
        float l = 0.f;
        int b, nlat = 0, j0 = 0;
        if (m < ML) { b = m >> 11; const int t = m & 2047; j0 = t - 128 < 0 ? 0 : t - 128; const int j1 = t + 128 > 2047 ? 2047 : t + 128; nlat = j1 - j0 + 1; }
        else b = (m - ML) >> 8;
        const int ntot = nlat + 256;
        for (int jj = 0; jj < ntot; ++jj) {
            const int kr = jj < nlat ? b * 2048 + j0 + jj : ML + b * 256 + (jj - nlat);
            const u32x4* kp = (const u32x4*)(P.KA() + (size_t)kr * 128 + kv * 64);
            float s = 0.f;
#pragma unroll
            for (int i = 0; i < 8; ++i) { const u32x4 w = kp[i]; s += q[8 * i] * bflo(w.x) + q[8 * i + 1] * bfhi(w.x) + q[8 * i + 2] * bflo(w.y) + q[8 * i + 3] * bfhi(w.y) + q[8 * i + 4] * bflo(w.z) + q[8 * i + 5] * bfhi(w.z) + q[8 * i + 6] * bflo(w.w) + q[8 * i + 7] * bfhi(w.w); }
            const float p = exp2f(s - MA);
            l += p;
            const u32x4* vp = (const u32x4*)(P.VA() + (size_t)kr * 128 + kv * 64);
#pragma unroll
            for (int i = 0; i < 8; ++i) { const u32x4 w = vp[i]; o[8 * i] += p * bflo(w.x); o[8 * i + 1] += p * bfhi(w.x); o[8 * i + 2] += p * bflo(w.y); o[8 * i + 3] += p * bfhi(w.y); o[8 * i + 4] += p * bflo(w.z); o[8 * i + 5] += p * bfhi(w.z); o[8 * i + 6] += p * bflo(w.w); o[8 * i + 7] += p * bfhi(w.w); }
        }
        l += exp2f(P.a_sink[h] * LOG2E - MA);
        const float inv = 1.0f / l;
        const u32x4* gp = (const u32x4*)(P.GA() + (size_t)m * 512 + h * 64);
        u32x4* op = (u32x4*)(P.O() + (size_t)m * 1024 + h * 64);
#pragma unroll
        for (int i = 0; i < 8; ++i) {
            const u32x4 w = gp[i]; u32x4 r;
            r.x = pack2(o[8 * i] * inv * bflo(w.x), o[8 * i + 1] * inv * bfhi(w.x)); r.y = pack2(o[8 * i + 2] * inv * bflo(w.y), o[8 * i + 3] * inv * bfhi(w.y));
            r.z = pack2(o[8 * i + 4] * inv * bflo(w.z), o[8 * i + 5] * inv * bfhi(w.z)); r.w = pack2(o[8 * i + 6] * inv * bflo(w.w), o[8 * i + 7] * inv * bfhi(w.w));
            op[i] = r;
        }
    }
}

__device__ __forceinline__ void phase_attnB(const Params& P, int vb, int nvb) {
    const float MB = 8.0f * maxabs64(P.b_q_norm) * maxabs64(P.b_k_norm) * LOG2E;
    float d1 = 0.f, d2 = 0.f;
    for (int i = 0; i < 64; ++i) { d1 += P.lq1[i] * P.lk1[i]; d2 += P.lq2[i] * P.lk2[i]; }
    const float lam = expf(d1) - expf(d2) + LAMBDA_INIT;
    for (long idx = (long)vb * blockDim.x + threadIdx.x; idx < (long)M * 16; idx += (long)nvb * blockDim.x) {
        const int qt = (int)(idx & 3); const long hm = idx >> 2; const int h = (int)(hm / M), m = (int)(hm % M);
        int b, nlat;
        if (m < ML) { b = m >> 11; nlat = 2048; } else { b = (m - ML) >> 8; nlat = 0; }
        const int ntot = nlat + 256;
        float rres[32];
        for (int s = 0; s < 2; ++s) {
            const int g = 2 * h + s;
            float q[64], o[32];
            const u32x4* qp = (const u32x4*)(P.QB() + (size_t)m * 512 + g * 64);
#pragma unroll
            for (int i = 0; i < 8; ++i) { const u32x4 w = qp[i]; q[8 * i] = bflo(w.x); q[8 * i + 1] = bfhi(w.x); q[8 * i + 2] = bflo(w.y); q[8 * i + 3] = bfhi(w.y); q[8 * i + 4] = bflo(w.z); q[8 * i + 5] = bfhi(w.z); q[8 * i + 6] = bflo(w.w); q[8 * i + 7] = bfhi(w.w); }
#pragma unroll
            for (int i = 0; i < 32; ++i) o[i] = 0.f;
            float l = 0.f;
            for (int jj = 0; jj < ntot; ++jj) {
                const int kr = jj < nlat ? b * 2048 + jj : ML + b * 256 + (jj - nlat);
                const u32x4* kp = (const u32x4*)(P.KB() + (size_t)kr * 512 + g * 64);
                float sc = 0.f;
#pragma unroll
                for (int i = 0; i < 8; ++i) { const u32x4 w = kp[i]; sc += q[8 * i] * bflo(w.x) + q[8 * i + 1] * bfhi(w.x) + q[8 * i + 2] * bflo(w.y) + q[8 * i + 3] * bfhi(w.y) + q[8 * i + 4] * bflo(w.z) + q[8 * i + 5] * bfhi(w.z) + q[8 * i + 6] * bflo(w.w) + q[8 * i + 7] * bfhi(w.w); }
                const float p = exp2f(sc - MB);
                l += p;
                const u32x4* vp = (const u32x4*)(P.VB() + (size_t)kr * 512 + h * 128 + qt * 32);
#pragma unroll
                for (int i = 0; i < 4; ++i) { const u32x4 w = vp[i]; o[8 * i] += p * bflo(w.x); o[8 * i + 1] += p * bfhi(w.x); o[8 * i + 2] += p * bflo(w.y); o[8 * i + 3] += p * bfhi(w.y); o[8 * i + 4] += p * bflo(w.z); o[8 * i + 5] += p * bfhi(w.z); o[8 * i + 6] += p * bflo(w.w); o[8 * i + 7] += p * bfhi(w.w); }
            }
            const float inv = 1.0f / l;
            if (s == 0) {
#pragma unroll
                for (int i = 0; i < 32; ++i) rres[i] = o[i] * inv;
            } else {
#pragma unroll
                for (int i = 0; i < 32; ++i) rres[i] -= lam * o[i] * inv;
            }
        }
        float ss = 0.f;
#pragma unroll
        for (int i = 0; i < 32; ++i) ss += rres[i] * rres[i];
        ss += __shfl_xor(ss, 1); ss += __shfl_xor(ss, 2);
        const float rn = rsqrtf(ss * (1.0f / 128.0f) + EPS) * (1.0f - LAMBDA_INIT);
        const u32x4* gp = (const u32x4*)(P.GB() + (size_t)m * 512 + h * 128 + qt * 32);
        const float* sl = P.b_subln + qt * 32;
        u32x4* op = (u32x4*)(P.O() + (size_t)m * 1024 + 512 + h * 128 + qt * 32);
#pragma unroll
        for (int i = 0; i < 4; ++i) {
            const u32x4 w = gp[i]; u32x4 r;
            r.x = pack2(rres[8 * i] * rn * sl[8 * i] * bflo(w.x), rres[8 * i + 1] * rn * sl[8 * i + 1] * bfhi(w.x));
            r.y = pack2(rres[8 * i + 2] * rn * sl[8 * i + 2] * bflo(w.y), rres[8 * i + 3] * rn * sl[8 * i + 3] * bfhi(w.y));
            r.z = pack2(rres[8 * i + 4] * rn * sl[8 * i + 4] * bflo(w.z), rres[8 * i + 5] * rn * sl[8 * i + 5] * bfhi(w.z));
            r.w = pack2(rres[8 * i + 6] * rn * sl[8 * i + 6] * bflo(w.w), rres[8 * i + 7] * rn * sl[8 * i + 7] * bfhi(w.w));
            op[i] = r;
        }
    }
}

typedef float f32x16 __attribute__((ext_vector_type(16)));
typedef short s16x4 __attribute__((ext_vector_type(4)));
typedef float f32x2_t __attribute__((ext_vector_type(2)));
typedef __bf16 bf16x2_t __attribute__((ext_vector_type(2)));
#define LDSAS __attribute__((address_space(3)))
__device__ __forceinline__ unsigned cvtpk(float lo, float hi) { f32x2_t v = {lo, hi}; bf16x2_t b = __builtin_convertvector(v, bf16x2_t); return __builtin_bit_cast(unsigned, b); }
__device__ __forceinline__ int crow(int r, int hi) { return (r & 3) + 8 * (r >> 2) + 4 * hi; }
__device__ __forceinline__ s16x4 vtr(const LDSAS unsigned char* p) { return __builtin_bit_cast(s16x4, __builtin_amdgcn_ds_read_tr16_b64_v4i16((LDSAS s16x4*)p)); }

constexpr int AB_K1 = 0, AB_K2 = 16384, AB_V = 32768;
constexpr int AB_XCH = 0, AB_SCR = 67584, AB_LDS = 67584 + 8 * 256;

__device__ __forceinline__ void attnB_unit(const Params& P, LDSAS unsigned char* lds, int b, int h, int qrow0, int t_begin, int t_end) {
    const int tid = otid(), lane = tid & 63, r32 = lane & 31, hi = lane >> 5;
    const int wid = __builtin_amdgcn_readfirstlane(tid >> 6);
    const int s = wid >> 2, qt = wid & 3;
    const int qrow = qrow0 + qt * 32 + r32;
    bf16x8 qf[4];
#pragma unroll
    for (int d0 = 0; d0 < 4; ++d0) qf[d0] = *(const bf16x8*)(P.QB() + (size_t)qrow * 512 + (2 * h + s) * 64 + d0 * 16 + hi * 8);
    f32x16 o[4];
#pragma unroll
    for (int i = 0; i < 4; ++i) o[i] = (f32x16){};
    float l = 0.f;
    const int krow = tid >> 3, kch = tid & 7, vrow = tid >> 4, vch = tid & 15;
    const int kwoff = krow * 128 + ((kch ^ ((krow >> 1) & 7)) * 16);
    const int vwoff = (vch >> 2) * 4096 + vrow * 64 + (vch & 3) * 16;
    u32x4 rk1, rk2, rv0, rv1;
#define AB_GLOAD(t) do { const int kr0_ = (t) < 32 ? b * 2048 + 64 * (t) : ML + b * 256 + 64 * ((t) - 32); \
        rk1 = *(const u32x4*)(P.KB() + (size_t)(kr0_ + krow) * 512 + (2 * h) * 64 + kch * 8); \
        rk2 = *(const u32x4*)(P.KB() + (size_t)(kr0_ + krow) * 512 + (2 * h + 1) * 64 + kch * 8); \
        rv0 = *(const u32x4*)(P.VB() + (size_t)(kr0_ + vrow) * 512 + h * 128 + vch * 8); \
        rv1 = *(const u32x4*)(P.VB() + (size_t)(kr0_ + vrow + 32) * 512 + h * 128 + vch * 8); } while (0)
#define AB_LWRITE(buf) do { *(LDSAS u32x4*)(lds + AB_K1 + (buf) * 8192 + kwoff) = rk1; *(LDSAS u32x4*)(lds + AB_K2 + (buf) * 8192 + kwoff) = rk2; \
        *(LDSAS u32x4*)(lds + AB_V + (buf) * 16384 + vwoff) = rv0; *(LDSAS u32x4*)(lds + AB_V + (buf) * 16384 + vwoff + 2048) = rv1; } while (0)
    const int kroff = (s ? AB_K2 : AB_K1) + r32 * 128, ksw = (r32 >> 1) & 7;
    const int vroff = AB_V + (4 * hi + ((lane & 15) >> 2)) * 64 + ((lane >> 4) & 1) * 32 + (lane & 3) * 8;
    AB_GLOAD(t_begin); AB_LWRITE(0); __syncthreads();
    for (int t = t_begin; t < t_end; ++t) {
        const int buf = (t - t_begin) & 1;
        const LDSAS unsigned char* kb = lds + buf * 8192 + kroff;
        f32x16 p0 = (f32x16){}, p1 = (f32x16){};
#pragma unroll
        for (int d0 = 0; d0 < 4; ++d0) {
            const int co = ((2 * d0 + hi) ^ ksw) * 16;
            const bf16x8 k0 = *(const LDSAS bf16x8*)(kb + co), k1 = *(const LDSAS bf16x8*)(kb + 4096 + co);
            p0 = __builtin_amdgcn_mfma_f32_32x32x16_bf16(k0, qf[d0], p0, 0, 0, 0);
            p1 = __builtin_amdgcn_mfma_f32_32x32x16_bf16(k1, qf[d0], p1, 0, 0, 0);
        }
        float ls = 0.f;
#pragma unroll
        for (int r = 0; r < 16; ++r) { p0[r] = __builtin_amdgcn_exp2f(p0[r]); p1[r] = __builtin_amdgcn_exp2f(p1[r]); ls += p0[r] + p1[r]; }
        l += ls;
        u32x4 pw[4];
        pw[0].x = cvtpk(p0[0], p0[1]); pw[0].y = cvtpk(p0[2], p0[3]); pw[0].z = cvtpk(p0[4], p0[5]); pw[0].w = cvtpk(p0[6], p0[7]);
        pw[1].x = cvtpk(p0[8], p0[9]); pw[1].y = cvtpk(p0[10], p0[11]); pw[1].z = cvtpk(p0[12], p0[13]); pw[1].w = cvtpk(p0[14], p0[15]);
        pw[2].x = cvtpk(p1[0], p1[1]); pw[2].y = cvtpk(p1[2], p1[3]); pw[2].z = cvtpk(p1[4], p1[5]); pw[2].w = cvtpk(p1[6], p1[7]);
        pw[3].x = cvtpk(p1[8], p1[9]); pw[3].y = cvtpk(p1[10], p1[11]); pw[3].z = cvtpk(p1[12], p1[13]); pw[3].w = cvtpk(p1[14], p1[15]);
        if (t + 1 < t_end) AB_GLOAD(t + 1);
        const LDSAS unsigned char* vb = lds + buf * 16384 + vroff;
#pragma unroll
        for (int d0 = 0; d0 < 4; ++d0)
#pragma unroll
            for (int ks = 0; ks < 4; ++ks) {
                const s16x4 lo = vtr(vb + d0 * 4096 + ks * 1024), hh = vtr(vb + d0 * 4096 + ks * 1024 + 512);
                const bf16x8 vf = (bf16x8){lo[0], lo[1], lo[2], lo[3], hh[0], hh[1], hh[2], hh[3]};
                o[d0] = __builtin_amdgcn_mfma_f32_32x32x16_bf16(__builtin_bit_cast(bf16x8, pw[ks]), vf, o[d0], 0, 0, 0);
                if (ks == 3) __builtin_amdgcn_sched_barrier(0);
            }
        if (t + 1 < t_end) AB_LWRITE(buf ^ 1);
        __syncthreads();
    }
#undef AB_GLOAD
#undef AB_LWRITE
    l += __shfl_xor(l, 32);
    LDSAS float* scr = (LDSAS float*)(lds + AB_SCR + wid * 256);
    LDSAS float* xch = (LDSAS float*)(lds + AB_XCH + qt * 16896);
    if (hi == 0) scr[r32] = (s ? P.scal()[0] : 1.0f) / l;
    float rl[16];
#pragma unroll
    for (int r = 0; r < 16; ++r) rl[r] = scr[crow(r, hi)];
    if (s == 1) {
#pragma unroll
        for (int d0 = 0; d0 < 4; ++d0)
#pragma unroll
            for (int r = 0; r < 16; ++r) xch[crow(r, hi) * 132 + d0 * 32 + r32] = o[d0][r] * rl[r];
    }
    __syncthreads();
    if (s == 0) {
        float ss[16];
#pragma unroll
        for (int r = 0; r < 16; ++r) {
            float s2 = 0.f;
#pragma unroll
            for (int d0 = 0; d0 < 4; ++d0) { const float v = o[d0][r] * rl[r] - xch[crow(r, hi) * 132 + d0 * 32 + r32]; o[d0][r] = v; s2 += v * v; }
            ss[r] = s2;
        }
#pragma unroll
        for (int r = 0; r < 16; ++r) {
            float s2 = ss[r];
            s2 += __shfl_xor(s2, 1); s2 += __shfl_xor(s2, 2); s2 += __shfl_xor(s2, 4); s2 += __shfl_xor(s2, 8); s2 += __shfl_xor(s2, 16);
            ss[r] = rsqrtf(s2 * (1.0f / 128.0f) + EPS) * (1.0f - LAMBDA_INIT);
        }
#pragma unroll
        for (int d0 = 0; d0 < 4; ++d0) {
            const float sl = P.b_subln[d0 * 32 + r32];
#pragma unroll
            for (int r = 0; r < 16; ++r) xch[crow(r, hi) * 132 + d0 * 32 + r32] = o[d0][r] * ss[r] * sl;
        }
        const int eq = lane >> 1, eseg = lane & 1;
        const size_t grow = (size_t)(qrow0 + qt * 32 + eq);
        const u32x4* gp = (const u32x4*)(P.GB() + grow * 512 + h * 128 + eseg * 64);
        u32x4* op = (u32x4*)(P.O() + grow * 1024 + 512 + h * 128 + eseg * 64);
#pragma unroll
        for (int i = 0; i < 8; ++i) {
            const f32x4 a = *(const LDSAS f32x4*)(xch + eq * 132 + eseg * 64 + i * 8), c = *(const LDSAS f32x4*)(xch + eq * 132 + eseg * 64 + i * 8 + 4);
            const u32x4 g = gp[i]; u32x4 ov;
            ov.x = cvtpk(a[0] * bflo(g.x), a[1] * bfhi(g.x)); ov.y = cvtpk(a[2] * bflo(g.y), a[3] * bfhi(g.y));
            ov.z = cvtpk(c[0] * bflo(g.z), c[1] * bfhi(g.z)); ov.w = cvtpk(c[2] * bflo(g.w), c[3] * bfhi(g.w));
            op[i] = ov;
        }
    }
    __syncthreads();
}

__device__ __forceinline__ void phase_attnB_mfma(const Params& P, LDSAS unsigned char* lds, int vb, int nvb) {
    for (int u = vb; u < 2048 + 256; u += nvb) {
        int pair, qrow0, t0;
        if (u < 2048) {
            int qblk;
            if (nvb == 256) { const int round = u >> 8, i = u & 255, xcd = i & 7, slot = i >> 3; pair = round * 16 + xcd * 2 + (slot >> 4); qblk = slot & 15; }
            else { pair = u >> 4; qblk = u & 15; }
            qrow0 = (pair >> 2) * 2048 + qblk * 128; t0 = 0;
        } else {
            const int v = u - 2048; pair = v >> 1;
            qrow0 = ML + (pair >> 2) * 256 + (v & 1) * 128; t0 = 32;
        }
        attnB_unit(P, lds, pair >> 2, pair & 3, qrow0, t0, 36);
    }
}

constexpr int AA_K = 0, AA_V = 16384;
__device__ __forceinline__ void attnA_unit(const Params& P, LDSAS unsigned char* lds, int b, int kvh, int qrow0, int qpos0, int kt0, int nwin) {
    const int tid = otid(), lane = tid & 63, r32 = lane & 31, hi = lane >> 5;
    const int wid = __builtin_amdgcn_readfirstlane(tid >> 6);
    const int head = kvh * 4 + (wid >> 1), qoff = (wid & 1) * 64;
    bf16x8 qf[2][4];
#pragma unroll
    for (int qq = 0; qq < 2; ++qq)
#pragma unroll
        for (int d0 = 0; d0 < 4; ++d0) qf[qq][d0] = *(const bf16x8*)(P.QA() + (size_t)(qrow0 + qoff + qq * 32 + r32) * 512 + head * 64 + d0 * 16 + hi * 8);
    f32x16 o[2][2];
#pragma unroll
    for (int i = 0; i < 2; ++i) { o[i][0] = (f32x16){}; o[i][1] = (f32x16){}; }
    float l[2] = {0.f, 0.f};
    const int krow = tid >> 3, kch = tid & 7;
    const int kwoff = krow * 128 + ((kch ^ ((krow >> 1) & 7)) * 16);
    const int vwoff = (kch >> 2) * 4096 + krow * 64 + (kch & 3) * 16;
    u32x4 rk, rv;
    const int nt = nwin + 4;
#define AA_KR0(i) ((i) < nwin ? b * 2048 + 64 * (kt0 + (i)) : ML + b * 256 + 64 * ((i) - nwin))
#define AA_GLOAD(i) do { const int kr0_ = AA_KR0(i); rk = *(const u32x4*)(P.KA() + (size_t)(kr0_ + krow) * 128 + kvh * 64 + kch * 8); rv = *(const u32x4*)(P.VA() + (size_t)(kr0_ + krow) * 128 + kvh * 64 + kch * 8); } while (0)
#define AA_LWRITE(buf) do { *(LDSAS u32x4*)(lds + AA_K + (buf) * 8192 + kwoff) = rk; *(LDSAS u32x4*)(lds + AA_V + (buf) * 8192 + vwoff) = rv; } while (0)
    const int kroff = AA_K + r32 * 128, ksw = (r32 >> 1) & 7;
    const int vroff = AA_V + (4 * hi + ((lane & 15) >> 2)) * 64 + ((lane >> 4) & 1) * 32 + (lane & 3) * 8;
    AA_GLOAD(0); AA_LWRITE(0); __syncthreads();
    for (int i = 0; i < nt; ++i) {
        const int buf = i & 1;
        if (i + 1 < nt) AA_GLOAD(i + 1);
        int cls = 1;
        if (i < nwin) { const int delta = 64 * (kt0 + i) - (qpos0 + qoff); cls = delta == -128 ? 2 : (delta == 128 ? 3 : ((delta >= -64 && delta <= 64) ? 1 : 0)); }
        if (cls != 0) {
            const LDSAS unsigned char* kb = lds + buf * 8192 + kroff;
            f32x16 p[2][2];
#pragma unroll
            for (int qq = 0; qq < 2; ++qq) { p[qq][0] = (f32x16){}; p[qq][1] = (f32x16){}; }
#pragma unroll
            for (int d0 = 0; d0 < 4; ++d0) {
                const int co = ((2 * d0 + hi) ^ ksw) * 16;
                const bf16x8 k0 = *(const LDSAS bf16x8*)(kb + co), k1 = *(const LDSAS bf16x8*)(kb + 4096 + co);
#pragma unroll
                for (int qq = 0; qq < 2; ++qq) {
                    p[qq][0] = __builtin_amdgcn_mfma_f32_32x32x16_bf16(k0, qf[qq][d0], p[qq][0], 0, 0, 0);
                    p[qq][1] = __builtin_amdgcn_mfma_f32_32x32x16_bf16(k1, qf[qq][d0], p[qq][1], 0, 0, 0);
                }
            }
            u32x4 pw[2][4];
#pragma unroll
            for (int qq = 0; qq < 2; ++qq) {
                float ls = 0.f;
#pragma unroll
                for (int r = 0; r < 16; ++r) { p[qq][0][r] = __builtin_amdgcn_exp2f(p[qq][0][r]); p[qq][1][r] = __builtin_amdgcn_exp2f(p[qq][1][r]); }
                if (cls >= 2) {
                    const int a = qq * 32 + r32;
#pragma unroll
                    for (int r = 0; r < 16; ++r) {
                        const int c0 = crow(r, hi), c1 = c0 + 32;
                        const bool v0 = cls == 2 ? (c0 >= a) : (c0 <= a), v1 = cls == 2 ? (c1 >= a) : (c1 <= a);
                        p[qq][0][r] = v0 ? p[qq][0][r] : 0.f; p[qq][1][r] = v1 ? p[qq][1][r] : 0.f;
                    }
                }
#pragma unroll
                for (int r = 0; r < 16; ++r) ls += p[qq][0][r] + p[qq][1][r];
                l[qq] += ls;
                const f32x16 &a0 = p[qq][0], &a1 = p[qq][1];
                pw[qq][0].x = cvtpk(a0[0], a0[1]); pw[qq][0].y = cvtpk(a0[2], a0[3]); pw[qq][0].z = cvtpk(a0[4], a0[5]); pw[qq][0].w = cvtpk(a0[6], a0[7]);
                pw[qq][1].x = cvtpk(a0[8], a0[9]); pw[qq][1].y = cvtpk(a0[10], a0[11]); pw[qq][1].z = cvtpk(a0[12], a0[13]); pw[qq][1].w = cvtpk(a0[14], a0[15]);
                pw[qq][2].x = cvtpk(a1[0], a1[1]); pw[qq][2].y = cvtpk(a1[2], a1[3]); pw[qq][2].z = cvtpk(a1[4], a1[5]); pw[qq][2].w = cvtpk(a1[6], a1[7]);
                pw[qq][3].x = cvtpk(a1[8], a1[9]); pw[qq][3].y = cvtpk(a1[10], a1[11]); pw[qq][3].z = cvtpk(a1[12], a1[13]); pw[qq][3].w = cvtpk(a1[14], a1[15]);
            }
            const LDSAS unsigned char* vb = lds + buf * 8192 + vroff;
#pragma unroll
            for (int d0 = 0; d0 < 2; ++d0)
#pragma unroll
                for (int ks = 0; ks < 4; ++ks) {
                    const s16x4 lo = vtr(vb + d0 * 4096 + ks * 1024), hh = vtr(vb + d0 * 4096 + ks * 1024 + 512);
                    const bf16x8 vf = (bf16x8){lo[0], lo[1], lo[2], lo[3], hh[0], hh[1], hh[2], hh[3]};
                    o[0][d0] = __builtin_amdgcn_mfma_f32_32x32x16_bf16(__builtin_bit_cast(bf16x8, pw[0][ks]), vf, o[0][d0], 0, 0, 0);
                    o[1][d0] = __builtin_amdgcn_mfma_f32_32x32x16_bf16(__builtin_bit_cast(bf16x8, pw[1][ks]), vf, o[1][d0], 0, 0, 0);
                }
        }
        if (i + 1 < nt) AA_LWRITE(buf ^ 1);
        __syncthreads();
    }
#undef AA_KR0
#undef AA_GLOAD
#undef AA_LWRITE
    const float sinkp = __builtin_amdgcn_exp2f(P.a_sink[head] * LOG2E);
    LDSAS float* stg = (LDSAS float*)(lds + wid * 8704);
    const int eq = lane >> 1, eseg = lane & 1;
#pragma unroll
    for (int qq = 0; qq < 2; ++qq) {
        float lt = l[qq]; lt += __shfl_xor(lt, 32);
        if (hi == 0) stg[r32] = 1.0f / (lt + sinkp);
        float rl[16];
#pragma unroll
        for (int r = 0; r < 16; ++r) rl[r] = stg[crow(r, hi)];
#pragma unroll
        for (int d0 = 0; d0 < 2; ++d0)
#pragma unroll
            for (int r = 0; r < 16; ++r) stg[crow(r, hi) * 68 + d0 * 32 + r32] = o[qq][d0][r] * rl[r];
        const size_t grow = (size_t)(qrow0 + qoff + qq * 32 + eq);
        const u32x4* gp = (const u32x4*)(P.GA() + grow * 512 + head * 64 + eseg * 32);
        u32x4* op = (u32x4*)(P.O() + grow * 1024 + head * 64 + eseg * 32);
#pragma unroll
        for (int i = 0; i < 4; ++i) {
            const f32x4 a = *(const LDSAS f32x4*)(stg + eq * 68 + eseg * 32 + i * 8), c = *(const LDSAS f32x4*)(stg + eq * 68 + eseg * 32 + i * 8 + 4);
            const u32x4 g = gp[i]; u32x4 ov;
            ov.x = cvtpk(a[0] * bflo(g.x), a[1] * bfhi(g.x)); ov.y = cvtpk(a[2] * bflo(g.y), a[3] * bfhi(g.y));
            ov.z = cvtpk(c[0] * bflo(g.z), c[1] * bfhi(g.z)); ov.w = cvtpk(c[2] * bflo(g.w), c[3] * bfhi(g.w));
            op[i] = ov;
        }
    }
    __syncthreads();
}

__device__ __forceinline__ void phase_attnA_mfma(const Params& P, LDSAS unsigned char* lds, int vb, int nvb) {
    for (int u = vb; u < 1024 + 128; u += nvb) {
        int b, kvh, qrow0, qpos0, kt0, nwin;
        if (u < 1024) {
            const int qblk = u & 15; kvh = (u >> 4) & 1; b = u >> 5;
            const int lo = 2 * qblk - 2 < 0 ? 0 : 2 * qblk - 2, hi_ = 2 * qblk + 3 > 31 ? 31 : 2 * qblk + 3;
            qrow0 = b * 2048 + qblk * 128; qpos0 = qblk * 128; kt0 = lo; nwin = hi_ - lo + 1;
        } else {
            const int v = u - 1024, half = v & 1; kvh = (v >> 1) & 1; b = v >> 2;
            qrow0 = ML + b * 256 + half * 128; qpos0 = 0; kt0 = 0; nwin = 0;
        }
        attnA_unit(P, lds, b, kvh, qrow0, qpos0, kt0, nwin);
    }
}

__device__ __forceinline__ void phase_gla(const Params& P, float* lds, int vb, int nvb) {
    const int tidx = otid();
    float* sa = lds; float* sk = lds + 128; float* sq = lds + 256;
    const int e = tidx;
    for (int unit = vb; unit < NB * 4 * 2; unit += nvb) {
        const int dr = unit & 1, h = (unit >> 1) & 3, b = unit >> 3;
        const float* wa = dr ? P.wa_b : P.wa_f; const float* ba = dr ? P.ba_b : P.ba_f;
        float S[128];
#pragma unroll
        for (int d = 0; d < 128; ++d) S[d] = 0.f;
        float war[16], bav = 0.f;
        if (e < 128) {
#pragma unroll
            for (int j = 0; j < 16; ++j) war[j] = wa[j * 512 + h * 128 + e];
            bav = ba[h * 128 + e];
        }
        for (int step = 0; step < L + T; ++step) {
            int m;
            if (step < L) m = ML + b * L + (dr ? L - 1 - step : step);
            else { const int t = step - L; m = b * T + (dr ? T - 1 - t : t); }
            __syncthreads();
            if (e < 128) {
                const float* rf = P.RF() + (size_t)m * 32 + dr * 16;
                float z = bav;
#pragma unroll
                for (int j = 0; j < 16; ++j) z += rf[j] * war[j];
                const float ls = fminf(z, 0.f) - log1pf(expf(-fabsf(z)));
                sa[e] = expf(ls * (1.0f / 16.0f));
                sk[e] = bf2f(P.KG()[(size_t)m * 512 + h * 128 + e]);
                sq[e] = bf2f(P.QG()[(size_t)m * 512 + h * 128 + e]);
            }
            __syncthreads();
            if (e < 256) {
            const float v = bf2f(P.VG()[(size_t)m * 1024 + h * 256 + e]);
            float o = 0.f;
#pragma unroll
            for (int d = 0; d < 128; ++d) { S[d] = sa[d] * S[d] + sk[d] * v; o += sq[d] * S[d]; }
            if (m < ML) P.OD()[((size_t)dr * ML + m) * 1024 + h * 256 + e] = (bf16_t)f2bf(o);
            }
        }
    }
}

constexpr int GL_QD = 0, GL_KD = 17408, GL_KT = 34816, GL_V = 53248, GL_DEC = 86016, GL_RF = 86528, GL_TOT = 90624, GL_WA = 92672, GL_END = 92672 + 17 * 128 * 4;
static_assert(GL_END <= pg8::STAGE_BYTES, "GLA LDS map");
__device__ __forceinline__ int pos16(int x) { return 8 * ((x >> 2) & 1) + (x & 3) + 4 * (x >> 3); }
__device__ __forceinline__ bf16x8 pack8(const f32x16& v, int o) {
    u32x4 w; w.x = cvtpk(v[o], v[o + 1]); w.y = cvtpk(v[o + 2], v[o + 3]); w.z = cvtpk(v[o + 4], v[o + 5]); w.w = cvtpk(v[o + 6], v[o + 7]);
    return __builtin_bit_cast(bf16x8, w);
}

__device__ __forceinline__ void phase_gla_mfma(const Params& P, LDSAS unsigned char* lds, int vb, int nvb) {
    const int tid = otid(), lane = tid & 63, r32 = lane & 31, hi = lane >> 5;
    const int wid = __builtin_amdgcn_readfirstlane(tid >> 6);
    const int d = tid & 127, seg = tid >> 7;
    for (int unit = vb; unit < NB * 8; unit += nvb) {
        const int dr = unit & 1, h = (unit >> 1) & 3, b = unit >> 3;
        const float* wa = dr ? P.wa_b : P.wa_f; const float* ba = dr ? P.ba_b : P.ba_f;
        __syncthreads();
        if (seg == 0) {
#pragma unroll
            for (int j = 0; j < 16; ++j) ((LDSAS float*)(lds + GL_WA))[j * 128 + d] = wa[j * 512 + h * 128 + d];
            ((LDSAS float*)(lds + GL_WA))[16 * 128 + d] = ba[h * 128 + d];
        }
        f32x16 S[4];
#pragma unroll
        for (int i = 0; i < 4; ++i) S[i] = (f32x16){};
        for (int n = 0; n < 36; ++n) {
            const bool latent = n >= 4;
            const int membase = latent ? b * T + 64 * (dr ? 31 - (n - 4) : (n - 4)) : ML + b * L + 64 * (dr ? 3 - n : n);
            __syncthreads();
            if (tid < 256) {
                const int row = tid >> 2, part = tid & 3;
                const f32x4 v = *(const f32x4*)(P.RF() + (size_t)(membase + row) * 32 + dr * 16 + part * 4);
                *(LDSAS f32x4*)(lds + GL_RF + (dr ? 63 - row : row) * 64 + part * 16) = v;
            }
#pragma unroll
            for (int k4 = 0; k4 < 4; ++k4) {
                const int idx = tid + 512 * k4, im = idx >> 5, ch = idx & 31;
                const u32x4 v = *(const u32x4*)(P.VG() + (size_t)(membase + im) * 1024 + h * 256 + ch * 8);
                *(LDSAS u32x4*)(lds + GL_V + (ch >> 2) * 4096 + (dr ? 63 - im : im) * 64 + (ch & 3) * 16) = v;
            }
            __syncthreads();
            unsigned short kraw[16], qraw[16];
#pragma unroll
            for (int ii = 0; ii < 16; ++ii) {
                const int i = seg * 16 + ii; const size_t row = (size_t)(membase + (dr ? 63 - i : i));
                kraw[ii] = P.KG()[row * 512 + h * 128 + d];
                qraw[ii] = latent ? P.QG()[row * 512 + h * 128 + d] : (unsigned short)0;
            }
            __builtin_amdgcn_sched_barrier(0);
            float war[16];
#pragma unroll
            for (int j = 0; j < 16; ++j) war[j] = ((const LDSAS float*)(lds + GL_WA))[j * 128 + d];
            const float bav = ((const LDSAS float*)(lds + GL_WA))[16 * 128 + d];
            float lb[16]; float run = 0.f;
#pragma unroll
            for (int ii = 0; ii < 16; ++ii) {
                const LDSAS float* rfl = (const LDSAS float*)(lds + GL_RF + (seg * 16 + ii) * 64);
                float z = bav;
#pragma unroll
                for (int j4 = 0; j4 < 4; ++j4) { const f32x4 r = *(const LDSAS f32x4*)(rfl + j4 * 4); z += r[0] * war[j4 * 4] + r[1] * war[j4 * 4 + 1] + r[2] * war[j4 * 4 + 2] + r[3] * war[j4 * 4 + 3]; }
                const float ls = fminf(z, 0.f) - __logf(1.0f + __expf(-fabsf(z)));
                run += ls * (1.0f / 16.0f); lb[ii] = run;
            }
            ((LDSAS float*)(lds + GL_TOT))[seg * 128 + d] = run;
            __syncthreads();
            float prefix = 0.f, total = 0.f;
#pragma unroll
            for (int s2 = 0; s2 < 4; ++s2) { const float tv = ((const LDSAS float*)(lds + GL_TOT))[s2 * 128 + d]; total += tv; if (s2 < seg) prefix += tv; }
            {
                float ktv[16];
                const int dp = ((d & ~15) + pos16(d & 15)) * 2;
#pragma unroll
                for (int ii = 0; ii < 16; ++ii) {
                    const int i = seg * 16 + ii; const float bb = prefix + lb[ii];
                    const float kk = bf2f(kraw[ii]);
                    ktv[pos16(ii)] = kk * __expf(total - bb);
                    if (latent) {
                        const float e = __expf(bb);
                        *(LDSAS bf16_t*)(lds + GL_QD + i * 272 + dp) = (bf16_t)f2bf(bf2f(qraw[ii]) * e);
                        *(LDSAS bf16_t*)(lds + GL_KD + i * 272 + dp) = (bf16_t)f2bf(kk * __builtin_amdgcn_rcpf(e));
                    }
                }
                u32x4 w0, w1;
                w0.x = cvtpk(ktv[0], ktv[1]); w0.y = cvtpk(ktv[2], ktv[3]); w0.z = cvtpk(ktv[4], ktv[5]); w0.w = cvtpk(ktv[6], ktv[7]);
                w1.x = cvtpk(ktv[8], ktv[9]); w1.y = cvtpk(ktv[10], ktv[11]); w1.z = cvtpk(ktv[12], ktv[13]); w1.w = cvtpk(ktv[14], ktv[15]);
                *(LDSAS u32x4*)(lds + GL_KT + d * 144 + seg * 32) = w0;
                *(LDSAS u32x4*)(lds + GL_KT + d * 144 + seg * 32 + 16) = w1;
                if (seg == 0) ((LDSAS float*)(lds + GL_DEC))[d] = __expf(total);
            }
            __syncthreads();
            bf16x8 vf[4];
#define GL_LOADV() do { const LDSAS unsigned char* vbp = lds + GL_V + wid * 4096 + (4 * hi + ((lane & 15) >> 2)) * 64 + ((lane >> 4) & 1) * 32 + (lane & 3) * 8; \
                _Pragma("unroll") for (int js = 0; js < 4; ++js) { const s16x4 lo = vtr(vbp + js * 1024), hh = vtr(vbp + js * 1024 + 512); vf[js] = (bf16x8){lo[0], lo[1], lo[2], lo[3], hh[0], hh[1], hh[2], hh[3]}; } } while (0)
            __builtin_amdgcn_sched_barrier(0);
            if (latent) {
                f32x16 X00 = (f32x16){}, X01 = (f32x16){}, X11 = (f32x16){};
                const LDSAS unsigned char* qb = lds + GL_QD + r32 * 272 + hi * 16;
                const LDSAS unsigned char* kb = lds + GL_KD + r32 * 272 + hi * 16;
#pragma unroll
                for (int s = 0; s < 8; ++s) {
                    const bf16x8 a0 = *(const LDSAS bf16x8*)(kb + s * 32), a1 = *(const LDSAS bf16x8*)(kb + 32 * 272 + s * 32);
                    const bf16x8 b0 = *(const LDSAS bf16x8*)(qb + s * 32), b1 = *(const LDSAS bf16x8*)(qb + 32 * 272 + s * 32);
                    X00 = __builtin_amdgcn_mfma_f32_32x32x16_bf16(a0, b0, X00, 0, 0, 0);
                    X01 = __builtin_amdgcn_mfma_f32_32x32x16_bf16(a0, b1, X01, 0, 0, 0);
                    X11 = __builtin_amdgcn_mfma_f32_32x32x16_bf16(a1, b1, X11, 0, 0, 0);
                    if (s & 1) __builtin_amdgcn_sched_barrier(0);
                }
#pragma unroll
                for (int r = 0; r < 16; ++r) { const bool keep = crow(r, hi) <= r32; X00[r] = keep ? X00[r] : 0.f; X11[r] = keep ? X11[r] : 0.f; }
                const bf16x8 A00a = pack8(X00, 0), A00b = pack8(X00, 8), A01a = pack8(X01, 0), A01b = pack8(X01, 8), A11a = pack8(X11, 0), A11b = pack8(X11, 8);
                __builtin_amdgcn_sched_barrier(0);
                GL_LOADV();
                f32x16 o0 = (f32x16){}, o1 = (f32x16){};
#pragma unroll
                for (int s = 0; s < 8; ++s) {
                    const bf16x8 Sb = pack8(S[s >> 1], (s & 1) * 8);
                    const bf16x8 q0 = *(const LDSAS bf16x8*)(qb + s * 32), q1 = *(const LDSAS bf16x8*)(qb + 32 * 272 + s * 32);
                    o0 = __builtin_amdgcn_mfma_f32_32x32x16_bf16(q0, Sb, o0, 0, 0, 0);
                    o1 = __builtin_amdgcn_mfma_f32_32x32x16_bf16(q1, Sb, o1, 0, 0, 0);
                    if (s & 1) __builtin_amdgcn_sched_barrier(0);
                }
                o0 = __builtin_amdgcn_mfma_f32_32x32x16_bf16(A00a, vf[0], o0, 0, 0, 0); o0 = __builtin_amdgcn_mfma_f32_32x32x16_bf16(A00b, vf[1], o0, 0, 0, 0);
                o1 = __builtin_amdgcn_mfma_f32_32x32x16_bf16(A01a, vf[0], o1, 0, 0, 0); o1 = __builtin_amdgcn_mfma_f32_32x32x16_bf16(A01b, vf[1], o1, 0, 0, 0);
                o1 = __builtin_amdgcn_mfma_f32_32x32x16_bf16(A11a, vf[2], o1, 0, 0, 0); o1 = __builtin_amdgcn_mfma_f32_32x32x16_bf16(A11b, vf[3], o1, 0, 0, 0);
                bf16_t* od = P.OD() + (size_t)dr * ML * 1024 + h * 256 + wid * 32 + r32;
#pragma unroll
                for (int r = 0; r < 16; ++r) {
                    const int i0 = crow(r, hi), i1 = 32 + i0;
                    od[(size_t)(membase + (dr ? 63 - i0 : i0)) * 1024] = (bf16_t)f2bf(o0[r]);
                    od[(size_t)(membase + (dr ? 63 - i1 : i1)) * 1024] = (bf16_t)f2bf(o1[r]);
                }
            } else { GL_LOADV(); }
#undef GL_LOADV
#pragma unroll
            for (int dt = 0; dt < 4; ++dt) {
                __builtin_amdgcn_sched_barrier(0);
#pragma unroll
                for (int g = 0; g < 4; ++g) {
                    const f32x4 dc = *(const LDSAS f32x4*)(lds + GL_DEC + (dt * 32 + 8 * g + 4 * hi) * 4);
                    S[dt][4 * g] *= dc[0]; S[dt][4 * g + 1] *= dc[1]; S[dt][4 * g + 2] *= dc[2]; S[dt][4 * g + 3] *= dc[3];
                }
                const LDSAS unsigned char* ktp = lds + GL_KT + (dt * 32 + r32) * 144 + hi * 16;
#pragma unroll
                for (int is = 0; is < 4; ++is) S[dt] = __builtin_amdgcn_mfma_f32_32x32x16_bf16(*(const LDSAS bf16x8*)(ktp + is * 32), vf[is], S[dt], 0, 0, 0);
            }
        }
    }
}

__device__ __forceinline__ void phase_finish(const Params& P, int vb, int nvb) {
    const int tidx = otid();
    const int lane = tidx & 63, wpb = blockDim.x >> 6, w = tidx >> 6;
    for (int row = vb * wpb + w; row < ML; row += nvb * wpb) {
        const int c0 = lane * 16;
        float v[16];
        const u32x4* pf = (const u32x4*)(P.OD() + (size_t)row * 1024 + c0);
        const u32x4* pb = (const u32x4*)(P.OD() + ((size_t)ML + row) * 1024 + c0);
        float ss = 0.f;
#pragma unroll
        for (int i = 0; i < 2; ++i) {
            const u32x4 a = pf[i], bq = pb[i];
            v[8 * i] = bflo(a.x) + bflo(bq.x); v[8 * i + 1] = bfhi(a.x) + bfhi(bq.x); v[8 * i + 2] = bflo(a.y) + bflo(bq.y); v[8 * i + 3] = bfhi(a.y) + bfhi(bq.y);
            v[8 * i + 4] = bflo(a.z) + bflo(bq.z); v[8 * i + 5] = bfhi(a.z) + bfhi(bq.z); v[8 * i + 6] = bflo(a.w) + bflo(bq.w); v[8 * i + 7] = bfhi(a.w) + bfhi(bq.w);
        }
#pragma unroll
        for (int i = 0; i < 16; ++i) ss += v[i] * v[i];
        ss += __shfl_xor(ss, 1); ss += __shfl_xor(ss, 2); ss += __shfl_xor(ss, 4); ss += __shfl_xor(ss, 8);
        const float rn = rsqrtf(ss * (1.0f / 256.0f) + EPS);
        const float* gn = P.gla_out_norm + (c0 & 255);
        const u32x4* gp = (const u32x4*)(P.GG() + (size_t)row * 1024 + c0);
        u32x4* op = (u32x4*)(P.A2() + (size_t)row * 1024 + c0);
#pragma unroll
        for (int i = 0; i < 2; ++i) {
            const u32x4 g = gp[i]; u32x4 r;
            r.x = pack2(v[8 * i] * rn * gn[8 * i] * bflo(g.x), v[8 * i + 1] * rn * gn[8 * i + 1] * bfhi(g.x));
            r.y = pack2(v[8 * i + 2] * rn * gn[8 * i + 2] * bflo(g.y), v[8 * i + 3] * rn * gn[8 * i + 3] * bfhi(g.y));
            r.z = pack2(v[8 * i + 4] * rn * gn[8 * i + 4] * bflo(g.z), v[8 * i + 5] * rn * gn[8 * i + 5] * bfhi(g.z));
            r.w = pack2(v[8 * i + 6] * rn * gn[8 * i + 6] * bflo(g.w), v[8 * i + 7] * rn * gn[8 * i + 7] * bfhi(g.w));
            op[i] = r;
        }
    }
}

namespace cg = cooperative_groups;
__global__ void __launch_bounds__(512) mega_kernel(Params Pk) {
    __shared__ __attribute__((aligned(16))) unsigned char lds[pg8::STAGE_BYTES];
    const int vb = blockIdx.x, nvb = gridDim.x;
    { const Params P = ldparams(); phase_pro0(P, lds, vb, nvb); }
    cg::this_grid().sync();
    { const Params P = ldparams(); phase_bias(P, lds, vb, nvb); phase_a0(P, vb, nvb); }
    cg::this_grid().sync();
    { const Params P = ldparams();
      EpiIn0 E{P.ws, 1, P.a_q_norm, P.a_k_norm, P.b_q_norm, P.b_k_norm};
      pg8::Gemm g{P.A(), P.Wt0(), M, N0, D}; pg8::StaticOrder S; S.init(M, N0, nvb, vb); pg8::gemm_phase<EpiIn0, pg8::StaticOrder, true, true>((LDSAS unsigned char*)lds, g, S, E); }
    cg::this_grid().sync();
    { const Params P = ldparams(); phase_attnA_mfma(P, (LDSAS unsigned char*)lds, vb, nvb); }
    { const Params P = ldparams(); phase_attnB_mfma(P, (LDSAS unsigned char*)lds, vb, nvb); }
    cg::this_grid().sync();
    { const Params P = ldparams();
      EpiOut0 E{P.x, P.ctx, P.norm_g + D, P.out, P.ws};
      pg8::Gemm g{P.O(), P.Wo0(), M, D, D}; pg8::StaticOrder S; S.init(M, D, nvb, vb); pg8::gemm_phase<EpiOut0, pg8::StaticOrder, true, true>((LDSAS unsigned char*)lds, g, S, E); }
    cg::this_grid().sync();
    { const Params P = ldparams();
      EpiIn1 E{P.ws, 16};
      pg8::Gemm g{P.A(), P.Wt1(), M, N1, D}; pg8::StaticOrder S; S.init(M, N1, nvb, vb); pg8::gemm_phase<EpiIn1, pg8::StaticOrder, true, true>((LDSAS unsigned char*)lds, g, S, E); }
    cg::this_grid().sync();
    { const Params P = ldparams(); phase_gla_mfma(P, (LDSAS unsigned char*)lds, vb, nvb); }
    cg::this_grid().sync();
    { const Params P = ldparams(); phase_finish(P, vb, nvb); }
    cg::this_grid().sync();
    { const Params P = ldparams();
      EpiOut1 E{P.ws, P.out};
      pg8::Gemm g{P.A2(), P.Wo1(), ML, D, D}; pg8::StaticOrder S; S.init(ML, D, nvb, vb); pg8::gemm_phase<EpiOut1, pg8::StaticOrder, true, true>((LDSAS unsigned char*)lds, g, S, E); }
}
}

extern "C" void kernel_launch(void* const* d_in, const int* in_sizes, int n_in, void* d_out, int out_size, void* d_ws, size_t ws_size, hipStream_t stream) {
    Params P{};
    const float* const* in = (const float* const*)d_in;
    P.x = in[0]; P.c = in[1]; P.ctx = in[2]; P.c_ctx = in[3]; P.adaln_w = in[4]; P.adaln_b = in[5]; P.norm_g = in[6]; P.w_out = in[7]; P.ab_w_in = in[8];
    P.a_q_norm = in[9]; P.a_k_norm = in[10]; P.a_sink = in[11]; P.b_q_norm = in[12]; P.b_k_norm = in[13]; P.lq1 = in[14]; P.lk1 = in[15]; P.lq2 = in[16]; P.lk2 = in[17];
    P.b_subln = in[18]; P.gla_w_in = in[19]; P.wa_f = in[20]; P.ba_f = in[21]; P.wa_b = in[22]; P.ba_b = in[23]; P.gla_out_norm = in[24];
    P.out = (float*)d_out;
    P.ws = (unsigned char*)d_ws;
    if (WS_NEED > ws_size) { fprintf(stderr, "workspace too small: need %zu have %zu\n", (size_t)WS_NEED, ws_size); return; }
    static int grid_blocks = 0;
    if (!grid_blocks) {
        int dev = 0, cus = 0, per_cu = 0;
        (void)hipGetDevice(&dev);
        (void)hipDeviceGetAttribute(&cus, hipDeviceAttributeMultiprocessorCount, dev);
        (void)hipOccupancyMaxActiveBlocksPerMultiprocessor(&per_cu, mega_kernel, 512, 0);
        if (per_cu > 1) per_cu = 1;
        grid_blocks = cus * per_cu;
    }
    void* args[] = {&P};
    hipError_t e = hipLaunchCooperativeKernel((void*)mega_kernel, dim3(grid_blocks), dim3(512), args, 0, stream);
    if (e != hipSuccess) fprintf(stderr, "cooperative launch failed: %s (grid %d)\n", hipGetErrorString(e), grid_blocks);
}
```

```cpp
#include <hip/hip_runtime.h>
#include <hip/hip_cooperative_groups.h>
#include <cstdint>
#include <cstdio>

namespace {
constexpr int NB = 32, T = 2048, L = 256, D = 1024;
constexpr int ML = NB * T, MC = NB * L, M = ML + MC;
constexpr int N0 = 3328, N1 = 3328, N0R = 3328, N1R = 3104;
constexpr float EPS = 1e-6f;
constexpr float LOG2E = 1.4426950408889634f;
constexpr float QSCALE = 0.125f * LOG2E;
constexpr float LAMBDA_INIT = 0.2f;

typedef unsigned short bf16_t;
typedef short bf16x8 __attribute__((ext_vector_type(8)));
typedef float f32x4 __attribute__((ext_vector_type(4)));
typedef unsigned u32x4 __attribute__((ext_vector_type(4)));
typedef unsigned u32x2 __attribute__((ext_vector_type(2)));

constexpr size_t al256(size_t x) { return (x + 255) & ~(size_t)255; }
constexpr size_t OFF_WT0 = 0;
constexpr size_t OFF_WT1 = OFF_WT0 + al256((size_t)N0 * D * 2);
constexpr size_t OFF_WO0 = OFF_WT1 + al256((size_t)N1 * D * 2);
constexpr size_t OFF_WO1 = OFF_WO0 + al256((size_t)D * D * 2);
constexpr size_t OFF_MOD = OFF_WO1 + al256((size_t)D * D * 2);
constexpr size_t OFF_BIAS0 = OFF_MOD + al256((size_t)2 * 33 * 3072 * 4);
constexpr size_t OFF_BIAS1 = OFF_BIAS0 + al256((size_t)33 * 3328 * 4);
constexpr size_t OFF_ROPE = OFF_BIAS1 + al256((size_t)33 * 3328 * 4);
constexpr size_t OFF_SCAL = OFF_ROPE + al256(64 * 16 * 2 * 4);
constexpr size_t OFF_BAR = OFF_SCAL + 256;
constexpr size_t OFF_PARTS = OFF_BAR + 16384;
constexpr size_t OFF_A = OFF_PARTS + al256((size_t)16 * M * 4);
constexpr size_t OFF_O = OFF_A + (size_t)M * D * 2;
constexpr size_t OFF_QKV = OFF_O + (size_t)M * D * 2;
constexpr size_t WS_NEED = OFF_QKV + (size_t)M * 3328 * 2;
constexpr size_t OFF_QA = OFF_QKV, OFF_KA = OFF_QA + (size_t)M * 512 * 2, OFF_VA = OFF_KA + (size_t)M * 128 * 2, OFF_GA = OFF_VA + (size_t)M * 128 * 2;
constexpr size_t OFF_QB = OFF_GA + (size_t)M * 512 * 2, OFF_KB = OFF_QB + (size_t)M * 512 * 2, OFF_VB = OFF_KB + (size_t)M * 512 * 2, OFF_GB = OFF_VB + (size_t)M * 512 * 2;
constexpr size_t OFF_QG = OFF_QKV, OFF_KG = OFF_QG + (size_t)M * 512 * 2, OFF_VG = OFF_KG + (size_t)M * 512 * 2, OFF_GG = OFF_VG + (size_t)M * 1024 * 2, OFF_RF = OFF_GG + (size_t)M * 1024 * 2;
static_assert(OFF_RF + (size_t)M * 32 * 4 <= WS_NEED, "layer-1 projections fit");
static_assert((size_t)2 * ML * 1024 * 2 <= (size_t)2 * M * D * 2, "OD fits over A + O");

struct Params {
    const float *x, *c, *ctx, *c_ctx, *adaln_w, *adaln_b, *norm_g, *w_out, *ab_w_in, *a_q_norm, *a_k_norm, *a_sink, *b_q_norm, *b_k_norm;
    const float *lq1, *lk1, *lq2, *lk2, *b_subln, *gla_w_in, *wa_f, *ba_f, *wa_b, *ba_b, *gla_out_norm;
    float* out;
    unsigned char* ws;
    int reps[12];
#define WSPTR(T, name, off) __device__ __forceinline__ T* name() const { return (T*)(ws + (off)); }
    WSPTR(bf16_t, Wt0, OFF_WT0) WSPTR(bf16_t, Wt1, OFF_WT1) WSPTR(bf16_t, Wo0, OFF_WO0) WSPTR(bf16_t, Wo1, OFF_WO1)
    WSPTR(float, mod, OFF_MOD) WSPTR(float, bias0, OFF_BIAS0) WSPTR(float, bias1, OFF_BIAS1) WSPTR(float, rope, OFF_ROPE) WSPTR(float, scal, OFF_SCAL) WSPTR(float, parts, OFF_PARTS)
    WSPTR(bf16_t, A, OFF_A) WSPTR(bf16_t, O, OFF_O)
    WSPTR(bf16_t, QA, OFF_QA) WSPTR(bf16_t, KA, OFF_KA) WSPTR(bf16_t, VA, OFF_VA) WSPTR(bf16_t, GA, OFF_GA)
    WSPTR(bf16_t, QB, OFF_QB) WSPTR(bf16_t, KB, OFF_KB) WSPTR(bf16_t, VB, OFF_VB) WSPTR(bf16_t, GB, OFF_GB)
    WSPTR(bf16_t, QG, OFF_QG) WSPTR(bf16_t, KG, OFF_KG) WSPTR(bf16_t, VG, OFF_VG) WSPTR(bf16_t, GG, OFF_GG) WSPTR(float, RF, OFF_RF)
    WSPTR(bf16_t, OD, OFF_A) WSPTR(bf16_t, A2, OFF_QKV)
#undef WSPTR
};

__device__ __forceinline__ int lane_id() { int l; asm volatile("v_mbcnt_lo_u32_b32 %0, -1, 0\n\tv_mbcnt_hi_u32_b32 %0, -1, %0" : "=v"(l)); return l; }
#define otid() otid_(g_wave)
__device__ __forceinline__ int otid_(int wave) { int t = wave * 64 + lane_id(); asm volatile("" : "+v"(t)); return t; }
__device__ __forceinline__ unsigned f2bf(float f) { unsigned u = __float_as_uint(f); u += 0x7FFFu + ((u >> 16) & 1u); return u >> 16; }
__device__ __forceinline__ unsigned pack2(float lo, float hi) { return f2bf(lo) | (f2bf(hi) << 16); }
__device__ __forceinline__ float bf2f(unsigned h) { return __uint_as_float(h << 16); }
__device__ __forceinline__ float bflo(unsigned w) { return __uint_as_float(w << 16); }
__device__ __forceinline__ float bfhi(unsigned w) { return __uint_as_float(w & 0xFFFF0000u); }
__device__ __forceinline__ float siluf(float v) { return v / (1.0f + __expf(-v)); }

__device__ __forceinline__ Params ldparams() {
#if defined(__HIP_DEVICE_COMPILE__)
    const __attribute__((address_space(4))) Params* pp = (const __attribute__((address_space(4))) Params*)__builtin_amdgcn_kernarg_segment_ptr();
    asm volatile("" : "+s"(pp));
    return *pp;
#else
    return Params{};
#endif
}

__device__ __forceinline__ int perm_local(int p, bool ropeType) {
    const int bj = p >> 7, wc = (p >> 5) & 3, low = p & 31;
    if (ropeType) return wc * 64 + bj * 32 + low;
    const int n = (low >> 4) & 1, fq = (low >> 2) & 3, e = low & 3;
    return wc * 64 + bj * 32 + fq * 8 + n * 4 + e;
}
__device__ __forceinline__ int src_col(int which, int np) {
    const int p = np & 255, tile = np >> 8;
    bool rope = false;
    if (which == 0) { const int g = tile * 4 + ((p >> 5) & 3); rope = (g < 10) || (g >= 20 && g < 36); }
    const int c = tile * 256 + perm_local(p, rope);
    const int nreal = which == 0 ? N0R : (which == 1 ? N1R : D);
    return c < nreal ? c : -1;
}

__device__ __forceinline__ int dst_row(int which, int c) {
    const int tile = c >> 8, cl = c & 255, wc = cl >> 6, bj = (cl >> 5) & 1, low = cl & 31;
    bool rope = false;
    if (which == 0) { const int g = tile * 4 + wc; rope = (g < 10) || (g >= 20 && g < 36); }
    int lo5 = low;
    if (!rope) { const int fq = low >> 3, n = (low >> 2) & 1, e = low & 3; lo5 = n * 16 + fq * 4 + e; }
    return tile * 256 + bj * 128 + wc * 32 + lo5;
}

__device__ __forceinline__ void wt_tile(const float* __restrict__ W, int ldw, int nreal, int which, bf16_t* __restrict__ dst, int c0, int k0, unsigned char* lds, int tid) {
    bf16_t* t = (bf16_t*)lds;
    __syncthreads();
#pragma unroll
    for (int i = 0; i < 2; ++i) {
        const int idx = tid + 512 * i, r = idx >> 4, c4 = (idx & 15) * 4;
        f32x4 v = (f32x4){0.f, 0.f, 0.f, 0.f};
        if (c0 + c4 < nreal) v = *(const f32x4*)(W + (size_t)(k0 + r) * ldw + c0 + c4);
#pragma unroll
        for (int j = 0; j < 4; ++j) t[(c4 + j) * 66 + r] = (bf16_t)f2bf(v[j]);
    }
    __syncthreads();
    const int c = tid >> 3, kc = tid & 7;
    const unsigned* tr = (const unsigned*)(t + c * 66 + kc * 8);
    u32x4 o; o.x = tr[0]; o.y = tr[1]; o.z = tr[2]; o.w = tr[3];
    *(u32x4*)(dst + (size_t)dst_row(which, c0 + c) * D + k0 + kc * 8) = o;
}

template <int MODE>
__device__ __forceinline__ void skinny_unit(const Params& P, int l, int c0, unsigned char* lds, int tid) {
    float* tab = (float*)lds;
    const int lane = tid & 63, w = tid >> 6;
    const float* W; int ldw, nreal;
    if (MODE == 0) { W = P.adaln_w + (size_t)l * D * 3072; ldw = 3072; nreal = 3072; }
    else { W = l ? P.gla_w_in : P.ab_w_in; ldw = l ? N1R : N0R; nreal = ldw; }
    const bool colok = c0 + lane < nreal;
    float acc[33];
#pragma unroll
    for (int r = 0; r < 33; ++r) acc[r] = 0.f;
    for (int half = 0; half < 2; ++half) {
        __syncthreads();
        for (int r = 0; r < 33; ++r) {
            float v;
            if (MODE == 0) v = siluf(r < 32 ? P.c[r * D + half * 512 + tid] : P.c_ctx[half * 512 + tid]);
            else v = P.mod()[((size_t)l * 33 + r) * 3072 + half * 512 + tid];
            tab[tid * 36 + r] = v;
        }
        __syncthreads();
#pragma unroll 4
        for (int kk = 0; kk < 64; ++kk) {
            const int k = w * 64 + kk;
            const float wv = colok ? W[(size_t)(half * 512 + k) * ldw + c0 + lane] : 0.f;
#pragma unroll
            for (int r4 = 0; r4 < 8; ++r4) { const f32x4 s = *(const f32x4*)(tab + k * 36 + r4 * 4); acc[r4 * 4] += s[0] * wv; acc[r4 * 4 + 1] += s[1] * wv; acc[r4 * 4 + 2] += s[2] * wv; acc[r4 * 4 + 3] += s[3] * wv; }
            acc[32] += tab[k * 36 + 32] * wv;
        }
    }
    __syncthreads();
#pragma unroll
    for (int r = 0; r < 33; ++r) tab[(w * 33 + r) * 64 + lane] = acc[r];
    __syncthreads();
    for (int idx = tid; idx < 33 * 64; idx += 512) {
        const int r = idx >> 6, col = idx & 63;
        float s = 0.f;
#pragma unroll
        for (int ww = 0; ww < 8; ++ww) s += tab[(ww * 33 + r) * 64 + col];
        if (MODE == 0) { const int j = c0 + col; P.mod()[((size_t)l * 33 + r) * 3072 + j] = s + P.adaln_b[l * 3072 + j]; }
        else { const int c = c0 + col; (l ? P.bias1() : P.bias0())[r * 3328 + dst_row(l, c)] = c < nreal ? s : 0.f; }
    }
}

__device__ __forceinline__ void phase_pro0(const Params& P, unsigned char* lds, int vb, int nvb, int g_wave) {
    const int tidx = otid();
    for (int item = vb; item < 96 + 2176; item += nvb) {
        if (item < 96) { skinny_unit<0>(P, item / 48, (item % 48) * 64, lds, tidx); continue; }
        int t = item - 96; int which; const float* W; bf16_t* dst; int ldw, nreal;
        if (t < 832) { which = 0; W = P.ab_w_in; dst = P.Wt0(); ldw = N0R; nreal = N0R; }
        else if ((t -= 832) < 832) { which = 1; W = P.gla_w_in; dst = P.Wt1(); ldw = N1R; nreal = N1R; }
        else if ((t -= 832) < 256) { which = 2; W = P.w_out; dst = P.Wo0(); ldw = D; nreal = D; }
        else { t -= 256; which = 3; W = P.w_out + (size_t)D * D; dst = P.Wo1(); ldw = D; nreal = D; }
        wt_tile(W, ldw, nreal, which, dst, (t >> 4) * 64, (t & 15) * 64, lds, tidx);
    }
    for (int idx = vb * 512 + tidx; idx < 64 * 16; idx += nvb * 512) {
        const int pos = idx >> 4, i = idx & 15;
        const double inv = pow(10000.0, -(double)i / 16.0);
        const double ang = (double)((float)pos * (float)inv);
        P.rope()[idx * 2 + 0] = (float)cos(ang);
        P.rope()[idx * 2 + 1] = (float)sin(ang);
    }
    if (vb == nvb - 1 && tidx == 0) {
        float d1 = 0.f, d2 = 0.f;
        for (int i = 0; i < 64; ++i) { d1 += P.lq1[i] * P.lk1[i]; d2 += P.lq2[i] * P.lk2[i]; }
        P.scal()[0] = expf(d1) - expf(d2) + LAMBDA_INIT;
    }
}

__device__ __forceinline__ void phase_bias(const Params& P, unsigned char* lds, int vb, int nvb, int g_wave) {
    const int tidx = otid();
    for (int item = vb; item < 104; item += nvb) skinny_unit<1>(P, item / 52, (item % 52) * 64, lds, tidx);
}

__device__ __forceinline__ void phase_a0(const Params& P, int vb, int nvb, int g_wave) {
    const int tidx = otid();
    const int lane = tidx & 63, wpb = blockDim.x >> 6, w = tidx >> 6;
    for (int row = vb * wpb + w; row < M; row += nvb * wpb) {
        const float* xin = row < ML ? P.x + (size_t)row * D : P.ctx + (size_t)(row - ML) * D;
        const int r = row < ML ? row >> 11 : 32;
        const float* sc = P.mod() + (size_t)r * 3072 + 1024;
        float ss = 0.f;
#pragma unroll
        for (int i = 0; i < 2; ++i) {
            const int c0 = i * 512 + lane * 8;
            const f32x4 a = *(const f32x4*)(xin + c0), b = *(const f32x4*)(xin + c0 + 4);
            const f32x4 g0 = *(const f32x4*)(P.norm_g + c0), g1 = *(const f32x4*)(P.norm_g + c0 + 4);
            const f32x4 s0 = *(const f32x4*)(sc + c0), s1 = *(const f32x4*)(sc + c0 + 4);
            ss += a[0] * a[0] + a[1] * a[1] + a[2] * a[2] + a[3] * a[3] + b[0] * b[0] + b[1] * b[1] + b[2] * b[2] + b[3] * b[3];
            const f32x4 ya = a * g0 * (1.0f + s0), yb = b * g1 * (1.0f + s1);
            u32x4 o; o.x = pack2(ya[0], ya[1]); o.y = pack2(ya[2], ya[3]); o.z = pack2(yb[0], yb[1]); o.w = pack2(yb[2], yb[3]);
            *(u32x4*)(P.A() + (size_t)row * D + c0) = o;
        }
#pragma unroll
        for (int o = 32; o >= 1; o >>= 1) ss += __shfl_xor(ss, o);
        if (lane == 0) P.parts()[row] = ss;
    }
}

namespace pg8 {
#define PG8_LAS __attribute__((address_space(3)))
typedef unsigned short bf16_t;
typedef short bf16x8 __attribute__((ext_vector_type(8)));
typedef float f32x4 __attribute__((ext_vector_type(4)));
typedef unsigned u32x4 __attribute__((ext_vector_type(4)));
constexpr int BM = 256, BK = 64, HALF = 128, HTB = HALF * BK * 2  , STAGE_BYTES = 8 * HTB, NXCD = 8, WGM = 8;

__host__ __device__ __forceinline__ int lds_byte(int r, int c) { const int st = (r >> 4) * 2 + (c >> 5), rr = r & 15, cc = c & 31, ob = rr * 64 + cc * 2; return st * 1024 + (ob ^ (((ob >> 9) & 1) << 5)); }
__host__ __device__ __forceinline__ void stage_rc(int b, int& R, int& C) { const int st = b / 1024, sb = b % 1024, swz = sb ^ (((sb >> 9) & 1) << 5); R = (st >> 1) * 16 + swz / 64; C = (st & 1) * 32 + (swz % 64) / 2; }
__host__ __device__ __forceinline__ int perm32(int rho) { const int n = rho >> 4, i = rho & 15; return 8 * (i >> 2) + 4 * n + (i & 3); }

struct Unit { int pm, pn; };
struct Gemm { const bf16_t* A; const bf16_t* Bt; int M, N, K; };

struct StaticOrder {
    int nM, nN, nwg, G, c;
    __host__ __device__ void init(int M, int N, int G_, int c_) { nM = M / BM; nN = N / BM; nwg = nM * nN; G = G_; c = c_; }
    __host__ __device__ bool next(int i, Unit& u) const {
        const long L = (long)i * G + c; if (L >= nwg) return false;
        int wgid = (int)L; { const int q = nwg / NXCD, r = nwg % NXCD, xcd = wgid % NXCD, off = wgid / NXCD; wgid = (xcd < r ? xcd * (q + 1) : r * (q + 1) + (xcd - r) * q) + off; }
        const int nig = WGM * nN, gid = wgid / nig, fm = gid * WGM, gsz = (nM - fm) < WGM ? (nM - fm) : WGM;
        u.pm = fm + ((wgid % nig) % gsz); u.pn = (wgid % nig) / gsz; return true;
    }
    __device__ __forceinline__ void a_ready(const Unit&) const {}
    __device__ __forceinline__ void done(const Unit&) const {}
};
template <class Epi, class Sched, bool ALIGN_EPI = false, bool SP2 = false>
__device__ __forceinline__ void gemm_phase(PG8_LAS unsigned char* lds, const Gemm g, const Sched& S, const Epi& E, int g_wave) {
    const int tid = otid(), wid = __builtin_amdgcn_readfirstlane(tid >> 6), lane = tid & 63, wr = wid >> 2, wc = wid & 3, fr = lane & 15, fq = lane >> 4;
    const int K = g.K, nt = K / BK;
    unsigned voffA[2], voffB[2];
#pragma unroll
    for (int i = 0; i < 2; ++i) { int R, C; stage_rc(tid * 16 + i * 8192, R, C); const int Rb = Epi::PERM ? ((R & ~31) + perm32(R & 31)) : R;
        voffA[i] = (unsigned)(R * K + C) * 2u; voffB[i] = (unsigned)(Rb * K + C) * 2u; }
    const size_t kstep = (size_t)(BK * 2);
    const size_t hstep = (size_t)HALF * K * 2;
    const size_t tstep = 2 * hstep;
    const unsigned ldsw = (unsigned)wid * 1024u;
    const int aoff = lds_byte(wr * 64 + fr, fq * 8), boff = lds_byte(wc * 32 + fr, fq * 8);
#define PG8_SA(b, h) (((b) * 2 + (h)) * HTB)
#define PG8_SB(b, h) ((4 + (b) * 2 + (h)) * HTB)
#define PG8_STAGE(bufoff, gbase, voff) do { _Pragma("unroll") for (int _i = 0; _i < 2; ++_i) \
        __builtin_amdgcn_global_load_lds((const unsigned*)((const char*)(gbase) + (voff)[_i]), (PG8_LAS unsigned*)(lds + (bufoff) + ldsw + _i * 8192), 16, 0, 0); } while (0)
#define PG8_LDA(dst, b, h) do { _Pragma("unroll") for (int m = 0; m < 4; ++m) _Pragma("unroll") for (int k = 0; k < 2; ++k) dst[m][k] = *(const PG8_LAS bf16x8*)(lds + PG8_SA(b, h) + aoff + m * 2048 + k * 1024); } while (0)
#define PG8_LDB(dst, b, h) do { _Pragma("unroll") for (int n = 0; n < 2; ++n) _Pragma("unroll") for (int k = 0; k < 2; ++k) dst[n][k] = *(const PG8_LAS bf16x8*)(lds + PG8_SB(b, h) + boff + n * 2048 + k * 1024); } while (0)
#define PG8_MMA(ai, bj, At, Bt) do { __builtin_amdgcn_s_setprio(1); _Pragma("unroll") for (int m = 0; m < 4; ++m) _Pragma("unroll") for (int n = 0; n < 2; ++n) _Pragma("unroll") for (int k = 0; k < 2; ++k) \
        acc[ai][bj][m][n] = __builtin_amdgcn_mfma_f32_16x16x32_bf16(Bt[n][k], At[m][k], acc[ai][bj][m][n], 0, 0, 0); __builtin_amdgcn_s_setprio(0); } while (0)
#define PG8_WAIT_V(n) asm volatile("s_waitcnt vmcnt(" #n ")" ::: "memory")
#define PG8_WAIT_L(n) asm volatile("s_waitcnt lgkmcnt(" #n ")" ::: "memory")
#define PG8_BAR __builtin_amdgcn_s_barrier()
#define PG8_SCHED __builtin_amdgcn_sched_barrier(0)
    Unit cur, nxt; int ui = 0;
    if (!S.next(0, cur)) return;
    f32x4 acc[2][2][4][2];
#pragma unroll
    for (int a = 0; a < 2; ++a)
#pragma unroll
        for (int b = 0; b < 2; ++b)
#pragma unroll
            for (int m = 0; m < 4; ++m)
#pragma unroll
                for (int n = 0; n < 2; ++n) acc[a][b][m][n] = (f32x4){0.f, 0.f, 0.f, 0.f};
    bf16x8 At[4][2], B0[2][2], B1[2][2];
    const char* cA = (const char*)g.A + (size_t)cur.pm * tstep; const char* cB = (const char*)g.Bt + (size_t)cur.pn * tstep;
    S.a_ready(cur);
    if constexpr (SP2) {
        PG8_STAGE(PG8_SB(0, 0), cB, voffB); PG8_STAGE(PG8_SB(0, 1), cB + hstep, voffB); PG8_STAGE(PG8_SA(0, 0), cA, voffA); PG8_STAGE(PG8_SA(0, 1), cA + hstep, voffA);
        if (wr == 1) PG8_BAR;
        PG8_WAIT_V(2); PG8_BAR;
        PG8_STAGE(PG8_SB(1, 0), cB + kstep, voffB); PG8_STAGE(PG8_SA(1, 0), cA + kstep, voffA); PG8_STAGE(PG8_SB(1, 1), cB + hstep + kstep, voffB);
        PG8_WAIT_V(6); PG8_BAR;
    } else {
        PG8_STAGE(PG8_SB(0, 0), cB, voffB); PG8_STAGE(PG8_SA(0, 0), cA, voffA); PG8_STAGE(PG8_SB(0, 1), cB + hstep, voffB); PG8_STAGE(PG8_SA(0, 1), cA + hstep, voffA);
        if (wr == 1) PG8_BAR;
        PG8_WAIT_V(4); PG8_BAR;
        PG8_STAGE(PG8_SB(1, 0), cB + kstep, voffB); PG8_STAGE(PG8_SA(1, 0), cA + kstep, voffA); PG8_STAGE(PG8_SB(1, 1), cB + hstep + kstep, voffB);
        PG8_WAIT_V(6); PG8_BAR;
    }
    for (;;) {
        const bool has_next = S.next(ui + 1, nxt);
        const char* nA = has_next ? (const char*)g.A + (size_t)nxt.pm * tstep : cA; const char* nB = has_next ? (const char*)g.Bt + (size_t)nxt.pn * tstep : cB;
        for (int t = 0; t < nt; t += 2) {
            const bool last = (t == nt - 2);
            const char* a1 = cA + (size_t)(t + 1) * kstep;
            const char* a2 = last ? nA : cA + (size_t)(t + 2) * kstep; const char* b2 = last ? nB : cB + (size_t)(t + 2) * kstep;
            const char* a3 = a2 + kstep; const char* b3 = b2 + kstep;
            if (last && has_next) S.a_ready(nxt);
            if constexpr (SP2) {
            PG8_LDB(B0, 0, 0); PG8_LDB(B1, 0, 1); PG8_SCHED; PG8_LDA(At, 0, 0); PG8_STAGE(PG8_SA(1, 1), a1 + hstep, voffA);
            PG8_WAIT_V(8); PG8_WAIT_L(0); PG8_BAR; PG8_MMA(0, 0, At, B0); PG8_MMA(0, 1, At, B1); PG8_BAR; PG8_SCHED;
            PG8_LDA(At, 0, 1); PG8_STAGE(PG8_SB(0, 0), b2, voffB); PG8_STAGE(PG8_SB(0, 1), b2 + hstep, voffB); PG8_STAGE(PG8_SA(0, 0), a2, voffA);
            PG8_WAIT_V(8); PG8_WAIT_L(0); PG8_BAR; PG8_MMA(1, 0, At, B0); PG8_MMA(1, 1, At, B1); PG8_BAR; PG8_SCHED;
            PG8_LDB(B0, 1, 0); PG8_LDB(B1, 1, 1); PG8_SCHED; PG8_LDA(At, 1, 0); PG8_STAGE(PG8_SA(0, 1), a2 + hstep, voffA);
            PG8_WAIT_V(8); PG8_WAIT_L(0); PG8_BAR; PG8_MMA(0, 0, At, B0); PG8_MMA(0, 1, At, B1); PG8_BAR; PG8_SCHED;
            PG8_LDA(At, 1, 1); PG8_STAGE(PG8_SB(1, 0), b3, voffB); PG8_STAGE(PG8_SB(1, 1), b3 + hstep, voffB); PG8_STAGE(PG8_SA(1, 0), a3, voffA);
            PG8_WAIT_V(8); PG8_WAIT_L(0); PG8_BAR; PG8_MMA(1, 0, At, B0); PG8_MMA(1, 1, At, B1); PG8_BAR; PG8_SCHED;
            } else {
            PG8_LDB(B0, 0, 0); PG8_SCHED; PG8_LDA(At, 0, 0); PG8_STAGE(PG8_SA(1, 1), a1 + hstep, voffA);
            PG8_WAIT_L(8); PG8_BAR; PG8_WAIT_L(0); PG8_MMA(0, 0, At, B0); PG8_BAR; PG8_SCHED;
            PG8_LDB(B1, 0, 1); PG8_STAGE(PG8_SB(0, 0), b2, voffB);
            PG8_BAR; PG8_WAIT_L(0); PG8_MMA(0, 1, At, B1); PG8_BAR;
            PG8_LDA(At, 0, 1); PG8_STAGE(PG8_SA(0, 0), a2, voffA);
            PG8_BAR; PG8_WAIT_L(0); PG8_MMA(1, 0, At, B0); PG8_BAR; PG8_SCHED;
            PG8_STAGE(PG8_SB(0, 1), b2 + hstep, voffB);
            PG8_WAIT_V(6); PG8_BAR; PG8_MMA(1, 1, At, B1); PG8_BAR;
            PG8_LDB(B0, 1, 0); PG8_SCHED; PG8_LDA(At, 1, 0); PG8_STAGE(PG8_SA(0, 1), a2 + hstep, voffA);
            PG8_WAIT_L(8); PG8_BAR; PG8_WAIT_L(0); PG8_MMA(0, 0, At, B0); PG8_BAR; PG8_SCHED;
            PG8_LDB(B1, 1, 1); PG8_STAGE(PG8_SB(1, 0), b3, voffB);
            PG8_BAR; PG8_WAIT_L(0); PG8_MMA(0, 1, At, B1); PG8_BAR;
            PG8_LDA(At, 1, 1); PG8_STAGE(PG8_SA(1, 0), a3, voffA);
            PG8_BAR; PG8_WAIT_L(0); PG8_MMA(1, 0, At, B0); PG8_BAR; PG8_SCHED;
            PG8_STAGE(PG8_SB(1, 1), b3 + hstep, voffB);
            PG8_WAIT_V(6); PG8_BAR; PG8_MMA(1, 1, At, B1); PG8_BAR;
            }
        }
        if constexpr (ALIGN_EPI) { if (wr == 0) PG8_BAR; }
        if constexpr (!Epi::AFTER_DRAIN) { E(acc, cur, wr, wc, fr, fq); S.done(cur); }
        if (!has_next) break;
#pragma unroll
        for (int a = 0; a < 2; ++a)
#pragma unroll
            for (int b = 0; b < 2; ++b)
#pragma unroll
                for (int m = 0; m < 4; ++m)
#pragma unroll
                    for (int n = 0; n < 2; ++n) acc[a][b][m][n] = (f32x4){0.f, 0.f, 0.f, 0.f};
        cur = nxt; cA = nA; cB = nB; ++ui;
        if constexpr (ALIGN_EPI) { if (wr == 1) PG8_BAR; }
    }
    PG8_WAIT_V(0);
    if constexpr (!ALIGN_EPI) { if (wr == 0) PG8_BAR; }
    PG8_BAR;
    if constexpr (Epi::AFTER_DRAIN) { E.fused(acc, cur, wr, wc, fr, fq, lds, wid, lane); S.done(cur); }
#undef PG8_SA
#undef PG8_SB
#undef PG8_STAGE
#undef PG8_LDA
#undef PG8_LDB
#undef PG8_MMA
#undef PG8_WAIT_V
#undef PG8_WAIT_L
#undef PG8_BAR
#undef PG8_SCHED
}
}

struct EpiIn0 {
    unsigned char* ws; int nparts;
    const float *aqn, *akn, *bqn, *bkn;
    static constexpr bool PERM = false, AFTER_DRAIN = false;
    __device__ __forceinline__ void operator()(const f32x4 (&acc)[2][2][4][2], const pg8::Unit& u, int wr, int wc, int fr, int fq) const { (*this)(acc, u.pm, u.pn, wr, wc, fr, fq); }
    __device__ __forceinline__ void operator()(const f32x4 (&acc)[2][2][4][2], int pm, int pn, int wr, int wc, int fr, int fq) const {
        const int g = 4 * pn + wc;
        const float* parts = (const float*)(ws + OFF_PARTS); const float* bias = (const float*)(ws + OFF_BIAS0); const float* rope = (const float*)(ws + OFF_ROPE);
        size_t doff; int ld, col, type; const float* gain = nullptr;
        if (g < 8) { doff = OFF_QA; ld = 512; col = g * 64; type = 2; gain = aqn; }
        else if (g < 10) { doff = OFF_KA; ld = 128; col = (g - 8) * 64; type = 3; gain = akn; }
        else if (g < 12) { doff = OFF_VA; ld = 128; col = (g - 10) * 64; type = 0; }
        else if (g < 20) { doff = OFF_GA; ld = 512; col = (g - 12) * 64; type = 1; }
        else if (g < 28) { doff = OFF_QB; ld = 512; col = (g - 20) * 64; type = 2; gain = bqn; }
        else if (g < 36) { doff = OFF_KB; ld = 512; col = (g - 28) * 64; type = 3; gain = bkn; }
        else if (g < 44) { doff = OFF_VB; ld = 512; col = (g - 36) * 64; type = 0; }
        else { doff = OFF_GB; ld = 512; col = (g - 44) * 64; type = 1; }
        bf16_t* dst = (bf16_t*)(ws + doff);
#pragma unroll
        for (int ai = 0; ai < 2; ++ai)
#pragma unroll
            for (int m = 0; m < 4; ++m) {
                const int row = pm * 256 + ai * 128 + wr * 64 + m * 16 + fr;
                float ss = 0.f;
                for (int i = 0; i < nparts; ++i) ss += parts[(size_t)i * M + row];
                const float rstd = rsqrtf(ss * (1.0f / 1024.0f) + EPS);
                const int r = row < ML ? row >> 11 : 32;
                const float* bptr = bias + (size_t)r * 3328 + pn * 256 + wc * 32 + fq * 4;
                f32x4 v[2][2];
#pragma unroll
                for (int bj = 0; bj < 2; ++bj)
#pragma unroll
                    for (int n = 0; n < 2; ++n) v[bj][n] = acc[ai][bj][m][n] * rstd + *(const f32x4*)(bptr + bj * 128 + n * 16);
                if (type >= 2) {
                    float s2 = 0.f;
#pragma unroll
                    for (int bj = 0; bj < 2; ++bj)
#pragma unroll
                        for (int n = 0; n < 2; ++n) s2 += v[bj][n][0] * v[bj][n][0] + v[bj][n][1] * v[bj][n][1] + v[bj][n][2] * v[bj][n][2] + v[bj][n][3] * v[bj][n][3];
                    s2 += __shfl_xor(s2, 16); s2 += __shfl_xor(s2, 32);
                    const float rn = rsqrtf(s2 * (1.0f / 64.0f) + EPS);
#pragma unroll
                    for (int bj = 0; bj < 2; ++bj)
#pragma unroll
                        for (int n = 0; n < 2; ++n) v[bj][n] = v[bj][n] * rn * *(const f32x4*)(gain + bj * 32 + n * 16 + fq * 4);
                    if (row < ML) {
                        const int t = row & 2047;
#pragma unroll
                        for (int bj = 0; bj < 2; ++bj) {
                            const int pos = bj == 0 ? (t >> 6) : (t & 63);
                            const float* cs = rope + (pos * 16 + fq * 4) * 2;
                            const f32x4 c01 = *(const f32x4*)cs, c23 = *(const f32x4*)(cs + 4);
                            const float cc[4] = {c01[0], c01[2], c23[0], c23[2]}, sn[4] = {c01[1], c01[3], c23[1], c23[3]};
#pragma unroll
                            for (int e = 0; e < 4; ++e) { const float x1 = v[bj][0][e], x2 = v[bj][1][e]; v[bj][0][e] = x1 * cc[e] - x2 * sn[e]; v[bj][1][e] = x2 * cc[e] + x1 * sn[e]; }
                        }
                    }
                    if (type == 2) {
#pragma unroll
                        for (int bj = 0; bj < 2; ++bj)
#pragma unroll
                            for (int n = 0; n < 2; ++n) v[bj][n] = v[bj][n] * QSCALE;
                    }
                } else if (type == 1) {
#pragma unroll
                    for (int bj = 0; bj < 2; ++bj)
#pragma unroll
                        for (int n = 0; n < 2; ++n)
#pragma unroll
                            for (int e = 0; e < 4; ++e) v[bj][n][e] = siluf(v[bj][n][e]);
                }
#pragma unroll
                for (int bj = 0; bj < 2; ++bj) {
                    u32x4 o; o.x = pack2(v[bj][0][0], v[bj][0][1]); o.y = pack2(v[bj][0][2], v[bj][0][3]); o.z = pack2(v[bj][1][0], v[bj][1][1]); o.w = pack2(v[bj][1][2], v[bj][1][3]);
                    *(u32x4*)(dst + (size_t)row * ld + col + bj * 32 + fq * 8) = o;
                }
            }
    }
};

struct EpiIn1 {
    unsigned char* ws; int nparts;
    static constexpr bool PERM = false, AFTER_DRAIN = false;
    __device__ __forceinline__ void operator()(const f32x4 (&acc)[2][2][4][2], const pg8::Unit& u, int wr, int wc, int fr, int fq) const { (*this)(acc, u.pm, u.pn, wr, wc, fr, fq); }
    __device__ __forceinline__ void operator()(const f32x4 (&acc)[2][2][4][2], int pm, int pn, int wr, int wc, int fr, int fq) const {
        const int g = 4 * pn + wc;
        if (g > 48) return;
        const float* parts = (const float*)(ws + OFF_PARTS); const float* bias = (const float*)(ws + OFF_BIAS1); float* RF = (float*)(ws + OFF_RF);
        size_t doff = OFF_QG; int ld = 0, col = 0, type;
        if (g < 8) { doff = OFF_QG; ld = 512; col = g * 64; type = 2; }
        else if (g < 16) { doff = OFF_KG; ld = 512; col = (g - 8) * 64; type = 0; }
        else if (g < 32) { doff = OFF_VG; ld = 1024; col = (g - 16) * 64; type = 0; }
        else if (g < 48) { doff = OFF_GG; ld = 1024; col = (g - 32) * 64; type = 1; }
        else type = 3;
        bf16_t* dst = (bf16_t*)(ws + doff);
#pragma unroll
        for (int ai = 0; ai < 2; ++ai)
#pragma unroll
            for (int m = 0; m < 4; ++m) {
                const int row = pm * 256 + ai * 128 + wr * 64 + m * 16 + fr;
                float ss = 0.f;
                for (int i = 0; i < nparts; ++i) ss += parts[(size_t)i * M + row];
                const float rstd = rsqrtf(ss * (1.0f / 1024.0f) + EPS);
                const int r = row < ML ? row >> 11 : 32;
                const float* bptr = bias + (size_t)r * 3328 + pn * 256 + wc * 32 + fq * 4;
                f32x4 v[2][2];
#pragma unroll
                for (int bj = 0; bj < 2; ++bj)
#pragma unroll
                    for (int n = 0; n < 2; ++n) v[bj][n] = acc[ai][bj][m][n] * rstd + *(const f32x4*)(bptr + bj * 128 + n * 16);
                if (type == 3) {
                    *(f32x4*)(RF + (size_t)row * 32 + fq * 8) = v[0][0];
                    *(f32x4*)(RF + (size_t)row * 32 + fq * 8 + 4) = v[0][1];
                    continue;
                }
                if (type == 2) {
#pragma unroll
                    for (int bj = 0; bj < 2; ++bj)
#pragma unroll
                        for (int n = 0; n < 2; ++n) v[bj][n] = v[bj][n] * 0.08838834764831845f;
                } else if (type == 1) {
#pragma unroll
                    for (int bj = 0; bj < 2; ++bj)
#pragma unroll
                        for (int n = 0; n < 2; ++n)
#pragma unroll
                            for (int e = 0; e < 4; ++e) v[bj][n][e] = siluf(v[bj][n][e]);
                }
#pragma unroll
                for (int bj = 0; bj < 2; ++bj) {
                    u32x4 o; o.x = pack2(v[bj][0][0], v[bj][0][1]); o.y = pack2(v[bj][0][2], v[bj][0][3]); o.z = pack2(v[bj][1][0], v[bj][1][1]); o.w = pack2(v[bj][1][2], v[bj][1][3]);
                    *(u32x4*)(dst + (size_t)row * ld + col + bj * 32 + fq * 8) = o;
                }
            }
    }
};

struct EpiOut0 {
    const float *x, *ctx, *g1; float* out; unsigned char* ws;
    static constexpr bool PERM = false, AFTER_DRAIN = false;
    __device__ __forceinline__ void operator()(const f32x4 (&acc)[2][2][4][2], const pg8::Unit& u, int wr, int wc, int fr, int fq) const { (*this)(acc, u.pm, u.pn, wr, wc, fr, fq); }
    __device__ __forceinline__ void operator()(const f32x4 (&acc)[2][2][4][2], int pm, int pn, int wr, int wc, int fr, int fq) const {
        const float* mod = (const float*)(ws + OFF_MOD); bf16_t* A1 = (bf16_t*)(ws + OFF_A); float* parts = (float*)(ws + OFF_PARTS);
#pragma unroll
        for (int ai = 0; ai < 2; ++ai)
#pragma unroll
            for (int m = 0; m < 4; ++m) {
                const int row = pm * 256 + ai * 128 + wr * 64 + m * 16 + fr;
                const int r = row < ML ? row >> 11 : 32;
                const float* xin = row < ML ? x + (size_t)row * D : ctx + (size_t)(row - ML) * D;
                const float* gt = mod + (size_t)r * 3072 + 2048;
                const float* sc = mod + (size_t)(33 + r) * 3072 + 1024;
                float ss = 0.f;
#pragma unroll
                for (int bj = 0; bj < 2; ++bj) {
                    const int c = pn * 256 + wc * 64 + bj * 32 + fq * 8;
                    f32x4 y[2];
#pragma unroll
                    for (int n = 0; n < 2; ++n) {
                        const f32x4 x1 = *(const f32x4*)(xin + c + n * 4) + *(const f32x4*)(gt + c + n * 4) * acc[ai][bj][m][n];
                        ss += x1[0] * x1[0] + x1[1] * x1[1] + x1[2] * x1[2] + x1[3] * x1[3];
                        if (row < ML) *(f32x4*)(out + (size_t)row * D + c + n * 4) = x1;
                        y[n] = x1 * *(const f32x4*)(g1 + c + n * 4) * (1.0f + *(const f32x4*)(sc + c + n * 4));
                    }
                    u32x4 o; o.x = pack2(y[0][0], y[0][1]); o.y = pack2(y[0][2], y[0][3]); o.z = pack2(y[1][0], y[1][1]); o.w = pack2(y[1][2], y[1][3]);
                    *(u32x4*)(A1 + (size_t)row * D + c) = o;
                }
                ss += __shfl_xor(ss, 16); ss += __shfl_xor(ss, 32);
                if (fq == 0) parts[(size_t)(4 * pn + wc) * M + row] = ss;
            }
    }
};

struct EpiOut1 {
    unsigned char* ws; float* out;
    static constexpr bool PERM = false, AFTER_DRAIN = false;
    __device__ __forceinline__ void operator()(const f32x4 (&acc)[2][2][4][2], const pg8::Unit& u, int wr, int wc, int fr, int fq) const { (*this)(acc, u.pm, u.pn, wr, wc, fr, fq); }
    __device__ __forceinline__ void operator()(const f32x4 (&acc)[2][2][4][2], int pm, int pn, int wr, int wc, int fr, int fq) const {
#pragma unroll
        for (int ai = 0; ai < 2; ++ai)
#pragma unroll
            for (int m = 0; m < 4; ++m) {
                const int row = pm * 256 + ai * 128 + wr * 64 + m * 16 + fr;
                const int r = row >> 11;
                const float* gt = (const float*)(ws + OFF_MOD) + (size_t)(33 + r) * 3072 + 2048;
#pragma unroll
                for (int bj = 0; bj < 2; ++bj)
#pragma unroll
                    for (int n = 0; n < 2; ++n) {
                        const int c = pn * 256 + wc * 64 + bj * 32 + fq * 8 + n * 4;
                        float* o = out + (size_t)row * D + c;
                        *(f32x4*)o = *(const f32x4*)o + *(const f32x4*)(gt + c) * acc[ai][bj][m][n];
                    }
            }
    }
};

typedef float f32x16 __attribute__((ext_vector_type(16)));
typedef short s16x4 __attribute__((ext_vector_type(4)));
typedef float f32x2_t __attribute__((ext_vector_type(2)));
typedef __bf16 bf16x2_t __attribute__((ext_vector_type(2)));
#define LDSAS __attribute__((address_space(3)))
__device__ __forceinline__ unsigned cvtpk(float lo, float hi) { f32x2_t v = {lo, hi}; bf16x2_t b = __builtin_convertvector(v, bf16x2_t); return __builtin_bit_cast(unsigned, b); }
__device__ __forceinline__ int crow(int r, int hi) { return (r & 3) + 8 * (r >> 2) + 4 * hi; }
__device__ __forceinline__ s16x4 vtr(const LDSAS unsigned char* p) { return __builtin_bit_cast(s16x4, __builtin_amdgcn_ds_read_tr16_b64_v4i16((LDSAS s16x4*)p)); }

constexpr int AB_K1 = 0, AB_K2 = 16384, AB_V = 32768;
constexpr int AB_XCH = 0, AB_SCR = 67584, AB_LDS = 67584 + 8 * 256;

__device__ __forceinline__ void attnB_unit(const Params& P, LDSAS unsigned char* lds, int b, int h, int qrow0, int t_begin, int t_end, int g_wave) {
    const int tid = otid(), lane = tid & 63, r32 = lane & 31, hi = lane >> 5;
    const int wid = __builtin_amdgcn_readfirstlane(tid >> 6);
    const int s = wid >> 2, qt = wid & 3;
    const int qrow = qrow0 + qt * 32 + r32;
    bf16x8 qf[4];
#pragma unroll
    for (int d0 = 0; d0 < 4; ++d0) qf[d0] = *(const bf16x8*)(P.QB() + (size_t)qrow * 512 + (2 * h + s) * 64 + d0 * 16 + hi * 8);
    f32x16 o[4];
#pragma unroll
    for (int i = 0; i < 4; ++i) o[i] = (f32x16){};
    float l = 0.f;
    const int krow = tid >> 3, kch = tid & 7, vrow = tid >> 4, vch = tid & 15;
    const int kwoff = krow * 128 + ((kch ^ ((krow >> 1) & 7)) * 16);
    const int vwoff = (vch >> 2) * 4096 + vrow * 64 + (vch & 3) * 16;
    u32x4 rk1, rk2, rv0, rv1;
#define AB_GLOAD(t) do { const int kr0_ = (t) < 32 ? b * 2048 + 64 * (t) : ML + b * 256 + 64 * ((t) - 32); \
        rk1 = *(const u32x4*)(P.KB() + (size_t)(kr0_ + krow) * 512 + (2 * h) * 64 + kch * 8); \
        rk2 = *(const u32x4*)(P.KB() + (size_t)(kr0_ + krow) * 512 + (2 * h + 1) * 64 + kch * 8); \
        rv0 = *(const u32x4*)(P.VB() + (size_t)(kr0_ + vrow) * 512 + h * 128 + vch * 8); \
        rv1 = *(const u32x4*)(P.VB() + (size_t)(kr0_ + vrow + 32) * 512 + h * 128 + vch * 8); } while (0)
#define AB_LWRITE(buf) do { *(LDSAS u32x4*)(lds + AB_K1 + (buf) * 8192 + kwoff) = rk1; *(LDSAS u32x4*)(lds + AB_K2 + (buf) * 8192 + kwoff) = rk2; \
        *(LDSAS u32x4*)(lds + AB_V + (buf) * 16384 + vwoff) = rv0; *(LDSAS u32x4*)(lds + AB_V + (buf) * 16384 + vwoff + 2048) = rv1; } while (0)
    const int kroff = (s ? AB_K2 : AB_K1) + r32 * 128, ksw = (r32 >> 1) & 7;
    const int vroff = AB_V + (4 * hi + ((lane & 15) >> 2)) * 64 + ((lane >> 4) & 1) * 32 + (lane & 3) * 8;
    AB_GLOAD(t_begin); AB_LWRITE(0); __syncthreads();
    for (int t = t_begin; t < t_end; ++t) {
        const int buf = (t - t_begin) & 1;
        const LDSAS unsigned char* kb = lds + buf * 8192 + kroff;
        f32x16 p0 = (f32x16){}, p1 = (f32x16){};
#pragma unroll
        for (int d0 = 0; d0 < 4; ++d0) {
            const int co = ((2 * d0 + hi) ^ ksw) * 16;
            const bf16x8 k0 = *(const LDSAS bf16x8*)(kb + co), k1 = *(const LDSAS bf16x8*)(kb + 4096 + co);
            p0 = __builtin_amdgcn_mfma_f32_32x32x16_bf16(k0, qf[d0], p0, 0, 0, 0);
            p1 = __builtin_amdgcn_mfma_f32_32x32x16_bf16(k1, qf[d0], p1, 0, 0, 0);
        }
        float ls = 0.f;
#pragma unroll
        for (int r = 0; r < 16; ++r) { p0[r] = __builtin_amdgcn_exp2f(p0[r]); p1[r] = __builtin_amdgcn_exp2f(p1[r]); ls += p0[r] + p1[r]; }
        l += ls;
        u32x4 pw[4];
        pw[0].x = cvtpk(p0[0], p0[1]); pw[0].y = cvtpk(p0[2], p0[3]); pw[0].z = cvtpk(p0[4], p0[5]); pw[0].w = cvtpk(p0[6], p0[7]);
        pw[1].x = cvtpk(p0[8], p0[9]); pw[1].y = cvtpk(p0[10], p0[11]); pw[1].z = cvtpk(p0[12], p0[13]); pw[1].w = cvtpk(p0[14], p0[15]);
        pw[2].x = cvtpk(p1[0], p1[1]); pw[2].y = cvtpk(p1[2], p1[3]); pw[2].z = cvtpk(p1[4], p1[5]); pw[2].w = cvtpk(p1[6], p1[7]);
        pw[3].x = cvtpk(p1[8], p1[9]); pw[3].y = cvtpk(p1[10], p1[11]); pw[3].z = cvtpk(p1[12], p1[13]); pw[3].w = cvtpk(p1[14], p1[15]);
        if (t + 1 < t_end) AB_GLOAD(t + 1);
        const LDSAS unsigned char* vb = lds + buf * 16384 + vroff;
#pragma unroll
        for (int d0 = 0; d0 < 4; ++d0)
#pragma unroll
            for (int ks = 0; ks < 4; ++ks) {
                const s16x4 lo = vtr(vb + d0 * 4096 + ks * 1024), hh = vtr(vb + d0 * 4096 + ks * 1024 + 512);
                const bf16x8 vf = (bf16x8){lo[0], lo[1], lo[2], lo[3], hh[0], hh[1], hh[2], hh[3]};
                o[d0] = __builtin_amdgcn_mfma_f32_32x32x16_bf16(__builtin_bit_cast(bf16x8, pw[ks]), vf, o[d0], 0, 0, 0);
                if (ks == 3) __builtin_amdgcn_sched_barrier(0);
            }
        if (t + 1 < t_end) AB_LWRITE(buf ^ 1);
        __syncthreads();
    }
#undef AB_GLOAD
#undef AB_LWRITE
    l += __shfl_xor(l, 32);
    LDSAS float* scr = (LDSAS float*)(lds + AB_SCR + wid * 256);
    LDSAS float* xch = (LDSAS float*)(lds + AB_XCH + qt * 16896);
    if (hi == 0) scr[r32] = (s ? P.scal()[0] : 1.0f) / l;
    float rl[16];
#pragma unroll
    for (int r = 0; r < 16; ++r) rl[r] = scr[crow(r, hi)];
    if (s == 1) {
#pragma unroll
        for (int d0 = 0; d0 < 4; ++d0)
#pragma unroll
            for (int r = 0; r < 16; ++r) xch[crow(r, hi) * 132 + d0 * 32 + r32] = o[d0][r] * rl[r];
    }
    __syncthreads();
    if (s == 0) {
        float ss[16];
#pragma unroll
        for (int r = 0; r < 16; ++r) {
            float s2 = 0.f;
#pragma unroll
            for (int d0 = 0; d0 < 4; ++d0) { const float v = o[d0][r] * rl[r] - xch[crow(r, hi) * 132 + d0 * 32 + r32]; o[d0][r] = v; s2 += v * v; }
            ss[r] = s2;
        }
#pragma unroll
        for (int r = 0; r < 16; ++r) {
            float s2 = ss[r];
            s2 += __shfl_xor(s2, 1); s2 += __shfl_xor(s2, 2); s2 += __shfl_xor(s2, 4); s2 += __shfl_xor(s2, 8); s2 += __shfl_xor(s2, 16);
            ss[r] = rsqrtf(s2 * (1.0f / 128.0f) + EPS) * (1.0f - LAMBDA_INIT);
        }
#pragma unroll
        for (int d0 = 0; d0 < 4; ++d0) {
            const float sl = P.b_subln[d0 * 32 + r32];
#pragma unroll
            for (int r = 0; r < 16; ++r) xch[crow(r, hi) * 132 + d0 * 32 + r32] = o[d0][r] * ss[r] * sl;
        }
        const int eq = lane >> 1, eseg = lane & 1;
        const size_t grow = (size_t)(qrow0 + qt * 32 + eq);
        const u32x4* gp = (const u32x4*)(P.GB() + grow * 512 + h * 128 + eseg * 64);
        u32x4* op = (u32x4*)(P.O() + grow * 1024 + 512 + h * 128 + eseg * 64);
#pragma unroll
        for (int i = 0; i < 8; ++i) {
            const f32x4 a = *(const LDSAS f32x4*)(xch + eq * 132 + eseg * 64 + i * 8), c = *(const LDSAS f32x4*)(xch + eq * 132 + eseg * 64 + i * 8 + 4);
            const u32x4 g = gp[i]; u32x4 ov;
            ov.x = cvtpk(a[0] * bflo(g.x), a[1] * bfhi(g.x)); ov.y = cvtpk(a[2] * bflo(g.y), a[3] * bfhi(g.y));
            ov.z = cvtpk(c[0] * bflo(g.z), c[1] * bfhi(g.z)); ov.w = cvtpk(c[2] * bflo(g.w), c[3] * bfhi(g.w));
            op[i] = ov;
        }
    }
    __syncthreads();
}

__device__ __forceinline__ void phase_attnB_mfma(const Params& P, LDSAS unsigned char* lds, int vb, int nvb, int g_wave) {
    for (int u = vb; u < 2048 + 256; u += nvb) {
        int pair, qrow0, t0;
        if (u < 2048) {
            int qblk;
            if (nvb == 256) { const int round = u >> 8, i = u & 255, xcd = i & 7, slot = i >> 3; pair = round * 16 + xcd * 2 + (slot >> 4); qblk = slot & 15; }
            else { pair = u >> 4; qblk = u & 15; }
            qrow0 = (pair >> 2) * 2048 + qblk * 128; t0 = 0;
        } else {
            const int v = u - 2048; pair = v >> 1;
            qrow0 = ML + (pair >> 2) * 256 + (v & 1) * 128; t0 = 32;
        }
        attnB_unit(P, lds, pair >> 2, pair & 3, qrow0, t0, 36, g_wave);
    }
}

constexpr int AA_K = 0, AA_V = 16384;
__device__ __forceinline__ void attnA_unit(const Params& P, LDSAS unsigned char* lds, int b, int kvh, int qrow0, int qpos0, int kt0, int nwin, int g_wave) {
    const int tid = otid(), lane = tid & 63, r32 = lane & 31, hi = lane >> 5;
    const int wid = __builtin_amdgcn_readfirstlane(tid >> 6);
    const int head = kvh * 4 + (wid >> 1), qoff = (wid & 1) * 64;
    bf16x8 qf[2][4];
#pragma unroll
    for (int qq = 0; qq < 2; ++qq)
#pragma unroll
        for (int d0 = 0; d0 < 4; ++d0) qf[qq][d0] = *(const bf16x8*)(P.QA() + (size_t)(qrow0 + qoff + qq * 32 + r32) * 512 + head * 64 + d0 * 16 + hi * 8);
    f32x16 o[2][2];
#pragma unroll
    for (int i = 0; i < 2; ++i) { o[i][0] = (f32x16){}; o[i][1] = (f32x16){}; }
    float l[2] = {0.f, 0.f};
    const int krow = tid >> 3, kch = tid & 7;
    const int kwoff = krow * 128 + ((kch ^ ((krow >> 1) & 7)) * 16);
    const int vwoff = (kch >> 2) * 4096 + krow * 64 + (kch & 3) * 16;
    u32x4 rk, rv;
    const int nt = nwin + 4;
#define AA_KR0(i) ((i) < nwin ? b * 2048 + 64 * (kt0 + (i)) : ML + b * 256 + 64 * ((i) - nwin))
#define AA_GLOAD(i) do { const int kr0_ = AA_KR0(i); rk = *(const u32x4*)(P.KA() + (size_t)(kr0_ + krow) * 128 + kvh * 64 + kch * 8); rv = *(const u32x4*)(P.VA() + (size_t)(kr0_ + krow) * 128 + kvh * 64 + kch * 8); } while (0)
#define AA_LWRITE(buf) do { *(LDSAS u32x4*)(lds + AA_K + (buf) * 8192 + kwoff) = rk; *(LDSAS u32x4*)(lds + AA_V + (buf) * 8192 + vwoff) = rv; } while (0)
    const int kroff = AA_K + r32 * 128, ksw = (r32 >> 1) & 7;
    const int vroff = AA_V + (4 * hi + ((lane & 15) >> 2)) * 64 + ((lane >> 4) & 1) * 32 + (lane & 3) * 8;
    AA_GLOAD(0); AA_LWRITE(0); __syncthreads();
    for (int i = 0; i < nt; ++i) {
        const int buf = i & 1;
        if (i + 1 < nt) AA_GLOAD(i + 1);
        int cls = 1;
        if (i < nwin) { const int delta = 64 * (kt0 + i) - (qpos0 + qoff); cls = delta == -128 ? 2 : (delta == 128 ? 3 : ((delta >= -64 && delta <= 64) ? 1 : 0)); }
        if (cls != 0) {
            const LDSAS unsigned char* kb = lds + buf * 8192 + kroff;
            f32x16 p[2][2];
#pragma unroll
            for (int qq = 0; qq < 2; ++qq) { p[qq][0] = (f32x16){}; p[qq][1] = (f32x16){}; }
#pragma unroll
            for (int d0 = 0; d0 < 4; ++d0) {
                const int co = ((2 * d0 + hi) ^ ksw) * 16;
                const bf16x8 k0 = *(const LDSAS bf16x8*)(kb + co), k1 = *(const LDSAS bf16x8*)(kb + 4096 + co);
#pragma unroll
                for (int qq = 0; qq < 2; ++qq) {
                    p[qq][0] = __builtin_amdgcn_mfma_f32_32x32x16_bf16(k0, qf[qq][d0], p[qq][0], 0, 0, 0);
                    p[qq][1] = __builtin_amdgcn_mfma_f32_32x32x16_bf16(k1, qf[qq][d0], p[qq][1], 0, 0, 0);
                }
            }
            u32x4 pw[2][4];
#pragma unroll
            for (int qq = 0; qq < 2; ++qq) {
                float ls = 0.f;
#pragma unroll
                for (int r = 0; r < 16; ++r) { p[qq][0][r] = __builtin_amdgcn_exp2f(p[qq][0][r]); p[qq][1][r] = __builtin_amdgcn_exp2f(p[qq][1][r]); }
                if (cls >= 2) {
                    int a = qq * 32 + r32;
                    asm volatile("" : "+v"(a));
#pragma unroll
                    for (int r = 0; r < 16; ++r) {
                        const int c0 = crow(r, hi), c1 = c0 + 32;
                        const bool v0 = cls == 2 ? (c0 >= a) : (c0 <= a), v1 = cls == 2 ? (c1 >= a) : (c1 <= a);
                        p[qq][0][r] = v0 ? p[qq][0][r] : 0.f; p[qq][1][r] = v1 ? p[qq][1][r] : 0.f;
                    }
                }
#pragma unroll
                for (int r = 0; r < 16; ++r) ls += p[qq][0][r] + p[qq][1][r];
                l[qq] += ls;
                const f32x16 &a0 = p[qq][0], &a1 = p[qq][1];
                pw[qq][0].x = cvtpk(a0[0], a0[1]); pw[qq][0].y = cvtpk(a0[2], a0[3]); pw[qq][0].z = cvtpk(a0[4], a0[5]); pw[qq][0].w = cvtpk(a0[6], a0[7]);
                pw[qq][1].x = cvtpk(a0[8], a0[9]); pw[qq][1].y = cvtpk(a0[10], a0[11]); pw[qq][1].z = cvtpk(a0[12], a0[13]); pw[qq][1].w = cvtpk(a0[14], a0[15]);
                pw[qq][2].x = cvtpk(a1[0], a1[1]); pw[qq][2].y = cvtpk(a1[2], a1[3]); pw[qq][2].z = cvtpk(a1[4], a1[5]); pw[qq][2].w = cvtpk(a1[6], a1[7]);
                pw[qq][3].x = cvtpk(a1[8], a1[9]); pw[qq][3].y = cvtpk(a1[10], a1[11]); pw[qq][3].z = cvtpk(a1[12], a1[13]); pw[qq][3].w = cvtpk(a1[14], a1[15]);
            }
            const LDSAS unsigned char* vb = lds + buf * 8192 + vroff;
#pragma unroll
            for (int d0 = 0; d0 < 2; ++d0)
#pragma unroll
                for (int ks = 0; ks < 4; ++ks) {
                    const s16x4 lo = vtr(vb + d0 * 4096 + ks * 1024), hh = vtr(vb + d0 * 4096 + ks * 1024 + 512);
                    const bf16x8 vf = (bf16x8){lo[0], lo[1], lo[2], lo[3], hh[0], hh[1], hh[2], hh[3]};
                    o[0][d0] = __builtin_amdgcn_mfma_f32_32x32x16_bf16(__builtin_bit_cast(bf16x8, pw[0][ks]), vf, o[0][d0], 0, 0, 0);
                    o[1][d0] = __builtin_amdgcn_mfma_f32_32x32x16_bf16(__builtin_bit_cast(bf16x8, pw[1][ks]), vf, o[1][d0], 0, 0, 0);
                }
        }
        if (i + 1 < nt) AA_LWRITE(buf ^ 1);
        __syncthreads();
    }
#undef AA_KR0
#undef AA_GLOAD
#undef AA_LWRITE
    const float sinkp = __builtin_amdgcn_exp2f(P.a_sink[head] * LOG2E);
    LDSAS float* stg = (LDSAS float*)(lds + wid * 8704);
    const int eq = lane >> 1, eseg = lane & 1;
#pragma unroll
    for (int qq = 0; qq < 2; ++qq) {
        float lt = l[qq]; lt += __shfl_xor(lt, 32);
        if (hi == 0) stg[r32] = 1.0f / (lt + sinkp);
        float rl[16];
#pragma unroll
        for (int r = 0; r < 16; ++r) rl[r] = stg[crow(r, hi)];
#pragma unroll
        for (int d0 = 0; d0 < 2; ++d0)
#pragma unroll
            for (int r = 0; r < 16; ++r) stg[crow(r, hi) * 68 + d0 * 32 + r32] = o[qq][d0][r] * rl[r];
        const size_t grow = (size_t)(qrow0 + qoff + qq * 32 + eq);
        const u32x4* gp = (const u32x4*)(P.GA() + grow * 512 + head * 64 + eseg * 32);
        u32x4* op = (u32x4*)(P.O() + grow * 1024 + head * 64 + eseg * 32);
#pragma unroll
        for (int i = 0; i < 4; ++i) {
            const f32x4 a = *(const LDSAS f32x4*)(stg + eq * 68 + eseg * 32 + i * 8), c = *(const LDSAS f32x4*)(stg + eq * 68 + eseg * 32 + i * 8 + 4);
            const u32x4 g = gp[i]; u32x4 ov;
            ov.x = cvtpk(a[0] * bflo(g.x), a[1] * bfhi(g.x)); ov.y = cvtpk(a[2] * bflo(g.y), a[3] * bfhi(g.y));
            ov.z = cvtpk(c[0] * bflo(g.z), c[1] * bfhi(g.z)); ov.w = cvtpk(c[2] * bflo(g.w), c[3] * bfhi(g.w));
            op[i] = ov;
        }
    }
    __syncthreads();
}

__device__ __forceinline__ void phase_attnA_mfma(const Params& P, LDSAS unsigned char* lds, int vb, int nvb, int g_wave) {
    for (int u = vb; u < 1024 + 128; u += nvb) {
        int b, kvh, qrow0, qpos0, kt0, nwin;
        if (u < 1024) {
            const int qblk = u & 15; kvh = (u >> 4) & 1; b = u >> 5;
            const int lo = 2 * qblk - 2 < 0 ? 0 : 2 * qblk - 2, hi_ = 2 * qblk + 3 > 31 ? 31 : 2 * qblk + 3;
            qrow0 = b * 2048 + qblk * 128; qpos0 = qblk * 128; kt0 = lo; nwin = hi_ - lo + 1;
        } else {
            const int v = u - 1024, half = v & 1; kvh = (v >> 1) & 1; b = v >> 2;
            qrow0 = ML + b * 256 + half * 128; qpos0 = 0; kt0 = 0; nwin = 0;
        }
        attnA_unit(P, lds, b, kvh, qrow0, qpos0, kt0, nwin, g_wave);
    }
}

constexpr int GL_QD = 0, GL_KD = 17408, GL_KT = 34816, GL_V = 53248, GL_DEC = 86016, GL_RF = 86528, GL_TOT = 90624, GL_WA = 92672, GL_END = 92672 + 17 * 128 * 4;
static_assert(GL_END <= pg8::STAGE_BYTES, "GLA LDS map");
__device__ __forceinline__ int pos16(int x) { return 8 * ((x >> 2) & 1) + (x & 3) + 4 * (x >> 3); }
__device__ __forceinline__ bf16x8 pack8(const f32x16& v, int o) {
    u32x4 w; w.x = cvtpk(v[o], v[o + 1]); w.y = cvtpk(v[o + 2], v[o + 3]); w.z = cvtpk(v[o + 4], v[o + 5]); w.w = cvtpk(v[o + 6], v[o + 7]);
    return __builtin_bit_cast(bf16x8, w);
}

__device__ __forceinline__ void phase_gla_mfma(const Params& P, LDSAS unsigned char* lds, int vb, int nvb, int g_wave) {
    const int tid = otid(), lane = tid & 63, r32 = lane & 31, hi = lane >> 5;
    const int wid = __builtin_amdgcn_readfirstlane(tid >> 6);
    const int d = tid & 127, seg = tid >> 7;
    for (int unit = vb; unit < NB * 8; unit += nvb) {
        const int dr = unit & 1, h = (unit >> 1) & 3, b = unit >> 3;
        const float* wa = dr ? P.wa_b : P.wa_f; const float* ba = dr ? P.ba_b : P.ba_f;
        __syncthreads();
        if (seg == 0) {
#pragma unroll
            for (int j = 0; j < 16; ++j) ((LDSAS float*)(lds + GL_WA))[j * 128 + d] = wa[j * 512 + h * 128 + d];
            ((LDSAS float*)(lds + GL_WA))[16 * 128 + d] = ba[h * 128 + d];
        }
        f32x16 S[4];
#pragma unroll
        for (int i = 0; i < 4; ++i) S[i] = (f32x16){};
        for (int n = 0; n < 36; ++n) {
            const bool latent = n >= 4;
            const int membase = latent ? b * T + 64 * (dr ? 31 - (n - 4) : (n - 4)) : ML + b * L + 64 * (dr ? 3 - n : n);
            __syncthreads();
            if (tid < 256) {
                const int row = tid >> 2, part = tid & 3;
                const f32x4 v = *(const f32x4*)(P.RF() + (size_t)(membase + row) * 32 + dr * 16 + part * 4);
                *(LDSAS f32x4*)(lds + GL_RF + (dr ? 63 - row : row) * 64 + part * 16) = v;
            }
#pragma unroll
            for (int k4 = 0; k4 < 4; ++k4) {
                const int idx = tid + 512 * k4, im = idx >> 5, ch = idx & 31;
                const u32x4 v = *(const u32x4*)(P.VG() + (size_t)(membase + im) * 1024 + h * 256 + ch * 8);
                *(LDSAS u32x4*)(lds + GL_V + (ch >> 2) * 4096 + (dr ? 63 - im : im) * 64 + (ch & 3) * 16) = v;
            }
            __syncthreads();
            unsigned short kraw[16], qraw[16];
#pragma unroll
            for (int ii = 0; ii < 16; ++ii) {
                const int i = seg * 16 + ii; const size_t row = (size_t)(membase + (dr ? 63 - i : i));
                kraw[ii] = P.KG()[row * 512 + h * 128 + d];
                qraw[ii] = latent ? P.QG()[row * 512 + h * 128 + d] : (unsigned short)0;
            }
            __builtin_amdgcn_sched_barrier(0);
            float war[16];
#pragma unroll
            for (int j = 0; j < 16; ++j) war[j] = ((const LDSAS float*)(lds + GL_WA))[j * 128 + d];
            const float bav = ((const LDSAS float*)(lds + GL_WA))[16 * 128 + d];
            float lb[16]; float run = 0.f;
#pragma unroll
            for (int ii = 0; ii < 16; ++ii) {
                const LDSAS float* rfl = (const LDSAS float*)(lds + GL_RF + (seg * 16 + ii) * 64);
                float z = bav;
#pragma unroll
                for (int j4 = 0; j4 < 4; ++j4) { const f32x4 r = *(const LDSAS f32x4*)(rfl + j4 * 4); z += r[0] * war[j4 * 4] + r[1] * war[j4 * 4 + 1] + r[2] * war[j4 * 4 + 2] + r[3] * war[j4 * 4 + 3]; }
                const float ls = fminf(z, 0.f) - __logf(1.0f + __expf(-fabsf(z)));
                run += ls * (1.0f / 16.0f); lb[ii] = run;
            }
            ((LDSAS float*)(lds + GL_TOT))[seg * 128 + d] = run;
            __syncthreads();
            float prefix = 0.f, total = 0.f;
#pragma unroll
            for (int s2 = 0; s2 < 4; ++s2) { const float tv = ((const LDSAS float*)(lds + GL_TOT))[s2 * 128 + d]; total += tv; if (s2 < seg) prefix += tv; }
            {
                float ktv[16];
                const int dp = ((d & ~15) + pos16(d & 15)) * 2;
#pragma unroll
                for (int ii = 0; ii < 16; ++ii) {
                    const int i = seg * 16 + ii; const float bb = prefix + lb[ii];
                    const float kk = bf2f(kraw[ii]);
                    ktv[pos16(ii)] = kk * __expf(total - bb);
                    if (latent) {
                        const float e = __expf(bb);
                        *(LDSAS bf16_t*)(lds + GL_QD + i * 272 + dp) = (bf16_t)f2bf(bf2f(qraw[ii]) * e);
                        *(LDSAS bf16_t*)(lds + GL_KD + i * 272 + dp) = (bf16_t)f2bf(kk * __builtin_amdgcn_rcpf(e));
                    }
                }
                u32x4 w0, w1;
                w0.x = cvtpk(ktv[0], ktv[1]); w0.y = cvtpk(ktv[2], ktv[3]); w0.z = cvtpk(ktv[4], ktv[5]); w0.w = cvtpk(ktv[6], ktv[7]);
                w1.x = cvtpk(ktv[8], ktv[9]); w1.y = cvtpk(ktv[10], ktv[11]); w1.z = cvtpk(ktv[12], ktv[13]); w1.w = cvtpk(ktv[14], ktv[15]);
                *(LDSAS u32x4*)(lds + GL_KT + d * 144 + seg * 32) = w0;
                *(LDSAS u32x4*)(lds + GL_KT + d * 144 + seg * 32 + 16) = w1;
                if (seg == 0) ((LDSAS float*)(lds + GL_DEC))[d] = __expf(total);
            }
            __syncthreads();
            bf16x8 vf[4];
#define GL_LOADV() do { const LDSAS unsigned char* vbp = lds + GL_V + wid * 4096 + (4 * hi + ((lane & 15) >> 2)) * 64 + ((lane >> 4) & 1) * 32 + (lane & 3) * 8; \
                _Pragma("unroll") for (int js = 0; js < 4; ++js) { const s16x4 lo = vtr(vbp + js * 1024), hh = vtr(vbp + js * 1024 + 512); vf[js] = (bf16x8){lo[0], lo[1], lo[2], lo[3], hh[0], hh[1], hh[2], hh[3]}; } } while (0)
            __builtin_amdgcn_sched_barrier(0);
            if (latent) {
                f32x16 X00 = (f32x16){}, X01 = (f32x16){}, X11 = (f32x16){};
                const LDSAS unsigned char* qb = lds + GL_QD + r32 * 272 + hi * 16;
                const LDSAS unsigned char* kb = lds + GL_KD + r32 * 272 + hi * 16;
#pragma unroll
                for (int s = 0; s < 8; ++s) {
                    const bf16x8 a0 = *(const LDSAS bf16x8*)(kb + s * 32), a1 = *(const LDSAS bf16x8*)(kb + 32 * 272 + s * 32);
                    const bf16x8 b0 = *(const LDSAS bf16x8*)(qb + s * 32), b1 = *(const LDSAS bf16x8*)(qb + 32 * 272 + s * 32);
                    X00 = __builtin_amdgcn_mfma_f32_32x32x16_bf16(a0, b0, X00, 0, 0, 0);
                    X01 = __builtin_amdgcn_mfma_f32_32x32x16_bf16(a0, b1, X01, 0, 0, 0);
                    X11 = __builtin_amdgcn_mfma_f32_32x32x16_bf16(a1, b1, X11, 0, 0, 0);
                    if (s & 1) __builtin_amdgcn_sched_barrier(0);
                }
#pragma unroll
                for (int r = 0; r < 16; ++r) { const bool keep = crow(r, hi) <= r32; X00[r] = keep ? X00[r] : 0.f; X11[r] = keep ? X11[r] : 0.f; }
                const bf16x8 A00a = pack8(X00, 0), A00b = pack8(X00, 8), A01a = pack8(X01, 0), A01b = pack8(X01, 8), A11a = pack8(X11, 0), A11b = pack8(X11, 8);
                __builtin_amdgcn_sched_barrier(0);
                GL_LOADV();
                f32x16 o0 = (f32x16){}, o1 = (f32x16){};
#pragma unroll
                for (int s = 0; s < 8; ++s) {
                    const bf16x8 Sb = pack8(S[s >> 1], (s & 1) * 8);
                    const bf16x8 q0 = *(const LDSAS bf16x8*)(qb + s * 32), q1 = *(const LDSAS bf16x8*)(qb + 32 * 272 + s * 32);
                    o0 = __builtin_amdgcn_mfma_f32_32x32x16_bf16(q0, Sb, o0, 0, 0, 0);
                    o1 = __builtin_amdgcn_mfma_f32_32x32x16_bf16(q1, Sb, o1, 0, 0, 0);
                    if (s & 1) __builtin_amdgcn_sched_barrier(0);
                }
                o0 = __builtin_amdgcn_mfma_f32_32x32x16_bf16(A00a, vf[0], o0, 0, 0, 0); o0 = __builtin_amdgcn_mfma_f32_32x32x16_bf16(A00b, vf[1], o0, 0, 0, 0);
                o1 = __builtin_amdgcn_mfma_f32_32x32x16_bf16(A01a, vf[0], o1, 0, 0, 0); o1 = __builtin_amdgcn_mfma_f32_32x32x16_bf16(A01b, vf[1], o1, 0, 0, 0);
                o1 = __builtin_amdgcn_mfma_f32_32x32x16_bf16(A11a, vf[2], o1, 0, 0, 0); o1 = __builtin_amdgcn_mfma_f32_32x32x16_bf16(A11b, vf[3], o1, 0, 0, 0);
                bf16_t* od = P.OD() + (size_t)dr * ML * 1024 + h * 256 + wid * 32 + r32;
#pragma unroll
                for (int r = 0; r < 16; ++r) {
                    const int i0 = crow(r, hi), i1 = 32 + i0;
                    od[(size_t)(membase + (dr ? 63 - i0 : i0)) * 1024] = (bf16_t)f2bf(o0[r]);
                    od[(size_t)(membase + (dr ? 63 - i1 : i1)) * 1024] = (bf16_t)f2bf(o1[r]);
                }
            } else { GL_LOADV(); }
#undef GL_LOADV
#pragma unroll
            for (int dt = 0; dt < 4; ++dt) {
                __builtin_amdgcn_sched_barrier(0);
#pragma unroll
                for (int g = 0; g < 4; ++g) {
                    const f32x4 dc = *(const LDSAS f32x4*)(lds + GL_DEC + (dt * 32 + 8 * g + 4 * hi) * 4);
                    S[dt][4 * g] *= dc[0]; S[dt][4 * g + 1] *= dc[1]; S[dt][4 * g + 2] *= dc[2]; S[dt][4 * g + 3] *= dc[3];
                }
                const LDSAS unsigned char* ktp = lds + GL_KT + (dt * 32 + r32) * 144 + hi * 16;
#pragma unroll
                for (int is = 0; is < 4; ++is) S[dt] = __builtin_amdgcn_mfma_f32_32x32x16_bf16(*(const LDSAS bf16x8*)(ktp + is * 32), vf[is], S[dt], 0, 0, 0);
            }
        }
    }
}

__device__ __forceinline__ void phase_finish(const Params& P, int vb, int nvb, int g_wave) {
    const int tidx = otid();
    const int lane = tidx & 63, wpb = blockDim.x >> 6, w = tidx >> 6;
    for (int row = vb * wpb + w; row < ML; row += nvb * wpb) {
        const int c0 = lane * 16;
        float v[16];
        const u32x4* pf = (const u32x4*)(P.OD() + (size_t)row * 1024 + c0);
        const u32x4* pb = (const u32x4*)(P.OD() + ((size_t)ML + row) * 1024 + c0);
        float ss = 0.f;
#pragma unroll
        for (int i = 0; i < 2; ++i) {
            const u32x4 a = pf[i], bq = pb[i];
            v[8 * i] = bflo(a.x) + bflo(bq.x); v[8 * i + 1] = bfhi(a.x) + bfhi(bq.x); v[8 * i + 2] = bflo(a.y) + bflo(bq.y); v[8 * i + 3] = bfhi(a.y) + bfhi(bq.y);
            v[8 * i + 4] = bflo(a.z) + bflo(bq.z); v[8 * i + 5] = bfhi(a.z) + bfhi(bq.z); v[8 * i + 6] = bflo(a.w) + bflo(bq.w); v[8 * i + 7] = bfhi(a.w) + bfhi(bq.w);
        }
#pragma unroll
        for (int i = 0; i < 16; ++i) ss += v[i] * v[i];
        ss += __shfl_xor(ss, 1); ss += __shfl_xor(ss, 2); ss += __shfl_xor(ss, 4); ss += __shfl_xor(ss, 8);
        const float rn = rsqrtf(ss * (1.0f / 256.0f) + EPS);
        const float* gn = P.gla_out_norm + (c0 & 255);
        const u32x4* gp = (const u32x4*)(P.GG() + (size_t)row * 1024 + c0);
        u32x4* op = (u32x4*)(P.A2() + (size_t)row * 1024 + c0);
#pragma unroll
        for (int i = 0; i < 2; ++i) {
            const u32x4 g = gp[i]; u32x4 r;
            r.x = pack2(v[8 * i] * rn * gn[8 * i] * bflo(g.x), v[8 * i + 1] * rn * gn[8 * i + 1] * bfhi(g.x));
            r.y = pack2(v[8 * i + 2] * rn * gn[8 * i + 2] * bflo(g.y), v[8 * i + 3] * rn * gn[8 * i + 3] * bfhi(g.y));
            r.z = pack2(v[8 * i + 4] * rn * gn[8 * i + 4] * bflo(g.z), v[8 * i + 5] * rn * gn[8 * i + 5] * bfhi(g.z));
            r.w = pack2(v[8 * i + 6] * rn * gn[8 * i + 6] * bflo(g.w), v[8 * i + 7] * rn * gn[8 * i + 7] * bfhi(g.w));
            op[i] = r;
        }
    }
}

namespace cg = cooperative_groups;
#define XB_TMO      128
#define XB_XCNT(j)  (256  + 64 * (j))
#define XB_XSUB(j)  (1280 + 64 * (j))
#define XB_XGEN(j)  (2304 + 64 * (j))
#define XB_TOP      3328
#define XB_TOPGEN   3392
#define XCD_BAR_WORDS 3456
#define XB_SPIN_CAP (1u << 22)
static_assert(XCD_BAR_WORDS * 4 <= 16384, "barrier words fit their workspace slot");
__device__ __forceinline__ unsigned xb_ld(unsigned* p) { return __hip_atomic_load(p, __ATOMIC_RELAXED, __HIP_MEMORY_SCOPE_AGENT); }
__device__ __forceinline__ unsigned xb_add(unsigned* p, unsigned v) { return __hip_atomic_fetch_add(p, v, __ATOMIC_RELAXED, __HIP_MEMORY_SCOPE_AGENT); }
__device__ __forceinline__ unsigned xb_xcc_id() { return (unsigned)__builtin_amdgcn_s_getreg((3 << 11) | 20) & 0xFu; }
#define XB_SPIN(cond, bar) do { unsigned _sp = 0; while (cond) { __builtin_amdgcn_s_sleep(1); \
    if ((++_sp & 255u) == 0u) { if (xb_ld(&(bar)[XB_TMO])) break; if (_sp > XB_SPIN_CAP) { atomicAdd(&(bar)[XB_TMO], 1u); break; } } } } while (0)
__device__ __forceinline__ void xcd_barrier_complete(unsigned* bar, unsigned x, unsigned G, unsigned& nloc, unsigned& nx) {
    unsigned sum, cnt, mine, sp = 0u;
    for (;;) {
        sum = 0u; cnt = 0u; mine = 0u;
#pragma unroll
        for (unsigned j = 0; j < 16; ++j) { const unsigned c = xb_ld(&bar[XB_XCNT(j)]); sum += c; cnt += (c > 0u) ? 1u : 0u; mine = (j == x) ? c : mine; }
        if (sum == G) break;
        __builtin_amdgcn_s_sleep(1);
        if ((++sp & 255u) == 0u) { if (xb_ld(&bar[XB_TMO])) break; if (sp > XB_SPIN_CAP) { atomicAdd(&bar[XB_TMO], 1u); break; } }
    }
    nloc = mine > 0u ? mine : 1u; nx = cnt > 0u ? cnt : 1u;
}
__device__ __forceinline__ void xcd_barrier(unsigned* bar, volatile LDSAS unsigned* st, unsigned G, int g_wave) {
    asm volatile("s_waitcnt vmcnt(0)" ::: "memory");
    __syncthreads();
    if (g_wave == 0 && lane_id() == 0) {
        const unsigned x = xb_xcc_id();
        __builtin_amdgcn_s_waitcnt(0);
        unsigned nloc = st[0], nx = st[1];
        if (nloc == 0u) { xcd_barrier_complete(bar, x, G, nloc, nx); st[0] = nloc; st[1] = nx; }
        const unsigned old = xb_add(&bar[XB_XSUB(x)], 1u);
        const unsigned gen = old / nloc;
        if (old + 1u == (gen + 1u) * nloc) {
            __builtin_amdgcn_fence(__ATOMIC_RELEASE, "agent");
            asm volatile("s_waitcnt vmcnt(0)" ::: "memory");
            const unsigned og = xb_add(&bar[XB_TOP], 1u);
            const unsigned tg = og / nx;
            if (og + 1u == (tg + 1u) * nx) xb_add(&bar[XB_TOPGEN], 1u);
            else XB_SPIN(xb_ld(&bar[XB_TOPGEN]) == tg, bar);
            __builtin_amdgcn_fence(__ATOMIC_ACQUIRE, "agent");
            xb_add(&bar[XB_XGEN(x)], 1u);
            asm volatile("s_waitcnt vmcnt(0)" ::: "memory");
        } else {
            XB_SPIN(xb_ld(&bar[XB_XGEN(x)]) == gen, bar);
            __builtin_amdgcn_fence(__ATOMIC_ACQUIRE, "agent");
            asm volatile("s_waitcnt vmcnt(0)" ::: "memory");
        }
    }
    __syncthreads();
}

#define GRID_BAR() xcd_barrier((unsigned*)(ldparams().ws + OFF_BAR), (volatile LDSAS unsigned*)(lds + pg8::STAGE_BYTES), (unsigned)nvb, g_wave)
#define REPEAT(k, ...) { const Params P = ldparams(); __VA_ARGS__ }
__global__ void __launch_bounds__(512) mega_kernel(Params Pk) {
    __shared__ __attribute__((aligned(16))) unsigned char lds[pg8::STAGE_BYTES + 16];
    const int vb = blockIdx.x, nvb = gridDim.x;
    const int g_wave = __builtin_amdgcn_readfirstlane((int)(threadIdx.x >> 6));
    if (threadIdx.x == 0) {
        ((volatile LDSAS unsigned*)(lds + pg8::STAGE_BYTES))[0] = 0u; ((volatile LDSAS unsigned*)(lds + pg8::STAGE_BYTES))[1] = 0u;
        (void)xb_add(&((unsigned*)(Pk.ws + OFF_BAR))[XB_XCNT(xb_xcc_id())], 1u);
    }
    REPEAT(0, phase_pro0(P, lds, vb, nvb, g_wave);)
    cg::this_grid().sync();
    REPEAT(1, phase_bias(P, lds, vb, nvb, g_wave); phase_a0(P, vb, nvb, g_wave);)
    GRID_BAR();
    REPEAT(2, EpiIn0 E{P.ws, 1, P.a_q_norm, P.a_k_norm, P.b_q_norm, P.b_k_norm};
      pg8::Gemm g{P.A(), P.Wt0(), M, N0, D}; pg8::StaticOrder S; S.init(M, N0, nvb, vb); pg8::gemm_phase<EpiIn0, pg8::StaticOrder, true, true>((LDSAS unsigned char*)lds, g, S, E, g_wave);)
    GRID_BAR();
    REPEAT(3, phase_attnA_mfma(P, (LDSAS unsigned char*)lds, vb, nvb, g_wave);)
    REPEAT(4, phase_attnB_mfma(P, (LDSAS unsigned char*)lds, vb, nvb, g_wave);)
    GRID_BAR();
    REPEAT(5, EpiOut0 E{P.x, P.ctx, P.norm_g + D, P.out, P.ws};
      pg8::Gemm g{P.O(), P.Wo0(), M, D, D}; pg8::StaticOrder S; S.init(M, D, nvb, vb); pg8::gemm_phase<EpiOut0, pg8::StaticOrder, true, true>((LDSAS unsigned char*)lds, g, S, E, g_wave);)
    GRID_BAR();
    REPEAT(6, EpiIn1 E{P.ws, 16};
      pg8::Gemm g{P.A(), P.Wt1(), M, N1, D}; pg8::StaticOrder S; S.init(M, N1, nvb, vb); pg8::gemm_phase<EpiIn1, pg8::StaticOrder, true, true>((LDSAS unsigned char*)lds, g, S, E, g_wave);)
    GRID_BAR();
    REPEAT(7, phase_gla_mfma(P, (LDSAS unsigned char*)lds, vb, nvb, g_wave);)
    GRID_BAR();
    REPEAT(8, phase_finish(P, vb, nvb, g_wave);)
    GRID_BAR();
    { const Params P = ldparams();
      EpiOut1 E{P.ws, P.out};
      pg8::Gemm g{P.A2(), P.Wo1(), ML, D, D}; pg8::StaticOrder S; S.init(ML, D, nvb, vb); pg8::gemm_phase<EpiOut1, pg8::StaticOrder, true, true>((LDSAS unsigned char*)lds, g, S, E, g_wave); }
}
}

extern "C" void kernel_launch(void* const* d_in, const int* in_sizes, int n_in, void* d_out, int out_size, void* d_ws, size_t ws_size, hipStream_t stream) {
    Params P{};
    const float* const* in = (const float* const*)d_in;
    P.x = in[0]; P.c = in[1]; P.ctx = in[2]; P.c_ctx = in[3]; P.adaln_w = in[4]; P.adaln_b = in[5]; P.norm_g = in[6]; P.w_out = in[7]; P.ab_w_in = in[8];
    P.a_q_norm = in[9]; P.a_k_norm = in[10]; P.a_sink = in[11]; P.b_q_norm = in[12]; P.b_k_norm = in[13]; P.lq1 = in[14]; P.lk1 = in[15]; P.lq2 = in[16]; P.lk2 = in[17];
    P.b_subln = in[18]; P.gla_w_in = in[19]; P.wa_f = in[20]; P.ba_f = in[21]; P.wa_b = in[22]; P.ba_b = in[23]; P.gla_out_norm = in[24];
    P.out = (float*)d_out;
    P.ws = (unsigned char*)d_ws;
    for (int i = 0; i < 12; ++i) P.reps[i] = 1;
#ifdef PROBE_PHASE
    P.reps[PROBE_PHASE] = 2;
#endif
    if (WS_NEED > ws_size) { fprintf(stderr, "workspace too small: need %zu have %zu\n", (size_t)WS_NEED, ws_size); return; }
    static int grid_blocks = 0;
    if (!grid_blocks) {
        int dev = 0, cus = 0, per_cu = 0;
        (void)hipGetDevice(&dev);
        (void)hipDeviceGetAttribute(&cus, hipDeviceAttributeMultiprocessorCount, dev);
        (void)hipOccupancyMaxActiveBlocksPerMultiprocessor(&per_cu, mega_kernel, 512, 0);
        if (per_cu > 1) per_cu = 1;
        grid_blocks = cus * per_cu;
    }
    (void)hipMemsetAsync((unsigned char*)d_ws + OFF_BAR, 0, 16384, stream);
    void* args[] = {&P};
    hipError_t e = hipLaunchCooperativeKernel((void*)mega_kernel, dim3(grid_blocks), dim3(512), args, 0, stream);
    if (e != hipSuccess) fprintf(stderr, "cooperative launch failed: %s (grid %d)\n", hipGetErrorString(e), grid_blocks);
}
```

```cpp
#include <hip/hip_runtime.h>
#include <hip/hip_cooperative_groups.h>
#include <cstdint>
#include <cstdio>

namespace {
constexpr int NB = 32, T = 2048, L = 256, D = 1024;
constexpr int ML = NB * T, MC = NB * L, M = ML + MC;
constexpr int N0 = 3328, N1 = 3328, N0R = 3328, N1R = 3104;
constexpr float EPS = 1e-6f;
constexpr float LOG2E = 1.4426950408889634f;
constexpr float QSCALE = 0.125f * LOG2E;
constexpr float LAMBDA_INIT = 0.2f;

typedef unsigned short bf16_t;
typedef short bf16x8 __attribute__((ext_vector_type(8)));
typedef float f32x4 __attribute__((ext_vector_type(4)));
typedef unsigned u32x4 __attribute__((ext_vector_type(4)));
typedef unsigned u32x2 __attribute__((ext_vector_type(2)));

constexpr size_t al256(size_t x) { return (x + 255) & ~(size_t)255; }
constexpr size_t OFF_WT0 = 0;
constexpr size_t OFF_WT1 = OFF_WT0 + al256((size_t)N0 * D * 2);
constexpr size_t OFF_WO0 = OFF_WT1 + al256((size_t)N1 * D * 2);
constexpr size_t OFF_WO1 = OFF_WO0 + al256((size_t)D * D * 2);
constexpr size_t OFF_MOD = OFF_WO1 + al256((size_t)D * D * 2);
constexpr size_t OFF_BIAS0 = OFF_MOD + al256((size_t)2 * 33 * 3072 * 4);
constexpr size_t OFF_BIAS1 = OFF_BIAS0 + al256((size_t)33 * 3328 * 4);
constexpr size_t OFF_ROPE = OFF_BIAS1 + al256((size_t)33 * 3328 * 4);
constexpr size_t OFF_SCAL = OFF_ROPE + al256(64 * 16 * 2 * 4);
constexpr size_t OFF_BAR = OFF_SCAL + 256;
constexpr size_t OFF_RS = OFF_BAR + 16384;
constexpr size_t OFF_PARTS = OFF_RS + al256((size_t)M * 4);
constexpr size_t OFF_A = OFF_PARTS + al256((size_t)16 * M * 4);
constexpr size_t OFF_O = OFF_A + (size_t)M * D * 2;
constexpr size_t OFF_QKV = OFF_O + (size_t)M * D * 2;
constexpr size_t OFF_X1B = OFF_QKV + (size_t)M * 3328 * 2;
constexpr size_t WS_NEED = OFF_X1B + (size_t)ML * D * 2;
constexpr size_t OFF_QA = OFF_QKV, OFF_KA = OFF_QA + (size_t)M * 512 * 2, OFF_VA = OFF_KA + (size_t)M * 128 * 2, OFF_GA = OFF_VA + (size_t)M * 128 * 2;
constexpr size_t OFF_QB = OFF_GA + (size_t)M * 512 * 2, OFF_KB = OFF_QB + (size_t)M * 512 * 2, OFF_VB = OFF_KB + (size_t)M * 512 * 2, OFF_GB = OFF_VB + (size_t)M * 512 * 2;
constexpr size_t OFF_QG = OFF_QKV, OFF_KG = OFF_QG + (size_t)M * 512 * 2, OFF_VG = OFF_KG + (size_t)M * 512 * 2, OFF_GG = OFF_VG + (size_t)M * 1024 * 2, OFF_RF = OFF_GG + (size_t)M * 1024 * 2;
static_assert(OFF_RF + (size_t)M * 32 * 4 <= WS_NEED, "layer-1 projections fit");
static_assert((size_t)2 * ML * 1024 * 2 <= (size_t)2 * M * D * 2, "OD fits over A + O");

struct Params {
    const float *x, *c, *ctx, *c_ctx, *adaln_w, *adaln_b, *norm_g, *w_out, *ab_w_in, *a_q_norm, *a_k_norm, *a_sink, *b_q_norm, *b_k_norm;
    const float *lq1, *lk1, *lq2, *lk2, *b_subln, *gla_w_in, *wa_f, *ba_f, *wa_b, *ba_b, *gla_out_norm;
    float* out;
    unsigned char* ws;
    int reps[12];
#define WSPTR(T, name, off) __device__ __forceinline__ T* name() const { return (T*)(ws + (off)); }
    WSPTR(bf16_t, Wt0, OFF_WT0) WSPTR(bf16_t, Wt1, OFF_WT1) WSPTR(bf16_t, Wo0, OFF_WO0) WSPTR(bf16_t, Wo1, OFF_WO1)
    WSPTR(float, mod, OFF_MOD) WSPTR(float, bias0, OFF_BIAS0) WSPTR(float, bias1, OFF_BIAS1) WSPTR(float, rope, OFF_ROPE) WSPTR(float, scal, OFF_SCAL) WSPTR(float, parts, OFF_PARTS)
    WSPTR(bf16_t, A, OFF_A) WSPTR(bf16_t, O, OFF_O)
    WSPTR(bf16_t, QA, OFF_QA) WSPTR(bf16_t, KA, OFF_KA) WSPTR(bf16_t, VA, OFF_VA) WSPTR(bf16_t, GA, OFF_GA)
    WSPTR(bf16_t, QB, OFF_QB) WSPTR(bf16_t, KB, OFF_KB) WSPTR(bf16_t, VB, OFF_VB) WSPTR(bf16_t, GB, OFF_GB)
    WSPTR(bf16_t, QG, OFF_QG) WSPTR(bf16_t, KG, OFF_KG) WSPTR(bf16_t, VG, OFF_VG) WSPTR(bf16_t, GG, OFF_GG) WSPTR(float, RF, OFF_RF)
    WSPTR(bf16_t, OD, OFF_A) WSPTR(bf16_t, A2, OFF_QKV)
#undef WSPTR
};

__device__ __forceinline__ int lane_id() { int l; asm volatile("v_mbcnt_lo_u32_b32 %0, -1, 0\n\tv_mbcnt_hi_u32_b32 %0, -1, %0" : "=v"(l)); return l; }
#define otid() otid_(g_wave)
__device__ __forceinline__ int otid_(int wave) { int t = wave * 64 + lane_id(); asm volatile("" : "+v"(t)); return t; }
__device__ __forceinline__ unsigned f2bf(float f) { unsigned u = __float_as_uint(f); u += 0x7FFFu + ((u >> 16) & 1u); return u >> 16; }
__device__ __forceinline__ unsigned pack2(float lo, float hi) { return f2bf(lo) | (f2bf(hi) << 16); }
typedef float f32x2_t __attribute__((ext_vector_type(2)));
typedef __bf16 bf16x2_t __attribute__((ext_vector_type(2)));
__device__ __forceinline__ unsigned cvtpk(float lo, float hi) { f32x2_t v = {lo, hi}; bf16x2_t b = __builtin_convertvector(v, bf16x2_t); return __builtin_bit_cast(unsigned, b); }
__device__ __forceinline__ float bf2f(unsigned h) { return __uint_as_float(h << 16); }
__device__ __forceinline__ float bflo(unsigned w) { return __uint_as_float(w << 16); }
__device__ __forceinline__ float bfhi(unsigned w) { return __uint_as_float(w & 0xFFFF0000u); }
__device__ __forceinline__ float sum_xor16(float x) { const auto r = __builtin_amdgcn_permlane16_swap(__float_as_uint(x), __float_as_uint(x), false, false); return __uint_as_float(r[0]) + __uint_as_float(r[1]); }
__device__ __forceinline__ float sum_xor32(float x) { const auto r = __builtin_amdgcn_permlane32_swap(__float_as_uint(x), __float_as_uint(x), false, false); return __uint_as_float(r[0]) + __uint_as_float(r[1]); }
__device__ __forceinline__ float siluf(float v) { return v * __builtin_amdgcn_rcpf(1.0f + __builtin_amdgcn_exp2f(-v * LOG2E)); }

__device__ __forceinline__ Params ldparams() {
#if defined(__HIP_DEVICE_COMPILE__)
    const __attribute__((address_space(4))) Params* pp = (const __attribute__((address_space(4))) Params*)__builtin_amdgcn_kernarg_segment_ptr();
    asm volatile("" : "+s"(pp));
    return *pp;
#else
    return Params{};
#endif
}

__device__ __forceinline__ int perm_local(int p, bool ropeType) {
    const int bj = p >> 7, wc = (p >> 5) & 3, low = p & 31;
    if (ropeType) return wc * 64 + bj * 32 + low;
    const int n = (low >> 4) & 1, fq = (low >> 2) & 3, e = low & 3;
    return wc * 64 + bj * 32 + fq * 8 + n * 4 + e;
}
__device__ __forceinline__ int src_col(int which, int np) {
    const int p = np & 255, tile = np >> 8;
    bool rope = false;
    if (which == 0) { const int g = tile * 4 + ((p >> 5) & 3); rope = (g < 10) || (g >= 20 && g < 36); }
    const int c = tile * 256 + perm_local(p, rope);
    const int nreal = which == 0 ? N0R : (which == 1 ? N1R : D);
    return c < nreal ? c : -1;
}

__device__ __forceinline__ int dst_row(int which, int c) {
    const int tile = c >> 8, cl = c & 255, wc = cl >> 6, bj = (cl >> 5) & 1, low = cl & 31;
    bool rope = false;
    if (which == 0) { const int g = tile * 4 + wc; rope = (g < 10) || (g >= 20 && g < 36); }
    int lo5 = low;
    if (!rope) { const int fq = low >> 3, n = (low >> 2) & 1, e = low & 3; lo5 = n * 16 + fq * 4 + e; }
    return tile * 256 + bj * 128 + wc * 32 + lo5;
}

__device__ __forceinline__ void wt_quad(const float* __restrict__ W, int ldw, int nreal, int which, bf16_t* __restrict__ dst, int c0, int k0, unsigned char* lds, int tid) {
    bf16_t* t = (bf16_t*)lds;
    __syncthreads();
    f32x4 v[8];
#pragma unroll
    for (int i = 0; i < 8; ++i) {
        const int idx = tid + 512 * i, r = idx >> 4, c4 = (idx & 15) * 4;
        const bool ok = c0 + c4 < nreal;
        const f32x4 t4 = *(const f32x4*)(W + (size_t)(k0 + r) * ldw + (ok ? c0 + c4 : 0));
        v[i] = ok ? t4 : (f32x4){0.f, 0.f, 0.f, 0.f};
    }
#pragma unroll
    for (int i = 0; i < 8; ++i) {
        const int idx = tid + 512 * i, r = idx >> 4, c4 = (idx & 15) * 4;
#pragma unroll
        for (int j = 0; j < 4; ++j) t[(c4 + j) * 264 + r] = (bf16_t)f2bf(v[i][j]);
    }
    __syncthreads();
    const int c = tid >> 3, kc = tid & 7;
    bf16_t* drow = dst + (size_t)dst_row(which, c0 + c) * D + k0 + kc * 32;
#pragma unroll
    for (int j = 0; j < 4; ++j) *(u32x4*)(drow + j * 8) = *(const u32x4*)(t + c * 264 + kc * 32 + j * 8);
}

template <int MODE>
__device__ __forceinline__ void skinny_unit(const Params& P, int l, int c0, unsigned char* lds, int tid) {
    float* tab = (float*)lds;
    const int lane = tid & 63, w = tid >> 6;
    const float* W; int ldw, nreal;
    if (MODE == 0) { W = P.adaln_w + (size_t)l * D * 3072; ldw = 3072; nreal = 3072; }
    else { W = l ? P.gla_w_in : P.ab_w_in; ldw = l ? N1R : N0R; nreal = ldw; }
    const bool colok = c0 + lane < nreal;
    float acc[33];
#pragma unroll
    for (int r = 0; r < 33; ++r) acc[r] = 0.f;
    for (int half = 0; half < 2; ++half) {
        __syncthreads();
        for (int r = 0; r < 33; ++r) {
            float v;
            if (MODE == 0) v = siluf(r < 32 ? P.c[r * D + half * 512 + tid] : P.c_ctx[half * 512 + tid]);
            else v = P.mod()[((size_t)l * 33 + r) * 3072 + half * 512 + tid];
            tab[tid * 36 + r] = v;
        }
        __syncthreads();
        const float* wp = W + (size_t)(half * 512 + w * 64) * ldw + (colok ? c0 + lane : 0);
        float wn[4];
#pragma unroll
        for (int j = 0; j < 4; ++j) wn[j] = wp[(size_t)j * ldw];
#pragma unroll 1
        for (int kk = 0; kk < 64; kk += 4) {
            float wc[4];
#pragma unroll
            for (int j = 0; j < 4; ++j) wc[j] = colok ? wn[j] : 0.f;
            const int kn = kk + 4 < 64 ? kk + 4 : 60;
#pragma unroll
            for (int j = 0; j < 4; ++j) wn[j] = wp[(size_t)(kn + j) * ldw];
#pragma unroll
            for (int j = 0; j < 4; ++j) {
                const int k = w * 64 + kk + j; const float wv = wc[j];
#pragma unroll
                for (int r4 = 0; r4 < 8; ++r4) { const f32x4 s = *(const f32x4*)(tab + k * 36 + r4 * 4); acc[r4 * 4] += s[0] * wv; acc[r4 * 4 + 1] += s[1] * wv; acc[r4 * 4 + 2] += s[2] * wv; acc[r4 * 4 + 3] += s[3] * wv; }
                acc[32] += tab[k * 36 + 32] * wv;
            }
        }
    }
    __syncthreads();
#pragma unroll
    for (int r = 0; r < 33; ++r) tab[(w * 33 + r) * 64 + lane] = acc[r];
    __syncthreads();
    for (int idx = tid; idx < 33 * 64; idx += 512) {
        const int r = idx >> 6, col = idx & 63;
        float s = 0.f;
#pragma unroll
        for (int ww = 0; ww < 8; ++ww) s += tab[(ww * 33 + r) * 64 + col];
        if (MODE == 0) { const int j = c0 + col; P.mod()[((size_t)l * 33 + r) * 3072 + j] = s + P.adaln_b[l * 3072 + j]; }
        else { const int c = c0 + col; (l ? P.bias1() : P.bias0())[r * 3328 + dst_row(l, c)] = c < nreal ? s : 0.f; }
    }
}

constexpr int TICKET_LDS = 140288 + 8;
#define TICKET_LOOP(ctr, N, ...) { volatile int* sh_ = (volatile int*)(lds + TICKET_LDS); unsigned* ctr_ = (unsigned*)(P.ws + OFF_BAR + 14336) + (ctr) * 16; \
        __syncthreads(); if (tidx == 0) *sh_ = (int)__hip_atomic_fetch_add(ctr_, 1u, __ATOMIC_RELAXED, __HIP_MEMORY_SCOPE_AGENT); __syncthreads(); \
        int item = *sh_; \
        while (item < (N)) { unsigned nx_ = 0; if (tidx == 0) nx_ = __hip_atomic_fetch_add(ctr_, 1u, __ATOMIC_RELAXED, __HIP_MEMORY_SCOPE_AGENT); \
            __VA_ARGS__ \
            __syncthreads(); if (tidx == 0) *sh_ = (int)nx_; __syncthreads(); item = *sh_; } }

__device__ __forceinline__ void phase_pro0(const Params& P, unsigned char* lds, int vb, int nvb, int g_wave) {
    const int tidx = otid();
    TICKET_LOOP(0, 96 + 544,
        if (item < 96) skinny_unit<0>(P, item / 48, (item % 48) * 64, lds, tidx);
        else {
            int t = item - 96; int which; const float* W; bf16_t* dst; int ldw, nreal;
            if (t < 208) { which = 0; W = P.ab_w_in; dst = P.Wt0(); ldw = N0R; nreal = N0R; }
            else if ((t -= 208) < 208) { which = 1; W = P.gla_w_in; dst = P.Wt1(); ldw = N1R; nreal = N1R; }
            else if ((t -= 208) < 64) { which = 2; W = P.w_out; dst = P.Wo0(); ldw = D; nreal = D; }
            else { t -= 64; which = 3; W = P.w_out + (size_t)D * D; dst = P.Wo1(); ldw = D; nreal = D; }
            wt_quad(W, ldw, nreal, which, dst, (t >> 2) * 64, (t & 3) * 256, lds, tidx);
        })
    if (vb == nvb - 1 && tidx == 0) {
        float d1 = 0.f, d2 = 0.f;
        for (int i = 0; i < 64; ++i) { d1 += P.lq1[i] * P.lk1[i]; d2 += P.lq2[i] * P.lk2[i]; }
        P.scal()[0] = expf(d1) - expf(d2) + LAMBDA_INIT;
    }
}

__device__ __forceinline__ void a0_row(const Params& P, int row, int lane) {
    const float* xin = row < ML ? P.x + (size_t)row * D : P.ctx + (size_t)(row - ML) * D;
    const int r = row < ML ? row >> 11 : 32;
    const float* sc = P.mod() + (size_t)r * 3072 + 1024;
    float ss = 0.f;
    f32x4 a[2], b[2], g0[2], g1[2], s0[2], s1[2];
#pragma unroll
    for (int i = 0; i < 2; ++i) {
        const int c0 = i * 512 + lane * 8;
        a[i] = *(const f32x4*)(xin + c0); b[i] = *(const f32x4*)(xin + c0 + 4);
        g0[i] = *(const f32x4*)(P.norm_g + c0); g1[i] = *(const f32x4*)(P.norm_g + c0 + 4);
        s0[i] = *(const f32x4*)(sc + c0); s1[i] = *(const f32x4*)(sc + c0 + 4);
    }
#pragma unroll
    for (int i = 0; i < 2; ++i) {
        const int c0 = i * 512 + lane * 8;
        ss += a[i][0] * a[i][0] + a[i][1] * a[i][1] + a[i][2] * a[i][2] + a[i][3] * a[i][3] + b[i][0] * b[i][0] + b[i][1] * b[i][1] + b[i][2] * b[i][2] + b[i][3] * b[i][3];
        const f32x4 ya = a[i] * g0[i] * (1.0f + s0[i]), yb = b[i] * g1[i] * (1.0f + s1[i]);
        u32x4 o; o.x = cvtpk(ya[0], ya[1]); o.y = cvtpk(ya[2], ya[3]); o.z = cvtpk(yb[0], yb[1]); o.w = cvtpk(yb[2], yb[3]);
        *(u32x4*)(P.A() + (size_t)row * D + c0) = o;
    }
    ss = sum_xor32(ss); ss = sum_xor16(ss);
#pragma unroll
    for (int o = 8; o >= 1; o >>= 1) ss += __shfl_xor(ss, o);
    if (lane == 0) ((float*)(P.ws + OFF_RS))[row] = rsqrtf(ss * (1.0f / 1024.0f) + EPS);
}

__device__ __forceinline__ void phase_bias_a0(const Params& P, unsigned char* lds, int vb, int nvb, int g_wave) {
    const int tidx = otid();
    const int lane = tidx & 63, w = tidx >> 6;
    TICKET_LOOP(1, 104 + M / 32,
        if (item < 104) skinny_unit<1>(P, item / 52, (item % 52) * 64, lds, tidx);
        else {
            const int row0 = (item - 104) * 32 + w * 4;
            for (int j = 0; j < 4; ++j) a0_row(P, row0 + j, lane);
        })
}

namespace pg8 {
#define PG8_LAS __attribute__((address_space(3)))
typedef unsigned short bf16_t;
typedef short bf16x8 __attribute__((ext_vector_type(8)));
typedef float f32x4 __attribute__((ext_vector_type(4)));
typedef unsigned u32x4 __attribute__((ext_vector_type(4)));
constexpr int BM = 256, BK = 64, HALF = 128, HTB = HALF * BK * 2  , STAGE_BYTES = 8 * HTB, NXCD = 8, WGM = 8;

__host__ __device__ __forceinline__ int lds_byte(int r, int c) { const int st = (r >> 4) * 2 + (c >> 5), rr = r & 15, cc = c & 31, ob = rr * 64 + cc * 2; return st * 1024 + (ob ^ (((ob >> 9) & 1) << 5)); }
__host__ __device__ __forceinline__ void stage_rc(int b, int& R, int& C) { const int st = b / 1024, sb = b % 1024, swz = sb ^ (((sb >> 9) & 1) << 5); R = (st >> 1) * 16 + swz / 64; C = (st & 1) * 32 + (swz % 64) / 2; }
__host__ __device__ __forceinline__ int perm32(int rho) { const int n = rho >> 4, i = rho & 15; return 8 * (i >> 2) + 4 * n + (i & 3); }

struct Unit { int pm, pn; };
struct Gemm { const bf16_t* A; const bf16_t* Bt; int M, N, K; };

struct StaticOrder {
    int nM, nN, nwg, G, c;
    __host__ __device__ void init(int M, int N, int G_, int c_) { nM = M / BM; nN = N / BM; nwg = nM * nN; G = G_; c = c_; }
    __host__ __device__ bool next(int i, Unit& u) const {
        const long L = (long)i * G + c; if (L >= nwg) return false;
        int wgid = (int)L; { const int q = nwg / NXCD, r = nwg % NXCD, xcd = wgid % NXCD, off = wgid / NXCD; wgid = (xcd < r ? xcd * (q + 1) : r * (q + 1) + (xcd - r) * q) + off; }
        const int nig = WGM * nN, gid = wgid / nig, fm = gid * WGM, gsz = (nM - fm) < WGM ? (nM - fm) : WGM;
        u.pm = fm + ((wgid % nig) % gsz); u.pn = (wgid % nig) / gsz; return true;
    }
    __device__ __forceinline__ void a_ready(const Unit&) const {}
    __device__ __forceinline__ void done(const Unit&) const {}
    static constexpr bool HALFN = false;
    __device__ __forceinline__ bool bhalf(const Unit&) const { return false; }
};
template <class Epi, class Sched, bool ALIGN_EPI = false, bool SP2 = false>
__device__ __forceinline__ void gemm_phase(PG8_LAS unsigned char* lds, const Gemm g, const Sched& S, const Epi& E, int g_wave) {
    const int tid = otid(), wid = __builtin_amdgcn_readfirstlane(tid >> 6), lane = tid & 63, wr = wid >> 2, wc = wid & 3, fr = lane & 15, fq = lane >> 4;
    const int K = g.K, nt = K / BK;
    unsigned voffA[2], voffB[2];
#pragma unroll
    for (int i = 0; i < 2; ++i) { int R, C; stage_rc(tid * 16 + i * 8192, R, C); const int Rb = Epi::PERM ? ((R & ~31) + perm32(R & 31)) : R;
        voffA[i] = (unsigned)(R * K + C) * 2u; voffB[i] = (unsigned)(Rb * K + C) * 2u; }
    const size_t kstep = (size_t)(BK * 2);
    const size_t hstep = (size_t)HALF * K * 2;
    const size_t tstep = 2 * hstep;
    const unsigned ldsw = (unsigned)wid * 1024u;
    const int aoff = lds_byte(wr * 64 + fr, fq * 8), boff = lds_byte(wc * 32 + fr, fq * 8);
#define PG8_SA(b, h) (((b) * 2 + (h)) * HTB)
#define PG8_SB(b, h) ((4 + (b) * 2 + (h)) * HTB)
#define PG8_STAGE(bufoff, gbase, voff) do { _Pragma("unroll") for (int _i = 0; _i < 2; ++_i) \
        __builtin_amdgcn_global_load_lds((const unsigned*)((const char*)(gbase) + (voff)[_i]), (PG8_LAS unsigned*)(lds + (bufoff) + ldsw + _i * 8192), 16, 0, 0); } while (0)
#define PG8_LDA(dst, b, h) do { _Pragma("unroll") for (int m = 0; m < 4; ++m) _Pragma("unroll") for (int k = 0; k < 2; ++k) dst[m][k] = *(const PG8_LAS bf16x8*)(lds + PG8_SA(b, h) + aoff + m * 2048 + k * 1024); } while (0)
#define PG8_LDB(dst, b, h) do { _Pragma("unroll") for (int n = 0; n < 2; ++n) _Pragma("unroll") for (int k = 0; k < 2; ++k) dst[n][k] = *(const PG8_LAS bf16x8*)(lds + PG8_SB(b, h) + boff + n * 2048 + k * 1024); } while (0)
#define PG8_MMA(ai, bj, At, Bt) do { __builtin_amdgcn_s_setprio(1); _Pragma("unroll") for (int m = 0; m < 4; ++m) _Pragma("unroll") for (int n = 0; n < 2; ++n) _Pragma("unroll") for (int k = 0; k < 2; ++k) \
        acc[ai][bj][m][n] = __builtin_amdgcn_mfma_f32_16x16x32_bf16(Bt[n][k], At[m][k], acc[ai][bj][m][n], 0, 0, 0); __builtin_amdgcn_s_setprio(0); } while (0)
#define PG8_WAIT_V(n) asm volatile("s_waitcnt vmcnt(" #n ")" ::: "memory")
#define PG8_WAIT_L(n) asm volatile("s_waitcnt lgkmcnt(" #n ")" ::: "memory")
#define PG8_BAR __builtin_amdgcn_s_barrier()
#define PG8_SCHED __builtin_amdgcn_sched_barrier(0)
    Unit cur, nxt; int ui = 0;
    if (!S.next(0, cur)) return;
    f32x4 acc[2][2][4][2];
#pragma unroll
    for (int a = 0; a < 2; ++a)
#pragma unroll
        for (int b = 0; b < 2; ++b)
#pragma unroll
            for (int m = 0; m < 4; ++m)
#pragma unroll
                for (int n = 0; n < 2; ++n) acc[a][b][m][n] = (f32x4){0.f, 0.f, 0.f, 0.f};
    bf16x8 At[4][2], B0[2][2], B1[2][2];
    const char* cA = (const char*)g.A + (size_t)cur.pm * tstep; const char* cB = (const char*)g.Bt + (size_t)cur.pn * tstep;
    S.a_ready(cur);
    if constexpr (SP2) {
        PG8_STAGE(PG8_SB(0, 0), cB, voffB); PG8_STAGE(PG8_SB(0, 1), cB + hstep, voffB); PG8_STAGE(PG8_SA(0, 0), cA, voffA); PG8_STAGE(PG8_SA(0, 1), cA + hstep, voffA);
        if (wr == 1) PG8_BAR;
        PG8_WAIT_V(2); PG8_BAR;
        PG8_STAGE(PG8_SB(1, 0), cB + kstep, voffB); PG8_STAGE(PG8_SA(1, 0), cA + kstep, voffA); PG8_STAGE(PG8_SB(1, 1), cB + hstep + kstep, voffB);
        PG8_WAIT_V(6); PG8_BAR;
    } else {
        PG8_STAGE(PG8_SB(0, 0), cB, voffB); PG8_STAGE(PG8_SA(0, 0), cA, voffA); PG8_STAGE(PG8_SB(0, 1), cB + hstep, voffB); PG8_STAGE(PG8_SA(0, 1), cA + hstep, voffA);
        if (wr == 1) PG8_BAR;
        PG8_WAIT_V(4); PG8_BAR;
        PG8_STAGE(PG8_SB(1, 0), cB + kstep, voffB); PG8_STAGE(PG8_SA(1, 0), cA + kstep, voffA); PG8_STAGE(PG8_SB(1, 1), cB + hstep + kstep, voffB);
        PG8_WAIT_V(6); PG8_BAR;
    }
    for (;;) {
        const bool has_next = S.next(ui + 1, nxt);
        const char* nA = has_next ? (const char*)g.A + (size_t)nxt.pm * tstep : cA; const char* nB = has_next ? (const char*)g.Bt + (size_t)nxt.pn * tstep : cB;
        const bool fullN = Sched::HALFN ? !S.bhalf(cur) : true;
        for (int t = 0; t < nt; t += 2) {
            const bool last = (t == nt - 2);
            const char* a1 = cA + (size_t)(t + 1) * kstep;
            const char* a2 = last ? nA : cA + (size_t)(t + 2) * kstep; const char* b2 = last ? nB : cB + (size_t)(t + 2) * kstep;
            const char* a3 = a2 + kstep; const char* b3 = b2 + kstep;
            if (last && has_next) S.a_ready(nxt);
            if constexpr (SP2) {
            PG8_LDB(B0, 0, 0); PG8_LDB(B1, 0, 1); PG8_SCHED; PG8_LDA(At, 0, 0); PG8_STAGE(PG8_SA(1, 1), a1 + hstep, voffA);
            PG8_WAIT_V(8); PG8_WAIT_L(0); PG8_BAR; PG8_MMA(0, 0, At, B0); if (!Sched::HALFN || fullN) PG8_MMA(0, 1, At, B1); PG8_BAR; PG8_SCHED;
            PG8_LDA(At, 0, 1); PG8_STAGE(PG8_SB(0, 0), b2, voffB); PG8_STAGE(PG8_SB(0, 1), b2 + hstep, voffB); PG8_STAGE(PG8_SA(0, 0), a2, voffA);
            PG8_WAIT_V(8); PG8_WAIT_L(0); PG8_BAR; PG8_MMA(1, 0, At, B0); if (!Sched::HALFN || fullN) PG8_MMA(1, 1, At, B1); PG8_BAR; PG8_SCHED;
            PG8_LDB(B0, 1, 0); PG8_LDB(B1, 1, 1); PG8_SCHED; PG8_LDA(At, 1, 0); PG8_STAGE(PG8_SA(0, 1), a2 + hstep, voffA);
            PG8_WAIT_V(8); PG8_WAIT_L(0); PG8_BAR; PG8_MMA(0, 0, At, B0); if (!Sched::HALFN || fullN) PG8_MMA(0, 1, At, B1); PG8_BAR; PG8_SCHED;
            PG8_LDA(At, 1, 1); PG8_STAGE(PG8_SB(1, 0), b3, voffB); PG8_STAGE(PG8_SB(1, 1), b3 + hstep, voffB); PG8_STAGE(PG8_SA(1, 0), a3, voffA);
            PG8_WAIT_V(8); PG8_WAIT_L(0); PG8_BAR; PG8_MMA(1, 0, At, B0); if (!Sched::HALFN || fullN) PG8_MMA(1, 1, At, B1); PG8_BAR; PG8_SCHED;
            } else {
            PG8_LDB(B0, 0, 0); PG8_SCHED; PG8_LDA(At, 0, 0); PG8_STAGE(PG8_SA(1, 1), a1 + hstep, voffA);
            PG8_WAIT_L(8); PG8_BAR; PG8_WAIT_L(0); PG8_MMA(0, 0, At, B0); PG8_BAR; PG8_SCHED;
            PG8_LDB(B1, 0, 1); PG8_STAGE(PG8_SB(0, 0), b2, voffB);
            PG8_BAR; PG8_WAIT_L(0); PG8_MMA(0, 1, At, B1); PG8_BAR;
            PG8_LDA(At, 0, 1); PG8_STAGE(PG8_SA(0, 0), a2, voffA);
            PG8_BAR; PG8_WAIT_L(0); PG8_MMA(1, 0, At, B0); PG8_BAR; PG8_SCHED;
            PG8_STAGE(PG8_SB(0, 1), b2 + hstep, voffB);
            PG8_WAIT_V(6); PG8_BAR; PG8_MMA(1, 1, At, B1); PG8_BAR;
            PG8_LDB(B0, 1, 0); PG8_SCHED; PG8_LDA(At, 1, 0); PG8_STAGE(PG8_SA(0, 1), a2 + hstep, voffA);
            PG8_WAIT_L(8); PG8_BAR; PG8_WAIT_L(0); PG8_MMA(0, 0, At, B0); PG8_BAR; PG8_SCHED;
            PG8_LDB(B1, 1, 1); PG8_STAGE(PG8_SB(1, 0), b3, voffB);
            PG8_BAR; PG8_WAIT_L(0); PG8_MMA(0, 1, At, B1); PG8_BAR;
            PG8_LDA(At, 1, 1); PG8_STAGE(PG8_SA(1, 0), a3, voffA);
            PG8_BAR; PG8_WAIT_L(0); PG8_MMA(1, 0, At, B0); PG8_BAR; PG8_SCHED;
            PG8_STAGE(PG8_SB(1, 1), b3 + hstep, voffB);
            PG8_WAIT_V(6); PG8_BAR; PG8_MMA(1, 1, At, B1); PG8_BAR;
            }
        }
        if constexpr (ALIGN_EPI) { if (wr == 0) PG8_BAR; }
        if constexpr (!Epi::AFTER_DRAIN) { E(acc, cur, wr, wc, fr, fq); S.done(cur); }
        if (!has_next) break;
#pragma unroll
        for (int a = 0; a < 2; ++a)
#pragma unroll
            for (int b = 0; b < 2; ++b)
#pragma unroll
                for (int m = 0; m < 4; ++m)
#pragma unroll
                    for (int n = 0; n < 2; ++n) acc[a][b][m][n] = (f32x4){0.f, 0.f, 0.f, 0.f};
        cur = nxt; cA = nA; cB = nB; ++ui;
        if constexpr (ALIGN_EPI) { if (wr == 1) PG8_BAR; }
    }
    PG8_WAIT_V(0);
    if constexpr (!ALIGN_EPI) { if (wr == 0) PG8_BAR; }
    PG8_BAR;
    if constexpr (Epi::AFTER_DRAIN) { E.fused(acc, cur, wr, wc, fr, fq, lds, wid, lane); S.done(cur); }
#undef PG8_SA
#undef PG8_SB
#undef PG8_STAGE
#undef PG8_LDA
#undef PG8_LDB
#undef PG8_MMA
#undef PG8_WAIT_V
#undef PG8_WAIT_L
#undef PG8_BAR
#undef PG8_SCHED
}
}

struct OrderIn1 {
    pg8::StaticOrder base; int G, c;
    __device__ void init(int G_, int c_) { base.init(ML, N1, G_, c_); G = G_; c = c_; }
    __device__ bool next(int i, pg8::Unit& u) const {
        const int Lx = i * G + c;
        if (Lx < 256 * 13) return base.next(i, u);
        const int r = Lx - 256 * 13; if (r >= 32 * 7) return false;
        const int j = r >> 5; u.pm = 256 + (r & 31); u.pn = j < 6 ? 2 + j : 12; return true;
    }
    __device__ __forceinline__ void a_ready(const pg8::Unit&) const {}
    __device__ __forceinline__ void done(const pg8::Unit&) const {}
    static constexpr bool HALFN = true;
    __device__ __forceinline__ bool bhalf(const pg8::Unit& u) const { return u.pn == 12; }
};

struct EpiIn0 {
    unsigned char* ws;
    const float *aqn, *akn, *bqn, *bkn;
    static constexpr bool PERM = false, AFTER_DRAIN = false;
    __device__ __forceinline__ void operator()(const f32x4 (&acc)[2][2][4][2], const pg8::Unit& u, int wr, int wc, int fr, int fq) const { (*this)(acc, u.pm, u.pn, wr, wc, fr, fq); }
    __device__ __forceinline__ void operator()(const f32x4 (&acc)[2][2][4][2], int pm, int pn, int wr, int wc, int fr, int fq) const {
        const int g = 4 * pn + wc;
        const float* rs = (const float*)(ws + OFF_RS);
        size_t doff; int ld, col, type; const float* gain = aqn;
        if (g < 8) { doff = OFF_QA; ld = 512; col = g * 64; type = 2; gain = aqn; }
        else if (g < 10) { doff = OFF_KA; ld = 128; col = (g - 8) * 64; type = 3; gain = akn; }
        else if (g < 12) { doff = OFF_VA; ld = 128; col = (g - 10) * 64; type = 0; }
        else if (g < 20) { doff = OFF_GA; ld = 512; col = (g - 12) * 64; type = 1; }
        else if (g < 28) { doff = OFF_QB; ld = 512; col = (g - 20) * 64; type = 2; gain = bqn; }
        else if (g < 36) { doff = OFF_KB; ld = 512; col = (g - 28) * 64; type = 3; gain = bkn; }
        else if (g < 44) { doff = OFF_VB; ld = 512; col = (g - 36) * 64; type = 0; }
        else { doff = OFF_GB; ld = 512; col = (g - 44) * 64; type = 1; }
        bf16_t* dst = (bf16_t*)(ws + doff);
        const bool lat = pm < 256; const int r = lat ? pm >> 3 : 32;
        const float* bptr = (const float*)(ws + OFF_BIAS0) + (size_t)r * 3328 + pn * 256 + wc * 32 + fq * 4;
        f32x4 bia[2][2], gn[2][2];
        const float qs = type == 2 ? QSCALE : 1.0f;
#pragma unroll
        for (int bj = 0; bj < 2; ++bj)
#pragma unroll
            for (int n = 0; n < 2; ++n) { bia[bj][n] = *(const f32x4*)(bptr + bj * 128 + n * 16); gn[bj][n] = *(const f32x4*)(gain + bj * 32 + n * 16 + fq * 4) * qs; }
        float rsv[2][4];
#pragma unroll
        for (int ai = 0; ai < 2; ++ai)
#pragma unroll
            for (int m = 0; m < 4; ++m) rsv[ai][m] = rs[pm * 256 + ai * 128 + wr * 64 + m * 16 + fr];
        float frq[4];
#pragma unroll
        for (int e = 0; e < 4; ++e) frq[e] = __builtin_amdgcn_exp2f(-(float)(fq * 4 + e) * 0.830482023721841f) * 0.15915494309189535f;
#pragma unroll
        for (int ai = 0; ai < 2; ++ai) {
            const float prow = (float)((pm * 4 + ai * 2 + wr) & 31);
            int fro = fr; asm volatile("" : "+v"(fro));
#pragma unroll
            for (int m = 0; m < 4; ++m) {
                const int row = pm * 256 + ai * 128 + wr * 64 + m * 16 + fr;
                const float rstd = rsv[ai][m];
                f32x4 v[2][2];
#pragma unroll
                for (int bj = 0; bj < 2; ++bj)
#pragma unroll
                    for (int n = 0; n < 2; ++n) v[bj][n] = acc[ai][bj][m][n] * rstd + bia[bj][n];
                if (type >= 2) {
                    float s2 = 0.f;
#pragma unroll
                    for (int bj = 0; bj < 2; ++bj)
#pragma unroll
                        for (int n = 0; n < 2; ++n) s2 += v[bj][n][0] * v[bj][n][0] + v[bj][n][1] * v[bj][n][1] + v[bj][n][2] * v[bj][n][2] + v[bj][n][3] * v[bj][n][3];
                    s2 = sum_xor16(s2); s2 = sum_xor32(s2);
                    const float rn = rsqrtf(s2 * (1.0f / 64.0f) + EPS);
#pragma unroll
                    for (int bj = 0; bj < 2; ++bj)
#pragma unroll
                        for (int n = 0; n < 2; ++n) v[bj][n] = v[bj][n] * rn * gn[bj][n];
                    if (lat) {
                        const float pcol = (float)(m * 16 + fro);
#pragma unroll
                        for (int bj = 0; bj < 2; ++bj) {
                            const float pos = bj ? pcol : prow;
#pragma unroll
                            for (int e = 0; e < 4; ++e) {
                                const float rev = pos * frq[e];
                                const float cc = __builtin_amdgcn_cosf(rev), sn = __builtin_amdgcn_sinf(rev);
                                const float x1 = v[bj][0][e], x2 = v[bj][1][e]; v[bj][0][e] = x1 * cc - x2 * sn; v[bj][1][e] = x2 * cc + x1 * sn;
                            }
                        }
                    }
                } else if (type == 1) {
#pragma unroll
                    for (int bj = 0; bj < 2; ++bj)
#pragma unroll
                        for (int n = 0; n < 2; ++n)
#pragma unroll
                            for (int e = 0; e < 4; ++e) v[bj][n][e] = siluf(v[bj][n][e]);
                }
#pragma unroll
                for (int bj = 0; bj < 2; ++bj) {
                    u32x4 o; o.x = cvtpk(v[bj][0][0], v[bj][0][1]); o.y = cvtpk(v[bj][0][2], v[bj][0][3]); o.z = cvtpk(v[bj][1][0], v[bj][1][1]); o.w = cvtpk(v[bj][1][2], v[bj][1][3]);
                    *(u32x4*)(dst + (size_t)row * ld + col + bj * 32 + fq * 8) = o;
                }
            }
        }
    }
};

struct EpiIn1 {
    unsigned char* ws;
    static constexpr bool PERM = false, AFTER_DRAIN = false;
    __device__ __forceinline__ void operator()(const f32x4 (&acc)[2][2][4][2], const pg8::Unit& u, int wr, int wc, int fr, int fq) const { (*this)(acc, u.pm, u.pn, wr, wc, fr, fq); }
    __device__ __forceinline__ void operator()(const f32x4 (&acc)[2][2][4][2], int pm, int pn, int wr, int wc, int fr, int fq) const {
        const int g = 4 * pn + wc;
        if (g > 48) return;
        const float* rs = (const float*)(ws + OFF_RS); float* RF = (float*)(ws + OFF_RF);
        size_t doff = OFF_QG; int ld = 0, col = 0, type;
        if (g < 8) { doff = OFF_QG; ld = 512; col = g * 64; type = 2; }
        else if (g < 16) { doff = OFF_KG; ld = 512; col = (g - 8) * 64; type = 0; }
        else if (g < 32) { doff = OFF_VG; ld = 1024; col = (g - 16) * 64; type = 0; }
        else if (g < 48) { doff = OFF_GG; ld = 1024; col = (g - 32) * 64; type = 1; }
        else type = 3;
        bf16_t* dst = (bf16_t*)(ws + doff);
        const int r = pm < 256 ? pm >> 3 : 32;
        const float* bptr = (const float*)(ws + OFF_BIAS1) + (size_t)r * 3328 + pn * 256 + wc * 32 + fq * 4;
        f32x4 bia[2][2];
#pragma unroll
        for (int bj = 0; bj < 2; ++bj)
#pragma unroll
            for (int n = 0; n < 2; ++n) bia[bj][n] = *(const f32x4*)(bptr + bj * 128 + n * 16);
        float rsv[2][4];
#pragma unroll
        for (int ai = 0; ai < 2; ++ai)
#pragma unroll
            for (int m = 0; m < 4; ++m) rsv[ai][m] = rs[pm * 256 + ai * 128 + wr * 64 + m * 16 + fr];
        const float sc = type == 2 ? 0.08838834764831845f : 1.0f;
#pragma unroll
        for (int ai = 0; ai < 2; ++ai)
#pragma unroll
            for (int m = 0; m < 4; ++m) {
                const int row = pm * 256 + ai * 128 + wr * 64 + m * 16 + fr;
                const float rstd = rsv[ai][m];
                f32x4 v[2][2];
#pragma unroll
                for (int bj = 0; bj < 2; ++bj)
#pragma unroll
                    for (int n = 0; n < 2; ++n) v[bj][n] = (acc[ai][bj][m][n] * rstd + bia[bj][n]) * sc;
                if (type == 3) {
                    *(f32x4*)(RF + (size_t)row * 32 + fq * 8) = v[0][0];
                    *(f32x4*)(RF + (size_t)row * 32 + fq * 8 + 4) = v[0][1];
                    continue;
                }
                if (type == 1) {
#pragma unroll
                    for (int bj = 0; bj < 2; ++bj)
#pragma unroll
                        for (int n = 0; n < 2; ++n)
#pragma unroll
                            for (int e = 0; e < 4; ++e) v[bj][n][e] = siluf(v[bj][n][e]);
                }
#pragma unroll
                for (int bj = 0; bj < 2; ++bj) {
                    u32x4 o; o.x = cvtpk(v[bj][0][0], v[bj][0][1]); o.y = cvtpk(v[bj][0][2], v[bj][0][3]); o.z = cvtpk(v[bj][1][0], v[bj][1][1]); o.w = cvtpk(v[bj][1][2], v[bj][1][3]);
                    *(u32x4*)(dst + (size_t)row * ld + col + bj * 32 + fq * 8) = o;
                }
            }
    }
};

struct EpiOut0 {
    const float *x, *ctx, *g1; float* out; unsigned char* ws;
    static constexpr bool PERM = false, AFTER_DRAIN = false;
    __device__ __forceinline__ void operator()(const f32x4 (&acc)[2][2][4][2], const pg8::Unit& u, int wr, int wc, int fr, int fq) const { (*this)(acc, u.pm, u.pn, wr, wc, fr, fq); }
    __device__ __forceinline__ void operator()(const f32x4 (&acc)[2][2][4][2], int pm, int pn, int wr, int wc, int fr, int fq) const {
        const float* mod = (const float*)(ws + OFF_MOD); bf16_t* A1 = (bf16_t*)(ws + OFF_A); float* parts = (float*)(ws + OFF_PARTS);
        const bool lat = pm < 256; const int r = lat ? pm >> 3 : 32;
        const int c0 = pn * 256 + wc * 64 + fq * 8;
        const float* gt = mod + (size_t)r * 3072 + 2048 + c0;
        const float* sc = mod + (size_t)(33 + r) * 3072 + 1024 + c0;
        f32x4 gtv[2][2], csv[2][2];
#pragma unroll
        for (int bj = 0; bj < 2; ++bj)
#pragma unroll
            for (int n = 0; n < 2; ++n) { gtv[bj][n] = *(const f32x4*)(gt + bj * 32 + n * 4); csv[bj][n] = *(const f32x4*)(g1 + c0 + bj * 32 + n * 4) * (1.0f + *(const f32x4*)(sc + bj * 32 + n * 4)); }
        const float* xbase = (lat ? x + (size_t)(pm * 256) * D : ctx + (size_t)(pm * 256 - ML) * D) + (size_t)(wr * 64 + fr) * D + c0;
        f32x4 xv[2][2][2];
#define EO0_LOAD(ri) do { const float* xp = xbase + (size_t)(((ri) >> 2) * 128 + ((ri) & 3) * 16) * D; \
            _Pragma("unroll") for (int bj = 0; bj < 2; ++bj) _Pragma("unroll") for (int n = 0; n < 2; ++n) xv[(ri) & 1][bj][n] = *(const f32x4*)(xp + bj * 32 + n * 4); } while (0)
        EO0_LOAD(0);
#pragma unroll
        for (int ri = 0; ri < 8; ++ri) {
            if (ri < 7) EO0_LOAD(ri + 1);
            {
                const int ai = ri >> 2, m = ri & 3;
                const int row = pm * 256 + ai * 128 + wr * 64 + m * 16 + fr;
                float ss = 0.f;
#pragma unroll
                for (int bj = 0; bj < 2; ++bj) {
                    f32x4 y[2], xk[2];
#pragma unroll
                    for (int n = 0; n < 2; ++n) {
                        const f32x4 x1 = xv[ri & 1][bj][n] + gtv[bj][n] * acc[ai][bj][m][n];
                        ss += x1[0] * x1[0] + x1[1] * x1[1] + x1[2] * x1[2] + x1[3] * x1[3];
                        xk[n] = x1;
                        y[n] = x1 * csv[bj][n];
                    }
                    u32x4 o; o.x = cvtpk(y[0][0], y[0][1]); o.y = cvtpk(y[0][2], y[0][3]); o.z = cvtpk(y[1][0], y[1][1]); o.w = cvtpk(y[1][2], y[1][3]);
                    *(u32x4*)(A1 + (size_t)row * D + c0 + bj * 32) = o;
                    if (lat) { u32x4 xb; xb.x = cvtpk(xk[0][0], xk[0][1]); xb.y = cvtpk(xk[0][2], xk[0][3]); xb.z = cvtpk(xk[1][0], xk[1][1]); xb.w = cvtpk(xk[1][2], xk[1][3]);
                        *(u32x4*)((bf16_t*)(ws + OFF_X1B) + (size_t)row * D + c0 + bj * 32) = xb; }
                }
                ss = sum_xor16(ss); ss = sum_xor32(ss);
                if (fq == 0) parts[(size_t)(4 * pn + wc) * M + row] = ss;
            }
            __builtin_amdgcn_sched_barrier(0);
        }
#undef EO0_LOAD
    }
};

struct EpiOut1 {
    unsigned char* ws; float* out;
    static constexpr bool PERM = false, AFTER_DRAIN = false;
    __device__ __forceinline__ void operator()(f32x4 (&acc)[2][2][4][2], const pg8::Unit& u, int wr, int wc, int fr, int fq) const {
        const int pm = u.pm, pn = u.pn;
        const int r = pm >> 3, c0 = pn * 256 + wc * 64 + fq * 8;
        const float* gt = (const float*)(ws + OFF_MOD) + (size_t)(33 + r) * 3072 + 2048 + c0;
        f32x4 gtv[2][2];
#pragma unroll
        for (int bj = 0; bj < 2; ++bj)
#pragma unroll
            for (int n = 0; n < 2; ++n) gtv[bj][n] = *(const f32x4*)(gt + bj * 32 + n * 4);
        const bf16_t* xbase = (const bf16_t*)(ws + OFF_X1B) + (size_t)(pm * 256 + wr * 64 + fr) * D + c0;
        u32x4 xv[4][2];
#define EO1_LOAD(ri) do { const bf16_t* xp = xbase + (size_t)(((ri) >> 2) * 128 + ((ri) & 3) * 16) * D; \
            xv[(ri) & 3][0] = *(const u32x4*)(xp); xv[(ri) & 3][1] = *(const u32x4*)(xp + 32); } while (0)
        EO1_LOAD(0); EO1_LOAD(1); EO1_LOAD(2); EO1_LOAD(3);
#pragma unroll
        for (int ri = 0; ri < 8; ++ri) {
            const int ai = ri >> 2, m = ri & 3;
#pragma unroll
            for (int bj = 0; bj < 2; ++bj) {
                const u32x4 w = xv[ri & 3][bj];
                const f32x4 x0 = (f32x4){bflo(w.x), bfhi(w.x), bflo(w.y), bfhi(w.y)}, x1 = (f32x4){bflo(w.z), bfhi(w.z), bflo(w.w), bfhi(w.w)};
                acc[ai][bj][m][0] = x0 + gtv[bj][0] * acc[ai][bj][m][0];
                acc[ai][bj][m][1] = x1 + gtv[bj][1] * acc[ai][bj][m][1];
            }
            if (ri + 4 < 8) EO1_LOAD(ri + 4);
            __builtin_amdgcn_sched_barrier(0);
        }
#undef EO1_LOAD
        float* obase = out + (size_t)(pm * 256 + wr * 64 + fr) * D + c0;
#pragma unroll
        for (int ri = 0; ri < 8; ++ri) {
            const int ai = ri >> 2, m = ri & 3;
            float* op = obase + (size_t)(ai * 128 + m * 16) * D;
#pragma unroll
            for (int bj = 0; bj < 2; ++bj)
#pragma unroll
                for (int n = 0; n < 2; ++n) *(f32x4*)(op + bj * 32 + n * 4) = acc[ai][bj][m][n];
        }
    }
};

typedef float f32x16 __attribute__((ext_vector_type(16)));
typedef short s16x4 __attribute__((ext_vector_type(4)));
#define LDSAS __attribute__((address_space(3)))
__device__ __forceinline__ int crow(int r, int hi) { return (r & 3) + 8 * (r >> 2) + 4 * hi; }
__device__ __forceinline__ s16x4 vtr(const LDSAS unsigned char* p) { return __builtin_bit_cast(s16x4, __builtin_amdgcn_ds_read_tr16_b64_v4i16((LDSAS s16x4*)p)); }

constexpr int AB_K1 = 0, AB_K2 = 16384, AB_V = 32768, AB_Q = 65536;
static_assert(AB_Q + 65536 <= 134144, "attention B LDS map");
__device__ __forceinline__ float fadd_s(float a, float b) { float r; asm("v_add_f32_e32 %0, %1, %2" : "=v"(r) : "v"(a), "v"(b)); return r; }

__device__ __forceinline__ void attnB_unit(const Params& P, LDSAS unsigned char* lds, int b, int h, int qrow0, int t_begin, int t_end, int g_wave) {
    const int tid = otid(), lane = tid & 63, r32 = lane & 31, hi = lane >> 5;
    const int wid = __builtin_amdgcn_readfirstlane(tid >> 6);
    LDSAS unsigned char* qlds = lds + AB_Q + wid * 8192 + r32 * 256;
    {
        const bf16_t* qg = P.QB() + (size_t)(qrow0 + wid * 32 + r32) * 512 + (2 * h) * 64 + hi * 8;
#pragma unroll
        for (int c2 = 0; c2 < 8; ++c2) {
            const u32x4 v = *(const u32x4*)(qg + (c2 >> 2) * 64 + (c2 & 3) * 16);
            *(LDSAS u32x4*)(qlds + (((2 * c2 + hi) ^ (r32 & 15)) * 16)) = v;
        }
    }
    f32x16 o1[4], o2[4];
#pragma unroll
    for (int i = 0; i < 4; ++i) { o1[i] = (f32x16){}; o2[i] = (f32x16){}; }
    float l1 = 0.f, l2 = 0.f;
    const int krow = tid >> 3, kch = tid & 7, vrow = tid >> 4, vch = tid & 15;
    const int kwoff = krow * 128 + ((kch ^ ((krow >> 1) & 7)) * 16);
    const int vwoff = (vch >> 2) * 4096 + vrow * 64 + (vch & 3) * 16;
    u32x4 rk1, rk2, rv0, rv1;
#define AB_GLOAD(t) do { const int kr0_ = (t) < 32 ? b * 2048 + 64 * (t) : ML + b * 256 + 64 * ((t) - 32); \
        rk1 = *(const u32x4*)(P.KB() + (size_t)(kr0_ + krow) * 512 + (2 * h) * 64 + kch * 8); \
        rk2 = *(const u32x4*)(P.KB() + (size_t)(kr0_ + krow) * 512 + (2 * h + 1) * 64 + kch * 8); \
        rv0 = *(const u32x4*)(P.VB() + (size_t)(kr0_ + vrow) * 512 + h * 128 + vch * 8); \
        rv1 = *(const u32x4*)(P.VB() + (size_t)(kr0_ + vrow + 32) * 512 + h * 128 + vch * 8); } while (0)
#define AB_LWRITE(buf) do { *(LDSAS u32x4*)(lds + AB_K1 + (buf) * 8192 + kwoff) = rk1; *(LDSAS u32x4*)(lds + AB_K2 + (buf) * 8192 + kwoff) = rk2; \
        *(LDSAS u32x4*)(lds + AB_V + (buf) * 16384 + vwoff) = rv0; *(LDSAS u32x4*)(lds + AB_V + (buf) * 16384 + vwoff + 2048) = rv1; } while (0)
#define AB_SCORES(sub, LSUM, PW) do { const LDSAS unsigned char* kb_ = lds + ((sub) ? AB_K2 : AB_K1) + buf * 8192 + r32 * 128; \
        f32x16 p0 = (f32x16){}, p1 = (f32x16){}; \
        _Pragma("unroll") for (int d0 = 0; d0 < 4; ++d0) { const int co = ((2 * d0 + hi) ^ ksw) * 16; \
            const bf16x8 qf = *(const LDSAS bf16x8*)(qlds + (((2 * (4 * (sub) + d0) + hi) ^ (r32 & 15)) * 16)); \
            const bf16x8 k0 = *(const LDSAS bf16x8*)(kb_ + co), k1 = *(const LDSAS bf16x8*)(kb_ + 4096 + co); \
            p0 = __builtin_amdgcn_mfma_f32_32x32x16_bf16(k0, qf, p0, 0, 0, 0); p1 = __builtin_amdgcn_mfma_f32_32x32x16_bf16(k1, qf, p1, 0, 0, 0); } \
        float ls_ = 0.f; \
        _Pragma("unroll") for (int r = 0; r < 16; ++r) { p0[r] = __builtin_amdgcn_exp2f(p0[r]); p1[r] = __builtin_amdgcn_exp2f(p1[r]); ls_ = fadd_s(ls_, p0[r]); ls_ = fadd_s(ls_, p1[r]); } \
        LSUM += ls_; \
        PW[0].x = cvtpk(p0[0], p0[1]); PW[0].y = cvtpk(p0[2], p0[3]); PW[0].z = cvtpk(p0[4], p0[5]); PW[0].w = cvtpk(p0[6], p0[7]); \
        PW[1].x = cvtpk(p0[8], p0[9]); PW[1].y = cvtpk(p0[10], p0[11]); PW[1].z = cvtpk(p0[12], p0[13]); PW[1].w = cvtpk(p0[14], p0[15]); \
        PW[2].x = cvtpk(p1[0], p1[1]); PW[2].y = cvtpk(p1[2], p1[3]); PW[2].z = cvtpk(p1[4], p1[5]); PW[2].w = cvtpk(p1[6], p1[7]); \
        PW[3].x = cvtpk(p1[8], p1[9]); PW[3].y = cvtpk(p1[10], p1[11]); PW[3].z = cvtpk(p1[12], p1[13]); PW[3].w = cvtpk(p1[14], p1[15]); } while (0)
    const int ksw = (r32 >> 1) & 7;
    const int vroff = AB_V + (4 * hi + ((lane & 15) >> 2)) * 64 + ((lane >> 4) & 1) * 32 + (lane & 3) * 8;
    AB_GLOAD(t_begin); AB_LWRITE(0); __syncthreads();
    for (int t = t_begin; t < t_end; ++t) {
        const int buf = (t - t_begin) & 1;
        u32x4 pw1[4], pw2[4];
        AB_SCORES(0, l1, pw1);
        __builtin_amdgcn_sched_barrier(0);
        AB_SCORES(1, l2, pw2);
        __builtin_amdgcn_sched_barrier(0);
        if (t + 1 < t_end) AB_GLOAD(t + 1);
        const LDSAS unsigned char* vb = lds + buf * 16384 + vroff;
        s16x4 vlo[2][4], vhi[2][4];
#define AB_VLOAD(slot, d0) do { _Pragma("unroll") for (int ks = 0; ks < 4; ++ks) { vlo[slot][ks] = vtr(vb + (d0) * 4096 + ks * 1024); vhi[slot][ks] = vtr(vb + (d0) * 4096 + ks * 1024 + 512); } } while (0)
        AB_VLOAD(0, 0);
#pragma unroll
        for (int d0 = 0; d0 < 4; ++d0) {
            if (d0 < 3) AB_VLOAD((d0 + 1) & 1, d0 + 1);
            __builtin_amdgcn_sched_barrier(0);
#pragma unroll
            for (int ks = 0; ks < 4; ++ks) {
                const s16x4 lo = vlo[d0 & 1][ks], hh = vhi[d0 & 1][ks];
                const bf16x8 vf = (bf16x8){lo[0], lo[1], lo[2], lo[3], hh[0], hh[1], hh[2], hh[3]};
                o1[d0] = __builtin_amdgcn_mfma_f32_32x32x16_bf16(__builtin_bit_cast(bf16x8, pw1[ks]), vf, o1[d0], 0, 0, 0);
                o2[d0] = __builtin_amdgcn_mfma_f32_32x32x16_bf16(__builtin_bit_cast(bf16x8, pw2[ks]), vf, o2[d0], 0, 0, 0);
            }
            __builtin_amdgcn_sched_barrier(0);
        }
#undef AB_VLOAD
        if (t + 1 < t_end) AB_LWRITE(buf ^ 1);
        __syncthreads();
    }
#undef AB_GLOAD
#undef AB_LWRITE
#undef AB_SCORES
    l1 = sum_xor32(l1); l2 = sum_xor32(l2);
    LDSAS float* stg = (LDSAS float*)(lds + wid * 8192);
    if (hi == 0) { stg[r32] = 1.0f / l1; stg[32 + r32] = P.scal()[0] / l2; }
    float ss[16];
#pragma unroll
    for (int r = 0; r < 16; ++r) {
        const float a = stg[crow(r, hi)], c = stg[32 + crow(r, hi)];
        float s2 = 0.f;
#pragma unroll
        for (int d0 = 0; d0 < 4; ++d0) { const float v = o1[d0][r] * a - o2[d0][r] * c; o1[d0][r] = v; s2 += v * v; }
        ss[r] = s2;
    }
#pragma unroll
    for (int r = 0; r < 16; ++r) {
        float s2 = ss[r];
        s2 += __shfl_xor(s2, 1); s2 += __shfl_xor(s2, 2); s2 += __shfl_xor(s2, 4); s2 += __shfl_xor(s2, 8); s2 = sum_xor16(s2);
        ss[r] = rsqrtf(s2 * (1.0f / 128.0f) + EPS) * (1.0f - LAMBDA_INIT);
    }
    const int eq = lane >> 1, eseg = lane & 1;
    const size_t grow = (size_t)(qrow0 + wid * 32 + eq);
#pragma unroll
    for (int half = 0; half < 2; ++half) {
#pragma unroll
        for (int dd = 0; dd < 2; ++dd) {
            const int d0 = half * 2 + dd; const float sl = P.b_subln[d0 * 32 + r32];
#pragma unroll
            for (int r = 0; r < 16; ++r) stg[crow(r, hi) * 64 + ((dd * 32 + r32) ^ ((crow(r, hi) & 7) * 4))] = o1[d0][r] * ss[r] * sl;
        }
        const u32x4* gp = (const u32x4*)(P.GB() + grow * 512 + h * 128 + half * 64 + eseg * 32);
        u32x4* op = (u32x4*)(P.O() + grow * 1024 + 512 + h * 128 + half * 64 + eseg * 32);
        u32x4 gv[4];
#pragma unroll
        for (int i = 0; i < 4; ++i) gv[i] = gp[i];
#pragma unroll
        for (int i = 0; i < 4; ++i) {
            const int c0 = eseg * 32 + i * 8;
            const f32x4 a = *(const LDSAS f32x4*)(stg + eq * 64 + (c0 ^ ((eq & 7) * 4))), c = *(const LDSAS f32x4*)(stg + eq * 64 + ((c0 + 4) ^ ((eq & 7) * 4)));
            const u32x4 g = gv[i]; u32x4 ov;
            ov.x = cvtpk(a[0] * bflo(g.x), a[1] * bfhi(g.x)); ov.y = cvtpk(a[2] * bflo(g.y), a[3] * bfhi(g.y));
            ov.z = cvtpk(c[0] * bflo(g.z), c[1] * bfhi(g.z)); ov.w = cvtpk(c[2] * bflo(g.w), c[3] * bfhi(g.w));
            op[i] = ov;
        }
    }
    __syncthreads();
}

__device__ __forceinline__ void phase_attnB_mfma(const Params& P, LDSAS unsigned char* lds, int vb, int nvb, int g_wave) {
    for (int it = 0; ; ++it) {
        int u;
        if (nvb == 256) { if (it < 4) u = it * 256 + vb; else if (it == 4 && vb >= 128) u = 1024 + (vb - 128); else break; }
        else { u = it * nvb + vb; if (u >= 1024 + 128) break; }
        int pair, qrow0, t0;
        if (u < 1024) {
            int qblk;
            if (nvb == 256) { const int round = u >> 8, i = u & 255, xcd = i & 7, slot = i >> 3; pair = round * 32 + xcd * 4 + (slot >> 3); qblk = slot & 7; }
            else { pair = u >> 3; qblk = u & 7; }
            qrow0 = (pair >> 2) * 2048 + qblk * 256; t0 = 0;
        } else {
            pair = u - 1024;
            qrow0 = ML + (pair >> 2) * 256; t0 = 32;
        }
        attnB_unit(P, lds, pair >> 2, pair & 3, qrow0, t0, 36, g_wave);
    }
}

constexpr int AA_K = 0, AA_V = 32768;
__device__ __forceinline__ void attnA_unit(const Params& P, LDSAS unsigned char* lds, int b, int kvh, int qrow0, int qpos0, int kt0, int nwin, int g_wave) {
    const int tid = otid(), lane = tid & 63, r32 = lane & 31, hi = lane >> 5;
    const int wid = __builtin_amdgcn_readfirstlane(tid >> 6);
    const int head = kvh * 4 + (wid >> 1), qoff = (wid & 1) * 64;
    bf16x8 qf[2][4];
#pragma unroll
    for (int qq = 0; qq < 2; ++qq)
#pragma unroll
        for (int d0 = 0; d0 < 4; ++d0) qf[qq][d0] = *(const bf16x8*)(P.QA() + (size_t)(qrow0 + qoff + qq * 32 + r32) * 512 + head * 64 + d0 * 16 + hi * 8);
    f32x16 o[2][2];
#pragma unroll
    for (int i = 0; i < 2; ++i) { o[i][0] = (f32x16){}; o[i][1] = (f32x16){}; }
    float l[2] = {0.f, 0.f};
    const int krow = tid >> 3, kch = tid & 7;
    const int kwoff = krow * 128 + ((kch ^ ((krow >> 1) & 7)) * 16);
    const int vwoff = (kch >> 2) * 4096 + krow * 64 + (kch & 3) * 16;
    u32x4 rk[2], rv[2];
    const int nt = nwin + 4, npair = (nt + 1) >> 1;
#define AA_KR0(i) ((i) < nwin ? b * 2048 + 64 * (kt0 + (i)) : ML + b * 256 + 64 * ((i) - nwin))
#define AA_GLOAD(pi) do { _Pragma("unroll") for (int sb_ = 0; sb_ < 2; ++sb_) { const int i_ = 2 * (pi) + sb_ < nt ? 2 * (pi) + sb_ : nt - 1; const int kr0_ = AA_KR0(i_); \
        rk[sb_] = *(const u32x4*)(P.KA() + (size_t)(kr0_ + krow) * 128 + kvh * 64 + kch * 8); rv[sb_] = *(const u32x4*)(P.VA() + (size_t)(kr0_ + krow) * 128 + kvh * 64 + kch * 8); } } while (0)
#define AA_LWRITE(buf) do { _Pragma("unroll") for (int sb_ = 0; sb_ < 2; ++sb_) { *(LDSAS u32x4*)(lds + AA_K + ((buf) * 2 + sb_) * 8192 + kwoff) = rk[sb_]; *(LDSAS u32x4*)(lds + AA_V + ((buf) * 2 + sb_) * 8192 + vwoff) = rv[sb_]; } } while (0)
    const int kroff = AA_K + r32 * 128, ksw = (r32 >> 1) & 7;
    const int vroff = AA_V + (4 * hi + ((lane & 15) >> 2)) * 64 + ((lane >> 4) & 1) * 32 + (lane & 3) * 8;
    AA_GLOAD(0); AA_LWRITE(0); __syncthreads();
    for (int pi = 0; pi < npair; ++pi) {
        const int pbuf = pi & 1;
        if (pi + 1 < npair) AA_GLOAD(pi + 1);
      for (int sub = 0; sub < 2; ++sub) {
        const int i = 2 * pi + sub, buf = pbuf * 2 + sub;
        int cls = i < nt ? 1 : 0;
        if (i < nwin) { const int delta = 64 * (kt0 + i) - (qpos0 + qoff); cls = delta == -128 ? 2 : (delta == 128 ? 3 : ((delta >= -64 && delta <= 64) ? 1 : 0)); }
        if (cls != 0) {
            const LDSAS unsigned char* kb = lds + buf * 8192 + kroff;
            u32x4 pw[2][4];
#pragma unroll
            for (int qq = 0; qq < 2; ++qq) {
                f32x16 p0 = (f32x16){}, p1 = (f32x16){};
#pragma unroll
                for (int d0 = 0; d0 < 4; ++d0) {
                    const int co = ((2 * d0 + hi) ^ ksw) * 16;
                    const bf16x8 k0 = *(const LDSAS bf16x8*)(kb + co), k1 = *(const LDSAS bf16x8*)(kb + 4096 + co);
                    p0 = __builtin_amdgcn_mfma_f32_32x32x16_bf16(k0, qf[qq][d0], p0, 0, 0, 0);
                    p1 = __builtin_amdgcn_mfma_f32_32x32x16_bf16(k1, qf[qq][d0], p1, 0, 0, 0);
                }
                float ls = 0.f;
#pragma unroll
                for (int r = 0; r < 16; ++r) { p0[r] = __builtin_amdgcn_exp2f(p0[r]); p1[r] = __builtin_amdgcn_exp2f(p1[r]); }
                if (cls >= 2) {
                    int a = qq * 32 + r32;
                    asm volatile("" : "+v"(a));
#pragma unroll
                    for (int r = 0; r < 16; ++r) {
                        const int c0 = crow(r, hi), c1 = c0 + 32;
                        const bool v0 = cls == 2 ? (c0 >= a) : (c0 <= a), v1 = cls == 2 ? (c1 >= a) : (c1 <= a);
                        p0[r] = v0 ? p0[r] : 0.f; p1[r] = v1 ? p1[r] : 0.f;
                    }
                }
#pragma unroll
                for (int r = 0; r < 16; ++r) ls += p0[r] + p1[r];
                l[qq] += ls;
                pw[qq][0].x = cvtpk(p0[0], p0[1]); pw[qq][0].y = cvtpk(p0[2], p0[3]); pw[qq][0].z = cvtpk(p0[4], p0[5]); pw[qq][0].w = cvtpk(p0[6], p0[7]);
                pw[qq][1].x = cvtpk(p0[8], p0[9]); pw[qq][1].y = cvtpk(p0[10], p0[11]); pw[qq][1].z = cvtpk(p0[12], p0[13]); pw[qq][1].w = cvtpk(p0[14], p0[15]);
                pw[qq][2].x = cvtpk(p1[0], p1[1]); pw[qq][2].y = cvtpk(p1[2], p1[3]); pw[qq][2].z = cvtpk(p1[4], p1[5]); pw[qq][2].w = cvtpk(p1[6], p1[7]);
                pw[qq][3].x = cvtpk(p1[8], p1[9]); pw[qq][3].y = cvtpk(p1[10], p1[11]); pw[qq][3].z = cvtpk(p1[12], p1[13]); pw[qq][3].w = cvtpk(p1[14], p1[15]);
                __builtin_amdgcn_sched_barrier(0);
            }
            const LDSAS unsigned char* vb = lds + buf * 8192 + vroff;
#pragma unroll
            for (int d0 = 0; d0 < 2; ++d0)
#pragma unroll
                for (int ks = 0; ks < 4; ++ks) {
                    const s16x4 lo = vtr(vb + d0 * 4096 + ks * 1024), hh = vtr(vb + d0 * 4096 + ks * 1024 + 512);
                    const bf16x8 vf = (bf16x8){lo[0], lo[1], lo[2], lo[3], hh[0], hh[1], hh[2], hh[3]};
                    o[0][d0] = __builtin_amdgcn_mfma_f32_32x32x16_bf16(__builtin_bit_cast(bf16x8, pw[0][ks]), vf, o[0][d0], 0, 0, 0);
                    o[1][d0] = __builtin_amdgcn_mfma_f32_32x32x16_bf16(__builtin_bit_cast(bf16x8, pw[1][ks]), vf, o[1][d0], 0, 0, 0);
                }
        }
      }
        if (pi + 1 < npair) AA_LWRITE(pbuf ^ 1);
        __syncthreads();
    }
#undef AA_KR0
#undef AA_GLOAD
#undef AA_LWRITE
    const float sinkp = __builtin_amdgcn_exp2f(P.a_sink[head] * LOG2E);
    LDSAS float* stg = (LDSAS float*)(lds + wid * 8704);
    const int eq = lane >> 1, eseg = lane & 1;
#pragma unroll
    for (int qq = 0; qq < 2; ++qq) {
        float lt = sum_xor32(l[qq]);
        if (hi == 0) stg[r32] = 1.0f / (lt + sinkp);
        float rl[16];
#pragma unroll
        for (int r = 0; r < 16; ++r) rl[r] = stg[crow(r, hi)];
#pragma unroll
        for (int d0 = 0; d0 < 2; ++d0)
#pragma unroll
            for (int r = 0; r < 16; ++r) stg[crow(r, hi) * 68 + d0 * 32 + r32] = o[qq][d0][r] * rl[r];
        const size_t grow = (size_t)(qrow0 + qoff + qq * 32 + eq);
        const u32x4* gp = (const u32x4*)(P.GA() + grow * 512 + head * 64 + eseg * 32);
        u32x4* op = (u32x4*)(P.O() + grow * 1024 + head * 64 + eseg * 32);
        u32x4 gv[4];
#pragma unroll
        for (int i = 0; i < 4; ++i) gv[i] = gp[i];
#pragma unroll
        for (int i = 0; i < 4; ++i) {
            const f32x4 a = *(const LDSAS f32x4*)(stg + eq * 68 + eseg * 32 + i * 8), c = *(const LDSAS f32x4*)(stg + eq * 68 + eseg * 32 + i * 8 + 4);
            const u32x4 g = gv[i]; u32x4 ov;
            ov.x = cvtpk(a[0] * bflo(g.x), a[1] * bfhi(g.x)); ov.y = cvtpk(a[2] * bflo(g.y), a[3] * bfhi(g.y));
            ov.z = cvtpk(c[0] * bflo(g.z), c[1] * bfhi(g.z)); ov.w = cvtpk(c[2] * bflo(g.w), c[3] * bfhi(g.w));
            op[i] = ov;
        }
    }
    __syncthreads();
}

__device__ __forceinline__ void phase_attnA_mfma(const Params& P, LDSAS unsigned char* lds, int vb, int nvb, int g_wave) {
    for (int u = vb; u < 1024 + 128; u += nvb) {
        int b, kvh, qrow0, qpos0, kt0, nwin;
        if (u < 1024) {
            int qblk;
            if (nvb == 256) { const int round = u >> 8, i = u & 255; b = round * 8 + (i & 7); kvh = (i >> 3) >> 4; qblk = (i >> 3) & 15; }
            else { qblk = u & 15; kvh = (u >> 4) & 1; b = u >> 5; }
            const int lo = 2 * qblk - 2 < 0 ? 0 : 2 * qblk - 2, hi_ = 2 * qblk + 3 > 31 ? 31 : 2 * qblk + 3;
            qrow0 = b * 2048 + qblk * 128; qpos0 = qblk * 128; kt0 = lo; nwin = hi_ - lo + 1;
        } else {
            const int v = u - 1024, half = v & 1; kvh = (v >> 1) & 1; b = v >> 2;
            qrow0 = ML + b * 256 + half * 128; qpos0 = 0; kt0 = 0; nwin = 0;
        }
        attnA_unit(P, lds, b, kvh, qrow0, qpos0, kt0, nwin, g_wave);
    }
}

constexpr int GL_QD = 0, GL_KD = 17408, GL_KT = 34816, GL_V = 53248, GL_DEC = 86016, GL_RF = 86528, GL_TOT = 90624, GL_WA = 92672, GL_RQ = 101376, GL_RK = 117760, GL_ATT = 134144, GL_END = 140288;
constexpr int KERNEL_LDS = (GL_END > pg8::STAGE_BYTES ? GL_END : pg8::STAGE_BYTES);
static_assert(TICKET_LDS == KERNEL_LDS + 8, "ticket word sits next to the barrier words");
__device__ __forceinline__ int pos16(int x) { return 8 * ((x >> 2) & 1) + (x & 3) + 4 * (x >> 3); }
__device__ __forceinline__ bf16x8 pack8(const f32x16& v, int o) {
    u32x4 w; w.x = cvtpk(v[o], v[o + 1]); w.y = cvtpk(v[o + 2], v[o + 3]); w.z = cvtpk(v[o + 4], v[o + 5]); w.w = cvtpk(v[o + 6], v[o + 7]);
    return __builtin_bit_cast(bf16x8, w);
}

__device__ __forceinline__ void phase_gla_mfma(const Params& P, LDSAS unsigned char* lds, int vb, int nvb, int g_wave) {
    const int tid = otid(), lane = tid & 63, r32 = lane & 31, hi = lane >> 5;
    const int wid = __builtin_amdgcn_readfirstlane(tid >> 6);
    const int it = wid >> 2, dt = wid & 3, d = dt * 32 + r32;
    for (int unit = vb; unit < NB * 8; unit += nvb) {
        const int dr = unit & 1, h = (unit >> 1) & 3, b = unit >> 3;
        const float* wa = dr ? P.wa_b : P.wa_f; const float* ba = dr ? P.ba_b : P.ba_f;
        __syncthreads();
        if (tid < 128) {
            u32x4 whi[2], wlo[2];
#pragma unroll
            for (int j = 0; j < 16; j += 2) {
                const float w0 = wa[j * 512 + h * 128 + tid] * LOG2E, w1 = wa[(j + 1) * 512 + h * 128 + tid] * LOG2E;
                const unsigned ph = cvtpk(w0, w1); const unsigned pl = cvtpk(w0 - bflo(ph), w1 - bfhi(ph));
                whi[j >> 3][(j >> 1) & 3] = ph; wlo[j >> 3][(j >> 1) & 3] = pl;
            }
            *(LDSAS u32x4*)(lds + GL_WA + tid * 32) = whi[0]; *(LDSAS u32x4*)(lds + GL_WA + tid * 32 + 16) = whi[1];
            *(LDSAS u32x4*)(lds + GL_WA + 4096 + tid * 32) = wlo[0]; *(LDSAS u32x4*)(lds + GL_WA + 4096 + tid * 32 + 16) = wlo[1];
            ((LDSAS float*)(lds + GL_WA + 8192))[tid] = ba[h * 128 + tid] * LOG2E;
        }
        f32x16 S[4];
#pragma unroll
        for (int i = 0; i < 4; ++i) S[i] = (f32x16){};
        f32x4 pf_rf; u32x4 pf_v[4], pf_q[2], pf_k[2];
        float lb[16];
#define GL_MEMBASE(n) ((n) >= 4 ? b * T + 64 * (dr ? 31 - ((n) - 4) : ((n) - 4)) : ML + b * L + 64 * (dr ? 3 - (n) : (n)))
#define GL_PREFETCH_V(n) do { const int mb_ = GL_MEMBASE(n); \
            _Pragma("unroll") for (int k4 = 0; k4 < 4; ++k4) { const int idx = tq + 512 * k4; pf_v[k4] = *(const u32x4*)(P.VG() + (size_t)(mb_ + (idx >> 5)) * 1024 + h * 256 + (idx & 31) * 8); } } while (0)
#define GL_PREFETCH_RQK(n) do { const int mb_ = GL_MEMBASE(n); \
            pf_rf = *(const f32x4*)(P.RF() + (size_t)(mb_ + ((tq & 255) >> 2)) * 32 + dr * 16 + (tq & 3) * 4); \
            _Pragma("unroll") for (int k2 = 0; k2 < 2; ++k2) { const int idx = tq + 512 * k2; pf_k[k2] = *(const u32x4*)(P.KG() + (size_t)(mb_ + (idx >> 4)) * 512 + h * 128 + (idx & 15) * 8); \
                pf_q[k2] = *(const u32x4*)(P.QG() + (size_t)(mb_ + (idx >> 4)) * 512 + h * 128 + (idx & 15) * 8); } } while (0)
#define GL_TOP(lat) do { \
            if (tq < 256) { \
                const unsigned h0 = cvtpk(pf_rf[0], pf_rf[1]), h1 = cvtpk(pf_rf[2], pf_rf[3]); \
                const unsigned l0 = cvtpk(pf_rf[0] - bflo(h0), pf_rf[1] - bfhi(h0)), l1 = cvtpk(pf_rf[2] - bflo(h1), pf_rf[3] - bfhi(h1)); \
                const int off = (dr ? 63 - (tq >> 2) : (tq >> 2)) * 32 + (tq & 3) * 8; \
                *(LDSAS u32x2*)(lds + GL_RF + off) = (u32x2){h0, h1}; *(LDSAS u32x2*)(lds + GL_RF + 2048 + off) = (u32x2){l0, l1}; \
            } \
            _Pragma("unroll") for (int k2 = 0; k2 < 2; ++k2) { const int idx = tq + 512 * k2, im = idx >> 4, ch = idx & 15; const int pr = dr ? 63 - im : im; \
                const int off = pr * 256 + ((ch ^ (4 * (pr & 3))) * 16); \
                *(LDSAS u32x4*)(lds + GL_RK + off) = pf_k[k2]; if (lat) *(LDSAS u32x4*)(lds + GL_RQ + off) = pf_q[k2]; } } while (0)
#define GL_Z() do { \
            const float bav = ((const LDSAS float*)(lds + GL_WA + 8192))[d]; \
            f32x16 z; \
            _Pragma("unroll") for (int r = 0; r < 16; ++r) z[r] = bav; \
            const bf16x8 ah = *(const LDSAS bf16x8*)(lds + GL_RF + (it * 32 + r32) * 32 + hi * 16), al = *(const LDSAS bf16x8*)(lds + GL_RF + 2048 + (it * 32 + r32) * 32 + hi * 16); \
            const bf16x8 bh = *(const LDSAS bf16x8*)(lds + GL_WA + d * 32 + hi * 16), bl = *(const LDSAS bf16x8*)(lds + GL_WA + 4096 + d * 32 + hi * 16); \
            z = __builtin_amdgcn_mfma_f32_32x32x16_bf16(ah, bh, z, 0, 0, 0); \
            z = __builtin_amdgcn_mfma_f32_32x32x16_bf16(al, bh, z, 0, 0, 0); \
            z = __builtin_amdgcn_mfma_f32_32x32x16_bf16(ah, bl, z, 0, 0, 0); \
            float gs[4]; \
            _Pragma("unroll") for (int g = 0; g < 4; ++g) { \
                float run = 0.f; \
                _Pragma("unroll") for (int j = 0; j < 4; ++j) { \
                    const float zz = z[4 * g + j]; \
                    run += (fminf(zz, 0.f) - __builtin_amdgcn_logf(1.0f + __builtin_amdgcn_exp2f(-fabsf(zz)))) * (1.0f / 16.0f); \
                    lb[4 * g + j] = run; \
                } \
                gs[g] = run; \
            } \
            float off = 0.f; \
            _Pragma("unroll") for (int g = 0; g < 4; ++g) {        \
                const auto sw = __builtin_amdgcn_permlane32_swap(__float_as_uint(gs[g]), __float_as_uint(gs[g]), false, false);        \
                const float o2 = off + (hi ? __uint_as_float(sw[0]) : 0.f); \
                _Pragma("unroll") for (int j = 0; j < 4; ++j) lb[4 * g + j] += o2; \
                off += __uint_as_float(sw[0]) + __uint_as_float(sw[1]); \
            } \
            if (hi == 0) ((LDSAS float*)(lds + GL_TOT))[it * 128 + d] = off; } while (0)
        { int tq = tid; asm volatile("" : "+v"(tq)); GL_PREFETCH_RQK(0); GL_PREFETCH_V(0); GL_TOP(false); GL_PREFETCH_RQK(1); }
        __syncthreads();
        GL_Z();
        __syncthreads();
        for (int n = 0; n < 36; ++n) {
            const bool latent = n >= 4;
            const int membase = GL_MEMBASE(n);
            const int nn = n + 1 < 36 ? n + 1 : 35, n2 = n + 2 < 36 ? n + 2 : 35;
            {
                const float t0 = ((const LDSAS float*)(lds + GL_TOT))[d], t1 = ((const LDSAS float*)(lds + GL_TOT))[128 + d];
                const float prefix = it ? t0 : 0.f;
                const float dec = __builtin_amdgcn_exp2f(t0 + t1);
                const int le = lane;
                const int trs = (le & 15) >> 2, trc = dt * 4 + ((le >> 4) & 1) * 2 + ((le & 3) >> 1);
                const int troff = (it * 32 + 4 * (le >> 5) + trs) * 256 + ((trc ^ (4 * trs)) * 16) + (le & 1) * 8;
                u32x2 kr[4], qr[4];
#pragma unroll
                for (int g = 0; g < 4; ++g) { kr[g] = __builtin_bit_cast(u32x2, vtr(lds + GL_RK + troff + g * 2048)); if (latent) qr[g] = __builtin_bit_cast(u32x2, vtr(lds + GL_RQ + troff + g * 2048)); }
                float ktv[16];
                const int dp = ((d & ~15) + pos16(d & 15)) * 2;
#pragma unroll
                for (int r = 0; r < 16; r += 2) {
                    const int i0 = it * 32 + crow(r, hi), i1 = i0 + 1;
                    const float e0 = __builtin_amdgcn_exp2f(prefix + lb[r]), e1 = __builtin_amdgcn_exp2f(prefix + lb[r + 1]);
                    const unsigned kw2 = kr[r >> 2][(r >> 1) & 1];
                    const float kd0 = bflo(kw2) * __builtin_amdgcn_rcpf(e0), kd1 = bfhi(kw2) * __builtin_amdgcn_rcpf(e1);
                    ktv[r] = kd0 * dec; ktv[r + 1] = kd1 * dec;
                    lb[r] = e0; lb[r + 1] = e1;
                    if (latent) {
                        const unsigned kw = cvtpk(kd0, kd1);
                        *(LDSAS bf16_t*)(lds + GL_KD + i0 * 272 + dp) = (bf16_t)kw; *(LDSAS bf16_t*)(lds + GL_KD + i1 * 272 + dp) = (bf16_t)(kw >> 16);
                    }
                }
                if (latent) {
#pragma unroll
                    for (int r = 0; r < 16; r += 2) {
                        const int i0 = it * 32 + crow(r, hi), i1 = i0 + 1;
                        const unsigned qw2 = qr[r >> 2][(r >> 1) & 1];
                        const unsigned qw = cvtpk(bflo(qw2) * lb[r], bfhi(qw2) * lb[r + 1]);
                        *(LDSAS bf16_t*)(lds + GL_QD + i0 * 272 + dp) = (bf16_t)qw; *(LDSAS bf16_t*)(lds + GL_QD + i1 * 272 + dp) = (bf16_t)(qw >> 16);
                    }
                }
                u32x4 w0, w1;
                w0.x = cvtpk(ktv[0], ktv[1]); w0.y = cvtpk(ktv[2], ktv[3]); w0.z = cvtpk(ktv[4], ktv[5]); w0.w = cvtpk(ktv[6], ktv[7]);
                w1.x = cvtpk(ktv[8], ktv[9]); w1.y = cvtpk(ktv[10], ktv[11]); w1.z = cvtpk(ktv[12], ktv[13]); w1.w = cvtpk(ktv[14], ktv[15]);
                *(LDSAS u32x4*)(lds + GL_KT + d * 144 + (2 * it) * 32 + hi * 16) = w0;
                *(LDSAS u32x4*)(lds + GL_KT + d * 144 + (2 * it + 1) * 32 + hi * 16) = w1;
                if (it == 0 && hi == 0) ((LDSAS float*)(lds + GL_DEC))[d] = dec;
            }
            const int tq = tid;
#pragma unroll
            for (int k4 = 0; k4 < 4; ++k4) { const int idx = tq + 512 * k4, im = idx >> 5, ch = idx & 31; *(LDSAS u32x4*)(lds + GL_V + (ch >> 2) * 4096 + (dr ? 63 - im : im) * 64 + (ch & 3) * 16) = pf_v[k4]; }
            __syncthreads();
            GL_TOP(nn >= 4);
            GL_PREFETCH_V(nn);
            GL_PREFETCH_RQK(n2);
            bf16x8 vf[4];
#define GL_LOADV() do { const LDSAS unsigned char* vbp = lds + GL_V + wid * 4096 + (4 * hiq + ((lq & 15) >> 2)) * 64 + ((lq >> 4) & 1) * 32 + (lq & 3) * 8; \
                _Pragma("unroll") for (int js = 0; js < 4; ++js) { const s16x4 lo = vtr(vbp + js * 1024), hh = vtr(vbp + js * 1024 + 512); vf[js] = (bf16x8){lo[0], lo[1], lo[2], lo[3], hh[0], hh[1], hh[2], hh[3]}; } } while (0)
            __builtin_amdgcn_sched_barrier(0);
            const int lq = lane;
            const int r32q = lq & 31, hiq = lq >> 5;
#define GL_SUPDATE() do { _Pragma("unroll") for (int dt2 = 0; dt2 < 4; ++dt2) { __builtin_amdgcn_sched_barrier(0); \
                _Pragma("unroll") for (int g = 0; g < 4; ++g) { const f32x4 dc = *(const LDSAS f32x4*)(lds + GL_DEC + (dt2 * 32 + 8 * g + 4 * hiq) * 4); \
                    S[dt2][4 * g] *= dc[0]; S[dt2][4 * g + 1] *= dc[1]; S[dt2][4 * g + 2] *= dc[2]; S[dt2][4 * g + 3] *= dc[3]; } \
                const LDSAS unsigned char* ktp = lds + GL_KT + (dt2 * 32 + r32q) * 144 + hiq * 16; \
                _Pragma("unroll") for (int is = 0; is < 4; ++is) S[dt2] = __builtin_amdgcn_mfma_f32_32x32x16_bf16(*(const LDSAS bf16x8*)(ktp + is * 32), vf[is], S[dt2], 0, 0, 0); } } while (0)
            GL_LOADV();
            f32x16 o0 = (f32x16){}, o1 = (f32x16){};
            if (latent) {
                if (wid < 3) {
                    f32x16 X = (f32x16){};
                    const LDSAS unsigned char* kb = lds + GL_KD + ((wid == 2 ? 32 : 0) + r32q) * 272 + hiq * 16;
                    const LDSAS unsigned char* qb2 = lds + GL_QD + ((wid >= 1 ? 32 : 0) + r32q) * 272 + hiq * 16;
#pragma unroll
                    for (int s = 0; s < 8; ++s) X = __builtin_amdgcn_mfma_f32_32x32x16_bf16(*(const LDSAS bf16x8*)(kb + s * 32), *(const LDSAS bf16x8*)(qb2 + s * 32), X, 0, 0, 0);
                    if (wid != 1) {
                        const int rq = r32;
#pragma unroll
                        for (int r = 0; r < 16; ++r) X[r] = (crow(r, hi) <= rq) ? X[r] : 0.f;
                    }
                    *(LDSAS bf16x8*)(lds + GL_ATT + wid * 2048 + lq * 16) = pack8(X, 0);
                    *(LDSAS bf16x8*)(lds + GL_ATT + wid * 2048 + 1024 + lq * 16) = pack8(X, 8);
                }
                __builtin_amdgcn_sched_barrier(0);
                const LDSAS unsigned char* qb = lds + GL_QD + r32q * 272 + hiq * 16;
#pragma unroll
                for (int s = 0; s < 8; ++s) {
                    const bf16x8 Sb = pack8(S[s >> 1], (s & 1) * 8);
                    const bf16x8 q0 = *(const LDSAS bf16x8*)(qb + s * 32), q1 = *(const LDSAS bf16x8*)(qb + 32 * 272 + s * 32);
                    o0 = __builtin_amdgcn_mfma_f32_32x32x16_bf16(q0, Sb, o0, 0, 0, 0);
                    o1 = __builtin_amdgcn_mfma_f32_32x32x16_bf16(q1, Sb, o1, 0, 0, 0);
                    if (s & 1) __builtin_amdgcn_sched_barrier(0);
                }
            }
            __syncthreads();
            if (latent) {
                {
                    const LDSAS unsigned char* ab = lds + GL_ATT + lq * 16;
                    o0 = __builtin_amdgcn_mfma_f32_32x32x16_bf16(*(const LDSAS bf16x8*)(ab), vf[0], o0, 0, 0, 0);
                    o0 = __builtin_amdgcn_mfma_f32_32x32x16_bf16(*(const LDSAS bf16x8*)(ab + 1024), vf[1], o0, 0, 0, 0);
                    __builtin_amdgcn_sched_barrier(0);
                    o1 = __builtin_amdgcn_mfma_f32_32x32x16_bf16(*(const LDSAS bf16x8*)(ab + 2048), vf[0], o1, 0, 0, 0);
                    o1 = __builtin_amdgcn_mfma_f32_32x32x16_bf16(*(const LDSAS bf16x8*)(ab + 3072), vf[1], o1, 0, 0, 0);
                    __builtin_amdgcn_sched_barrier(0);
                    o1 = __builtin_amdgcn_mfma_f32_32x32x16_bf16(*(const LDSAS bf16x8*)(ab + 4096), vf[2], o1, 0, 0, 0);
                    o1 = __builtin_amdgcn_mfma_f32_32x32x16_bf16(*(const LDSAS bf16x8*)(ab + 5120), vf[3], o1, 0, 0, 0);
                }
                LDSAS unsigned char* ost = lds + GL_V + wid * 4096;
#pragma unroll
                for (int r = 0; r < 16; r += 2) {
                    const int i0 = crow(r, hi);
                    const unsigned w0 = cvtpk(o0[r], o0[r + 1]), w1 = cvtpk(o1[r], o1[r + 1]);
                    *(LDSAS bf16_t*)(ost + i0 * 64 + r32 * 2) = (bf16_t)w0; *(LDSAS bf16_t*)(ost + (i0 + 1) * 64 + r32 * 2) = (bf16_t)(w0 >> 16);
                    *(LDSAS bf16_t*)(ost + (32 + i0) * 64 + r32 * 2) = (bf16_t)w1; *(LDSAS bf16_t*)(ost + (33 + i0) * 64 + r32 * 2) = (bf16_t)(w1 >> 16);
                }
                bf16_t* od = P.OD() + (size_t)dr * ML * 1024 + h * 256 + wid * 32;
#pragma unroll
                for (int k4 = 0; k4 < 4; ++k4) {
                    const int p = lane + 64 * k4, i = p >> 2, part = p & 3;
                    const u32x4 v = *(const LDSAS u32x4*)(ost + i * 64 + part * 16);
                    *(u32x4*)(od + (size_t)(membase + (dr ? 63 - i : i)) * 1024 + part * 8) = v;
                }
            }
            GL_SUPDATE();
            GL_Z();
            __syncthreads();
#undef GL_LOADV
#undef GL_SUPDATE
        }
#undef GL_PREFETCH_V
#undef GL_PREFETCH_RQK
#undef GL_TOP
#undef GL_Z
#undef GL_MEMBASE
    }
}

__device__ __forceinline__ void phase_rstd1(const Params& P, int vb, int nvb, int g_wave) {
    const int tidx = otid();
    for (int row = vb * 512 + tidx; row < M; row += nvb * 512) {
        float ss = 0.f;
#pragma unroll
        for (int i = 0; i < 16; ++i) ss += P.parts()[(size_t)i * M + row];
        ((float*)(P.ws + OFF_RS))[row] = rsqrtf(ss * (1.0f / 1024.0f) + EPS);
    }
}

__device__ __forceinline__ void phase_finish(const Params& P, int vb, int nvb, int g_wave) {
    const int tidx = otid();
    const int lane = tidx & 63, wpb = blockDim.x >> 6, w = tidx >> 6;
    for (int row = vb * wpb + w; row < ML; row += nvb * wpb) {
        const int c0 = lane * 16;
        float v[16];
        const u32x4* pf = (const u32x4*)(P.OD() + (size_t)row * 1024 + c0);
        const u32x4* pb = (const u32x4*)(P.OD() + ((size_t)ML + row) * 1024 + c0);
        float ss = 0.f;
#pragma unroll
        for (int i = 0; i < 2; ++i) {
            const u32x4 a = pf[i], bq = pb[i];
            v[8 * i] = bflo(a.x) + bflo(bq.x); v[8 * i + 1] = bfhi(a.x) + bfhi(bq.x); v[8 * i + 2] = bflo(a.y) + bflo(bq.y); v[8 * i + 3] = bfhi(a.y) + bfhi(bq.y);
            v[8 * i + 4] = bflo(a.z) + bflo(bq.z); v[8 * i + 5] = bfhi(a.z) + bfhi(bq.z); v[8 * i + 6] = bflo(a.w) + bflo(bq.w); v[8 * i + 7] = bfhi(a.w) + bfhi(bq.w);
        }
#pragma unroll
        for (int i = 0; i < 16; ++i) ss += v[i] * v[i];
        ss += __shfl_xor(ss, 1); ss += __shfl_xor(ss, 2); ss += __shfl_xor(ss, 4); ss += __shfl_xor(ss, 8);
        const float rn = rsqrtf(ss * (1.0f / 256.0f) + EPS);
        float gn[16];
        { const f32x4* gnp = (const f32x4*)(P.gla_out_norm + (c0 & 255));
#pragma unroll
          for (int i = 0; i < 4; ++i) { const f32x4 t4 = gnp[i]; gn[4 * i] = t4[0]; gn[4 * i + 1] = t4[1]; gn[4 * i + 2] = t4[2]; gn[4 * i + 3] = t4[3]; } }
        const u32x4* gp = (const u32x4*)(P.GG() + (size_t)row * 1024 + c0);
        u32x4* op = (u32x4*)(P.A2() + (size_t)row * 1024 + c0);
        const u32x4 gq[2] = {gp[0], gp[1]};
#pragma unroll
        for (int i = 0; i < 2; ++i) {
            const u32x4 g = gq[i]; u32x4 r;
            r.x = cvtpk(v[8 * i] * rn * gn[8 * i] * bflo(g.x), v[8 * i + 1] * rn * gn[8 * i + 1] * bfhi(g.x));
            r.y = cvtpk(v[8 * i + 2] * rn * gn[8 * i + 2] * bflo(g.y), v[8 * i + 3] * rn * gn[8 * i + 3] * bfhi(g.y));
            r.z = cvtpk(v[8 * i + 4] * rn * gn[8 * i + 4] * bflo(g.z), v[8 * i + 5] * rn * gn[8 * i + 5] * bfhi(g.z));
            r.w = cvtpk(v[8 * i + 6] * rn * gn[8 * i + 6] * bflo(g.w), v[8 * i + 7] * rn * gn[8 * i + 7] * bfhi(g.w));
            op[i] = r;
        }
    }
}

namespace cg = cooperative_groups;
#define XB_TMO      128
#define XB_XCNT(j)  (256  + 64 * (j))
#define XB_XSUB(j)  (1280 + 64 * (j))
#define XB_XGEN(j)  (2304 + 64 * (j))
#define XB_TOP      3328
#define XB_TOPGEN   3392
#define XCD_BAR_WORDS 3456
#define XB_SPIN_CAP (1u << 22)
static_assert(XCD_BAR_WORDS * 4 <= 16384, "barrier words fit their workspace slot");
__device__ __forceinline__ unsigned xb_ld(unsigned* p) { return __hip_atomic_load(p, __ATOMIC_RELAXED, __HIP_MEMORY_SCOPE_AGENT); }
__device__ __forceinline__ unsigned xb_add(unsigned* p, unsigned v) { return __hip_atomic_fetch_add(p, v, __ATOMIC_RELAXED, __HIP_MEMORY_SCOPE_AGENT); }
__device__ __forceinline__ unsigned xb_xcc_id() { return (unsigned)__builtin_amdgcn_s_getreg((3 << 11) | 20) & 0xFu; }
#define XB_SPIN(cond, bar) do { unsigned _sp = 0; while (cond) { __builtin_amdgcn_s_sleep(1); \
    if ((++_sp & 255u) == 0u) { if (xb_ld(&(bar)[XB_TMO])) break; if (_sp > XB_SPIN_CAP) { atomicAdd(&(bar)[XB_TMO], 1u); break; } } } } while (0)
__device__ __forceinline__ void xcd_barrier_complete(unsigned* bar, unsigned x, unsigned G, unsigned& nloc, unsigned& nx) {
    unsigned sum, cnt, mine, sp = 0u;
    for (;;) {
        sum = 0u; cnt = 0u; mine = 0u;
#pragma unroll
        for (unsigned j = 0; j < 16; ++j) { const unsigned c = xb_ld(&bar[XB_XCNT(j)]); sum += c; cnt += (c > 0u) ? 1u : 0u; mine = (j == x) ? c : mine; }
        if (sum == G) break;
        __builtin_amdgcn_s_sleep(1);
        if ((++sp & 255u) == 0u) { if (xb_ld(&bar[XB_TMO])) break; if (sp > XB_SPIN_CAP) { atomicAdd(&bar[XB_TMO], 1u); break; } }
    }
    nloc = mine > 0u ? mine : 1u; nx = cnt > 0u ? cnt : 1u;
}
__device__ __forceinline__ void xcd_barrier(unsigned* bar, volatile LDSAS unsigned* st, unsigned G, int g_wave) {
    asm volatile("s_waitcnt vmcnt(0)" ::: "memory");
    __syncthreads();
    if (g_wave == 0 && lane_id() == 0) {
        const unsigned x = xb_xcc_id();
        __builtin_amdgcn_s_waitcnt(0);
        unsigned nloc = st[0], nx = st[1];
        if (nloc == 0u) { xcd_barrier_complete(bar, x, G, nloc, nx); st[0] = nloc; st[1] = nx; }
        const unsigned old = xb_add(&bar[XB_XSUB(x)], 1u);
        const unsigned gen = old / nloc;
        if (old + 1u == (gen + 1u) * nloc) {
            __builtin_amdgcn_fence(__ATOMIC_RELEASE, "agent");
            asm volatile("s_waitcnt vmcnt(0)" ::: "memory");
            const unsigned og = xb_add(&bar[XB_TOP], 1u);
            const unsigned tg = og / nx;
            if (og + 1u == (tg + 1u) * nx) xb_add(&bar[XB_TOPGEN], 1u);
            else XB_SPIN(xb_ld(&bar[XB_TOPGEN]) == tg, bar);
            __builtin_amdgcn_fence(__ATOMIC_ACQUIRE, "agent");
            xb_add(&bar[XB_XGEN(x)], 1u);
            asm volatile("s_waitcnt vmcnt(0)" ::: "memory");
        } else {
            XB_SPIN(xb_ld(&bar[XB_XGEN(x)]) == gen, bar);
            __builtin_amdgcn_fence(__ATOMIC_ACQUIRE, "agent");
            asm volatile("s_waitcnt vmcnt(0)" ::: "memory");
        }
    }
    __syncthreads();
}

#define GRID_BAR() xcd_barrier((unsigned*)(ldparams().ws + OFF_BAR), (volatile LDSAS unsigned*)(lds + KERNEL_LDS), (unsigned)nvb, g_wave)
#define REPEAT(k, ...) { const Params P = ldparams(); __VA_ARGS__ }
__global__ void __launch_bounds__(512) mega_kernel(Params Pk) {
    __shared__ __attribute__((aligned(16))) unsigned char lds[KERNEL_LDS + 16];
    const int vb = blockIdx.x, nvb = gridDim.x;
    const int g_wave = __builtin_amdgcn_readfirstlane((int)(threadIdx.x >> 6));
    if (threadIdx.x == 0) {
        ((volatile LDSAS unsigned*)(lds + KERNEL_LDS))[0] = 0u; ((volatile LDSAS unsigned*)(lds + KERNEL_LDS))[1] = 0u;
        (void)xb_add(&((unsigned*)(Pk.ws + OFF_BAR))[XB_XCNT(xb_xcc_id())], 1u);
    }
#ifdef PROBE_A
#define STAMP(k) do { if (vb == 0 && g_wave == 0 && lane_id() == 0) ((unsigned long long*)(ldparams().ws + OFF_BAR + 14336))[k] = __builtin_amdgcn_s_memrealtime(); } while (0)
#else
#define STAMP(k) do { } while (0)
#endif
    STAMP(0);
    REPEAT(0, phase_pro0(P, lds, vb, nvb, g_wave);)
    STAMP(1);
    if (ldparams().reps[11] != 0) cg::this_grid().sync();
    GRID_BAR();
    REPEAT(1, phase_bias_a0(P, lds, vb, nvb, g_wave);)
    STAMP(2);
    GRID_BAR();
    REPEAT(2, EpiIn0 E{P.ws, P.a_q_norm, P.a_k_norm, P.b_q_norm, P.b_k_norm};
      pg8::Gemm g{P.A(), P.Wt0(), M, N0, D}; pg8::StaticOrder S; S.init(M, N0, nvb, vb); pg8::gemm_phase<EpiIn0, pg8::StaticOrder, true, true>((LDSAS unsigned char*)lds, g, S, E, g_wave);)
    STAMP(3);
    GRID_BAR();
    REPEAT(3, phase_attnA_mfma(P, (LDSAS unsigned char*)lds, vb, nvb, g_wave);)
    REPEAT(4, phase_attnB_mfma(P, (LDSAS unsigned char*)lds, vb, nvb, g_wave);)
    STAMP(4);
    GRID_BAR();
    REPEAT(5, EpiOut0 E{P.x, P.ctx, P.norm_g + D, P.out, P.ws};
      pg8::Gemm g{P.O(), P.Wo0(), M, D, D}; pg8::StaticOrder S; S.init(M, D, nvb, vb); pg8::gemm_phase<EpiOut0, pg8::StaticOrder, true, true>((LDSAS unsigned char*)lds, g, S, E, g_wave);)
    STAMP(5);
    GRID_BAR();
    { const Params P = ldparams(); phase_rstd1(P, vb, nvb, g_wave); }
    GRID_BAR();
    REPEAT(6, EpiIn1 E{P.ws};
      pg8::Gemm g{P.A(), P.Wt1(), M, N1, D}; OrderIn1 S; S.init(nvb, vb); pg8::gemm_phase<EpiIn1, OrderIn1, true, true>((LDSAS unsigned char*)lds, g, S, E, g_wave);)
    STAMP(6);
    GRID_BAR();
    REPEAT(7, phase_gla_mfma(P, (LDSAS unsigned char*)lds, vb, nvb, g_wave);)
    STAMP(7);
    GRID_BAR();
    REPEAT(8, phase_finish(P, vb, nvb, g_wave);)
    STAMP(8);
    GRID_BAR();
    { const Params P = ldparams();
      EpiOut1 E{P.ws, P.out};
      pg8::Gemm g{P.A2(), P.Wo1(), ML, D, D}; pg8::StaticOrder S; S.init(ML, D, nvb, vb); pg8::gemm_phase<EpiOut1, pg8::StaticOrder, true, true>((LDSAS unsigned char*)lds, g, S, E, g_wave); }
#ifdef PROBE_A
    STAMP(9);
    GRID_BAR();
    if (vb == 0 && g_wave == 0 && lane_id() == 0) {
        const Params P = ldparams(); const unsigned long long* ts = (const unsigned long long*)(P.ws + OFF_BAR + 14336);
        P.out[0] += (float)(ts[PROBE_A + 1] - ts[PROBE_A]) * 0.01f;
        P.out[1] += (float)(ts[PROBE_B + 1] - ts[PROBE_B]) * 0.01f;
    }
#endif
}
}

extern "C" void kernel_launch(void* const* d_in, const int* in_sizes, int n_in, void* d_out, int out_size, void* d_ws, size_t ws_size, hipStream_t stream) {
    Params P{};
    const float* const* in = (const float* const*)d_in;
    P.x = in[0]; P.c = in[1]; P.ctx = in[2]; P.c_ctx = in[3]; P.adaln_w = in[4]; P.adaln_b = in[5]; P.norm_g = in[6]; P.w_out = in[7]; P.ab_w_in = in[8];
    P.a_q_norm = in[9]; P.a_k_norm = in[10]; P.a_sink = in[11]; P.b_q_norm = in[12]; P.b_k_norm = in[13]; P.lq1 = in[14]; P.lk1 = in[15]; P.lq2 = in[16]; P.lk2 = in[17];
    P.b_subln = in[18]; P.gla_w_in = in[19]; P.wa_f = in[20]; P.ba_f = in[21]; P.wa_b = in[22]; P.ba_b = in[23]; P.gla_out_norm = in[24];
    P.out = (float*)d_out;
    P.ws = (unsigned char*)d_ws;
    for (int i = 0; i < 12; ++i) P.reps[i] = 1;
    P.reps[11] = 0;
#ifdef PROBE_PHASE
    P.reps[PROBE_PHASE] = 2;
#endif
    if (WS_NEED > ws_size) { fprintf(stderr, "workspace too small: need %zu have %zu\n", (size_t)WS_NEED, ws_size); return; }
    static int grid_blocks = 0;
    if (!grid_blocks) {
        int dev = 0, cus = 0, per_cu = 0;
        (void)hipGetDevice(&dev);
        (void)hipDeviceGetAttribute(&cus, hipDeviceAttributeMultiprocessorCount, dev);
        (void)hipOccupancyMaxActiveBlocksPerMultiprocessor(&per_cu, mega_kernel, 512, 0);
        if (per_cu > 1) per_cu = 1;
        grid_blocks = cus * per_cu;
    }
    (void)hipMemsetAsync((unsigned char*)d_ws + OFF_BAR, 0, 16384, stream);
    void* args[] = {&P};
    hipError_t e = hipLaunchCooperativeKernel((void*)mega_kernel, dim3(grid_blocks), dim3(512), args, 0, stream);
    if (e != hipSuccess) fprintf(stderr, "cooperative launch failed: %s (grid %d)\n", hipGetErrorString(e), grid_blocks);
}
```

```cpp
#include <hip/hip_runtime.h>
#include <hip/hip_cooperative_groups.h>
#include <cstdint>
#include <cstdio>

namespace {
constexpr int NB = 32, T = 2048, L = 256, D = 1024;
constexpr int ML = NB * T, MC = NB * L, M = ML + MC;
constexpr int N0 = 3328, N1 = 3328, N0R = 3328, N1R = 3104;
constexpr float EPS = 1e-6f;
constexpr float LOG2E = 1.4426950408889634f;
constexpr float QSCALE = 0.125f * LOG2E;
constexpr float LAMBDA_INIT = 0.2f;

typedef unsigned short bf16_t;
typedef short bf16x8 __attribute__((ext_vector_type(8)));
typedef float f32x4 __attribute__((ext_vector_type(4)));
typedef unsigned u32x4 __attribute__((ext_vector_type(4)));
typedef unsigned u32x2 __attribute__((ext_vector_type(2)));

constexpr size_t al256(size_t x) { return (x + 255) & ~(size_t)255; }
constexpr size_t OFF_WT0 = 0;
constexpr size_t OFF_WT1 = OFF_WT0 + al256((size_t)N0 * D * 2);
constexpr size_t OFF_WO0 = OFF_WT1 + al256((size_t)N1 * D * 2);
constexpr size_t OFF_WO1 = OFF_WO0 + al256((size_t)D * D * 2);
constexpr size_t OFF_MOD = OFF_WO1 + al256((size_t)D * D * 2);
constexpr size_t OFF_BIAS0 = OFF_MOD + al256((size_t)2 * 33 * 3072 * 4);
constexpr size_t OFF_BIAS1 = OFF_BIAS0 + al256((size_t)33 * 3328 * 4);
constexpr size_t OFF_ROPE = OFF_BIAS1 + al256((size_t)33 * 3328 * 4);
constexpr size_t OFF_SCAL = OFF_ROPE + al256(64 * 16 * 2 * 4);
constexpr size_t OFF_BAR = OFF_SCAL + 256;
constexpr size_t OFF_RS = OFF_BAR + 16384;
constexpr size_t OFF_PARTS = OFF_RS + al256((size_t)M * 4);
constexpr size_t OFF_A = OFF_PARTS + al256((size_t)16 * M * 4);
constexpr size_t OFF_O = OFF_A + (size_t)M * D * 2;
constexpr size_t OFF_QKV = OFF_O + (size_t)M * D * 2;
constexpr size_t OFF_X1B = OFF_QKV + (size_t)M * 3328 * 2;
constexpr size_t WS_NEED = OFF_X1B + (size_t)ML * D * 2;
constexpr size_t OFF_QA = OFF_QKV, OFF_KA = OFF_QA + (size_t)M * 512 * 2, OFF_VA = OFF_KA + (size_t)M * 128 * 2, OFF_GA = OFF_VA + (size_t)M * 128 * 2;
constexpr size_t OFF_QB = OFF_GA + (size_t)M * 512 * 2, OFF_KB = OFF_QB + (size_t)M * 512 * 2, OFF_VB = OFF_KB + (size_t)M * 512 * 2, OFF_GB = OFF_VB + (size_t)M * 512 * 2;
constexpr size_t OFF_QG = OFF_QKV, OFF_KG = OFF_QG + (size_t)M * 512 * 2, OFF_VG = OFF_KG + (size_t)M * 512 * 2, OFF_GG = OFF_VG + (size_t)M * 1024 * 2, OFF_RF = OFF_GG + (size_t)M * 1024 * 2;
static_assert(OFF_RF + (size_t)M * 32 * 4 <= WS_NEED, "layer-1 projections fit");
static_assert((size_t)2 * ML * 1024 * 2 <= (size_t)2 * M * D * 2, "OD fits over A + O");

struct Params {
    const float *x, *c, *ctx, *c_ctx, *adaln_w, *adaln_b, *norm_g, *w_out, *ab_w_in, *a_q_norm, *a_k_norm, *a_sink, *b_q_norm, *b_k_norm;
    const float *lq1, *lk1, *lq2, *lk2, *b_subln, *gla_w_in, *wa_f, *ba_f, *wa_b, *ba_b, *gla_out_norm;
    float* out;
    unsigned char* ws;
    int reps[12];
#define WSPTR(T, name, off) __device__ __forceinline__ T* name() const { return (T*)(ws + (off)); }
    WSPTR(bf16_t, Wt0, OFF_WT0) WSPTR(bf16_t, Wt1, OFF_WT1) WSPTR(bf16_t, Wo0, OFF_WO0) WSPTR(bf16_t, Wo1, OFF_WO1)
    WSPTR(float, mod, OFF_MOD) WSPTR(float, bias0, OFF_BIAS0) WSPTR(float, bias1, OFF_BIAS1) WSPTR(float, rope, OFF_ROPE) WSPTR(float, scal, OFF_SCAL) WSPTR(float, parts, OFF_PARTS)
    WSPTR(bf16_t, A, OFF_A) WSPTR(bf16_t, O, OFF_O)
    WSPTR(bf16_t, QA, OFF_QA) WSPTR(bf16_t, KA, OFF_KA) WSPTR(bf16_t, VA, OFF_VA) WSPTR(bf16_t, GA, OFF_GA)
    WSPTR(bf16_t, QB, OFF_QB) WSPTR(bf16_t, KB, OFF_KB) WSPTR(bf16_t, VB, OFF_VB) WSPTR(bf16_t, GB, OFF_GB)
    WSPTR(bf16_t, QG, OFF_QG) WSPTR(bf16_t, KG, OFF_KG) WSPTR(bf16_t, VG, OFF_VG) WSPTR(bf16_t, GG, OFF_GG) WSPTR(float, RF, OFF_RF)
    WSPTR(bf16_t, OD, OFF_A) WSPTR(bf16_t, A2, OFF_QKV)
#undef WSPTR
};

__device__ __forceinline__ int lane_id() { int l; asm volatile("v_mbcnt_lo_u32_b32 %0, -1, 0\n\tv_mbcnt_hi_u32_b32 %0, -1, %0" : "=v"(l)); return l; }
#define otid() otid_(g_wave)
__device__ __forceinline__ int otid_(int wave) { int t = wave * 64 + lane_id(); asm volatile("" : "+v"(t)); return t; }
__device__ __forceinline__ unsigned f2bf(float f) { unsigned u = __float_as_uint(f); u += 0x7FFFu + ((u >> 16) & 1u); return u >> 16; }
__device__ __forceinline__ unsigned pack2(float lo, float hi) { return f2bf(lo) | (f2bf(hi) << 16); }
typedef float f32x2_t __attribute__((ext_vector_type(2)));
typedef __bf16 bf16x2_t __attribute__((ext_vector_type(2)));
__device__ __forceinline__ unsigned cvtpk(float lo, float hi) { f32x2_t v = {lo, hi}; bf16x2_t b = __builtin_convertvector(v, bf16x2_t); return __builtin_bit_cast(unsigned, b); }
__device__ __forceinline__ float bf2f(unsigned h) { return __uint_as_float(h << 16); }
__device__ __forceinline__ float bflo(unsigned w) { return __uint_as_float(w << 16); }
__device__ __forceinline__ float bfhi(unsigned w) { return __uint_as_float(w & 0xFFFF0000u); }
__device__ __forceinline__ float sum_xor16(float x) { const auto r = __builtin_amdgcn_permlane16_swap(__float_as_uint(x), __float_as_uint(x), false, false); return __uint_as_float(r[0]) + __uint_as_float(r[1]); }
__device__ __forceinline__ float sum_xor32(float x) { const auto r = __builtin_amdgcn_permlane32_swap(__float_as_uint(x), __float_as_uint(x), false, false); return __uint_as_float(r[0]) + __uint_as_float(r[1]); }
__device__ __forceinline__ float siluf(float v) { return v * __builtin_amdgcn_rcpf(1.0f + __builtin_amdgcn_exp2f(-v * LOG2E)); }

__device__ __forceinline__ Params ldparams() {
#if defined(__HIP_DEVICE_COMPILE__)
    const __attribute__((address_space(4))) Params* pp = (const __attribute__((address_space(4))) Params*)__builtin_amdgcn_kernarg_segment_ptr();
    asm volatile("" : "+s"(pp));
    return *pp;
#else
    return Params{};
#endif
}

__device__ __forceinline__ int perm_local(int p, bool ropeType) {
    const int bj = p >> 7, wc = (p >> 5) & 3, low = p & 31;
    if (ropeType) return wc * 64 + bj * 32 + low;
    const int n = (low >> 4) & 1, fq = (low >> 2) & 3, e = low & 3;
    return wc * 64 + bj * 32 + fq * 8 + n * 4 + e;
}
__device__ __forceinline__ int src_col(int which, int np) {
    const int p = np & 255, tile = np >> 8;
    bool rope = false;
    if (which == 0) { const int g = tile * 4 + ((p >> 5) & 3); rope = (g < 10) || (g >= 20 && g < 36); }
    const int c = tile * 256 + perm_local(p, rope);
    const int nreal = which == 0 ? N0R : (which == 1 ? N1R : D);
    return c < nreal ? c : -1;
}

__device__ __forceinline__ int dst_row(int which, int c) {
    const int tile = c >> 8, cl = c & 255, wc = cl >> 6, bj = (cl >> 5) & 1, low = cl & 31;
    bool rope = false;
    if (which == 0) { const int g = tile * 4 + wc; rope = (g < 10) || (g >= 20 && g < 36); }
    int lo5 = low;
    if (!rope) { const int fq = low >> 3, n = (low >> 2) & 1, e = low & 3; lo5 = n * 16 + fq * 4 + e; }
    return tile * 256 + bj * 128 + wc * 32 + lo5;
}

__device__ __forceinline__ void wt_quad(const float* __restrict__ W, int ldw, int nreal, int which, bf16_t* __restrict__ dst, int c0, int k0, unsigned char* lds, int tid) {
    bf16_t* t = (bf16_t*)lds;
    __syncthreads();
    f32x4 v[8];
#pragma unroll
    for (int i = 0; i < 8; ++i) {
        const int idx = tid + 512 * i, r = idx >> 4, c4 = (idx & 15) * 4;
        const bool ok = c0 + c4 < nreal;
        const f32x4 t4 = *(const f32x4*)(W + (size_t)(k0 + r) * ldw + (ok ? c0 + c4 : 0));
        v[i] = ok ? t4 : (f32x4){0.f, 0.f, 0.f, 0.f};
    }
#pragma unroll
    for (int i = 0; i < 8; ++i) {
        const int idx = tid + 512 * i, r = idx >> 4, c4 = (idx & 15) * 4;
#pragma unroll
        for (int j = 0; j < 4; ++j) t[(c4 + j) * 264 + r] = (bf16_t)f2bf(v[i][j]);
    }
    __syncthreads();
    const int c = tid >> 3, kc = tid & 7;
    bf16_t* drow = dst + (size_t)dst_row(which, c0 + c) * D + k0 + kc * 32;
#pragma unroll
    for (int j = 0; j < 4; ++j) *(u32x4*)(drow + j * 8) = *(const u32x4*)(t + c * 264 + kc * 32 + j * 8);
}

template <int MODE>
__device__ __forceinline__ void skinny_unit(const Params& P, int l, int c0, unsigned char* lds, int tid) {
    float* tab = (float*)lds;
    const int lane = tid & 63, w = tid >> 6;
    const float* W; int ldw, nreal;
    if (MODE == 0) { W = P.adaln_w + (size_t)l * D * 3072; ldw = 3072; nreal = 3072; }
    else { W = l ? P.gla_w_in : P.ab_w_in; ldw = l ? N1R : N0R; nreal = ldw; }
    const bool colok = c0 + lane < nreal;
    float acc[33];
#pragma unroll
    for (int r = 0; r < 33; ++r) acc[r] = 0.f;
    for (int half = 0; half < 2; ++half) {
        __syncthreads();
        for (int r = 0; r < 33; ++r) {
            float v;
            if (MODE == 0) v = siluf(r < 32 ? P.c[r * D + half * 512 + tid] : P.c_ctx[half * 512 + tid]);
            else v = P.mod()[((size_t)l * 33 + r) * 3072 + half * 512 + tid];
            tab[tid * 36 + r] = v;
        }
        __syncthreads();
        const float* wp = W + (size_t)(half * 512 + w * 64) * ldw + (colok ? c0 + lane : 0);
        float wn[4];
#pragma unroll
        for (int j = 0; j < 4; ++j) wn[j] = wp[(size_t)j * ldw];
#pragma unroll 1
        for (int kk = 0; kk < 64; kk += 4) {
            float wc[4];
#pragma unroll
            for (int j = 0; j < 4; ++j) wc[j] = colok ? wn[j] : 0.f;
            const int kn = kk + 4 < 64 ? kk + 4 : 60;
#pragma unroll
            for (int j = 0; j < 4; ++j) wn[j] = wp[(size_t)(kn + j) * ldw];
#pragma unroll
            for (int j = 0; j < 4; ++j) {
                const int k = w * 64 + kk + j; const float wv = wc[j];
#pragma unroll
                for (int r4 = 0; r4 < 8; ++r4) { const f32x4 s = *(const f32x4*)(tab + k * 36 + r4 * 4); acc[r4 * 4] += s[0] * wv; acc[r4 * 4 + 1] += s[1] * wv; acc[r4 * 4 + 2] += s[2] * wv; acc[r4 * 4 + 3] += s[3] * wv; }
                acc[32] += tab[k * 36 + 32] * wv;
            }
        }
    }
    __syncthreads();
#pragma unroll
    for (int r = 0; r < 33; ++r) tab[(w * 33 + r) * 64 + lane] = acc[r];
    __syncthreads();
    for (int idx = tid; idx < 33 * 64; idx += 512) {
        const int r = idx >> 6, col = idx & 63;
        float s = 0.f;
#pragma unroll
        for (int ww = 0; ww < 8; ++ww) s += tab[(ww * 33 + r) * 64 + col];
        if (MODE == 0) { const int j = c0 + col; P.mod()[((size_t)l * 33 + r) * 3072 + j] = s + P.adaln_b[l * 3072 + j]; }
        else { const int c = c0 + col; (l ? P.bias1() : P.bias0())[r * 3328 + dst_row(l, c)] = c < nreal ? s : 0.f; }
    }
}

constexpr int TICKET_LDS = 140288 + 8;
#define TICKET_LOOP(ctr, N, ...) { volatile int* sh_ = (volatile int*)(lds + TICKET_LDS); unsigned* ctr_ = (unsigned*)(P.ws + OFF_BAR + 14336) + (ctr) * 16; \
        __syncthreads(); if (tidx == 0) *sh_ = (int)__hip_atomic_fetch_add(ctr_, 1u, __ATOMIC_RELAXED, __HIP_MEMORY_SCOPE_AGENT); __syncthreads(); \
        int item = *sh_; \
        while (item < (N)) { unsigned nx_ = 0; if (tidx == 0) nx_ = __hip_atomic_fetch_add(ctr_, 1u, __ATOMIC_RELAXED, __HIP_MEMORY_SCOPE_AGENT); \
            __VA_ARGS__ \
            __syncthreads(); if (tidx == 0) *sh_ = (int)nx_; __syncthreads(); item = *sh_; } }

__device__ __forceinline__ void phase_pro0(const Params& P, unsigned char* lds, int vb, int nvb, int g_wave) {
    const int tidx = otid();
    TICKET_LOOP(0, 96 + 544,
        if (item < 96) skinny_unit<0>(P, item / 48, (item % 48) * 64, lds, tidx);
        else {
            int t = item - 96; int which; const float* W; bf16_t* dst; int ldw, nreal;
            if (t < 208) { which = 0; W = P.ab_w_in; dst = P.Wt0(); ldw = N0R; nreal = N0R; }
            else if ((t -= 208) < 208) { which = 1; W = P.gla_w_in; dst = P.Wt1(); ldw = N1R; nreal = N1R; }
            else if ((t -= 208) < 64) { which = 2; W = P.w_out; dst = P.Wo0(); ldw = D; nreal = D; }
            else { t -= 64; which = 3; W = P.w_out + (size_t)D * D; dst = P.Wo1(); ldw = D; nreal = D; }
            wt_quad(W, ldw, nreal, which, dst, (t >> 2) * 64, (t & 3) * 256, lds, tidx);
        })
    if (vb == nvb - 1 && tidx == 0) {
        float d1 = 0.f, d2 = 0.f;
        for (int i = 0; i < 64; ++i) { d1 += P.lq1[i] * P.lk1[i]; d2 += P.lq2[i] * P.lk2[i]; }
        P.scal()[0] = expf(d1) - expf(d2) + LAMBDA_INIT;
    }
}

__device__ __forceinline__ void a0_row(const Params& P, int row, int lane) {
    const float* xin = row < ML ? P.x + (size_t)row * D : P.ctx + (size_t)(row - ML) * D;
    const int r = row < ML ? row >> 11 : 32;
    const float* sc = P.mod() + (size_t)r * 3072 + 1024;
    float ss = 0.f;
    f32x4 a[2], b[2], g0[2], g1[2], s0[2], s1[2];
#pragma unroll
    for (int i = 0; i < 2; ++i) {
        const int c0 = i * 512 + lane * 8;
        a[i] = *(const f32x4*)(xin + c0); b[i] = *(const f32x4*)(xin + c0 + 4);
        g0[i] = *(const f32x4*)(P.norm_g + c0); g1[i] = *(const f32x4*)(P.norm_g + c0 + 4);
        s0[i] = *(const f32x4*)(sc + c0); s1[i] = *(const f32x4*)(sc + c0 + 4);
    }
#pragma unroll
    for (int i = 0; i < 2; ++i) {
        const int c0 = i * 512 + lane * 8;
        ss += a[i][0] * a[i][0] + a[i][1] * a[i][1] + a[i][2] * a[i][2] + a[i][3] * a[i][3] + b[i][0] * b[i][0] + b[i][1] * b[i][1] + b[i][2] * b[i][2] + b[i][3] * b[i][3];
        const f32x4 ya = a[i] * g0[i] * (1.0f + s0[i]), yb = b[i] * g1[i] * (1.0f + s1[i]);
        u32x4 o; o.x = cvtpk(ya[0], ya[1]); o.y = cvtpk(ya[2], ya[3]); o.z = cvtpk(yb[0], yb[1]); o.w = cvtpk(yb[2], yb[3]);
        *(u32x4*)(P.A() + (size_t)row * D + c0) = o;
    }
    ss = sum_xor32(ss); ss = sum_xor16(ss);
#pragma unroll
    for (int o = 8; o >= 1; o >>= 1) ss += __shfl_xor(ss, o);
    if (lane == 0) ((float*)(P.ws + OFF_RS))[row] = rsqrtf(ss * (1.0f / 1024.0f) + EPS);
}

__device__ __forceinline__ void phase_bias_a0(const Params& P, unsigned char* lds, int vb, int nvb, int g_wave) {
    const int tidx = otid();
    const int lane = tidx & 63, w = tidx >> 6;
    TICKET_LOOP(1, 104 + M / 32,
        if (item < 104) skinny_unit<1>(P, item / 52, (item % 52) * 64, lds, tidx);
        else {
            const int row0 = (item - 104) * 32 + w * 4;
            for (int j = 0; j < 4; ++j) a0_row(P, row0 + j, lane);
        })
}

namespace pg8 {
#define PG8_LAS __attribute__((address_space(3)))
typedef unsigned short bf16_t;
typedef short bf16x8 __attribute__((ext_vector_type(8)));
typedef float f32x4 __attribute__((ext_vector_type(4)));
typedef unsigned u32x4 __attribute__((ext_vector_type(4)));
constexpr int BM = 256, BK = 64, HALF = 128, HTB = HALF * BK * 2  , STAGE_BYTES = 8 * HTB, NXCD = 8, WGM = 8;

__host__ __device__ __forceinline__ int lds_byte(int r, int c) { const int st = (r >> 4) * 2 + (c >> 5), rr = r & 15, cc = c & 31, ob = rr * 64 + cc * 2; return st * 1024 + (ob ^ (((ob >> 9) & 1) << 5)); }
__host__ __device__ __forceinline__ void stage_rc(int b, int& R, int& C) { const int st = b / 1024, sb = b % 1024, swz = sb ^ (((sb >> 9) & 1) << 5); R = (st >> 1) * 16 + swz / 64; C = (st & 1) * 32 + (swz % 64) / 2; }
__host__ __device__ __forceinline__ int perm32(int rho) { const int n = rho >> 4, i = rho & 15; return 8 * (i >> 2) + 4 * n + (i & 3); }

struct Unit { int pm, pn; };
struct Gemm { const bf16_t* A; const bf16_t* Bt; int M, N, K; };

struct StaticOrder {
    int nM, nN, nwg, G, c;
    __host__ __device__ void init(int M, int N, int G_, int c_) { nM = M / BM; nN = N / BM; nwg = nM * nN; G = G_; c = c_; }
    __host__ __device__ bool next(int i, Unit& u) const {
        const long L = (long)i * G + c; if (L >= nwg) return false;
        int wgid = (int)L; { const int q = nwg / NXCD, r = nwg % NXCD, xcd = wgid % NXCD, off = wgid / NXCD; wgid = (xcd < r ? xcd * (q + 1) : r * (q + 1) + (xcd - r) * q) + off; }
        const int nig = WGM * nN, gid = wgid / nig, fm = gid * WGM, gsz = (nM - fm) < WGM ? (nM - fm) : WGM;
        u.pm = fm + ((wgid % nig) % gsz); u.pn = (wgid % nig) / gsz; return true;
    }
    __device__ __forceinline__ void a_ready(const Unit&) const {}
    __device__ __forceinline__ void done(const Unit&) const {}
};
template <class Epi, class Sched, bool ALIGN_EPI = false, bool SP2 = false>
__device__ __forceinline__ void gemm_phase(PG8_LAS unsigned char* lds, const Gemm g, const Sched& S, const Epi& E, int g_wave) {
    const int tid = otid(), wid = __builtin_amdgcn_readfirstlane(tid >> 6), lane = tid & 63, wr = wid >> 2, wc = wid & 3, fr = lane & 15, fq = lane >> 4;
    const int K = g.K, nt = K / BK;
    unsigned voffA[2], voffB[2];
#pragma unroll
    for (int i = 0; i < 2; ++i) { int R, C; stage_rc(tid * 16 + i * 8192, R, C); const int Rb = Epi::PERM ? ((R & ~31) + perm32(R & 31)) : R;
        voffA[i] = (unsigned)(R * K + C) * 2u; voffB[i] = (unsigned)(Rb * K + C) * 2u; }
    const size_t kstep = (size_t)(BK * 2);
    const size_t hstep = (size_t)HALF * K * 2;
    const size_t tstep = 2 * hstep;
    const unsigned ldsw = (unsigned)wid * 1024u;
    const int aoff = lds_byte(wr * 64 + fr, fq * 8), boff = lds_byte(wc * 32 + fr, fq * 8);
#define PG8_SA(b, h) (((b) * 2 + (h)) * HTB)
#define PG8_SB(b, h) ((4 + (b) * 2 + (h)) * HTB)
#define PG8_STAGE(bufoff, gbase, voff) do { _Pragma("unroll") for (int _i = 0; _i < 2; ++_i) \
        __builtin_amdgcn_global_load_lds((const unsigned*)((const char*)(gbase) + (voff)[_i]), (PG8_LAS unsigned*)(lds + (bufoff) + ldsw + _i * 8192), 16, 0, 0); } while (0)
#define PG8_LDA(dst, b, h) do { _Pragma("unroll") for (int m = 0; m < 4; ++m) _Pragma("unroll") for (int k = 0; k < 2; ++k) dst[m][k] = *(const PG8_LAS bf16x8*)(lds + PG8_SA(b, h) + aoff + m * 2048 + k * 1024); } while (0)
#define PG8_LDB(dst, b, h) do { _Pragma("unroll") for (int n = 0; n < 2; ++n) _Pragma("unroll") for (int k = 0; k < 2; ++k) dst[n][k] = *(const PG8_LAS bf16x8*)(lds + PG8_SB(b, h) + boff + n * 2048 + k * 1024); } while (0)
#define PG8_MMA(ai, bj, At, Bt) do { __builtin_amdgcn_s_setprio(1); _Pragma("unroll") for (int m = 0; m < 4; ++m) _Pragma("unroll") for (int n = 0; n < 2; ++n) _Pragma("unroll") for (int k = 0; k < 2; ++k) \
        acc[ai][bj][m][n] = __builtin_amdgcn_mfma_f32_16x16x32_bf16(Bt[n][k], At[m][k], acc[ai][bj][m][n], 0, 0, 0); __builtin_amdgcn_s_setprio(0); } while (0)
#define PG8_WAIT_V(n) asm volatile("s_waitcnt vmcnt(" #n ")" ::: "memory")
#define PG8_WAIT_L(n) asm volatile("s_waitcnt lgkmcnt(" #n ")" ::: "memory")
#define PG8_BAR __builtin_amdgcn_s_barrier()
#define PG8_SCHED __builtin_amdgcn_sched_barrier(0)
    Unit cur, nxt; int ui = 0;
    if (!S.next(0, cur)) return;
    f32x4 acc[2][2][4][2];
#pragma unroll
    for (int a = 0; a < 2; ++a)
#pragma unroll
        for (int b = 0; b < 2; ++b)
#pragma unroll
            for (int m = 0; m < 4; ++m)
#pragma unroll
                for (int n = 0; n < 2; ++n) acc[a][b][m][n] = (f32x4){0.f, 0.f, 0.f, 0.f};
    bf16x8 At[4][2], B0[2][2], B1[2][2];
    const char* cA = (const char*)g.A + (size_t)cur.pm * tstep; const char* cB = (const char*)g.Bt + (size_t)cur.pn * tstep;
    S.a_ready(cur);
    if constexpr (SP2) {
        PG8_STAGE(PG8_SB(0, 0), cB, voffB); PG8_STAGE(PG8_SB(0, 1), cB + hstep, voffB); PG8_STAGE(PG8_SA(0, 0), cA, voffA); PG8_STAGE(PG8_SA(0, 1), cA + hstep, voffA);
        if (wr == 1) PG8_BAR;
        PG8_WAIT_V(2); PG8_BAR;
        PG8_STAGE(PG8_SB(1, 0), cB + kstep, voffB); PG8_STAGE(PG8_SA(1, 0), cA + kstep, voffA); PG8_STAGE(PG8_SB(1, 1), cB + hstep + kstep, voffB);
        PG8_WAIT_V(6); PG8_BAR;
    } else {
        PG8_STAGE(PG8_SB(0, 0), cB, voffB); PG8_STAGE(PG8_SA(0, 0), cA, voffA); PG8_STAGE(PG8_SB(0, 1), cB + hstep, voffB); PG8_STAGE(PG8_SA(0, 1), cA + hstep, voffA);
        if (wr == 1) PG8_BAR;
        PG8_WAIT_V(4); PG8_BAR;
        PG8_STAGE(PG8_SB(1, 0), cB + kstep, voffB); PG8_STAGE(PG8_SA(1, 0), cA + kstep, voffA); PG8_STAGE(PG8_SB(1, 1), cB + hstep + kstep, voffB);
        PG8_WAIT_V(6); PG8_BAR;
    }
    for (;;) {
        const bool has_next = S.next(ui + 1, nxt);
        const char* nA = has_next ? (const char*)g.A + (size_t)nxt.pm * tstep : cA; const char* nB = has_next ? (const char*)g.Bt + (size_t)nxt.pn * tstep : cB;
        for (int t = 0; t < nt; t += 2) {
            const bool last = (t == nt - 2);
            const char* a1 = cA + (size_t)(t + 1) * kstep;
            const char* a2 = last ? nA : cA + (size_t)(t + 2) * kstep; const char* b2 = last ? nB : cB + (size_t)(t + 2) * kstep;
            const char* a3 = a2 + kstep; const char* b3 = b2 + kstep;
            if (last && has_next) S.a_ready(nxt);
            if constexpr (SP2) {
            PG8_LDB(B0, 0, 0); PG8_LDB(B1, 0, 1); PG8_SCHED; PG8_LDA(At, 0, 0); PG8_STAGE(PG8_SA(1, 1), a1 + hstep, voffA);
            PG8_WAIT_V(8); PG8_WAIT_L(0); PG8_BAR; PG8_MMA(0, 0, At, B0); PG8_MMA(0, 1, At, B1); PG8_BAR; PG8_SCHED;
            PG8_LDA(At, 0, 1); PG8_STAGE(PG8_SB(0, 0), b2, voffB); PG8_STAGE(PG8_SB(0, 1), b2 + hstep, voffB); PG8_STAGE(PG8_SA(0, 0), a2, voffA);
            PG8_WAIT_V(8); PG8_WAIT_L(0); PG8_BAR; PG8_MMA(1, 0, At, B0); PG8_MMA(1, 1, At, B1); PG8_BAR; PG8_SCHED;
            PG8_LDB(B0, 1, 0); PG8_LDB(B1, 1, 1); PG8_SCHED; PG8_LDA(At, 1, 0); PG8_STAGE(PG8_SA(0, 1), a2 + hstep, voffA);
            PG8_WAIT_V(8); PG8_WAIT_L(0); PG8_BAR; PG8_MMA(0, 0, At, B0); PG8_MMA(0, 1, At, B1); PG8_BAR; PG8_SCHED;
            PG8_LDA(At, 1, 1); PG8_STAGE(PG8_SB(1, 0), b3, voffB); PG8_STAGE(PG8_SB(1, 1), b3 + hstep, voffB); PG8_STAGE(PG8_SA(1, 0), a3, voffA);
            PG8_WAIT_V(8); PG8_WAIT_L(0); PG8_BAR; PG8_MMA(1, 0, At, B0); PG8_MMA(1, 1, At, B1); PG8_BAR; PG8_SCHED;
            } else {
            PG8_LDB(B0, 0, 0); PG8_SCHED; PG8_LDA(At, 0, 0); PG8_STAGE(PG8_SA(1, 1), a1 + hstep, voffA);
            PG8_WAIT_L(8); PG8_BAR; PG8_WAIT_L(0); PG8_MMA(0, 0, At, B0); PG8_BAR; PG8_SCHED;
            PG8_LDB(B1, 0, 1); PG8_STAGE(PG8_SB(0, 0), b2, voffB);
            PG8_BAR; PG8_WAIT_L(0); PG8_MMA(0, 1, At, B1); PG8_BAR;
            PG8_LDA(At, 0, 1); PG8_STAGE(PG8_SA(0, 0), a2, voffA);
            PG8_BAR; PG8_WAIT_L(0); PG8_MMA(1, 0, At, B0); PG8_BAR; PG8_SCHED;
            PG8_STAGE(PG8_SB(0, 1), b2 + hstep, voffB);
            PG8_WAIT_V(6); PG8_BAR; PG8_MMA(1, 1, At, B1); PG8_BAR;
            PG8_LDB(B0, 1, 0); PG8_SCHED; PG8_LDA(At, 1, 0); PG8_STAGE(PG8_SA(0, 1), a2 + hstep, voffA);
            PG8_WAIT_L(8); PG8_BAR; PG8_WAIT_L(0); PG8_MMA(0, 0, At, B0); PG8_BAR; PG8_SCHED;
            PG8_LDB(B1, 1, 1); PG8_STAGE(PG8_SB(1, 0), b3, voffB);
            PG8_BAR; PG8_WAIT_L(0); PG8_MMA(0, 1, At, B1); PG8_BAR;
            PG8_LDA(At, 1, 1); PG8_STAGE(PG8_SA(1, 0), a3, voffA);
            PG8_BAR; PG8_WAIT_L(0); PG8_MMA(1, 0, At, B0); PG8_BAR; PG8_SCHED;
            PG8_STAGE(PG8_SB(1, 1), b3 + hstep, voffB);
            PG8_WAIT_V(6); PG8_BAR; PG8_MMA(1, 1, At, B1); PG8_BAR;
            }
        }
        if constexpr (ALIGN_EPI) { if (wr == 0) PG8_BAR; }
        if constexpr (!Epi::AFTER_DRAIN) { E(acc, cur, wr, wc, fr, fq); S.done(cur); }
        if (!has_next) break;
#pragma unroll
        for (int a = 0; a < 2; ++a)
#pragma unroll
            for (int b = 0; b < 2; ++b)
#pragma unroll
                for (int m = 0; m < 4; ++m)
#pragma unroll
                    for (int n = 0; n < 2; ++n) acc[a][b][m][n] = (f32x4){0.f, 0.f, 0.f, 0.f};
        cur = nxt; cA = nA; cB = nB; ++ui;
        if constexpr (ALIGN_EPI) { if (wr == 1) PG8_BAR; }
    }
    PG8_WAIT_V(0);
    if constexpr (!ALIGN_EPI) { if (wr == 0) PG8_BAR; }
    PG8_BAR;
    if constexpr (Epi::AFTER_DRAIN) { E.fused(acc, cur, wr, wc, fr, fq, lds, wid, lane); S.done(cur); }
#undef PG8_SA
#undef PG8_SB
#undef PG8_STAGE
#undef PG8_LDA
#undef PG8_LDB
#undef PG8_MMA
#undef PG8_WAIT_V
#undef PG8_WAIT_L
#undef PG8_BAR
#undef PG8_SCHED
}
}

struct OrderIn1 {
    pg8::StaticOrder base; int G, c;
    __device__ void init(int G_, int c_) { base.init(ML, N1, G_, c_); G = G_; c = c_; }
    __device__ bool next(int i, pg8::Unit& u) const {
        const int Lx = i * G + c;
        if (Lx < 256 * 13) return base.next(i, u);
        const int r = Lx - 256 * 13; if (r >= 32 * 7) return false;
        const int j = r >> 5; u.pm = 256 + (r & 31); u.pn = j < 6 ? 2 + j : 12; return true;
    }
    __device__ __forceinline__ void a_ready(const pg8::Unit&) const {}
    __device__ __forceinline__ void done(const pg8::Unit&) const {}
};

struct EpiIn0 {
    unsigned char* ws;
    const float *aqn, *akn, *bqn, *bkn;
    static constexpr bool PERM = false, AFTER_DRAIN = false;
    __device__ __forceinline__ void operator()(const f32x4 (&acc)[2][2][4][2], const pg8::Unit& u, int wr, int wc, int fr, int fq) const { (*this)(acc, u.pm, u.pn, wr, wc, fr, fq); }
    __device__ __forceinline__ void operator()(const f32x4 (&acc)[2][2][4][2], int pm, int pn, int wr, int wc, int fr, int fq) const {
        const int g = 4 * pn + wc;
        const float* rs = (const float*)(ws + OFF_RS);
        size_t doff; int ld, col, type; const float* gain = aqn;
        if (g < 8) { doff = OFF_QA; ld = 512; col = g * 64; type = 2; gain = aqn; }
        else if (g < 10) { doff = OFF_KA; ld = 128; col = (g - 8) * 64; type = 3; gain = akn; }
        else if (g < 12) { doff = OFF_VA; ld = 128; col = (g - 10) * 64; type = 0; }
        else if (g < 20) { doff = OFF_GA; ld = 512; col = (g - 12) * 64; type = 1; }
        else if (g < 28) { doff = OFF_QB; ld = 512; col = (g - 20) * 64; type = 2; gain = bqn; }
        else if (g < 36) { doff = OFF_KB; ld = 512; col = (g - 28) * 64; type = 3; gain = bkn; }
        else if (g < 44) { doff = OFF_VB; ld = 512; col = (g - 36) * 64; type = 0; }
        else { doff = OFF_GB; ld = 512; col = (g - 44) * 64; type = 1; }
        bf16_t* dst = (bf16_t*)(ws + doff);
        const bool lat = pm < 256; const int r = lat ? pm >> 3 : 32;
        const float* bptr = (const float*)(ws + OFF_BIAS0) + (size_t)r * 3328 + pn * 256 + wc * 32 + fq * 4;
        f32x4 bia[2][2], gn[2][2];
        const float qs = type == 2 ? QSCALE : 1.0f;
#pragma unroll
        for (int bj = 0; bj < 2; ++bj)
#pragma unroll
            for (int n = 0; n < 2; ++n) { bia[bj][n] = *(const f32x4*)(bptr + bj * 128 + n * 16); gn[bj][n] = *(const f32x4*)(gain + bj * 32 + n * 16 + fq * 4) * qs; }
        float rsv[2][4];
#pragma unroll
        for (int ai = 0; ai < 2; ++ai)
#pragma unroll
            for (int m = 0; m < 4; ++m) rsv[ai][m] = rs[pm * 256 + ai * 128 + wr * 64 + m * 16 + fr];
        float frq[4];
#pragma unroll
        for (int e = 0; e < 4; ++e) frq[e] = __builtin_amdgcn_exp2f(-(float)(fq * 4 + e) * 0.830482023721841f) * 0.15915494309189535f;
#pragma unroll
        for (int ai = 0; ai < 2; ++ai) {
            const float prow = (float)((pm * 4 + ai * 2 + wr) & 31);
            int fro = fr; asm volatile("" : "+v"(fro));
#pragma unroll
            for (int m = 0; m < 4; ++m) {
                const int row = pm * 256 + ai * 128 + wr * 64 + m * 16 + fr;
                const float rstd = rsv[ai][m];
                f32x4 v[2][2];
#pragma unroll
                for (int bj = 0; bj < 2; ++bj)
#pragma unroll
                    for (int n = 0; n < 2; ++n) v[bj][n] = acc[ai][bj][m][n] * rstd + bia[bj][n];
                if (type >= 2) {
                    float s2 = 0.f;
#pragma unroll
                    for (int bj = 0; bj < 2; ++bj)
#pragma unroll
                        for (int n = 0; n < 2; ++n) s2 += v[bj][n][0] * v[bj][n][0] + v[bj][n][1] * v[bj][n][1] + v[bj][n][2] * v[bj][n][2] + v[bj][n][3] * v[bj][n][3];
                    s2 = sum_xor16(s2); s2 = sum_xor32(s2);
                    const float rn = rsqrtf(s2 * (1.0f / 64.0f) + EPS);
#pragma unroll
                    for (int bj = 0; bj < 2; ++bj)
#pragma unroll
                        for (int n = 0; n < 2; ++n) v[bj][n] = v[bj][n] * rn * gn[bj][n];
                    if (lat) {
                        const float pcol = (float)(m * 16 + fro);
#pragma unroll
                        for (int bj = 0; bj < 2; ++bj) {
                            const float pos = bj ? pcol : prow;
#pragma unroll
                            for (int e = 0; e < 4; ++e) {
                                const float rev = pos * frq[e];
                                const float cc = __builtin_amdgcn_cosf(rev), sn = __builtin_amdgcn_sinf(rev);
                                const float x1 = v[bj][0][e], x2 = v[bj][1][e]; v[bj][0][e] = x1 * cc - x2 * sn; v[bj][1][e] = x2 * cc + x1 * sn;
                            }
                        }
                    }
                } else if (type == 1) {
#pragma unroll
                    for (int bj = 0; bj < 2; ++bj)
#pragma unroll
                        for (int n = 0; n < 2; ++n)
#pragma unroll
                            for (int e = 0; e < 4; ++e) v[bj][n][e] = siluf(v[bj][n][e]);
                }
#pragma unroll
                for (int bj = 0; bj < 2; ++bj) {
                    u32x4 o; o.x = cvtpk(v[bj][0][0], v[bj][0][1]); o.y = cvtpk(v[bj][0][2], v[bj][0][3]); o.z = cvtpk(v[bj][1][0], v[bj][1][1]); o.w = cvtpk(v[bj][1][2], v[bj][1][3]);
                    *(u32x4*)(dst + (size_t)row * ld + col + bj * 32 + fq * 8) = o;
                }
            }
        }
    }
};

struct EpiIn1 {
    unsigned char* ws;
    static constexpr bool PERM = false, AFTER_DRAIN = false;
    __device__ __forceinline__ void operator()(const f32x4 (&acc)[2][2][4][2], const pg8::Unit& u, int wr, int wc, int fr, int fq) const { (*this)(acc, u.pm, u.pn, wr, wc, fr, fq); }
    __device__ __forceinline__ void operator()(const f32x4 (&acc)[2][2][4][2], int pm, int pn, int wr, int wc, int fr, int fq) const {
        const int g = 4 * pn + wc;
        if (g > 48) return;
        const float* rs = (const float*)(ws + OFF_RS); float* RF = (float*)(ws + OFF_RF);
        size_t doff = OFF_QG; int ld = 0, col = 0, type;
        if (g < 8) { doff = OFF_QG; ld = 512; col = g * 64; type = 2; }
        else if (g < 16) { doff = OFF_KG; ld = 512; col = (g - 8) * 64; type = 0; }
        else if (g < 32) { doff = OFF_VG; ld = 1024; col = (g - 16) * 64; type = 0; }
        else if (g < 48) { doff = OFF_GG; ld = 1024; col = (g - 32) * 64; type = 1; }
        else type = 3;
        bf16_t* dst = (bf16_t*)(ws + doff);
        const int r = pm < 256 ? pm >> 3 : 32;
        const float* bptr = (const float*)(ws + OFF_BIAS1) + (size_t)r * 3328 + pn * 256 + wc * 32 + fq * 4;
        f32x4 bia[2][2];
#pragma unroll
        for (int bj = 0; bj < 2; ++bj)
#pragma unroll
            for (int n = 0; n < 2; ++n) bia[bj][n] = *(const f32x4*)(bptr + bj * 128 + n * 16);
        float rsv[2][4];
#pragma unroll
        for (int ai = 0; ai < 2; ++ai)
#pragma unroll
            for (int m = 0; m < 4; ++m) rsv[ai][m] = rs[pm * 256 + ai * 128 + wr * 64 + m * 16 + fr];
        const float sc = type == 2 ? 0.08838834764831845f : 1.0f;
#pragma unroll
        for (int ai = 0; ai < 2; ++ai)
#pragma unroll
            for (int m = 0; m < 4; ++m) {
                const int row = pm * 256 + ai * 128 + wr * 64 + m * 16 + fr;
                const float rstd = rsv[ai][m];
                f32x4 v[2][2];
#pragma unroll
                for (int bj = 0; bj < 2; ++bj)
#pragma unroll
                    for (int n = 0; n < 2; ++n) v[bj][n] = (acc[ai][bj][m][n] * rstd + bia[bj][n]) * sc;
                if (type == 3) {
                    *(f32x4*)(RF + (size_t)row * 32 + fq * 8) = v[0][0];
                    *(f32x4*)(RF + (size_t)row * 32 + fq * 8 + 4) = v[0][1];
                    continue;
                }
                if (type == 1) {
#pragma unroll
                    for (int bj = 0; bj < 2; ++bj)
#pragma unroll
                        for (int n = 0; n < 2; ++n)
#pragma unroll
                            for (int e = 0; e < 4; ++e) v[bj][n][e] = siluf(v[bj][n][e]);
                }
#pragma unroll
                for (int bj = 0; bj < 2; ++bj) {
                    u32x4 o; o.x = cvtpk(v[bj][0][0], v[bj][0][1]); o.y = cvtpk(v[bj][0][2], v[bj][0][3]); o.z = cvtpk(v[bj][1][0], v[bj][1][1]); o.w = cvtpk(v[bj][1][2], v[bj][1][3]);
                    *(u32x4*)(dst + (size_t)row * ld + col + bj * 32 + fq * 8) = o;
                }
            }
    }
};

struct EpiOut0 {
    const float *x, *ctx, *g1; float* out; unsigned char* ws;
    static constexpr bool PERM = false, AFTER_DRAIN = false;
    __device__ __forceinline__ void operator()(const f32x4 (&acc)[2][2][4][2], const pg8::Unit& u, int wr, int wc, int fr, int fq) const { (*this)(acc, u.pm, u.pn, wr, wc, fr, fq); }
    __device__ __forceinline__ void operator()(const f32x4 (&acc)[2][2][4][2], int pm, int pn, int wr, int wc, int fr, int fq) const {
        const float* mod = (const float*)(ws + OFF_MOD); bf16_t* A1 = (bf16_t*)(ws + OFF_A); float* parts = (float*)(ws + OFF_PARTS);
        const bool lat = pm < 256; const int r = lat ? pm >> 3 : 32;
        const int c0 = pn * 256 + wc * 64 + fq * 8;
        const float* gt = mod + (size_t)r * 3072 + 2048 + c0;
        const float* sc = mod + (size_t)(33 + r) * 3072 + 1024 + c0;
        f32x4 gtv[2][2], csv[2][2];
#pragma unroll
        for (int bj = 0; bj < 2; ++bj)
#pragma unroll
            for (int n = 0; n < 2; ++n) { gtv[bj][n] = *(const f32x4*)(gt + bj * 32 + n * 4); csv[bj][n] = *(const f32x4*)(g1 + c0 + bj * 32 + n * 4) * (1.0f + *(const f32x4*)(sc + bj * 32 + n * 4)); }
        const float* xbase = (lat ? x + (size_t)(pm * 256) * D : ctx + (size_t)(pm * 256 - ML) * D) + (size_t)(wr * 64 + fr) * D + c0;
        f32x4 xv[2][2][2];
#define EO0_LOAD(ri) do { const float* xp = xbase + (size_t)(((ri) >> 2) * 128 + ((ri) & 3) * 16) * D; \
            _Pragma("unroll") for (int bj = 0; bj < 2; ++bj) _Pragma("unroll") for (int n = 0; n < 2; ++n) xv[(ri) & 1][bj][n] = *(const f32x4*)(xp + bj * 32 + n * 4); } while (0)
        EO0_LOAD(0);
#pragma unroll
        for (int ri = 0; ri < 8; ++ri) {
            if (ri < 7) EO0_LOAD(ri + 1);
            {
                const int ai = ri >> 2, m = ri & 3;
                const int row = pm * 256 + ai * 128 + wr * 64 + m * 16 + fr;
                float ss = 0.f;
#pragma unroll
                for (int bj = 0; bj < 2; ++bj) {
                    f32x4 y[2], xk[2];
#pragma unroll
                    for (int n = 0; n < 2; ++n) {
                        const f32x4 x1 = xv[ri & 1][bj][n] + gtv[bj][n] * acc[ai][bj][m][n];
                        ss += x1[0] * x1[0] + x1[1] * x1[1] + x1[2] * x1[2] + x1[3] * x1[3];
                        xk[n] = x1;
                        y[n] = x1 * csv[bj][n];
                    }
                    u32x4 o; o.x = cvtpk(y[0][0], y[0][1]); o.y = cvtpk(y[0][2], y[0][3]); o.z = cvtpk(y[1][0], y[1][1]); o.w = cvtpk(y[1][2], y[1][3]);
                    *(u32x4*)(A1 + (size_t)row * D + c0 + bj * 32) = o;
                    if (lat) { u32x4 xb; xb.x = cvtpk(xk[0][0], xk[0][1]); xb.y = cvtpk(xk[0][2], xk[0][3]); xb.z = cvtpk(xk[1][0], xk[1][1]); xb.w = cvtpk(xk[1][2], xk[1][3]);
                        *(u32x4*)((bf16_t*)(ws + OFF_X1B) + (size_t)row * D + c0 + bj * 32) = xb; }
                }
                ss = sum_xor16(ss); ss = sum_xor32(ss);
                if (fq == 0) parts[(size_t)(4 * pn + wc) * M + row] = ss;
            }
            __builtin_amdgcn_sched_barrier(0);
        }
#undef EO0_LOAD
    }
};

struct EpiOut1 {
    unsigned char* ws; float* out;
    static constexpr bool PERM = false, AFTER_DRAIN = false;
    __device__ __forceinline__ void operator()(f32x4 (&acc)[2][2][4][2], const pg8::Unit& u, int wr, int wc, int fr, int fq) const {
        const int pm = u.pm, pn = u.pn;
        const int r = pm >> 3, c0 = pn * 256 + wc * 64 + fq * 8;
        const float* gt = (const float*)(ws + OFF_MOD) + (size_t)(33 + r) * 3072 + 2048 + c0;
        f32x4 gtv[2][2];
#pragma unroll
        for (int bj = 0; bj < 2; ++bj)
#pragma unroll
            for (int n = 0; n < 2; ++n) gtv[bj][n] = *(const f32x4*)(gt + bj * 32 + n * 4);
        const bf16_t* xbase = (const bf16_t*)(ws + OFF_X1B) + (size_t)(pm * 256 + wr * 64 + fr) * D + c0;
        u32x4 xv[8][2];
#define EO1_LOAD(ri) do { const bf16_t* xp = xbase + (size_t)(((ri) >> 2) * 128 + ((ri) & 3) * 16) * D; \
            xv[(ri)][0] = *(const u32x4*)(xp); xv[(ri)][1] = *(const u32x4*)(xp + 32); } while (0)
#pragma unroll
        for (int ri = 0; ri < 8; ++ri) EO1_LOAD(ri);
#pragma unroll
        for (int ri = 0; ri < 8; ++ri) {
            const int ai = ri >> 2, m = ri & 3;
#pragma unroll
            for (int bj = 0; bj < 2; ++bj) {
                const u32x4 w = xv[ri][bj];
                const f32x4 x0 = (f32x4){bflo(w.x), bfhi(w.x), bflo(w.y), bfhi(w.y)}, x1 = (f32x4){bflo(w.z), bfhi(w.z), bflo(w.w), bfhi(w.w)};
                acc[ai][bj][m][0] = x0 + gtv[bj][0] * acc[ai][bj][m][0];
                acc[ai][bj][m][1] = x1 + gtv[bj][1] * acc[ai][bj][m][1];
            }
        }
#undef EO1_LOAD
        float* obase = out + (size_t)(pm * 256 + wr * 64 + fr) * D + c0;
#pragma unroll
        for (int ri = 0; ri < 8; ++ri) {
            const int ai = ri >> 2, m = ri & 3;
            float* op = obase + (size_t)(ai * 128 + m * 16) * D;
#pragma unroll
            for (int bj = 0; bj < 2; ++bj)
#pragma unroll
                for (int n = 0; n < 2; ++n) *(f32x4*)(op + bj * 32 + n * 4) = acc[ai][bj][m][n];
        }
    }
};

typedef float f32x16 __attribute__((ext_vector_type(16)));
typedef short s16x4 __attribute__((ext_vector_type(4)));
#define LDSAS __attribute__((address_space(3)))
__device__ __forceinline__ int crow(int r, int hi) { return (r & 3) + 8 * (r >> 2) + 4 * hi; }
__device__ __forceinline__ s16x4 vtr(const LDSAS unsigned char* p) { return __builtin_bit_cast(s16x4, __builtin_amdgcn_ds_read_tr16_b64_v4i16((LDSAS s16x4*)p)); }

constexpr int AB_K1 = 0, AB_K2 = 16384, AB_V = 32768, AB_Q = 65536;
static_assert(AB_Q + 65536 <= 134144, "attention B LDS map");
__device__ __forceinline__ float fadd_s(float a, float b) { float r; asm("v_add_f32_e32 %0, %1, %2" : "=v"(r) : "v"(a), "v"(b)); return r; }

__device__ __forceinline__ void attnB_unit(const Params& P, LDSAS unsigned char* lds, int b, int h, int qrow0, int t_begin, int t_end, int g_wave) {
    const int tid = otid(), lane = tid & 63, r32 = lane & 31, hi = lane >> 5;
    const int wid = __builtin_amdgcn_readfirstlane(tid >> 6);
    LDSAS unsigned char* qlds = lds + AB_Q + wid * 8192 + r32 * 256;
    {
        const bf16_t* qg = P.QB() + (size_t)(qrow0 + wid * 32 + r32) * 512 + (2 * h) * 64 + hi * 8;
#pragma unroll
        for (int c2 = 0; c2 < 8; ++c2) {
            const u32x4 v = *(const u32x4*)(qg + (c2 >> 2) * 64 + (c2 & 3) * 16);
            *(LDSAS u32x4*)(qlds + (((2 * c2 + hi) ^ (r32 & 15)) * 16)) = v;
        }
    }
    f32x16 o1[4], o2[4];
#pragma unroll
    for (int i = 0; i < 4; ++i) { o1[i] = (f32x16){}; o2[i] = (f32x16){}; }
    float l1 = 0.f, l2 = 0.f;
    const int krow = tid >> 3, kch = tid & 7, vrow = tid >> 4, vch = tid & 15;
    const int kwoff = krow * 128 + ((kch ^ ((krow >> 1) & 7)) * 16);
    const int vwoff = (vch >> 2) * 4096 + vrow * 64 + (vch & 3) * 16;
    u32x4 rk1, rk2, rv0, rv1;
#define AB_GLOAD(t) do { const int kr0_ = (t) < 32 ? b * 2048 + 64 * (t) : ML + b * 256 + 64 * ((t) - 32); \
        rk1 = *(const u32x4*)(P.KB() + (size_t)(kr0_ + krow) * 512 + (2 * h) * 64 + kch * 8); \
        rk2 = *(const u32x4*)(P.KB() + (size_t)(kr0_ + krow) * 512 + (2 * h + 1) * 64 + kch * 8); \
        rv0 = *(const u32x4*)(P.VB() + (size_t)(kr0_ + vrow) * 512 + h * 128 + vch * 8); \
        rv1 = *(const u32x4*)(P.VB() + (size_t)(kr0_ + vrow + 32) * 512 + h * 128 + vch * 8); } while (0)
#define AB_LWRITE(buf) do { *(LDSAS u32x4*)(lds + AB_K1 + (buf) * 8192 + kwoff) = rk1; *(LDSAS u32x4*)(lds + AB_K2 + (buf) * 8192 + kwoff) = rk2; \
        *(LDSAS u32x4*)(lds + AB_V + (buf) * 16384 + vwoff) = rv0; *(LDSAS u32x4*)(lds + AB_V + (buf) * 16384 + vwoff + 2048) = rv1; } while (0)
#define AB_SCORES(sub, LSUM, PW) do { const LDSAS unsigned char* kb_ = lds + ((sub) ? AB_K2 : AB_K1) + buf * 8192 + r32 * 128; \
        f32x16 p0 = (f32x16){}, p1 = (f32x16){}; \
        _Pragma("unroll") for (int d0 = 0; d0 < 4; ++d0) { const int co = ((2 * d0 + hi) ^ ksw) * 16; \
            const bf16x8 qf = *(const LDSAS bf16x8*)(qlds + (((2 * (4 * (sub) + d0) + hi) ^ (r32 & 15)) * 16)); \
            const bf16x8 k0 = *(const LDSAS bf16x8*)(kb_ + co), k1 = *(const LDSAS bf16x8*)(kb_ + 4096 + co); \
            p0 = __builtin_amdgcn_mfma_f32_32x32x16_bf16(k0, qf, p0, 0, 0, 0); p1 = __builtin_amdgcn_mfma_f32_32x32x16_bf16(k1, qf, p1, 0, 0, 0); } \
        float ls_ = 0.f; \
        _Pragma("unroll") for (int r = 0; r < 16; ++r) { p0[r] = __builtin_amdgcn_exp2f(p0[r]); p1[r] = __builtin_amdgcn_exp2f(p1[r]); ls_ = fadd_s(ls_, p0[r]); ls_ = fadd_s(ls_, p1[r]); } \
        LSUM += ls_; \
        PW[0].x = cvtpk(p0[0], p0[1]); PW[0].y = cvtpk(p0[2], p0[3]); PW[0].z = cvtpk(p0[4], p0[5]); PW[0].w = cvtpk(p0[6], p0[7]); \
        PW[1].x = cvtpk(p0[8], p0[9]); PW[1].y = cvtpk(p0[10], p0[11]); PW[1].z = cvtpk(p0[12], p0[13]); PW[1].w = cvtpk(p0[14], p0[15]); \
        PW[2].x = cvtpk(p1[0], p1[1]); PW[2].y = cvtpk(p1[2], p1[3]); PW[2].z = cvtpk(p1[4], p1[5]); PW[2].w = cvtpk(p1[6], p1[7]); \
        PW[3].x = cvtpk(p1[8], p1[9]); PW[3].y = cvtpk(p1[10], p1[11]); PW[3].z = cvtpk(p1[12], p1[13]); PW[3].w = cvtpk(p1[14], p1[15]); } while (0)
    const int ksw = (r32 >> 1) & 7;
    const int vroff = AB_V + (4 * hi + ((lane & 15) >> 2)) * 64 + ((lane >> 4) & 1) * 32 + (lane & 3) * 8;
    AB_GLOAD(t_begin); AB_LWRITE(0); __syncthreads();
    for (int t = t_begin; t < t_end; ++t) {
        const int buf = (t - t_begin) & 1;
        u32x4 pw1[4], pw2[4];
        AB_SCORES(0, l1, pw1);
        __builtin_amdgcn_sched_barrier(0);
        AB_SCORES(1, l2, pw2);
        __builtin_amdgcn_sched_barrier(0);
        if (t + 1 < t_end) AB_GLOAD(t + 1);
        const LDSAS unsigned char* vb = lds + buf * 16384 + vroff;
        s16x4 vlo[2][4], vhi[2][4];
#define AB_VLOAD(slot, d0) do { _Pragma("unroll") for (int ks = 0; ks < 4; ++ks) { vlo[slot][ks] = vtr(vb + (d0) * 4096 + ks * 1024); vhi[slot][ks] = vtr(vb + (d0) * 4096 + ks * 1024 + 512); } } while (0)
        AB_VLOAD(0, 0);
#pragma unroll
        for (int d0 = 0; d0 < 4; ++d0) {
            if (d0 < 3) AB_VLOAD((d0 + 1) & 1, d0 + 1);
            __builtin_amdgcn_sched_barrier(0);
#pragma unroll
            for (int ks = 0; ks < 4; ++ks) {
                const s16x4 lo = vlo[d0 & 1][ks], hh = vhi[d0 & 1][ks];
                const bf16x8 vf = (bf16x8){lo[0], lo[1], lo[2], lo[3], hh[0], hh[1], hh[2], hh[3]};
                o1[d0] = __builtin_amdgcn_mfma_f32_32x32x16_bf16(__builtin_bit_cast(bf16x8, pw1[ks]), vf, o1[d0], 0, 0, 0);
                o2[d0] = __builtin_amdgcn_mfma_f32_32x32x16_bf16(__builtin_bit_cast(bf16x8, pw2[ks]), vf, o2[d0], 0, 0, 0);
            }
            __builtin_amdgcn_sched_barrier(0);
        }
#undef AB_VLOAD
        if (t + 1 < t_end) AB_LWRITE(buf ^ 1);
        __syncthreads();
    }
#undef AB_GLOAD
#undef AB_LWRITE
#undef AB_SCORES
    l1 = sum_xor32(l1); l2 = sum_xor32(l2);
    LDSAS float* stg = (LDSAS float*)(lds + wid * 8192);
    if (hi == 0) { stg[r32] = 1.0f / l1; stg[32 + r32] = P.scal()[0] / l2; }
    float ss[16];
#pragma unroll
    for (int r = 0; r < 16; ++r) {
        const float a = stg[crow(r, hi)], c = stg[32 + crow(r, hi)];
        float s2 = 0.f;
#pragma unroll
        for (int d0 = 0; d0 < 4; ++d0) { const float v = o1[d0][r] * a - o2[d0][r] * c; o1[d0][r] = v; s2 += v * v; }
        ss[r] = s2;
    }
#pragma unroll
    for (int r = 0; r < 16; ++r) {
        float s2 = ss[r];
        s2 += __shfl_xor(s2, 1); s2 += __shfl_xor(s2, 2); s2 += __shfl_xor(s2, 4); s2 += __shfl_xor(s2, 8); s2 = sum_xor16(s2);
        ss[r] = rsqrtf(s2 * (1.0f / 128.0f) + EPS) * (1.0f - LAMBDA_INIT);
    }
    const int eq = lane >> 1, eseg = lane & 1;
    const size_t grow = (size_t)(qrow0 + wid * 32 + eq);
#pragma unroll
    for (int half = 0; half < 2; ++half) {
#pragma unroll
        for (int dd = 0; dd < 2; ++dd) {
            const int d0 = half * 2 + dd; const float sl = P.b_subln[d0 * 32 + r32];
#pragma unroll
            for (int r = 0; r < 16; ++r) stg[crow(r, hi) * 64 + ((dd * 32 + r32) ^ ((crow(r, hi) & 7) * 4))] = o1[d0][r] * ss[r] * sl;
        }
        const u32x4* gp = (const u32x4*)(P.GB() + grow * 512 + h * 128 + half * 64 + eseg * 32);
        u32x4* op = (u32x4*)(P.O() + grow * 1024 + 512 + h * 128 + half * 64 + eseg * 32);
        u32x4 gv[4];
#pragma unroll
        for (int i = 0; i < 4; ++i) gv[i] = gp[i];
#pragma unroll
        for (int i = 0; i < 4; ++i) {
            const int c0 = eseg * 32 + i * 8;
            const f32x4 a = *(const LDSAS f32x4*)(stg + eq * 64 + (c0 ^ ((eq & 7) * 4))), c = *(const LDSAS f32x4*)(stg + eq * 64 + ((c0 + 4) ^ ((eq & 7) * 4)));
            const u32x4 g = gv[i]; u32x4 ov;
            ov.x = cvtpk(a[0] * bflo(g.x), a[1] * bfhi(g.x)); ov.y = cvtpk(a[2] * bflo(g.y), a[3] * bfhi(g.y));
            ov.z = cvtpk(c[0] * bflo(g.z), c[1] * bfhi(g.z)); ov.w = cvtpk(c[2] * bflo(g.w), c[3] * bfhi(g.w));
            op[i] = ov;
        }
    }
    __syncthreads();
}

__device__ __forceinline__ void phase_attnB_mfma(const Params& P, LDSAS unsigned char* lds, int vb, int nvb, int g_wave) {
    for (int it = 0; ; ++it) {
        int u;
        if (nvb == 256) { if (it < 4) u = it * 256 + vb; else if (it == 4 && vb >= 128) u = 1024 + (vb - 128); else break; }
        else { u = it * nvb + vb; if (u >= 1024 + 128) break; }
        int pair, qrow0, t0;
        if (u < 1024) {
            int qblk;
            if (nvb == 256) { const int round = u >> 8, i = u & 255, xcd = i & 7, slot = i >> 3; pair = round * 32 + xcd * 4 + (slot >> 3); qblk = slot & 7; }
            else { pair = u >> 3; qblk = u & 7; }
            qrow0 = (pair >> 2) * 2048 + qblk * 256; t0 = 0;
        } else {
            pair = u - 1024;
            qrow0 = ML + (pair >> 2) * 256; t0 = 32;
        }
        attnB_unit(P, lds, pair >> 2, pair & 3, qrow0, t0, 36, g_wave);
    }
}

constexpr int AA_K = 0, AA_V = 32768;
__device__ __forceinline__ void attnA_unit(const Params& P, LDSAS unsigned char* lds, int b, int kvh, int qrow0, int qpos0, int kt0, int nwin, int g_wave) {
    const int tid = otid(), lane = tid & 63, r32 = lane & 31, hi = lane >> 5;
    const int wid = __builtin_amdgcn_readfirstlane(tid >> 6);
    const int head = kvh * 4 + (wid >> 1), qoff = (wid & 1) * 64;
    bf16x8 qf[2][4];
#pragma unroll
    for (int qq = 0; qq < 2; ++qq)
#pragma unroll
        for (int d0 = 0; d0 < 4; ++d0) qf[qq][d0] = *(const bf16x8*)(P.QA() + (size_t)(qrow0 + qoff + qq * 32 + r32) * 512 + head * 64 + d0 * 16 + hi * 8);
    f32x16 o[2][2];
#pragma unroll
    for (int i = 0; i < 2; ++i) { o[i][0] = (f32x16){}; o[i][1] = (f32x16){}; }
    float l[2] = {0.f, 0.f};
    const int krow = tid >> 3, kch = tid & 7;
    const int kwoff = krow * 128 + ((kch ^ ((krow >> 1) & 7)) * 16);
    const int vwoff = (kch >> 2) * 4096 + krow * 64 + (kch & 3) * 16;
    u32x4 rk[2], rv[2];
    const int nt = nwin + 4, npair = (nt + 1) >> 1;
#define AA_KR0(i) ((i) < nwin ? b * 2048 + 64 * (kt0 + (i)) : ML + b * 256 + 64 * ((i) - nwin))
#define AA_GLOAD(pi) do { _Pragma("unroll") for (int sb_ = 0; sb_ < 2; ++sb_) { const int i_ = 2 * (pi) + sb_ < nt ? 2 * (pi) + sb_ : nt - 1; const int kr0_ = AA_KR0(i_); \
        rk[sb_] = *(const u32x4*)(P.KA() + (size_t)(kr0_ + krow) * 128 + kvh * 64 + kch * 8); rv[sb_] = *(const u32x4*)(P.VA() + (size_t)(kr0_ + krow) * 128 + kvh * 64 + kch * 8); } } while (0)
#define AA_LWRITE(buf) do { _Pragma("unroll") for (int sb_ = 0; sb_ < 2; ++sb_) { *(LDSAS u32x4*)(lds + AA_K + ((buf) * 2 + sb_) * 8192 + kwoff) = rk[sb_]; *(LDSAS u32x4*)(lds + AA_V + ((buf) * 2 + sb_) * 8192 + vwoff) = rv[sb_]; } } while (0)
    const int kroff = AA_K + r32 * 128, ksw = (r32 >> 1) & 7;
    const int vroff = AA_V + (4 * hi + ((lane & 15) >> 2)) * 64 + ((lane >> 4) & 1) * 32 + (lane & 3) * 8;
    AA_GLOAD(0); AA_LWRITE(0); __syncthreads();
    for (int pi = 0; pi < npair; ++pi) {
        const int pbuf = pi & 1;
        if (pi + 1 < npair) AA_GLOAD(pi + 1);
      for (int sub = 0; sub < 2; ++sub) {
        const int i = 2 * pi + sub, buf = pbuf * 2 + sub;
        int cls = i < nt ? 1 : 0;
        if (i < nwin) { const int delta = 64 * (kt0 + i) - (qpos0 + qoff); cls = delta == -128 ? 2 : (delta == 128 ? 3 : ((delta >= -64 && delta <= 64) ? 1 : 0)); }
        if (cls != 0) {
            const LDSAS unsigned char* kb = lds + buf * 8192 + kroff;
            u32x4 pw[2][4];
#pragma unroll
            for (int qq = 0; qq < 2; ++qq) {
                f32x16 p0 = (f32x16){}, p1 = (f32x16){};
#pragma unroll
                for (int d0 = 0; d0 < 4; ++d0) {
                    const int co = ((2 * d0 + hi) ^ ksw) * 16;
                    const bf16x8 k0 = *(const LDSAS bf16x8*)(kb + co), k1 = *(const LDSAS bf16x8*)(kb + 4096 + co);
                    p0 = __builtin_amdgcn_mfma_f32_32x32x16_bf16(k0, qf[qq][d0], p0, 0, 0, 0);
                    p1 = __builtin_amdgcn_mfma_f32_32x32x16_bf16(k1, qf[qq][d0], p1, 0, 0, 0);
                }
                float ls = 0.f;
#pragma unroll
                for (int r = 0; r < 16; ++r) { p0[r] = __builtin_amdgcn_exp2f(p0[r]); p1[r] = __builtin_amdgcn_exp2f(p1[r]); }
                if (cls >= 2) {
                    int a = qq * 32 + r32;
                    asm volatile("" : "+v"(a));
#pragma unroll
                    for (int r = 0; r < 16; ++r) {
                        const int c0 = crow(r, hi), c1 = c0 + 32;
                        const bool v0 = cls == 2 ? (c0 >= a) : (c0 <= a), v1 = cls == 2 ? (c1 >= a) : (c1 <= a);
                        p0[r] = v0 ? p0[r] : 0.f; p1[r] = v1 ? p1[r] : 0.f;
                    }
                }
#pragma unroll
                for (int r = 0; r < 16; ++r) ls += p0[r] + p1[r];
                l[qq] += ls;
                pw[qq][0].x = cvtpk(p0[0], p0[1]); pw[qq][0].y = cvtpk(p0[2], p0[3]); pw[qq][0].z = cvtpk(p0[4], p0[5]); pw[qq][0].w = cvtpk(p0[6], p0[7]);
                pw[qq][1].x = cvtpk(p0[8], p0[9]); pw[qq][1].y = cvtpk(p0[10], p0[11]); pw[qq][1].z = cvtpk(p0[12], p0[13]); pw[qq][1].w = cvtpk(p0[14], p0[15]);
                pw[qq][2].x = cvtpk(p1[0], p1[1]); pw[qq][2].y = cvtpk(p1[2], p1[3]); pw[qq][2].z = cvtpk(p1[4], p1[5]); pw[qq][2].w = cvtpk(p1[6], p1[7]);
                pw[qq][3].x = cvtpk(p1[8], p1[9]); pw[qq][3].y = cvtpk(p1[10], p1[11]); pw[qq][3].z = cvtpk(p1[12], p1[13]); pw[qq][3].w = cvtpk(p1[14], p1[15]);
                __builtin_amdgcn_sched_barrier(0);
            }
            const LDSAS unsigned char* vb = lds + buf * 8192 + vroff;
#pragma unroll
            for (int d0 = 0; d0 < 2; ++d0)
#pragma unroll
                for (int ks = 0; ks < 4; ++ks) {
                    const s16x4 lo = vtr(vb + d0 * 4096 + ks * 1024), hh = vtr(vb + d0 * 4096 + ks * 1024 + 512);
                    const bf16x8 vf = (bf16x8){lo[0], lo[1], lo[2], lo[3], hh[0], hh[1], hh[2], hh[3]};
                    o[0][d0] = __builtin_amdgcn_mfma_f32_32x32x16_bf16(__builtin_bit_cast(bf16x8, pw[0][ks]), vf, o[0][d0], 0, 0, 0);
                    o[1][d0] = __builtin_amdgcn_mfma_f32_32x32x16_bf16(__builtin_bit_cast(bf16x8, pw[1][ks]), vf, o[1][d0], 0, 0, 0);
                }
        }
      }
        if (pi + 1 < npair) AA_LWRITE(pbuf ^ 1);
        __syncthreads();
    }
#undef AA_KR0
#undef AA_GLOAD
#undef AA_LWRITE
    const float sinkp = __builtin_amdgcn_exp2f(P.a_sink[head] * LOG2E);
    LDSAS float* stg = (LDSAS float*)(lds + wid * 8704);
    const int eq = lane >> 1, eseg = lane & 1;
#pragma unroll
    for (int qq = 0; qq < 2; ++qq) {
        float lt = sum_xor32(l[qq]);
        if (hi == 0) stg[r32] = 1.0f / (lt + sinkp);
        float rl[16];
#pragma unroll
        for (int r = 0; r < 16; ++r) rl[r] = stg[crow(r, hi)];
#pragma unroll
        for (int d0 = 0; d0 < 2; ++d0)
#pragma unroll
            for (int r = 0; r < 16; ++r) stg[crow(r, hi) * 68 + d0 * 32 + r32] = o[qq][d0][r] * rl[r];
        const size_t grow = (size_t)(qrow0 + qoff + qq * 32 + eq);
        const u32x4* gp = (const u32x4*)(P.GA() + grow * 512 + head * 64 + eseg * 32);
        u32x4* op = (u32x4*)(P.O() + grow * 1024 + head * 64 + eseg * 32);
        u32x4 gv[4];
#pragma unroll
        for (int i = 0; i < 4; ++i) gv[i] = gp[i];
#pragma unroll
        for (int i = 0; i < 4; ++i) {
            const f32x4 a = *(const LDSAS f32x4*)(stg + eq * 68 + eseg * 32 + i * 8), c = *(const LDSAS f32x4*)(stg + eq * 68 + eseg * 32 + i * 8 + 4);
            const u32x4 g = gv[i]; u32x4 ov;
            ov.x = cvtpk(a[0] * bflo(g.x), a[1] * bfhi(g.x)); ov.y = cvtpk(a[2] * bflo(g.y), a[3] * bfhi(g.y));
            ov.z = cvtpk(c[0] * bflo(g.z), c[1] * bfhi(g.z)); ov.w = cvtpk(c[2] * bflo(g.w), c[3] * bfhi(g.w));
            op[i] = ov;
        }
    }
    __syncthreads();
}

__device__ __forceinline__ void phase_attnA_mfma(const Params& P, LDSAS unsigned char* lds, int vb, int nvb, int g_wave) {
    for (int u = vb; u < 1024 + 128; u += nvb) {
        int b, kvh, qrow0, qpos0, kt0, nwin;
        if (u < 1024) {
            int qblk;
            if (nvb == 256) { const int round = u >> 8, i = u & 255; b = round * 8 + (i & 7); kvh = (i >> 3) >> 4; qblk = (i >> 3) & 15; }
            else { qblk = u & 15; kvh = (u >> 4) & 1; b = u >> 5; }
            const int lo = 2 * qblk - 2 < 0 ? 0 : 2 * qblk - 2, hi_ = 2 * qblk + 3 > 31 ? 31 : 2 * qblk + 3;
            qrow0 = b * 2048 + qblk * 128; qpos0 = qblk * 128; kt0 = lo; nwin = hi_ - lo + 1;
        } else {
            const int v = u - 1024, half = v & 1; kvh = (v >> 1) & 1; b = v >> 2;
            qrow0 = ML + b * 256 + half * 128; qpos0 = 0; kt0 = 0; nwin = 0;
        }
        attnA_unit(P, lds, b, kvh, qrow0, qpos0, kt0, nwin, g_wave);
    }
}

constexpr int GL_QD = 0, GL_KD = 17408, GL_KT = 34816, GL_V = 53248, GL_DEC = 86016, GL_RF = 86528, GL_TOT = 90624, GL_WA = 92672, GL_RQ = 101376, GL_RK = 117760, GL_ATT = 134144, GL_END = 140288;
constexpr int KERNEL_LDS = (GL_END > pg8::STAGE_BYTES ? GL_END : pg8::STAGE_BYTES);
static_assert(TICKET_LDS == KERNEL_LDS + 8, "ticket word sits next to the barrier words");
__device__ __forceinline__ int pos16(int x) { return 8 * ((x >> 2) & 1) + (x & 3) + 4 * (x >> 3); }
__device__ __forceinline__ bf16x8 pack8(const f32x16& v, int o) {
    u32x4 w; w.x = cvtpk(v[o], v[o + 1]); w.y = cvtpk(v[o + 2], v[o + 3]); w.z = cvtpk(v[o + 4], v[o + 5]); w.w = cvtpk(v[o + 6], v[o + 7]);
    return __builtin_bit_cast(bf16x8, w);
}

__device__ __forceinline__ void phase_gla_mfma(const Params& P, LDSAS unsigned char* lds, int vb, int nvb, int g_wave) {
    const int tid = otid(), lane = tid & 63, r32 = lane & 31, hi = lane >> 5;
    const int wid = __builtin_amdgcn_readfirstlane(tid >> 6);
    const int it = wid >> 2, dt = wid & 3, d = dt * 32 + r32;
    for (int unit = vb; unit < NB * 8; unit += nvb) {
        const int dr = unit & 1, h = (unit >> 1) & 3, b = unit >> 3;
        const float* wa = dr ? P.wa_b : P.wa_f; const float* ba = dr ? P.ba_b : P.ba_f;
        __syncthreads();
        if (tid < 128) {
            u32x4 whi[2], wlo[2];
#pragma unroll
            for (int j = 0; j < 16; j += 2) {
                const float w0 = wa[j * 512 + h * 128 + tid] * LOG2E, w1 = wa[(j + 1) * 512 + h * 128 + tid] * LOG2E;
                const unsigned ph = cvtpk(w0, w1); const unsigned pl = cvtpk(w0 - bflo(ph), w1 - bfhi(ph));
                whi[j >> 3][(j >> 1) & 3] = ph; wlo[j >> 3][(j >> 1) & 3] = pl;
            }
            *(LDSAS u32x4*)(lds + GL_WA + tid * 32) = whi[0]; *(LDSAS u32x4*)(lds + GL_WA + tid * 32 + 16) = whi[1];
            *(LDSAS u32x4*)(lds + GL_WA + 4096 + tid * 32) = wlo[0]; *(LDSAS u32x4*)(lds + GL_WA + 4096 + tid * 32 + 16) = wlo[1];
            ((LDSAS float*)(lds + GL_WA + 8192))[tid] = ba[h * 128 + tid] * LOG2E;
        }
        f32x16 S[4];
#pragma unroll
        for (int i = 0; i < 4; ++i) S[i] = (f32x16){};
        f32x4 pf_rf; u32x4 pf_v[4], pf_q[2], pf_k[2];
        float lb[16];
#define GL_MEMBASE(n) ((n) >= 4 ? b * T + 64 * (dr ? 31 - ((n) - 4) : ((n) - 4)) : ML + b * L + 64 * (dr ? 3 - (n) : (n)))
#define GL_PREFETCH_V(n) do { const int mb_ = GL_MEMBASE(n); \
            _Pragma("unroll") for (int k4 = 0; k4 < 4; ++k4) { const int idx = tq + 512 * k4; pf_v[k4] = *(const u32x4*)(P.VG() + (size_t)(mb_ + (idx >> 5)) * 1024 + h * 256 + (idx & 31) * 8); } } while (0)
#define GL_PREFETCH_RQK(n) do { const int mb_ = GL_MEMBASE(n); \
            pf_rf = *(const f32x4*)(P.RF() + (size_t)(mb_ + ((tq & 255) >> 2)) * 32 + dr * 16 + (tq & 3) * 4); \
            _Pragma("unroll") for (int k2 = 0; k2 < 2; ++k2) { const int idx = tq + 512 * k2; pf_k[k2] = *(const u32x4*)(P.KG() + (size_t)(mb_ + (idx >> 4)) * 512 + h * 128 + (idx & 15) * 8); \
                pf_q[k2] = *(const u32x4*)(P.QG() + (size_t)(mb_ + (idx >> 4)) * 512 + h * 128 + (idx & 15) * 8); } } while (0)
#define GL_TOP(lat) do { \
            if (tq < 256) { \
                const unsigned h0 = cvtpk(pf_rf[0], pf_rf[1]), h1 = cvtpk(pf_rf[2], pf_rf[3]); \
                const unsigned l0 = cvtpk(pf_rf[0] - bflo(h0), pf_rf[1] - bfhi(h0)), l1 = cvtpk(pf_rf[2] - bflo(h1), pf_rf[3] - bfhi(h1)); \
                const int off = (dr ? 63 - (tq >> 2) : (tq >> 2)) * 32 + (tq & 3) * 8; \
                *(LDSAS u32x2*)(lds + GL_RF + off) = (u32x2){h0, h1}; *(LDSAS u32x2*)(lds + GL_RF + 2048 + off) = (u32x2){l0, l1}; \
            } \
            _Pragma("unroll") for (int k2 = 0; k2 < 2; ++k2) { const int idx = tq + 512 * k2, im = idx >> 4, ch = idx & 15; const int pr = dr ? 63 - im : im; \
                const int off = pr * 256 + ((ch ^ (4 * (pr & 3))) * 16); \
                *(LDSAS u32x4*)(lds + GL_RK + off) = pf_k[k2]; if (lat) *(LDSAS u32x4*)(lds + GL_RQ + off) = pf_q[k2]; } } while (0)
#define GL_Z() do { \
            const float bav = ((const LDSAS float*)(lds + GL_WA + 8192))[d]; \
            f32x16 z; \
            _Pragma("unroll") for (int r = 0; r < 16; ++r) z[r] = bav; \
            const bf16x8 ah = *(const LDSAS bf16x8*)(lds + GL_RF + (it * 32 + r32) * 32 + hi * 16), al = *(const LDSAS bf16x8*)(lds + GL_RF + 2048 + (it * 32 + r32) * 32 + hi * 16); \
            const bf16x8 bh = *(const LDSAS bf16x8*)(lds + GL_WA + d * 32 + hi * 16), bl = *(const LDSAS bf16x8*)(lds + GL_WA + 4096 + d * 32 + hi * 16); \
            z = __builtin_amdgcn_mfma_f32_32x32x16_bf16(ah, bh, z, 0, 0, 0); \
            z = __builtin_amdgcn_mfma_f32_32x32x16_bf16(al, bh, z, 0, 0, 0); \
            z = __builtin_amdgcn_mfma_f32_32x32x16_bf16(ah, bl, z, 0, 0, 0); \
            float gs[4]; \
            _Pragma("unroll") for (int g = 0; g < 4; ++g) { \
                float run = 0.f; \
                _Pragma("unroll") for (int j = 0; j < 4; ++j) { \
                    const float zz = z[4 * g + j]; \
                    run += (fminf(zz, 0.f) - __builtin_amdgcn_logf(1.0f + __builtin_amdgcn_exp2f(-fabsf(zz)))) * (1.0f / 16.0f); \
                    lb[4 * g + j] = run; \
                } \
                gs[g] = run; \
            } \
            float off = 0.f; \
            _Pragma("unroll") for (int g = 0; g < 4; ++g) {        \
                const auto sw = __builtin_amdgcn_permlane32_swap(__float_as_uint(gs[g]), __float_as_uint(gs[g]), false, false);        \
                const float o2 = off + (hi ? __uint_as_float(sw[0]) : 0.f); \
                _Pragma("unroll") for (int j = 0; j < 4; ++j) lb[4 * g + j] += o2; \
                off += __uint_as_float(sw[0]) + __uint_as_float(sw[1]); \
            } \
            if (hi == 0) ((LDSAS float*)(lds + GL_TOT))[it * 128 + d] = off; } while (0)
        { int tq = tid; asm volatile("" : "+v"(tq)); GL_PREFETCH_RQK(0); GL_PREFETCH_V(0); GL_TOP(false); GL_PREFETCH_RQK(1); }
        __syncthreads();
        GL_Z();
        __syncthreads();
        for (int n = 0; n < 36; ++n) {
            const bool latent = n >= 4;
            const int membase = GL_MEMBASE(n);
            const int nn = n + 1 < 36 ? n + 1 : 35, n2 = n + 2 < 36 ? n + 2 : 35;
            {
                const float t0 = ((const LDSAS float*)(lds + GL_TOT))[d], t1 = ((const LDSAS float*)(lds + GL_TOT))[128 + d];
                const float prefix = it ? t0 : 0.f;
                const float dec = __builtin_amdgcn_exp2f(t0 + t1);
                const int le = lane;
                const int trs = (le & 15) >> 2, trc = dt * 4 + ((le >> 4) & 1) * 2 + ((le & 3) >> 1);
                const int troff = (it * 32 + 4 * (le >> 5) + trs) * 256 + ((trc ^ (4 * trs)) * 16) + (le & 1) * 8;
                u32x2 kr[4], qr[4];
#pragma unroll
                for (int g = 0; g < 4; ++g) { kr[g] = __builtin_bit_cast(u32x2, vtr(lds + GL_RK + troff + g * 2048)); if (latent) qr[g] = __builtin_bit_cast(u32x2, vtr(lds + GL_RQ + troff + g * 2048)); }
                float ktv[16];
                const int dp = ((d & ~15) + pos16(d & 15)) * 2;
#pragma unroll
                for (int r = 0; r < 16; r += 2) {
                    const int i0 = it * 32 + crow(r, hi), i1 = i0 + 1;
                    const float e0 = __builtin_amdgcn_exp2f(prefix + lb[r]), e1 = __builtin_amdgcn_exp2f(prefix + lb[r + 1]);
                    const unsigned kw2 = kr[r >> 2][(r >> 1) & 1];
                    const float kd0 = bflo(kw2) * __builtin_amdgcn_rcpf(e0), kd1 = bfhi(kw2) * __builtin_amdgcn_rcpf(e1);
                    ktv[r] = kd0 * dec; ktv[r + 1] = kd1 * dec;
                    lb[r] = e0; lb[r + 1] = e1;
                    if (latent) {
                        const unsigned kw = cvtpk(kd0, kd1);
                        *(LDSAS bf16_t*)(lds + GL_KD + i0 * 272 + dp) = (bf16_t)kw; *(LDSAS bf16_t*)(lds + GL_KD + i1 * 272 + dp) = (bf16_t)(kw >> 16);
                    }
                }
                if (latent) {
#pragma unroll
                    for (int r = 0; r < 16; r += 2) {
                        const int i0 = it * 32 + crow(r, hi), i1 = i0 + 1;
                        const unsigned qw2 = qr[r >> 2][(r >> 1) & 1];
                        const unsigned qw = cvtpk(bflo(qw2) * lb[r], bfhi(qw2) * lb[r + 1]);
                        *(LDSAS bf16_t*)(lds + GL_QD + i0 * 272 + dp) = (bf16_t)qw; *(LDSAS bf16_t*)(lds + GL_QD + i1 * 272 + dp) = (bf16_t)(qw >> 16);
                    }
                }
                u32x4 w0, w1;
                w0.x = cvtpk(ktv[0], ktv[1]); w0.y = cvtpk(ktv[2], ktv[3]); w0.z = cvtpk(ktv[4], ktv[5]); w0.w = cvtpk(ktv[6], ktv[7]);
                w1.x = cvtpk(ktv[8], ktv[9]); w1.y = cvtpk(ktv[10], ktv[11]); w1.z = cvtpk(ktv[12], ktv[13]); w1.w = cvtpk(ktv[14], ktv[15]);
                *(LDSAS u32x4*)(lds + GL_KT + d * 144 + (2 * it) * 32 + hi * 16) = w0;
                *(LDSAS u32x4*)(lds + GL_KT + d * 144 + (2 * it + 1) * 32 + hi * 16) = w1;
                if (it == 0 && hi == 0) ((LDSAS float*)(lds + GL_DEC))[d] = dec;
            }
            const int tq = tid;
#pragma unroll
            for (int k4 = 0; k4 < 4; ++k4) { const int idx = tq + 512 * k4, im = idx >> 5, ch = idx & 31; *(LDSAS u32x4*)(lds + GL_V + (ch >> 2) * 4096 + (dr ? 63 - im : im) * 64 + (ch & 3) * 16) = pf_v[k4]; }
            __syncthreads();
            GL_TOP(nn >= 4);
            GL_PREFETCH_V(nn);
            GL_PREFETCH_RQK(n2);
            bf16x8 vf[4];
#define GL_LOADV() do { const LDSAS unsigned char* vbp = lds + GL_V + wid * 4096 + (4 * hiq + ((lq & 15) >> 2)) * 64 + ((lq >> 4) & 1) * 32 + (lq & 3) * 8; \
                _Pragma("unroll") for (int js = 0; js < 4; ++js) { const s16x4 lo = vtr(vbp + js * 1024), hh = vtr(vbp + js * 1024 + 512); vf[js] = (bf16x8){lo[0], lo[1], lo[2], lo[3], hh[0], hh[1], hh[2], hh[3]}; } } while (0)
            __builtin_amdgcn_sched_barrier(0);
            const int lq = lane;
            const int r32q = lq & 31, hiq = lq >> 5;
#define GL_SUPDATE() do { _Pragma("unroll") for (int dt2 = 0; dt2 < 4; ++dt2) { __builtin_amdgcn_sched_barrier(0); \
                _Pragma("unroll") for (int g = 0; g < 4; ++g) { const f32x4 dc = *(const LDSAS f32x4*)(lds + GL_DEC + (dt2 * 32 + 8 * g + 4 * hiq) * 4); \
                    S[dt2][4 * g] *= dc[0]; S[dt2][4 * g + 1] *= dc[1]; S[dt2][4 * g + 2] *= dc[2]; S[dt2][4 * g + 3] *= dc[3]; } \
                const LDSAS unsigned char* ktp = lds + GL_KT + (dt2 * 32 + r32q) * 144 + hiq * 16; \
                _Pragma("unroll") for (int is = 0; is < 4; ++is) S[dt2] = __builtin_amdgcn_mfma_f32_32x32x16_bf16(*(const LDSAS bf16x8*)(ktp + is * 32), vf[is], S[dt2], 0, 0, 0); } } while (0)
            GL_LOADV();
            f32x16 o0 = (f32x16){}, o1 = (f32x16){};
            if (latent) {
                if (wid < 3) {
                    f32x16 X = (f32x16){};
                    const LDSAS unsigned char* kb = lds + GL_KD + ((wid == 2 ? 32 : 0) + r32q) * 272 + hiq * 16;
                    const LDSAS unsigned char* qb2 = lds + GL_QD + ((wid >= 1 ? 32 : 0) + r32q) * 272 + hiq * 16;
#pragma unroll
                    for (int s = 0; s < 8; ++s) X = __builtin_amdgcn_mfma_f32_32x32x16_bf16(*(const LDSAS bf16x8*)(kb + s * 32), *(const LDSAS bf16x8*)(qb2 + s * 32), X, 0, 0, 0);
                    if (wid != 1) {
                        const int rq = r32;
#pragma unroll
                        for (int r = 0; r < 16; ++r) X[r] = (crow(r, hi) <= rq) ? X[r] : 0.f;
                    }
                    *(LDSAS bf16x8*)(lds + GL_ATT + wid * 2048 + lq * 16) = pack8(X, 0);
                    *(LDSAS bf16x8*)(lds + GL_ATT + wid * 2048 + 1024 + lq * 16) = pack8(X, 8);
                }
                __builtin_amdgcn_sched_barrier(0);
                const LDSAS unsigned char* qb = lds + GL_QD + r32q * 272 + hiq * 16;
#pragma unroll
                for (int s = 0; s < 8; ++s) {
                    const bf16x8 Sb = pack8(S[s >> 1], (s & 1) * 8);
                    const bf16x8 q0 = *(const LDSAS bf16x8*)(qb + s * 32), q1 = *(const LDSAS bf16x8*)(qb + 32 * 272 + s * 32);
                    o0 = __builtin_amdgcn_mfma_f32_32x32x16_bf16(q0, Sb, o0, 0, 0, 0);
                    o1 = __builtin_amdgcn_mfma_f32_32x32x16_bf16(q1, Sb, o1, 0, 0, 0);
                    if (s & 1) __builtin_amdgcn_sched_barrier(0);
                }
            }
            __syncthreads();
            if (latent) {
                {
                    const LDSAS unsigned char* ab = lds + GL_ATT + lq * 16;
                    o0 = __builtin_amdgcn_mfma_f32_32x32x16_bf16(*(const LDSAS bf16x8*)(ab), vf[0], o0, 0, 0, 0);
                    o0 = __builtin_amdgcn_mfma_f32_32x32x16_bf16(*(const LDSAS bf16x8*)(ab + 1024), vf[1], o0, 0, 0, 0);
                    __builtin_amdgcn_sched_barrier(0);
                    o1 = __builtin_amdgcn_mfma_f32_32x32x16_bf16(*(const LDSAS bf16x8*)(ab + 2048), vf[0], o1, 0, 0, 0);
                    o1 = __builtin_amdgcn_mfma_f32_32x32x16_bf16(*(const LDSAS bf16x8*)(ab + 3072), vf[1], o1, 0, 0, 0);
                    __builtin_amdgcn_sched_barrier(0);
                    o1 = __builtin_amdgcn_mfma_f32_32x32x16_bf16(*(const LDSAS bf16x8*)(ab + 4096), vf[2], o1, 0, 0, 0);
                    o1 = __builtin_amdgcn_mfma_f32_32x32x16_bf16(*(const LDSAS bf16x8*)(ab + 5120), vf[3], o1, 0, 0, 0);
                }
                LDSAS unsigned char* ost = lds + GL_V + wid * 4096;
#pragma unroll
                for (int r = 0; r < 16; r += 2) {
                    const int i0 = crow(r, hi);
                    const unsigned w0 = cvtpk(o0[r], o0[r + 1]), w1 = cvtpk(o1[r], o1[r + 1]);
                    *(LDSAS bf16_t*)(ost + i0 * 64 + r32 * 2) = (bf16_t)w0; *(LDSAS bf16_t*)(ost + (i0 + 1) * 64 + r32 * 2) = (bf16_t)(w0 >> 16);
                    *(LDSAS bf16_t*)(ost + (32 + i0) * 64 + r32 * 2) = (bf16_t)w1; *(LDSAS bf16_t*)(ost + (33 + i0) * 64 + r32 * 2) = (bf16_t)(w1 >> 16);
                }
                bf16_t* od = P.OD() + (size_t)dr * ML * 1024 + h * 256 + wid * 32;
#pragma unroll
                for (int k4 = 0; k4 < 4; ++k4) {
                    const int p = lane + 64 * k4, i = p >> 2, part = p & 3;
                    const u32x4 v = *(const LDSAS u32x4*)(ost + i * 64 + part * 16);
                    *(u32x4*)(od + (size_t)(membase + (dr ? 63 - i : i)) * 1024 + part * 8) = v;
                }
            }
            GL_SUPDATE();
            GL_Z();
            __syncthreads();
#undef GL_LOADV
#undef GL_SUPDATE
        }
#undef GL_PREFETCH_V
#undef GL_PREFETCH_RQK
#undef GL_TOP
#undef GL_Z
#undef GL_MEMBASE
    }
}

__device__ __forceinline__ void phase_rstd1(const Params& P, int vb, int nvb, int g_wave) {
    const int tidx = otid();
    for (int row = vb * 512 + tidx; row < M; row += nvb * 512) {
        float ss = 0.f;
#pragma unroll
        for (int i = 0; i < 16; ++i) ss += P.parts()[(size_t)i * M + row];
        ((float*)(P.ws + OFF_RS))[row] = rsqrtf(ss * (1.0f / 1024.0f) + EPS);
    }
}

__device__ __forceinline__ void phase_finish(const Params& P, int vb, int nvb, int g_wave) {
    const int tidx = otid();
    const int lane = tidx & 63, wpb = blockDim.x >> 6, w = tidx >> 6;
    for (int row = vb * wpb + w; row < ML; row += nvb * wpb) {
        const int c0 = lane * 16;
        float v[16];
        const u32x4* pf = (const u32x4*)(P.OD() + (size_t)row * 1024 + c0);
        const u32x4* pb = (const u32x4*)(P.OD() + ((size_t)ML + row) * 1024 + c0);
        float ss = 0.f;
#pragma unroll
        for (int i = 0; i < 2; ++i) {
            const u32x4 a = pf[i], bq = pb[i];
            v[8 * i] = bflo(a.x) + bflo(bq.x); v[8 * i + 1] = bfhi(a.x) + bfhi(bq.x); v[8 * i + 2] = bflo(a.y) + bflo(bq.y); v[8 * i + 3] = bfhi(a.y) + bfhi(bq.y);
            v[8 * i + 4] = bflo(a.z) + bflo(bq.z); v[8 * i + 5] = bfhi(a.z) + bfhi(bq.z); v[8 * i + 6] = bflo(a.w) + bflo(bq.w); v[8 * i + 7] = bfhi(a.w) + bfhi(bq.w);
        }
#pragma unroll
        for (int i = 0; i < 16; ++i) ss += v[i] * v[i];
        ss += __shfl_xor(ss, 1); ss += __shfl_xor(ss, 2); ss += __shfl_xor(ss, 4); ss += __shfl_xor(ss, 8);
        const float rn = rsqrtf(ss * (1.0f / 256.0f) + EPS);
        float gn[16];
        { const f32x4* gnp = (const f32x4*)(P.gla_out_norm + (c0 & 255));
#pragma unroll
          for (int i = 0; i < 4; ++i) { const f32x4 t4 = gnp[i]; gn[4 * i] = t4[0]; gn[4 * i + 1] = t4[1]; gn[4 * i + 2] = t4[2]; gn[4 * i + 3] = t4[3]; } }
        const u32x4* gp = (const u32x4*)(P.GG() + (size_t)row * 1024 + c0);
        u32x4* op = (u32x4*)(P.A2() + (size_t)row * 1024 + c0);
        const u32x4 gq[2] = {gp[0], gp[1]};
#pragma unroll
        for (int i = 0; i < 2; ++i) {
            const u32x4 g = gq[i]; u32x4 r;
            r.x = cvtpk(v[8 * i] * rn * gn[8 * i] * bflo(g.x), v[8 * i + 1] * rn * gn[8 * i + 1] * bfhi(g.x));
            r.y = cvtpk(v[8 * i + 2] * rn * gn[8 * i + 2] * bflo(g.y), v[8 * i + 3] * rn * gn[8 * i + 3] * bfhi(g.y));
            r.z = cvtpk(v[8 * i + 4] * rn * gn[8 * i + 4] * bflo(g.z), v[8 * i + 5] * rn * gn[8 * i + 5] * bfhi(g.z));
            r.w = cvtpk(v[8 * i + 6] * rn * gn[8 * i + 6] * bflo(g.w), v[8 * i + 7] * rn * gn[8 * i + 7] * bfhi(g.w));
            op[i] = r;
        }
    }
}

namespace cg = cooperative_groups;
#define XB_TMO      128
#define XB_XCNT(j)  (256  + 64 * (j))
#define XB_XSUB(j)  (1280 + 64 * (j))
#define XB_XGEN(j)  (2304 + 64 * (j))
#define XB_TOP      3328
#define XB_TOPGEN   3392
#define XCD_BAR_WORDS 3456
#define XB_SPIN_CAP (1u << 22)
static_assert(XCD_BAR_WORDS * 4 <= 16384, "barrier words fit their workspace slot");
__device__ __forceinline__ unsigned xb_ld(unsigned* p) { return __hip_atomic_load(p, __ATOMIC_RELAXED, __HIP_MEMORY_SCOPE_AGENT); }
__device__ __forceinline__ unsigned xb_add(unsigned* p, unsigned v) { return __hip_atomic_fetch_add(p, v, __ATOMIC_RELAXED, __HIP_MEMORY_SCOPE_AGENT); }
__device__ __forceinline__ unsigned xb_xcc_id() { return (unsigned)__builtin_amdgcn_s_getreg((3 << 11) | 20) & 0xFu; }
#define XB_SPIN(cond, bar) do { unsigned _sp = 0; while (cond) { __builtin_amdgcn_s_sleep(1); \
    if ((++_sp & 255u) == 0u) { if (xb_ld(&(bar)[XB_TMO])) break; if (_sp > XB_SPIN_CAP) { atomicAdd(&(bar)[XB_TMO], 1u); break; } } } } while (0)
__device__ __forceinline__ void xcd_barrier_complete(unsigned* bar, unsigned x, unsigned G, unsigned& nloc, unsigned& nx) {
    unsigned sum, cnt, mine, sp = 0u;
    for (;;) {
        sum = 0u; cnt = 0u; mine = 0u;
#pragma unroll
        for (unsigned j = 0; j < 16; ++j) { const unsigned c = xb_ld(&bar[XB_XCNT(j)]); sum += c; cnt += (c > 0u) ? 1u : 0u; mine = (j == x) ? c : mine; }
        if (sum == G) break;
        __builtin_amdgcn_s_sleep(1);
        if ((++sp & 255u) == 0u) { if (xb_ld(&bar[XB_TMO])) break; if (sp > XB_SPIN_CAP) { atomicAdd(&bar[XB_TMO], 1u); break; } }
    }
    nloc = mine > 0u ? mine : 1u; nx = cnt > 0u ? cnt : 1u;
}
__device__ __forceinline__ void xcd_barrier(unsigned* bar, volatile LDSAS unsigned* st, unsigned G, int g_wave) {
    asm volatile("s_waitcnt vmcnt(0)" ::: "memory");
    __syncthreads();
    if (g_wave == 0 && lane_id() == 0) {
        const unsigned x = xb_xcc_id();
        __builtin_amdgcn_s_waitcnt(0);
        unsigned nloc = st[0], nx = st[1];
        if (nloc == 0u) { xcd_barrier_complete(bar, x, G, nloc, nx); st[0] = nloc; st[1] = nx; }
        const unsigned old = xb_add(&bar[XB_XSUB(x)], 1u);
        const unsigned gen = old / nloc;
        if (old + 1u == (gen + 1u) * nloc) {
            __builtin_amdgcn_fence(__ATOMIC_RELEASE, "agent");
            asm volatile("s_waitcnt vmcnt(0)" ::: "memory");
            const unsigned og = xb_add(&bar[XB_TOP], 1u);
            const unsigned tg = og / nx;
            if (og + 1u == (tg + 1u) * nx) xb_add(&bar[XB_TOPGEN], 1u);
            else XB_SPIN(xb_ld(&bar[XB_TOPGEN]) == tg, bar);
            __builtin_amdgcn_fence(__ATOMIC_ACQUIRE, "agent");
            xb_add(&bar[XB_XGEN(x)], 1u);
            asm volatile("s_waitcnt vmcnt(0)" ::: "memory");
        } else {
            XB_SPIN(xb_ld(&bar[XB_XGEN(x)]) == gen, bar);
            __builtin_amdgcn_fence(__ATOMIC_ACQUIRE, "agent");
            asm volatile("s_waitcnt vmcnt(0)" ::: "memory");
        }
    }
    __syncthreads();
}

#define GRID_BAR() xcd_barrier((unsigned*)(ldparams().ws + OFF_BAR), (volatile LDSAS unsigned*)(lds + KERNEL_LDS), (unsigned)nvb, g_wave)
#define REPEAT(k, ...) { const Params P = ldparams(); __VA_ARGS__ }
__global__ void __launch_bounds__(512) mega_kernel(Params Pk) {
    __shared__ __attribute__((aligned(16))) unsigned char lds[KERNEL_LDS + 16];
    const int vb = blockIdx.x, nvb = gridDim.x;
    const int g_wave = __builtin_amdgcn_readfirstlane((int)(threadIdx.x >> 6));
    if (threadIdx.x == 0) {
        ((volatile LDSAS unsigned*)(lds + KERNEL_LDS))[0] = 0u; ((volatile LDSAS unsigned*)(lds + KERNEL_LDS))[1] = 0u;
        (void)xb_add(&((unsigned*)(Pk.ws + OFF_BAR))[XB_XCNT(xb_xcc_id())], 1u);
    }
#ifdef PROBE_A
#define STAMP(k) do { if (vb == 0 && g_wave == 0 && lane_id() == 0) ((unsigned long long*)(ldparams().ws + OFF_BAR + 14336))[k] = __builtin_amdgcn_s_memrealtime(); } while (0)
#else
#define STAMP(k) do { } while (0)
#endif
    STAMP(0);
    REPEAT(0, phase_pro0(P, lds, vb, nvb, g_wave);)
    STAMP(1);
    if (ldparams().reps[11] != 0) cg::this_grid().sync();
    GRID_BAR();
    REPEAT(1, phase_bias_a0(P, lds, vb, nvb, g_wave);)
    STAMP(2);
    GRID_BAR();
    REPEAT(2, EpiIn0 E{P.ws, P.a_q_norm, P.a_k_norm, P.b_q_norm, P.b_k_norm};
      pg8::Gemm g{P.A(), P.Wt0(), M, N0, D}; pg8::StaticOrder S; S.init(M, N0, nvb, vb); pg8::gemm_phase<EpiIn0, pg8::StaticOrder, true, true>((LDSAS unsigned char*)lds, g, S, E, g_wave);)
    STAMP(3);
    GRID_BAR();
    REPEAT(3, phase_attnA_mfma(P, (LDSAS unsigned char*)lds, vb, nvb, g_wave);)
    REPEAT(4, phase_attnB_mfma(P, (LDSAS unsigned char*)lds, vb, nvb, g_wave);)
    STAMP(4);
    GRID_BAR();
    REPEAT(5, EpiOut0 E{P.x, P.ctx, P.norm_g + D, P.out, P.ws};
      pg8::Gemm g{P.O(), P.Wo0(), M, D, D}; pg8::StaticOrder S; S.init(M, D, nvb, vb); pg8::gemm_phase<EpiOut0, pg8::StaticOrder, true, true>((LDSAS unsigned char*)lds, g, S, E, g_wave);)
    STAMP(5);
    GRID_BAR();
    { const Params P = ldparams(); phase_rstd1(P, vb, nvb, g_wave); }
    GRID_BAR();
    REPEAT(6, EpiIn1 E{P.ws};
      pg8::Gemm g{P.A(), P.Wt1(), M, N1, D}; OrderIn1 S; S.init(nvb, vb); pg8::gemm_phase<EpiIn1, OrderIn1, true, true>((LDSAS unsigned char*)lds, g, S, E, g_wave);)
    STAMP(6);
    GRID_BAR();
    REPEAT(7, phase_gla_mfma(P, (LDSAS unsigned char*)lds, vb, nvb, g_wave);)
    STAMP(7);
    GRID_BAR();
    REPEAT(8, phase_finish(P, vb, nvb, g_wave);)
    STAMP(8);
    GRID_BAR();
    { const Params P = ldparams();
      EpiOut1 E{P.ws, P.out};
      pg8::Gemm g{P.A2(), P.Wo1(), ML, D, D}; pg8::StaticOrder S; S.init(ML, D, nvb, vb); pg8::gemm_phase<EpiOut1, pg8::StaticOrder, true, true>((LDSAS unsigned char*)lds, g, S, E, g_wave); }
#ifdef PROBE_A
    STAMP(9);
    GRID_BAR();
    if (vb == 0 && g_wave == 0 && lane_id() == 0) {
        const Params P = ldparams(); const unsigned long long* ts = (const unsigned long long*)(P.ws + OFF_BAR + 14336);
        P.out[0] += (float)(ts[PROBE_A + 1] - ts[PROBE_A]) * 0.01f;
        P.out[1] += (float)(ts[PROBE_B + 1] - ts[PROBE_B]) * 0.01f;
    }
#endif
}
}

extern "C" void kernel_launch(void* const* d_in, const int* in_sizes, int n_in, void* d_out, int out_size, void* d_ws, size_t ws_size, hipStream_t stream) {
    Params P{};
    const float* const* in = (const float* const*)d_in;
    P.x = in[0]; P.c = in[1]; P.ctx = in[2]; P.c_ctx = in[3]; P.adaln_w = in[4]; P.adaln_b = in[5]; P.norm_g = in[6]; P.w_out = in[7]; P.ab_w_in = in[8];
    P.a_q_norm = in[9]; P.a_k_norm = in[10]; P.a_sink = in[11]; P.b_q_norm = in[12]; P.b_k_norm = in[13]; P.lq1 = in[14]; P.lk1 = in[15]; P.lq2 = in[16]; P.lk2 = in[17];
    P.b_subln = in[18]; P.gla_w_in = in[19]; P.wa_f = in[20]; P.ba_f = in[21]; P.wa_b = in[22]; P.ba_b = in[23]; P.gla_out_norm = in[24];
    P.out = (float*)d_out;
    P.ws = (unsigned char*)d_ws;
    for (int i = 0; i < 12; ++i) P.reps[i] = 1;
    P.reps[11] = 0;
#ifdef PROBE_PHASE
    P.reps[PROBE_PHASE] = 2;
#endif
    if (WS_NEED > ws_size) { fprintf(stderr, "workspace too small: need %zu have %zu\n", (size_t)WS_NEED, ws_size); return; }
    static int grid_blocks = 0;
    if (!grid_blocks) {
        int dev = 0, cus = 0, per_cu = 0;
        (void)hipGetDevice(&dev);
        (void)hipDeviceGetAttribute(&cus, hipDeviceAttributeMultiprocessorCount, dev);
        (void)hipOccupancyMaxActiveBlocksPerMultiprocessor(&per_cu, mega_kernel, 512, 0);
        if (per_cu > 1) per_cu = 1;
        grid_blocks = cus * per_cu;
    }
    (void)hipMemsetAsync((unsigned char*)d_ws + OFF_BAR, 0, 16384, stream);
    void* args[] = {&P};
    hipError_t e = hipLaunchCooperativeKernel((void*)mega_kernel, dim3(grid_blocks), dim3(512), args, 0, stream);
    if (e != hipSuccess) fprintf(stderr, "cooperative launch failed: %s (grid %d)\n", hipGetErrorString(e), grid_blocks);
}
```

```cpp
#include <hip/hip_runtime.h>
#include <hip/hip_cooperative_groups.h>
#include <cstdint>
#include <cstdio>

namespace {
constexpr int NB = 32, T = 2048, L = 256, D = 1024;
constexpr int ML = NB * T, MC = NB * L, M = ML + MC;
constexpr int N0 = 3328, N1 = 3328, N0R = 3328, N1R = 3104;
constexpr float EPS = 1e-6f;
constexpr float LOG2E = 1.4426950408889634f;
constexpr float QSCALE = 0.125f * LOG2E;
constexpr float LAMBDA_INIT = 0.2f;

typedef unsigned short bf16_t;
typedef short bf16x8 __attribute__((ext_vector_type(8)));
typedef float f32x4 __attribute__((ext_vector_type(4)));
typedef unsigned u32x4 __attribute__((ext_vector_type(4)));
typedef unsigned u32x2 __attribute__((ext_vector_type(2)));

constexpr size_t al256(size_t x) { return (x + 255) & ~(size_t)255; }
constexpr size_t OFF_WT0 = 0;
constexpr size_t OFF_WT1 = OFF_WT0 + al256((size_t)N0 * D * 2);
constexpr size_t OFF_WO0 = OFF_WT1 + al256((size_t)N1 * D * 2);
constexpr size_t OFF_WO1 = OFF_WO0 + al256((size_t)D * D * 2);
constexpr size_t OFF_MOD = OFF_WO1 + al256((size_t)D * D * 2);
constexpr size_t OFF_BIAS0 = OFF_MOD + al256((size_t)2 * 33 * 3072 * 4);
constexpr size_t OFF_BIAS1 = OFF_BIAS0 + al256((size_t)33 * 3328 * 4);
constexpr size_t OFF_ROPE = OFF_BIAS1 + al256((size_t)33 * 3328 * 4);
constexpr size_t OFF_SCAL = OFF_ROPE + al256(64 * 16 * 2 * 4);
constexpr size_t OFF_BAR = OFF_SCAL + 256;
constexpr size_t OFF_RS = OFF_BAR + 16384;
constexpr size_t OFF_PARTS = OFF_RS + al256((size_t)M * 4);
constexpr size_t OFF_A = OFF_PARTS + al256((size_t)16 * M * 4);
constexpr size_t OFF_O = OFF_A + (size_t)M * D * 2;
constexpr size_t OFF_QKV = OFF_O + (size_t)M * D * 2;
constexpr size_t OFF_X1B = OFF_QKV + (size_t)M * 3328 * 2;
constexpr size_t WS_NEED = OFF_X1B + (size_t)ML * D * 2;
constexpr size_t OFF_QA = OFF_QKV, OFF_KA = OFF_QA + (size_t)M * 512 * 2, OFF_VA = OFF_KA + (size_t)M * 128 * 2, OFF_GA = OFF_VA + (size_t)M * 128 * 2;
constexpr size_t OFF_QB = OFF_GA + (size_t)M * 512 * 2, OFF_KB = OFF_QB + (size_t)M * 512 * 2, OFF_VB = OFF_KB + (size_t)M * 512 * 2, OFF_GB = OFF_VB + (size_t)M * 512 * 2;
constexpr size_t OFF_QG = OFF_QKV, OFF_KG = OFF_QG + (size_t)M * 512 * 2, OFF_VG = OFF_KG + (size_t)M * 512 * 2, OFF_GG = OFF_VG + (size_t)M * 1024 * 2, OFF_RF = OFF_GG + (size_t)M * 1024 * 2;
static_assert(OFF_RF + (size_t)M * 32 * 4 <= WS_NEED, "layer-1 projections fit");
static_assert((size_t)2 * ML * 1024 * 2 <= (size_t)2 * M * D * 2, "OD fits over A + O");

struct Params {
    const float *x, *c, *ctx, *c_ctx, *adaln_w, *adaln_b, *norm_g, *w_out, *ab_w_in, *a_q_norm, *a_k_norm, *a_sink, *b_q_norm, *b_k_norm;
    const float *lq1, *lk1, *lq2, *lk2, *b_subln, *gla_w_in, *wa_f, *ba_f, *wa_b, *ba_b, *gla_out_norm;
    float* out;
    unsigned char* ws;
    int reps[12];
#define WSPTR(T, name, off) __device__ __forceinline__ T* name() const { return (T*)(ws + (off)); }
    WSPTR(bf16_t, Wt0, OFF_WT0) WSPTR(bf16_t, Wt1, OFF_WT1) WSPTR(bf16_t, Wo0, OFF_WO0) WSPTR(bf16_t, Wo1, OFF_WO1)
    WSPTR(float, mod, OFF_MOD) WSPTR(float, bias0, OFF_BIAS0) WSPTR(float, bias1, OFF_BIAS1) WSPTR(float, rope, OFF_ROPE) WSPTR(float, scal, OFF_SCAL) WSPTR(float, parts, OFF_PARTS)
    WSPTR(bf16_t, A, OFF_A) WSPTR(bf16_t, O, OFF_O)
    WSPTR(bf16_t, QA, OFF_QA) WSPTR(bf16_t, KA, OFF_KA) WSPTR(bf16_t, VA, OFF_VA) WSPTR(bf16_t, GA, OFF_GA)
    WSPTR(bf16_t, QB, OFF_QB) WSPTR(bf16_t, KB, OFF_KB) WSPTR(bf16_t, VB, OFF_VB) WSPTR(bf16_t, GB, OFF_GB)
    WSPTR(bf16_t, QG, OFF_QG) WSPTR(bf16_t, KG, OFF_KG) WSPTR(bf16_t, VG, OFF_VG) WSPTR(bf16_t, GG, OFF_GG) WSPTR(float, RF, OFF_RF)
    WSPTR(bf16_t, OD, OFF_A) WSPTR(bf16_t, A2, OFF_QKV)
#undef WSPTR
};

__device__ __forceinline__ int lane_id() { int l; asm volatile("v_mbcnt_lo_u32_b32 %0, -1, 0\n\tv_mbcnt_hi_u32_b32 %0, -1, %0" : "=v"(l)); return l; }
#define otid() otid_(g_wave)
__device__ __forceinline__ int otid_(int wave) { int t = wave * 64 + lane_id(); asm volatile("" : "+v"(t)); return t; }
__device__ __forceinline__ unsigned f2bf(float f) { unsigned u = __float_as_uint(f); u += 0x7FFFu + ((u >> 16) & 1u); return u >> 16; }
__device__ __forceinline__ unsigned pack2(float lo, float hi) { return f2bf(lo) | (f2bf(hi) << 16); }
typedef float f32x2_t __attribute__((ext_vector_type(2)));
typedef __bf16 bf16x2_t __attribute__((ext_vector_type(2)));
__device__ __forceinline__ unsigned cvtpk(float lo, float hi) { f32x2_t v = {lo, hi}; bf16x2_t b = __builtin_convertvector(v, bf16x2_t); return __builtin_bit_cast(unsigned, b); }
__device__ __forceinline__ float bf2f(unsigned h) { return __uint_as_float(h << 16); }
__device__ __forceinline__ float bflo(unsigned w) { return __uint_as_float(w << 16); }
__device__ __forceinline__ float bfhi(unsigned w) { return __uint_as_float(w & 0xFFFF0000u); }
__device__ __forceinline__ float sum_xor16(float x) { const auto r = __builtin_amdgcn_permlane16_swap(__float_as_uint(x), __float_as_uint(x), false, false); return __uint_as_float(r[0]) + __uint_as_float(r[1]); }
__device__ __forceinline__ float sum_xor32(float x) { const auto r = __builtin_amdgcn_permlane32_swap(__float_as_uint(x), __float_as_uint(x), false, false); return __uint_as_float(r[0]) + __uint_as_float(r[1]); }
template <int CTRL> __device__ __forceinline__ float dppf(float x) { return __int_as_float(__builtin_amdgcn_mov_dpp(__float_as_int(x), CTRL, 0xF, 0xF, true)); }
__device__ __forceinline__ float sum_row16(float x) { x += dppf<0xB1>(x); x += dppf<0x4E>(x); x += dppf<0x124>(x); x += dppf<0x128>(x); return x; }
__device__ __forceinline__ float siluf(float v) { return v * __builtin_amdgcn_rcpf(1.0f + __builtin_amdgcn_exp2f(-v * LOG2E)); }

__device__ __forceinline__ Params ldparams() {
#if defined(__HIP_DEVICE_COMPILE__)
    const __attribute__((address_space(4))) Params* pp = (const __attribute__((address_space(4))) Params*)__builtin_amdgcn_kernarg_segment_ptr();
    asm volatile("" : "+s"(pp));
    return *pp;
#else
    return Params{};
#endif
}

__device__ __forceinline__ int perm_local(int p, bool ropeType) {
    const int bj = p >> 7, wc = (p >> 5) & 3, low = p & 31;
    if (ropeType) return wc * 64 + bj * 32 + low;
    const int n = (low >> 4) & 1, fq = (low >> 2) & 3, e = low & 3;
    return wc * 64 + bj * 32 + fq * 8 + n * 4 + e;
}
__device__ __forceinline__ int src_col(int which, int np) {
    const int p = np & 255, tile = np >> 8;
    bool rope = false;
    if (which == 0) { const int g = tile * 4 + ((p >> 5) & 3); rope = (g < 10) || (g >= 20 && g < 36); }
    const int c = tile * 256 + perm_local(p, rope);
    const int nreal = which == 0 ? N0R : (which == 1 ? N1R : D);
    return c < nreal ? c : -1;
}

__device__ __forceinline__ int dst_row(int which, int c) {
    const int tile = c >> 8, cl = c & 255, wc = cl >> 6, bj = (cl >> 5) & 1, low = cl & 31;
    bool rope = false;
    if (which == 0) { const int g = tile * 4 + wc; rope = (g < 10) || (g >= 20 && g < 36); }
    int lo5 = low;
    if (!rope) { const int fq = low >> 3, n = (low >> 2) & 1, e = low & 3; lo5 = n * 16 + fq * 4 + e; }
    return tile * 256 + bj * 128 + wc * 32 + lo5;
}

__device__ __forceinline__ void wt_quad(const float* __restrict__ W, int ldw, int nreal, int which, bf16_t* __restrict__ dst, int c0, int k0, unsigned char* lds, int tid) {
    bf16_t* t = (bf16_t*)lds;
    __syncthreads();
    f32x4 v[8];
#pragma unroll
    for (int i = 0; i < 8; ++i) {
        const int idx = tid + 512 * i, r = idx >> 4, c4 = (idx & 15) * 4;
        const bool ok = c0 + c4 < nreal;
        const f32x4 t4 = *(const f32x4*)(W + (size_t)(k0 + r) * ldw + (ok ? c0 + c4 : 0));
        v[i] = ok ? t4 : (f32x4){0.f, 0.f, 0.f, 0.f};
    }
#pragma unroll
    for (int i = 0; i < 8; ++i) {
        const int idx = tid + 512 * i, r = idx >> 4, c4 = (idx & 15) * 4;
#pragma unroll
        for (int j = 0; j < 4; ++j) t[(c4 + j) * 264 + r] = (bf16_t)f2bf(v[i][j]);
    }
    __syncthreads();
    const int c = tid >> 3, kc = tid & 7;
    bf16_t* drow = dst + (size_t)dst_row(which, c0 + c) * D + k0 + kc * 32;
#pragma unroll
    for (int j = 0; j < 4; ++j) *(u32x4*)(drow + j * 8) = *(const u32x4*)(t + c * 264 + kc * 32 + j * 8);
}

template <int MODE>
__device__ __forceinline__ void skinny_unit(const Params& P, int l, int c0, unsigned char* lds, int tid) {
    float* tab = (float*)lds;
    const int lane = tid & 63, w = tid >> 6;
    const float* W; int ldw, nreal;
    if (MODE == 0) { W = P.adaln_w + (size_t)l * D * 3072; ldw = 3072; nreal = 3072; }
    else { W = l ? P.gla_w_in : P.ab_w_in; ldw = l ? N1R : N0R; nreal = ldw; }
    const bool colok = c0 + lane < nreal;
    float acc[33];
#pragma unroll
    for (int r = 0; r < 33; ++r) acc[r] = 0.f;
    for (int half = 0; half < 2; ++half) {
        __syncthreads();
        for (int r = 0; r < 33; ++r) {
            float v;
            if (MODE == 0) v = siluf(r < 32 ? P.c[r * D + half * 512 + tid] : P.c_ctx[half * 512 + tid]);
            else v = P.mod()[((size_t)l * 33 + r) * 3072 + half * 512 + tid];
            tab[tid * 36 + r] = v;
        }
        __syncthreads();
        const float* wp = W + (size_t)(half * 512 + w * 64) * ldw + (colok ? c0 + lane : 0);
        float wn[4];
#pragma unroll
        for (int j = 0; j < 4; ++j) wn[j] = wp[(size_t)j * ldw];
#pragma unroll 1
        for (int kk = 0; kk < 64; kk += 4) {
            float wc[4];
#pragma unroll
            for (int j = 0; j < 4; ++j) wc[j] = colok ? wn[j] : 0.f;
            const int kn = kk + 4 < 64 ? kk + 4 : 60;
#pragma unroll
            for (int j = 0; j < 4; ++j) wn[j] = wp[(size_t)(kn + j) * ldw];
#pragma unroll
            for (int j = 0; j < 4; ++j) {
                const int k = w * 64 + kk + j; const float wv = wc[j];
#pragma unroll
                for (int r4 = 0; r4 < 8; ++r4) { const f32x4 s = *(const f32x4*)(tab + k * 36 + r4 * 4); acc[r4 * 4] += s[0] * wv; acc[r4 * 4 + 1] += s[1] * wv; acc[r4 * 4 + 2] += s[2] * wv; acc[r4 * 4 + 3] += s[3] * wv; }
                acc[32] += tab[k * 36 + 32] * wv;
            }
        }
    }
    __syncthreads();
#pragma unroll
    for (int r = 0; r < 33; ++r) tab[(w * 33 + r) * 64 + lane] = acc[r];
    __syncthreads();
    for (int idx = tid; idx < 33 * 64; idx += 512) {
        const int r = idx >> 6, col = idx & 63;
        float s = 0.f;
#pragma unroll
        for (int ww = 0; ww < 8; ++ww) s += tab[(ww * 33 + r) * 64 + col];
        if (MODE == 0) { const int j = c0 + col; P.mod()[((size_t)l * 33 + r) * 3072 + j] = s + P.adaln_b[l * 3072 + j]; }
        else { const int c = c0 + col; (l ? P.bias1() : P.bias0())[r * 3328 + dst_row(l, c)] = c < nreal ? s : 0.f; }
    }
}

constexpr int TICKET_LDS = 140288 + 8;
#define TICKET_LOOP(ctr, N, ...) { volatile int* sh_ = (volatile int*)(lds + TICKET_LDS); unsigned* ctr_ = (unsigned*)(P.ws + OFF_BAR + 14336) + (ctr) * 16; \
        __syncthreads(); if (tidx == 0) *sh_ = (int)__hip_atomic_fetch_add(ctr_, 1u, __ATOMIC_RELAXED, __HIP_MEMORY_SCOPE_AGENT); __syncthreads(); \
        int item = *sh_; \
        while (item < (N)) { unsigned nx_ = 0; if (tidx == 0) nx_ = __hip_atomic_fetch_add(ctr_, 1u, __ATOMIC_RELAXED, __HIP_MEMORY_SCOPE_AGENT); \
            __VA_ARGS__ \
            __syncthreads(); if (tidx == 0) *sh_ = (int)nx_; __syncthreads(); item = *sh_; } }

__device__ __forceinline__ void phase_pro0(const Params& P, unsigned char* lds, int vb, int nvb, int g_wave) {
    const int tidx = otid();
    TICKET_LOOP(0, 96 + 544,
        if (item < 96) skinny_unit<0>(P, item / 48, (item % 48) * 64, lds, tidx);
        else {
            int t = item - 96; int which; const float* W; bf16_t* dst; int ldw, nreal;
            if (t < 208) { which = 0; W = P.ab_w_in; dst = P.Wt0(); ldw = N0R; nreal = N0R; }
            else if ((t -= 208) < 208) { which = 1; W = P.gla_w_in; dst = P.Wt1(); ldw = N1R; nreal = N1R; }
            else if ((t -= 208) < 64) { which = 2; W = P.w_out; dst = P.Wo0(); ldw = D; nreal = D; }
            else { t -= 64; which = 3; W = P.w_out + (size_t)D * D; dst = P.Wo1(); ldw = D; nreal = D; }
            wt_quad(W, ldw, nreal, which, dst, (t >> 2) * 64, (t & 3) * 256, lds, tidx);
        })
    if (vb == nvb - 1 && tidx < 64) {
        float d1 = P.lq1[tidx] * P.lk1[tidx], d2 = P.lq2[tidx] * P.lk2[tidx];
        d1 = sum_xor32(sum_xor16(sum_row16(d1))); d2 = sum_xor32(sum_xor16(sum_row16(d2)));
        if (tidx == 0) P.scal()[0] = expf(d1) - expf(d2) + LAMBDA_INIT;
    }
}

__device__ __forceinline__ void a0_row(const Params& P, int row, int lane) {
    const float* xin = row < ML ? P.x + (size_t)row * D : P.ctx + (size_t)(row - ML) * D;
    const int r = row < ML ? row >> 11 : 32;
    const float* sc = P.mod() + (size_t)r * 3072 + 1024;
    float ss = 0.f;
    f32x4 a[2], b[2], g0[2], g1[2], s0[2], s1[2];
#pragma unroll
    for (int i = 0; i < 2; ++i) {
        const int c0 = i * 512 + lane * 8;
        a[i] = *(const f32x4*)(xin + c0); b[i] = *(const f32x4*)(xin + c0 + 4);
        g0[i] = *(const f32x4*)(P.norm_g + c0); g1[i] = *(const f32x4*)(P.norm_g + c0 + 4);
        s0[i] = *(const f32x4*)(sc + c0); s1[i] = *(const f32x4*)(sc + c0 + 4);
    }
#pragma unroll
    for (int i = 0; i < 2; ++i) {
        const int c0 = i * 512 + lane * 8;
        ss += a[i][0] * a[i][0] + a[i][1] * a[i][1] + a[i][2] * a[i][2] + a[i][3] * a[i][3] + b[i][0] * b[i][0] + b[i][1] * b[i][1] + b[i][2] * b[i][2] + b[i][3] * b[i][3];
        const f32x4 ya = a[i] * g0[i] * (1.0f + s0[i]), yb = b[i] * g1[i] * (1.0f + s1[i]);
        u32x4 o; o.x = cvtpk(ya[0], ya[1]); o.y = cvtpk(ya[2], ya[3]); o.z = cvtpk(yb[0], yb[1]); o.w = cvtpk(yb[2], yb[3]);
        *(u32x4*)(P.A() + (size_t)row * D + c0) = o;
    }
    ss = sum_row16(ss); ss = sum_xor16(ss); ss = sum_xor32(ss);
    if (lane == 0) ((float*)(P.ws + OFF_RS))[row] = rsqrtf(ss * (1.0f / 1024.0f) + EPS);
}

__device__ __forceinline__ void phase_bias_a0(const Params& P, unsigned char* lds, int vb, int nvb, int g_wave) {
    const int tidx = otid();
    const int lane = tidx & 63, w = tidx >> 6;
    TICKET_LOOP(1, 104 + M / 32,
        if (item < 104) skinny_unit<1>(P, item / 52, (item % 52) * 64, lds, tidx);
        else {
            const int row0 = (item - 104) * 32 + w * 4;
            for (int j = 0; j < 4; ++j) a0_row(P, row0 + j, lane);
        })
}

namespace pg8 {
#define PG8_LAS __attribute__((address_space(3)))
typedef unsigned short bf16_t;
typedef short bf16x8 __attribute__((ext_vector_type(8)));
typedef float f32x4 __attribute__((ext_vector_type(4)));
typedef unsigned u32x4 __attribute__((ext_vector_type(4)));
constexpr int BM = 256, BK = 64, HALF = 128, HTB = HALF * BK * 2  , STAGE_BYTES = 8 * HTB, NXCD = 8, WGM = 8;

__host__ __device__ __forceinline__ int lds_byte(int r, int c) { const int st = (r >> 4) * 2 + (c >> 5), rr = r & 15, cc = c & 31, ob = rr * 64 + cc * 2; return st * 1024 + (ob ^ (((ob >> 9) & 1) << 5)); }
__host__ __device__ __forceinline__ void stage_rc(int b, int& R, int& C) { const int st = b / 1024, sb = b % 1024, swz = sb ^ (((sb >> 9) & 1) << 5); R = (st >> 1) * 16 + swz / 64; C = (st & 1) * 32 + (swz % 64) / 2; }
__host__ __device__ __forceinline__ int perm32(int rho) { const int n = rho >> 4, i = rho & 15; return 8 * (i >> 2) + 4 * n + (i & 3); }

struct Unit { int pm, pn; };
struct Gemm { const bf16_t* A; const bf16_t* Bt; int M, N, K; };

struct StaticOrder {
    int nM, nN, nwg, G, c;
    __host__ __device__ void init(int M, int N, int G_, int c_) { nM = M / BM; nN = N / BM; nwg = nM * nN; G = G_; c = c_; }
    __host__ __device__ bool next(int i, Unit& u) const {
        const long L = (long)i * G + c; if (L >= nwg) return false;
        int wgid = (int)L; { const int q = nwg / NXCD, r = nwg % NXCD, xcd = wgid % NXCD, off = wgid / NXCD; wgid = (xcd < r ? xcd * (q + 1) : r * (q + 1) + (xcd - r) * q) + off; }
        const int nig = WGM * nN, gid = wgid / nig, fm = gid * WGM, gsz = (nM - fm) < WGM ? (nM - fm) : WGM;
        u.pm = fm + ((wgid % nig) % gsz); u.pn = (wgid % nig) / gsz; return true;
    }
    __device__ __forceinline__ void a_ready(const Unit&) const {}
    __device__ __forceinline__ void done(const Unit&) const {}
};
template <class Epi, class Sched, bool ALIGN_EPI = false, bool SP2 = false>
__device__ __forceinline__ void gemm_phase(PG8_LAS unsigned char* lds, const Gemm g, const Sched& S, const Epi& E, int g_wave) {
    const int tid = otid(), wid = __builtin_amdgcn_readfirstlane(tid >> 6), lane = tid & 63, wr = wid >> 2, wc = wid & 3, fr = lane & 15, fq = lane >> 4;
    const int K = g.K, nt = K / BK;
    unsigned voffA[2], voffB[2];
#pragma unroll
    for (int i = 0; i < 2; ++i) { int R, C; stage_rc(tid * 16 + i * 8192, R, C); const int Rb = Epi::PERM ? ((R & ~31) + perm32(R & 31)) : R;
        voffA[i] = (unsigned)(R * K + C) * 2u; voffB[i] = (unsigned)(Rb * K + C) * 2u; }
    const size_t kstep = (size_t)(BK * 2);
    const size_t hstep = (size_t)HALF * K * 2;
    const size_t tstep = 2 * hstep;
    const unsigned ldsw = (unsigned)wid * 1024u;
    const int aoff = lds_byte(wr * 64 + fr, fq * 8), boff = lds_byte(wc * 32 + fr, fq * 8);
#define PG8_SA(b, h) (((b) * 2 + (h)) * HTB)
#define PG8_SB(b, h) ((4 + (b) * 2 + (h)) * HTB)
#define PG8_STAGE(bufoff, gbase, voff) do { _Pragma("unroll") for (int _i = 0; _i < 2; ++_i) \
        __builtin_amdgcn_global_load_lds((const unsigned*)((const char*)(gbase) + (voff)[_i]), (PG8_LAS unsigned*)(lds + (bufoff) + ldsw + _i * 8192), 16, 0, 0); } while (0)
#define PG8_LDA(dst, b, h) do { _Pragma("unroll") for (int m = 0; m < 4; ++m) _Pragma("unroll") for (int k = 0; k < 2; ++k) dst[m][k] = *(const PG8_LAS bf16x8*)(lds + PG8_SA(b, h) + aoff + m * 2048 + k * 1024); } while (0)
#define PG8_LDB(dst, b, h) do { _Pragma("unroll") for (int n = 0; n < 2; ++n) _Pragma("unroll") for (int k = 0; k < 2; ++k) dst[n][k] = *(const PG8_LAS bf16x8*)(lds + PG8_SB(b, h) + boff + n * 2048 + k * 1024); } while (0)
#define PG8_MMA(ai, bj, At, Bt) do { __builtin_amdgcn_s_setprio(1); _Pragma("unroll") for (int m = 0; m < 4; ++m) _Pragma("unroll") for (int n = 0; n < 2; ++n) _Pragma("unroll") for (int k = 0; k < 2; ++k) \
        acc[ai][bj][m][n] = __builtin_amdgcn_mfma_f32_16x16x32_bf16(Bt[n][k], At[m][k], acc[ai][bj][m][n], 0, 0, 0); __builtin_amdgcn_s_setprio(0); } while (0)
#define PG8_WAIT_V(n) asm volatile("s_waitcnt vmcnt(" #n ")" ::: "memory")
#define PG8_WAIT_L(n) asm volatile("s_waitcnt lgkmcnt(" #n ")" ::: "memory")
#define PG8_BAR __builtin_amdgcn_s_barrier()
#define PG8_SCHED __builtin_amdgcn_sched_barrier(0)
    Unit cur, nxt; int ui = 0;
    if (!S.next(0, cur)) return;
    f32x4 acc[2][2][4][2];
#pragma unroll
    for (int a = 0; a < 2; ++a)
#pragma unroll
        for (int b = 0; b < 2; ++b)
#pragma unroll
            for (int m = 0; m < 4; ++m)
#pragma unroll
                for (int n = 0; n < 2; ++n) acc[a][b][m][n] = (f32x4){0.f, 0.f, 0.f, 0.f};
    bf16x8 At[4][2], B0[2][2], B1[2][2];
    const char* cA = (const char*)g.A + (size_t)cur.pm * tstep; const char* cB = (const char*)g.Bt + (size_t)cur.pn * tstep;
    S.a_ready(cur);
    if constexpr (SP2) {
        PG8_STAGE(PG8_SB(0, 0), cB, voffB); PG8_STAGE(PG8_SB(0, 1), cB + hstep, voffB); PG8_STAGE(PG8_SA(0, 0), cA, voffA); PG8_STAGE(PG8_SA(0, 1), cA + hstep, voffA);
        if (wr == 1) PG8_BAR;
        PG8_WAIT_V(2); PG8_BAR;
        PG8_STAGE(PG8_SB(1, 0), cB + kstep, voffB); PG8_STAGE(PG8_SA(1, 0), cA + kstep, voffA); PG8_STAGE(PG8_SB(1, 1), cB + hstep + kstep, voffB);
        PG8_WAIT_V(6); PG8_BAR;
    } else {
        PG8_STAGE(PG8_SB(0, 0), cB, voffB); PG8_STAGE(PG8_SA(0, 0), cA, voffA); PG8_STAGE(PG8_SB(0, 1), cB + hstep, voffB); PG8_STAGE(PG8_SA(0, 1), cA + hstep, voffA);
        if (wr == 1) PG8_BAR;
        PG8_WAIT_V(4); PG8_BAR;
        PG8_STAGE(PG8_SB(1, 0), cB + kstep, voffB); PG8_STAGE(PG8_SA(1, 0), cA + kstep, voffA); PG8_STAGE(PG8_SB(1, 1), cB + hstep + kstep, voffB);
        PG8_WAIT_V(6); PG8_BAR;
    }
    for (;;) {
        const bool has_next = S.next(ui + 1, nxt);
        const char* nA = has_next ? (const char*)g.A + (size_t)nxt.pm * tstep : cA; const char* nB = has_next ? (const char*)g.Bt + (size_t)nxt.pn * tstep : cB;
        for (int t = 0; t < nt; t += 2) {
            const bool last = (t == nt - 2);
            const char* a1 = cA + (size_t)(t + 1) * kstep;
            const char* a2 = last ? nA : cA + (size_t)(t + 2) * kstep; const char* b2 = last ? nB : cB + (size_t)(t + 2) * kstep;
            const char* a3 = a2 + kstep; const char* b3 = b2 + kstep;
            if (last && has_next) S.a_ready(nxt);
            if constexpr (SP2) {
            PG8_LDB(B0, 0, 0); PG8_LDB(B1, 0, 1); PG8_SCHED; PG8_LDA(At, 0, 0); PG8_STAGE(PG8_SA(1, 1), a1 + hstep, voffA);
            PG8_WAIT_V(8); PG8_WAIT_L(0); PG8_BAR; PG8_MMA(0, 0, At, B0); PG8_MMA(0, 1, At, B1); PG8_BAR; PG8_SCHED;
            PG8_LDA(At, 0, 1); PG8_STAGE(PG8_SB(0, 0), b2, voffB); PG8_STAGE(PG8_SB(0, 1), b2 + hstep, voffB); PG8_STAGE(PG8_SA(0, 0), a2, voffA);
            PG8_WAIT_V(8); PG8_WAIT_L(0); PG8_BAR; PG8_MMA(1, 0, At, B0); PG8_MMA(1, 1, At, B1); PG8_BAR; PG8_SCHED;
            PG8_LDB(B0, 1, 0); PG8_LDB(B1, 1, 1); PG8_SCHED; PG8_LDA(At, 1, 0); PG8_STAGE(PG8_SA(0, 1), a2 + hstep, voffA);
            PG8_WAIT_V(8); PG8_WAIT_L(0); PG8_BAR; PG8_MMA(0, 0, At, B0); PG8_MMA(0, 1, At, B1); PG8_BAR; PG8_SCHED;
            PG8_LDA(At, 1, 1); PG8_STAGE(PG8_SB(1, 0), b3, voffB); PG8_STAGE(PG8_SB(1, 1), b3 + hstep, voffB); PG8_STAGE(PG8_SA(1, 0), a3, voffA);
            PG8_WAIT_V(8); PG8_WAIT_L(0); PG8_BAR; PG8_MMA(1, 0, At, B0); PG8_MMA(1, 1, At, B1); PG8_BAR; PG8_SCHED;
            } else {
            PG8_LDB(B0, 0, 0); PG8_SCHED; PG8_LDA(At, 0, 0); PG8_STAGE(PG8_SA(1, 1), a1 + hstep, voffA);
            PG8_WAIT_L(8); PG8_BAR; PG8_WAIT_L(0); PG8_MMA(0, 0, At, B0); PG8_BAR; PG8_SCHED;
            PG8_LDB(B1, 0, 1); PG8_STAGE(PG8_SB(0, 0), b2, voffB);
            PG8_BAR; PG8_WAIT_L(0); PG8_MMA(0, 1, At, B1); PG8_BAR;
            PG8_LDA(At, 0, 1); PG8_STAGE(PG8_SA(0, 0), a2, voffA);
            PG8_BAR; PG8_WAIT_L(0); PG8_MMA(1, 0, At, B0); PG8_BAR; PG8_SCHED;
            PG8_STAGE(PG8_SB(0, 1), b2 + hstep, voffB);
            PG8_WAIT_V(6); PG8_BAR; PG8_MMA(1, 1, At, B1); PG8_BAR;
            PG8_LDB(B0, 1, 0); PG8_SCHED; PG8_LDA(At, 1, 0); PG8_STAGE(PG8_SA(0, 1), a2 + hstep, voffA);
            PG8_WAIT_L(8); PG8_BAR; PG8_WAIT_L(0); PG8_MMA(0, 0, At, B0); PG8_BAR; PG8_SCHED;
            PG8_LDB(B1, 1, 1); PG8_STAGE(PG8_SB(1, 0), b3, voffB);
            PG8_BAR; PG8_WAIT_L(0); PG8_MMA(0, 1, At, B1); PG8_BAR;
            PG8_LDA(At, 1, 1); PG8_STAGE(PG8_SA(1, 0), a3, voffA);
            PG8_BAR; PG8_WAIT_L(0); PG8_MMA(1, 0, At, B0); PG8_BAR; PG8_SCHED;
            PG8_STAGE(PG8_SB(1, 1), b3 + hstep, voffB);
            PG8_WAIT_V(6); PG8_BAR; PG8_MMA(1, 1, At, B1); PG8_BAR;
            }
        }
        if constexpr (ALIGN_EPI) { if (wr == 0) PG8_BAR; }
        if constexpr (!Epi::AFTER_DRAIN) { E(acc, cur, wr, wc, fr, fq); S.done(cur); }
        if (!has_next) break;
#pragma unroll
        for (int a = 0; a < 2; ++a)
#pragma unroll
            for (int b = 0; b < 2; ++b)
#pragma unroll
                for (int m = 0; m < 4; ++m)
#pragma unroll
                    for (int n = 0; n < 2; ++n) acc[a][b][m][n] = (f32x4){0.f, 0.f, 0.f, 0.f};
        cur = nxt; cA = nA; cB = nB; ++ui;
        if constexpr (ALIGN_EPI) { if (wr == 1) PG8_BAR; }
    }
    PG8_WAIT_V(0);
    if constexpr (!ALIGN_EPI) { if (wr == 0) PG8_BAR; }
    PG8_BAR;
    if constexpr (Epi::AFTER_DRAIN) { E.fused(acc, cur, wr, wc, fr, fq, lds, wid, lane); S.done(cur); }
#undef PG8_SA
#undef PG8_SB
#undef PG8_STAGE
#undef PG8_LDA
#undef PG8_LDB
#undef PG8_MMA
#undef PG8_WAIT_V
#undef PG8_WAIT_L
#undef PG8_BAR
#undef PG8_SCHED
}
}

struct OrderIn1 {
    pg8::StaticOrder base; int G, c;
    __device__ void init(int G_, int c_) { base.init(ML, N1, G_, c_); G = G_; c = c_; }
    __device__ bool next(int i, pg8::Unit& u) const {
        const int Lx = i * G + c;
        if (Lx < 256 * 13) return base.next(i, u);
        const int r = Lx - 256 * 13; if (r >= 32 * 7) return false;
        const int j = r >> 5; u.pm = 256 + (r & 31); u.pn = j < 6 ? 2 + j : 12; return true;
    }
    __device__ __forceinline__ void a_ready(const pg8::Unit&) const {}
    __device__ __forceinline__ void done(const pg8::Unit&) const {}
};

struct EpiIn0 {
    unsigned char* ws;
    const float *aqn, *akn, *bqn, *bkn;
    static constexpr bool PERM = false, AFTER_DRAIN = false;
    __device__ __forceinline__ void operator()(const f32x4 (&acc)[2][2][4][2], const pg8::Unit& u, int wr, int wc, int fr, int fq) const { (*this)(acc, u.pm, u.pn, wr, wc, fr, fq); }
    __device__ __forceinline__ void operator()(const f32x4 (&acc)[2][2][4][2], int pm, int pn, int wr, int wc, int fr, int fq) const {
        const int g = 4 * pn + wc;
        const float* rs = (const float*)(ws + OFF_RS);
        size_t doff; int ld, col, type; const float* gain = aqn;
        if (g < 8) { doff = OFF_QA; ld = 512; col = g * 64; type = 2; gain = aqn; }
        else if (g < 10) { doff = OFF_KA; ld = 128; col = (g - 8) * 64; type = 3; gain = akn; }
        else if (g < 12) { doff = OFF_VA; ld = 128; col = (g - 10) * 64; type = 0; }
        else if (g < 20) { doff = OFF_GA; ld = 512; col = (g - 12) * 64; type = 1; }
        else if (g < 28) { doff = OFF_QB; ld = 512; col = (g - 20) * 64; type = 2; gain = bqn; }
        else if (g < 36) { doff = OFF_KB; ld = 512; col = (g - 28) * 64; type = 3; gain = bkn; }
        else if (g < 44) { doff = OFF_VB; ld = 512; col = (g - 36) * 64; type = 0; }
        else { doff = OFF_GB; ld = 512; col = (g - 44) * 64; type = 1; }
        bf16_t* dst = (bf16_t*)(ws + doff);
        const bool lat = pm < 256; const int r = lat ? pm >> 3 : 32;
        const float* bptr = (const float*)(ws + OFF_BIAS0) + (size_t)r * 3328 + pn * 256 + wc * 32 + fq * 4;
        f32x4 bia[2][2], gn[2][2];
        const float qs = type == 2 ? QSCALE : 1.0f;
#pragma unroll
        for (int bj = 0; bj < 2; ++bj)
#pragma unroll
            for (int n = 0; n < 2; ++n) { bia[bj][n] = *(const f32x4*)(bptr + bj * 128 + n * 16); gn[bj][n] = *(const f32x4*)(gain + bj * 32 + n * 16 + fq * 4) * qs; }
        float rsv[2][4];
#pragma unroll
        for (int ai = 0; ai < 2; ++ai)
#pragma unroll
            for (int m = 0; m < 4; ++m) rsv[ai][m] = rs[pm * 256 + ai * 128 + wr * 64 + m * 16 + fr];
        float frq[4];
#pragma unroll
        for (int e = 0; e < 4; ++e) frq[e] = __builtin_amdgcn_exp2f(-(float)(fq * 4 + e) * 0.830482023721841f) * 0.15915494309189535f;
#pragma unroll
        for (int ai = 0; ai < 2; ++ai) {
            const float prow = (float)((pm * 4 + ai * 2 + wr) & 31);
            int fro = fr; asm volatile("" : "+v"(fro));
#pragma unroll
            for (int m = 0; m < 4; ++m) {
                const int row = pm * 256 + ai * 128 + wr * 64 + m * 16 + fr;
                const float rstd = rsv[ai][m];
                f32x4 v[2][2];
#pragma unroll
                for (int bj = 0; bj < 2; ++bj)
#pragma unroll
                    for (int n = 0; n < 2; ++n) v[bj][n] = acc[ai][bj][m][n] * rstd + bia[bj][n];
                if (type >= 2) {
                    float s2 = 0.f;
#pragma unroll
                    for (int bj = 0; bj < 2; ++bj)
#pragma unroll
                        for (int n = 0; n < 2; ++n) s2 += v[bj][n][0] * v[bj][n][0] + v[bj][n][1] * v[bj][n][1] + v[bj][n][2] * v[bj][n][2] + v[bj][n][3] * v[bj][n][3];
                    s2 = sum_xor16(s2); s2 = sum_xor32(s2);
                    const float rn = rsqrtf(s2 * (1.0f / 64.0f) + EPS);
#pragma unroll
                    for (int bj = 0; bj < 2; ++bj)
#pragma unroll
                        for (int n = 0; n < 2; ++n) v[bj][n] = v[bj][n] * rn * gn[bj][n];
                    if (lat) {
                        const float pcol = (float)(m * 16 + fro);
#pragma unroll
                        for (int bj = 0; bj < 2; ++bj) {
                            const float pos = bj ? pcol : prow;
#pragma unroll
                            for (int e = 0; e < 4; ++e) {
                                const float rev = pos * frq[e];
                                const float cc = __builtin_amdgcn_cosf(rev), sn = __builtin_amdgcn_sinf(rev);
                                const float x1 = v[bj][0][e], x2 = v[bj][1][e]; v[bj][0][e] = x1 * cc - x2 * sn; v[bj][1][e] = x2 * cc + x1 * sn;
                            }
                        }
                    }
                } else if (type == 1) {
#pragma unroll
                    for (int bj = 0; bj < 2; ++bj)
#pragma unroll
                        for (int n = 0; n < 2; ++n)
#pragma unroll
                            for (int e = 0; e < 4; ++e) v[bj][n][e] = siluf(v[bj][n][e]);
                }
#pragma unroll
                for (int bj = 0; bj < 2; ++bj) {
                    u32x4 o; o.x = cvtpk(v[bj][0][0], v[bj][0][1]); o.y = cvtpk(v[bj][0][2], v[bj][0][3]); o.z = cvtpk(v[bj][1][0], v[bj][1][1]); o.w = cvtpk(v[bj][1][2], v[bj][1][3]);
                    *(u32x4*)(dst + (size_t)row * ld + col + bj * 32 + fq * 8) = o;
                }
            }
        }
    }
};

struct EpiIn1 {
    unsigned char* ws;
    static constexpr bool PERM = false, AFTER_DRAIN = false;
    __device__ __forceinline__ void operator()(const f32x4 (&acc)[2][2][4][2], const pg8::Unit& u, int wr, int wc, int fr, int fq) const { (*this)(acc, u.pm, u.pn, wr, wc, fr, fq); }
    __device__ __forceinline__ void operator()(const f32x4 (&acc)[2][2][4][2], int pm, int pn, int wr, int wc, int fr, int fq) const {
        const int g = 4 * pn + wc;
        if (g > 48) return;
        const float* rs = (const float*)(ws + OFF_RS); float* RF = (float*)(ws + OFF_RF);
        size_t doff = OFF_QG; int ld = 0, col = 0, type;
        if (g < 8) { doff = OFF_QG; ld = 512; col = g * 64; type = 2; }
        else if (g < 16) { doff = OFF_KG; ld = 512; col = (g - 8) * 64; type = 0; }
        else if (g < 32) { doff = OFF_VG; ld = 1024; col = (g - 16) * 64; type = 0; }
        else if (g < 48) { doff = OFF_GG; ld = 1024; col = (g - 32) * 64; type = 1; }
        else type = 3;
        bf16_t* dst = (bf16_t*)(ws + doff);
        const int r = pm < 256 ? pm >> 3 : 32;
        const float* bptr = (const float*)(ws + OFF_BIAS1) + (size_t)r * 3328 + pn * 256 + wc * 32 + fq * 4;
        f32x4 bia[2][2];
#pragma unroll
        for (int bj = 0; bj < 2; ++bj)
#pragma unroll
            for (int n = 0; n < 2; ++n) bia[bj][n] = *(const f32x4*)(bptr + bj * 128 + n * 16);
        float rsv[2][4];
#pragma unroll
        for (int ai = 0; ai < 2; ++ai)
#pragma unroll
            for (int m = 0; m < 4; ++m) rsv[ai][m] = rs[pm * 256 + ai * 128 + wr * 64 + m * 16 + fr];
        const float sc = type == 2 ? 0.08838834764831845f : 1.0f;
#pragma unroll
        for (int ai = 0; ai < 2; ++ai)
#pragma unroll
            for (int m = 0; m < 4; ++m) {
                const int row = pm * 256 + ai * 128 + wr * 64 + m * 16 + fr;
                const float rstd = rsv[ai][m];
                f32x4 v[2][2];
#pragma unroll
                for (int bj = 0; bj < 2; ++bj)
#pragma unroll
                    for (int n = 0; n < 2; ++n) v[bj][n] = (acc[ai][bj][m][n] * rstd + bia[bj][n]) * sc;
                if (type == 3) {
                    *(f32x4*)(RF + (size_t)row * 32 + fq * 8) = v[0][0];
                    *(f32x4*)(RF + (size_t)row * 32 + fq * 8 + 4) = v[0][1];
                    continue;
                }
                if (type == 1) {
#pragma unroll
                    for (int bj = 0; bj < 2; ++bj)
#pragma unroll
                        for (int n = 0; n < 2; ++n)
#pragma unroll
                            for (int e = 0; e < 4; ++e) v[bj][n][e] = siluf(v[bj][n][e]);
                }
#pragma unroll
                for (int bj = 0; bj < 2; ++bj) {
                    u32x4 o; o.x = cvtpk(v[bj][0][0], v[bj][0][1]); o.y = cvtpk(v[bj][0][2], v[bj][0][3]); o.z = cvtpk(v[bj][1][0], v[bj][1][1]); o.w = cvtpk(v[bj][1][2], v[bj][1][3]);
                    *(u32x4*)(dst + (size_t)row * ld + col + bj * 32 + fq * 8) = o;
                }
            }
    }
};

struct EpiOut0 {
    const float *x, *ctx, *g1; float* out; unsigned char* ws;
    static constexpr bool PERM = false, AFTER_DRAIN = false;
    __device__ __forceinline__ void operator()(const f32x4 (&acc)[2][2][4][2], const pg8::Unit& u, int wr, int wc, int fr, int fq) const { (*this)(acc, u.pm, u.pn, wr, wc, fr, fq); }
    __device__ __forceinline__ void operator()(const f32x4 (&acc)[2][2][4][2], int pm, int pn, int wr, int wc, int fr, int fq) const {
        const float* mod = (const float*)(ws + OFF_MOD); bf16_t* A1 = (bf16_t*)(ws + OFF_A); float* parts = (float*)(ws + OFF_PARTS);
        const bool lat = pm < 256; const int r = lat ? pm >> 3 : 32;
        const int c0 = pn * 256 + wc * 64 + fq * 8;
        const float* gt = mod + (size_t)r * 3072 + 2048 + c0;
        const float* sc = mod + (size_t)(33 + r) * 3072 + 1024 + c0;
        f32x4 gtv[2][2], csv[2][2];
#pragma unroll
        for (int bj = 0; bj < 2; ++bj)
#pragma unroll
            for (int n = 0; n < 2; ++n) { gtv[bj][n] = *(const f32x4*)(gt + bj * 32 + n * 4); csv[bj][n] = *(const f32x4*)(g1 + c0 + bj * 32 + n * 4) * (1.0f + *(const f32x4*)(sc + bj * 32 + n * 4)); }
        const float* xbase = (lat ? x + (size_t)(pm * 256) * D : ctx + (size_t)(pm * 256 - ML) * D) + (size_t)(wr * 64 + fr) * D + c0;
        f32x4 xv[2][2][2];
#define EO0_LOAD(ri) do { const float* xp = xbase + (size_t)(((ri) >> 2) * 128 + ((ri) & 3) * 16) * D; \
            _Pragma("unroll") for (int bj = 0; bj < 2; ++bj) _Pragma("unroll") for (int n = 0; n < 2; ++n) xv[(ri) & 1][bj][n] = *(const f32x4*)(xp + bj * 32 + n * 4); } while (0)
        EO0_LOAD(0);
#pragma unroll
        for (int ri = 0; ri < 8; ++ri) {
            if (ri < 7) EO0_LOAD(ri + 1);
            {
                const int ai = ri >> 2, m = ri & 3;
                const int row = pm * 256 + ai * 128 + wr * 64 + m * 16 + fr;
                float ss = 0.f;
#pragma unroll
                for (int bj = 0; bj < 2; ++bj) {
                    f32x4 y[2], xk[2];
#pragma unroll
                    for (int n = 0; n < 2; ++n) {
                        const f32x4 x1 = xv[ri & 1][bj][n] + gtv[bj][n] * acc[ai][bj][m][n];
                        ss += x1[0] * x1[0] + x1[1] * x1[1] + x1[2] * x1[2] + x1[3] * x1[3];
                        xk[n] = x1;
                        y[n] = x1 * csv[bj][n];
                    }
                    u32x4 o; o.x = cvtpk(y[0][0], y[0][1]); o.y = cvtpk(y[0][2], y[0][3]); o.z = cvtpk(y[1][0], y[1][1]); o.w = cvtpk(y[1][2], y[1][3]);
                    *(u32x4*)(A1 + (size_t)row * D + c0 + bj * 32) = o;
                    if (lat) { u32x4 xb; xb.x = cvtpk(xk[0][0], xk[0][1]); xb.y = cvtpk(xk[0][2], xk[0][3]); xb.z = cvtpk(xk[1][0], xk[1][1]); xb.w = cvtpk(xk[1][2], xk[1][3]);
                        *(u32x4*)((bf16_t*)(ws + OFF_X1B) + (size_t)row * D + c0 + bj * 32) = xb; }
                }
                ss = sum_xor16(ss); ss = sum_xor32(ss);
                if (fq == 0) parts[(size_t)(4 * pn + wc) * M + row] = ss;
            }
            __builtin_amdgcn_sched_barrier(0);
        }
#undef EO0_LOAD
    }
};

struct EpiOut1 {
    unsigned char* ws; float* out;
    static constexpr bool PERM = false, AFTER_DRAIN = false;
    __device__ __forceinline__ void operator()(f32x4 (&acc)[2][2][4][2], const pg8::Unit& u, int wr, int wc, int fr, int fq) const {
        const int pm = u.pm, pn = u.pn;
        const int r = pm >> 3, c0 = pn * 256 + wc * 64 + fq * 8;
        const float* gt = (const float*)(ws + OFF_MOD) + (size_t)(33 + r) * 3072 + 2048 + c0;
        f32x4 gtv[2][2];
#pragma unroll
        for (int bj = 0; bj < 2; ++bj)
#pragma unroll
            for (int n = 0; n < 2; ++n) gtv[bj][n] = *(const f32x4*)(gt + bj * 32 + n * 4);
        const bf16_t* xbase = (const bf16_t*)(ws + OFF_X1B) + (size_t)(pm * 256 + wr * 64 + fr) * D + c0;
        u32x4 xv[4][2];
#define EO1_LOAD(ri) do { const bf16_t* xp = xbase + (size_t)(((ri) >> 2) * 128 + ((ri) & 3) * 16) * D; \
            xv[(ri) & 3][0] = *(const u32x4*)(xp); xv[(ri) & 3][1] = *(const u32x4*)(xp + 32); } while (0)
        EO1_LOAD(0); EO1_LOAD(1); EO1_LOAD(2); EO1_LOAD(3);
#pragma unroll
        for (int ri = 0; ri < 8; ++ri) {
            const int ai = ri >> 2, m = ri & 3;
#pragma unroll
            for (int bj = 0; bj < 2; ++bj) {
                const u32x4 w = xv[ri & 3][bj];
                const f32x4 x0 = (f32x4){bflo(w.x), bfhi(w.x), bflo(w.y), bfhi(w.y)}, x1 = (f32x4){bflo(w.z), bfhi(w.z), bflo(w.w), bfhi(w.w)};
                acc[ai][bj][m][0] = x0 + gtv[bj][0] * acc[ai][bj][m][0];
                acc[ai][bj][m][1] = x1 + gtv[bj][1] * acc[ai][bj][m][1];
            }
            if (ri + 4 < 8) EO1_LOAD(ri + 4);
            __builtin_amdgcn_sched_barrier(0);
        }
#undef EO1_LOAD
        float* obase = out + (size_t)(pm * 256 + wr * 64 + fr) * D + c0;
#pragma unroll
        for (int ri = 0; ri < 8; ++ri) {
            const int ai = ri >> 2, m = ri & 3;
            float* op = obase + (size_t)(ai * 128 + m * 16) * D;
#pragma unroll
            for (int bj = 0; bj < 2; ++bj)
#pragma unroll
                for (int n = 0; n < 2; ++n) *(f32x4*)(op + bj * 32 + n * 4) = acc[ai][bj][m][n];
        }
    }
};

typedef float f32x16 __attribute__((ext_vector_type(16)));
typedef short s16x4 __attribute__((ext_vector_type(4)));
#define LDSAS __attribute__((address_space(3)))
__device__ __forceinline__ int crow(int r, int hi) { return (r & 3) + 8 * (r >> 2) + 4 * hi; }
__device__ __forceinline__ s16x4 vtr(const LDSAS unsigned char* p) { return __builtin_bit_cast(s16x4, __builtin_amdgcn_ds_read_tr16_b64_v4i16((LDSAS s16x4*)p)); }

constexpr int AB_K1 = 0, AB_K2 = 16384, AB_V = 32768, AB_Q = 65536;
static_assert(AB_Q + 65536 <= 134144, "attention B LDS map");
__device__ __forceinline__ float fadd_s(float a, float b) { float r; asm("v_add_f32_e32 %0, %1, %2" : "=v"(r) : "v"(a), "v"(b)); return r; }

__device__ __forceinline__ void attnB_unit(const Params& P, LDSAS unsigned char* lds, int b, int h, int qrow0, int t_begin, int t_end, int g_wave) {
    const int tid = otid(), lane = tid & 63, r32 = lane & 31, hi = lane >> 5;
    const int wid = __builtin_amdgcn_readfirstlane(tid >> 6);
    LDSAS unsigned char* qlds = lds + AB_Q + wid * 8192 + r32 * 256;
    {
        const bf16_t* qg = P.QB() + (size_t)(qrow0 + wid * 32 + r32) * 512 + (2 * h) * 64 + hi * 8;
#pragma unroll
        for (int c2 = 0; c2 < 8; ++c2) {
            const u32x4 v = *(const u32x4*)(qg + (c2 >> 2) * 64 + (c2 & 3) * 16);
            *(LDSAS u32x4*)(qlds + (((2 * c2 + hi) ^ (r32 & 15)) * 16)) = v;
        }
    }
    f32x16 o1[4], o2[4];
#pragma unroll
    for (int i = 0; i < 4; ++i) { o1[i] = (f32x16){}; o2[i] = (f32x16){}; }
    float l1 = 0.f, l2 = 0.f;
    const int krow = tid >> 3, kch = tid & 7, vrow = tid >> 4, vch = tid & 15;
    const int kwoff = krow * 128 + ((kch ^ ((krow >> 1) & 7)) * 16);
    const int vwoff = (vch >> 2) * 4096 + vrow * 64 + (vch & 3) * 16;
    u32x4 rk1, rk2, rv0, rv1;
#define AB_GLOAD(t) do { const int kr0_ = (t) < 32 ? b * 2048 + 64 * (t) : ML + b * 256 + 64 * ((t) - 32); \
        rk1 = *(const u32x4*)(P.KB() + (size_t)(kr0_ + krow) * 512 + (2 * h) * 64 + kch * 8); \
        rk2 = *(const u32x4*)(P.KB() + (size_t)(kr0_ + krow) * 512 + (2 * h + 1) * 64 + kch * 8); \
        rv0 = *(const u32x4*)(P.VB() + (size_t)(kr0_ + vrow) * 512 + h * 128 + vch * 8); \
        rv1 = *(const u32x4*)(P.VB() + (size_t)(kr0_ + vrow + 32) * 512 + h * 128 + vch * 8); } while (0)
#define AB_LWRITE(buf) do { *(LDSAS u32x4*)(lds + AB_K1 + (buf) * 8192 + kwoff) = rk1; *(LDSAS u32x4*)(lds + AB_K2 + (buf) * 8192 + kwoff) = rk2; \
        *(LDSAS u32x4*)(lds + AB_V + (buf) * 16384 + vwoff) = rv0; *(LDSAS u32x4*)(lds + AB_V + (buf) * 16384 + vwoff + 2048) = rv1; } while (0)
#define AB_SCORES(sub, LSUM, PW) do { const LDSAS unsigned char* kb_ = lds + ((sub) ? AB_K2 : AB_K1) + buf * 8192 + r32 * 128; \
        f32x16 p0 = (f32x16){}, p1 = (f32x16){}; \
        _Pragma("unroll") for (int d0 = 0; d0 < 4; ++d0) { const int co = ((2 * d0 + hi) ^ ksw) * 16; \
            const bf16x8 qf = *(const LDSAS bf16x8*)(qlds + (((2 * (4 * (sub) + d0) + hi) ^ (r32 & 15)) * 16)); \
            const bf16x8 k0 = *(const LDSAS bf16x8*)(kb_ + co), k1 = *(const LDSAS bf16x8*)(kb_ + 4096 + co); \
            p0 = __builtin_amdgcn_mfma_f32_32x32x16_bf16(k0, qf, p0, 0, 0, 0); p1 = __builtin_amdgcn_mfma_f32_32x32x16_bf16(k1, qf, p1, 0, 0, 0); } \
        float ls_ = 0.f; \
        _Pragma("unroll") for (int r = 0; r < 16; ++r) { p0[r] = __builtin_amdgcn_exp2f(p0[r]); p1[r] = __builtin_amdgcn_exp2f(p1[r]); ls_ = fadd_s(ls_, p0[r]); ls_ = fadd_s(ls_, p1[r]); } \
        LSUM += ls_; \
        PW[0].x = cvtpk(p0[0], p0[1]); PW[0].y = cvtpk(p0[2], p0[3]); PW[0].z = cvtpk(p0[4], p0[5]); PW[0].w = cvtpk(p0[6], p0[7]); \
        PW[1].x = cvtpk(p0[8], p0[9]); PW[1].y = cvtpk(p0[10], p0[11]); PW[1].z = cvtpk(p0[12], p0[13]); PW[1].w = cvtpk(p0[14], p0[15]); \
        PW[2].x = cvtpk(p1[0], p1[1]); PW[2].y = cvtpk(p1[2], p1[3]); PW[2].z = cvtpk(p1[4], p1[5]); PW[2].w = cvtpk(p1[6], p1[7]); \
        PW[3].x = cvtpk(p1[8], p1[9]); PW[3].y = cvtpk(p1[10], p1[11]); PW[3].z = cvtpk(p1[12], p1[13]); PW[3].w = cvtpk(p1[14], p1[15]); } while (0)
    const int ksw = (r32 >> 1) & 7;
    const int vroff = AB_V + (4 * hi + ((lane & 15) >> 2)) * 64 + ((lane >> 4) & 1) * 32 + (lane & 3) * 8;
    AB_GLOAD(t_begin); AB_LWRITE(0); __syncthreads();
    for (int t = t_begin; t < t_end; ++t) {
        const int buf = (t - t_begin) & 1;
        u32x4 pw1[4], pw2[4];
        AB_SCORES(0, l1, pw1);
        __builtin_amdgcn_sched_barrier(0);
        AB_SCORES(1, l2, pw2);
        __builtin_amdgcn_sched_barrier(0);
        if (t + 1 < t_end) AB_GLOAD(t + 1);
        const LDSAS unsigned char* vb = lds + buf * 16384 + vroff;
        s16x4 vlo[2][4], vhi[2][4];
#define AB_VLOAD(slot, d0) do { _Pragma("unroll") for (int ks = 0; ks < 4; ++ks) { vlo[slot][ks] = vtr(vb + (d0) * 4096 + ks * 1024); vhi[slot][ks] = vtr(vb + (d0) * 4096 + ks * 1024 + 512); } } while (0)
        AB_VLOAD(0, 0);
#pragma unroll
        for (int d0 = 0; d0 < 4; ++d0) {
            if (d0 < 3) AB_VLOAD((d0 + 1) & 1, d0 + 1);
            __builtin_amdgcn_sched_barrier(0);
#pragma unroll
            for (int ks = 0; ks < 4; ++ks) {
                const s16x4 lo = vlo[d0 & 1][ks], hh = vhi[d0 & 1][ks];
                const bf16x8 vf = (bf16x8){lo[0], lo[1], lo[2], lo[3], hh[0], hh[1], hh[2], hh[3]};
                o1[d0] = __builtin_amdgcn_mfma_f32_32x32x16_bf16(__builtin_bit_cast(bf16x8, pw1[ks]), vf, o1[d0], 0, 0, 0);
                o2[d0] = __builtin_amdgcn_mfma_f32_32x32x16_bf16(__builtin_bit_cast(bf16x8, pw2[ks]), vf, o2[d0], 0, 0, 0);
            }
            __builtin_amdgcn_sched_barrier(0);
        }
#undef AB_VLOAD
        if (t + 1 < t_end) AB_LWRITE(buf ^ 1);
        __syncthreads();
    }
#undef AB_GLOAD
#undef AB_LWRITE
#undef AB_SCORES
    l1 = sum_xor32(l1); l2 = sum_xor32(l2);
    LDSAS float* stg = (LDSAS float*)(lds + wid * 8192);
    if (hi == 0) { stg[r32] = 1.0f / l1; stg[32 + r32] = P.scal()[0] / l2; }
    float ss[16];
#pragma unroll
    for (int r = 0; r < 16; ++r) {
        const float a = stg[crow(r, hi)], c = stg[32 + crow(r, hi)];
        float s2 = 0.f;
#pragma unroll
        for (int d0 = 0; d0 < 4; ++d0) { const float v = o1[d0][r] * a - o2[d0][r] * c; o1[d0][r] = v; s2 += v * v; }
        ss[r] = s2;
    }
#pragma unroll
    for (int r = 0; r < 16; ++r) {
        float s2 = ss[r];
        s2 = sum_row16(s2); s2 = sum_xor16(s2);
        ss[r] = rsqrtf(s2 * (1.0f / 128.0f) + EPS) * (1.0f - LAMBDA_INIT);
    }
    const int eq = lane >> 1, eseg = lane & 1;
    const size_t grow = (size_t)(qrow0 + wid * 32 + eq);
#pragma unroll
    for (int half = 0; half < 2; ++half) {
#pragma unroll
        for (int dd = 0; dd < 2; ++dd) {
            const int d0 = half * 2 + dd; const float sl = P.b_subln[d0 * 32 + r32];
#pragma unroll
            for (int r = 0; r < 16; ++r) stg[crow(r, hi) * 64 + ((dd * 32 + r32) ^ ((crow(r, hi) & 7) * 4))] = o1[d0][r] * ss[r] * sl;
        }
        const u32x4* gp = (const u32x4*)(P.GB() + grow * 512 + h * 128 + half * 64 + eseg * 32);
        u32x4* op = (u32x4*)(P.O() + grow * 1024 + 512 + h * 128 + half * 64 + eseg * 32);
        u32x4 gv[4];
#pragma unroll
        for (int i = 0; i < 4; ++i) gv[i] = gp[i];
#pragma unroll
        for (int i = 0; i < 4; ++i) {
            const int c0 = eseg * 32 + i * 8;
            const f32x4 a = *(const LDSAS f32x4*)(stg + eq * 64 + (c0 ^ ((eq & 7) * 4))), c = *(const LDSAS f32x4*)(stg + eq * 64 + ((c0 + 4) ^ ((eq & 7) * 4)));
            const u32x4 g = gv[i]; u32x4 ov;
            ov.x = cvtpk(a[0] * bflo(g.x), a[1] * bfhi(g.x)); ov.y = cvtpk(a[2] * bflo(g.y), a[3] * bfhi(g.y));
            ov.z = cvtpk(c[0] * bflo(g.z), c[1] * bfhi(g.z)); ov.w = cvtpk(c[2] * bflo(g.w), c[3] * bfhi(g.w));
            op[i] = ov;
        }
    }
    __syncthreads();
}

__device__ __forceinline__ void phase_attnB_mfma(const Params& P, LDSAS unsigned char* lds, int vb, int nvb, int g_wave) {
    for (int it = 0; ; ++it) {
        int u;
        if (nvb == 256) { if (it < 4) u = it * 256 + vb; else if (it == 4 && vb >= 128) u = 1024 + (vb - 128); else break; }
        else { u = it * nvb + vb; if (u >= 1024 + 128) break; }
        int pair, qrow0, t0;
        if (u < 1024) {
            int qblk;
            if (nvb == 256) { const int round = u >> 8, i = u & 255, xcd = i & 7, slot = i >> 3; pair = round * 32 + xcd * 4 + (slot >> 3); qblk = slot & 7; }
            else { pair = u >> 3; qblk = u & 7; }
            qrow0 = (pair >> 2) * 2048 + qblk * 256; t0 = 0;
        } else {
            pair = u - 1024;
            qrow0 = ML + (pair >> 2) * 256; t0 = 32;
        }
        attnB_unit(P, lds, pair >> 2, pair & 3, qrow0, t0, 36, g_wave);
    }
}

constexpr int AA_K = 0, AA_V = 32768;
__device__ __forceinline__ void attnA_unit(const Params& P, LDSAS unsigned char* lds, int b, int kvh, int qrow0, int qpos0, int kt0, int nwin, int g_wave) {
    const int tid = otid(), lane = tid & 63, r32 = lane & 31, hi = lane >> 5;
    const int wid = __builtin_amdgcn_readfirstlane(tid >> 6);
    const int head = kvh * 4 + (wid >> 1), qoff = (wid & 1) * 64;
    bf16x8 qf[2][4];
#pragma unroll
    for (int qq = 0; qq < 2; ++qq)
#pragma unroll
        for (int d0 = 0; d0 < 4; ++d0) qf[qq][d0] = *(const bf16x8*)(P.QA() + (size_t)(qrow0 + qoff + qq * 32 + r32) * 512 + head * 64 + d0 * 16 + hi * 8);
    f32x16 o[2][2];
#pragma unroll
    for (int i = 0; i < 2; ++i) { o[i][0] = (f32x16){}; o[i][1] = (f32x16){}; }
    float l[2] = {0.f, 0.f};
    const int krow = tid >> 3, kch = tid & 7;
    const int kwoff = krow * 128 + ((kch ^ ((krow >> 1) & 7)) * 16);
    const int vwoff = (kch >> 2) * 4096 + krow * 64 + (kch & 3) * 16;
    u32x4 rk[2], rv[2];
    const int nt = nwin + 4, npair = (nt + 1) >> 1;
#define AA_KR0(i) ((i) < nwin ? b * 2048 + 64 * (kt0 + (i)) : ML + b * 256 + 64 * ((i) - nwin))
#define AA_GLOAD(pi) do { _Pragma("unroll") for (int sb_ = 0; sb_ < 2; ++sb_) { const int i_ = 2 * (pi) + sb_ < nt ? 2 * (pi) + sb_ : nt - 1; const int kr0_ = AA_KR0(i_); \
        rk[sb_] = *(const u32x4*)(P.KA() + (size_t)(kr0_ + krow) * 128 + kvh * 64 + kch * 8); rv[sb_] = *(const u32x4*)(P.VA() + (size_t)(kr0_ + krow) * 128 + kvh * 64 + kch * 8); } } while (0)
#define AA_LWRITE(buf) do { _Pragma("unroll") for (int sb_ = 0; sb_ < 2; ++sb_) { *(LDSAS u32x4*)(lds + AA_K + ((buf) * 2 + sb_) * 8192 + kwoff) = rk[sb_]; *(LDSAS u32x4*)(lds + AA_V + ((buf) * 2 + sb_) * 8192 + vwoff) = rv[sb_]; } } while (0)
    const int kroff = AA_K + r32 * 128, ksw = (r32 >> 1) & 7;
    const int vroff = AA_V + (4 * hi + ((lane & 15) >> 2)) * 64 + ((lane >> 4) & 1) * 32 + (lane & 3) * 8;
    AA_GLOAD(0); AA_LWRITE(0); __syncthreads();
    for (int pi = 0; pi < npair; ++pi) {
        const int pbuf = pi & 1;
        if (pi + 1 < npair) AA_GLOAD(pi + 1);
      for (int sub = 0; sub < 2; ++sub) {
        const int i = 2 * pi + sub, buf = pbuf * 2 + sub;
        int cls = i < nt ? 1 : 0;
        if (i < nwin) { const int delta = 64 * (kt0 + i) - (qpos0 + qoff); cls = delta == -128 ? 2 : (delta == 128 ? 3 : ((delta >= -64 && delta <= 64) ? 1 : 0)); }
        if (cls != 0) {
            const LDSAS unsigned char* kb = lds + buf * 8192 + kroff;
            u32x4 pw[2][4];
#pragma unroll
            for (int qq = 0; qq < 2; ++qq) {
                f32x16 p0 = (f32x16){}, p1 = (f32x16){};
#pragma unroll
                for (int d0 = 0; d0 < 4; ++d0) {
                    const int co = ((2 * d0 + hi) ^ ksw) * 16;
                    const bf16x8 k0 = *(const LDSAS bf16x8*)(kb + co), k1 = *(const LDSAS bf16x8*)(kb + 4096 + co);
                    p0 = __builtin_amdgcn_mfma_f32_32x32x16_bf16(k0, qf[qq][d0], p0, 0, 0, 0);
                    p1 = __builtin_amdgcn_mfma_f32_32x32x16_bf16(k1, qf[qq][d0], p1, 0, 0, 0);
                }
                float ls = 0.f;
#pragma unroll
                for (int r = 0; r < 16; ++r) { p0[r] = __builtin_amdgcn_exp2f(p0[r]); p1[r] = __builtin_amdgcn_exp2f(p1[r]); }
                if (cls >= 2) {
                    int a = qq * 32 + r32;
                    asm volatile("" : "+v"(a));
#pragma unroll
                    for (int r = 0; r < 16; ++r) {
                        const int c0 = crow(r, hi), c1 = c0 + 32;
                        const bool v0 = cls == 2 ? (c0 >= a) : (c0 <= a), v1 = cls == 2 ? (c1 >= a) : (c1 <= a);
                        p0[r] = v0 ? p0[r] : 0.f; p1[r] = v1 ? p1[r] : 0.f;
                    }
                }
#pragma unroll
                for (int r = 0; r < 16; ++r) ls += p0[r] + p1[r];
                l[qq] += ls;
                pw[qq][0].x = cvtpk(p0[0], p0[1]); pw[qq][0].y = cvtpk(p0[2], p0[3]); pw[qq][0].z = cvtpk(p0[4], p0[5]); pw[qq][0].w = cvtpk(p0[6], p0[7]);
                pw[qq][1].x = cvtpk(p0[8], p0[9]); pw[qq][1].y = cvtpk(p0[10], p0[11]); pw[qq][1].z = cvtpk(p0[12], p0[13]); pw[qq][1].w = cvtpk(p0[14], p0[15]);
                pw[qq][2].x = cvtpk(p1[0], p1[1]); pw[qq][2].y = cvtpk(p1[2], p1[3]); pw[qq][2].z = cvtpk(p1[4], p1[5]); pw[qq][2].w = cvtpk(p1[6], p1[7]);
                pw[qq][3].x = cvtpk(p1[8], p1[9]); pw[qq][3].y = cvtpk(p1[10], p1[11]); pw[qq][3].z = cvtpk(p1[12], p1[13]); pw[qq][3].w = cvtpk(p1[14], p1[15]);
                __builtin_amdgcn_sched_barrier(0);
            }
            const LDSAS unsigned char* vb = lds + buf * 8192 + vroff;
#pragma unroll
            for (int d0 = 0; d0 < 2; ++d0)
#pragma unroll
                for (int ks = 0; ks < 4; ++ks) {
                    const s16x4 lo = vtr(vb + d0 * 4096 + ks * 1024), hh = vtr(vb + d0 * 4096 + ks * 1024 + 512);
                    const bf16x8 vf = (bf16x8){lo[0], lo[1], lo[2], lo[3], hh[0], hh[1], hh[2], hh[3]};
                    o[0][d0] = __builtin_amdgcn_mfma_f32_32x32x16_bf16(__builtin_bit_cast(bf16x8, pw[0][ks]), vf, o[0][d0], 0, 0, 0);
                    o[1][d0] = __builtin_amdgcn_mfma_f32_32x32x16_bf16(__builtin_bit_cast(bf16x8, pw[1][ks]), vf, o[1][d0], 0, 0, 0);
                }
        }
      }
        if (pi + 1 < npair) AA_LWRITE(pbuf ^ 1);
        __syncthreads();
    }
#undef AA_KR0
#undef AA_GLOAD
#undef AA_LWRITE
    const float sinkp = __builtin_amdgcn_exp2f(P.a_sink[head] * LOG2E);
    LDSAS float* stg = (LDSAS float*)(lds + wid * 8704);
    const int eq = lane >> 1, eseg = lane & 1;
#pragma unroll
    for (int qq = 0; qq < 2; ++qq) {
        float lt = sum_xor32(l[qq]);
        if (hi == 0) stg[r32] = 1.0f / (lt + sinkp);
        float rl[16];
#pragma unroll
        for (int r = 0; r < 16; ++r) rl[r] = stg[crow(r, hi)];
#pragma unroll
        for (int d0 = 0; d0 < 2; ++d0)
#pragma unroll
            for (int r = 0; r < 16; ++r) stg[crow(r, hi) * 68 + d0 * 32 + r32] = o[qq][d0][r] * rl[r];
        const size_t grow = (size_t)(qrow0 + qoff + qq * 32 + eq);
        const u32x4* gp = (const u32x4*)(P.GA() + grow * 512 + head * 64 + eseg * 32);
        u32x4* op = (u32x4*)(P.O() + grow * 1024 + head * 64 + eseg * 32);
        u32x4 gv[4];
#pragma unroll
        for (int i = 0; i < 4; ++i) gv[i] = gp[i];
#pragma unroll
        for (int i = 0; i < 4; ++i) {
            const f32x4 a = *(const LDSAS f32x4*)(stg + eq * 68 + eseg * 32 + i * 8), c = *(const LDSAS f32x4*)(stg + eq * 68 + eseg * 32 + i * 8 + 4);
            const u32x4 g = gv[i]; u32x4 ov;
            ov.x = cvtpk(a[0] * bflo(g.x), a[1] * bfhi(g.x)); ov.y = cvtpk(a[2] * bflo(g.y), a[3] * bfhi(g.y));
            ov.z = cvtpk(c[0] * bflo(g.z), c[1] * bfhi(g.z)); ov.w = cvtpk(c[2] * bflo(g.w), c[3] * bfhi(g.w));
            op[i] = ov;
        }
    }
    __syncthreads();
}

__device__ __forceinline__ void phase_attnA_mfma(const Params& P, LDSAS unsigned char* lds, int vb, int nvb, int g_wave) {
    for (int u = vb; u < 1024 + 128; u += nvb) {
        int b, kvh, qrow0, qpos0, kt0, nwin;
        if (u < 1024) {
            int qblk;
            if (nvb == 256) { const int round = u >> 8, i = u & 255; b = round * 8 + (i & 7); kvh = (i >> 3) >> 4; qblk = (i >> 3) & 15; }
            else { qblk = u & 15; kvh = (u >> 4) & 1; b = u >> 5; }
            const int lo = 2 * qblk - 2 < 0 ? 0 : 2 * qblk - 2, hi_ = 2 * qblk + 3 > 31 ? 31 : 2 * qblk + 3;
            qrow0 = b * 2048 + qblk * 128; qpos0 = qblk * 128; kt0 = lo; nwin = hi_ - lo + 1;
        } else {
            const int v = u - 1024, half = v & 1; kvh = (v >> 1) & 1; b = v >> 2;
            qrow0 = ML + b * 256 + half * 128; qpos0 = 0; kt0 = 0; nwin = 0;
        }
        attnA_unit(P, lds, b, kvh, qrow0, qpos0, kt0, nwin, g_wave);
    }
}

constexpr int GL_QD = 0, GL_KD = 17408, GL_KT = 34816, GL_V = 53248, GL_DEC = 86016, GL_RF = 86528, GL_TOT = 90624, GL_WA = 92672, GL_RQ = 101376, GL_RK = 117760, GL_ATT = 134144, GL_END = 140288;
constexpr int KERNEL_LDS = (GL_END > pg8::STAGE_BYTES ? GL_END : pg8::STAGE_BYTES);
static_assert(TICKET_LDS == KERNEL_LDS + 8, "ticket word sits next to the barrier words");
__device__ __forceinline__ int pos16(int x) { return 8 * ((x >> 2) & 1) + (x & 3) + 4 * (x >> 3); }
__device__ __forceinline__ bf16x8 pack8(const f32x16& v, int o) {
    u32x4 w; w.x = cvtpk(v[o], v[o + 1]); w.y = cvtpk(v[o + 2], v[o + 3]); w.z = cvtpk(v[o + 4], v[o + 5]); w.w = cvtpk(v[o + 6], v[o + 7]);
    return __builtin_bit_cast(bf16x8, w);
}

__device__ __forceinline__ void phase_gla_mfma(const Params& P, LDSAS unsigned char* lds, int vb, int nvb, int g_wave) {
    const int tid = otid(), lane = tid & 63, r32 = lane & 31, hi = lane >> 5;
    const int wid = __builtin_amdgcn_readfirstlane(tid >> 6);
    const int it = wid >> 2, dt = wid & 3, d = dt * 32 + r32;
    for (int unit = vb; unit < NB * 8; unit += nvb) {
        const int dr = unit & 1, h = (unit >> 1) & 3, b = unit >> 3;
        const float* wa = dr ? P.wa_b : P.wa_f; const float* ba = dr ? P.ba_b : P.ba_f;
        __syncthreads();
        if (tid < 128) {
            u32x4 whi[2], wlo[2];
#pragma unroll
            for (int j = 0; j < 16; j += 2) {
                const float w0 = wa[j * 512 + h * 128 + tid] * LOG2E, w1 = wa[(j + 1) * 512 + h * 128 + tid] * LOG2E;
                const unsigned ph = cvtpk(w0, w1); const unsigned pl = cvtpk(w0 - bflo(ph), w1 - bfhi(ph));
                whi[j >> 3][(j >> 1) & 3] = ph; wlo[j >> 3][(j >> 1) & 3] = pl;
            }
            *(LDSAS u32x4*)(lds + GL_WA + tid * 32) = whi[0]; *(LDSAS u32x4*)(lds + GL_WA + tid * 32 + 16) = whi[1];
            *(LDSAS u32x4*)(lds + GL_WA + 4096 + tid * 32) = wlo[0]; *(LDSAS u32x4*)(lds + GL_WA + 4096 + tid * 32 + 16) = wlo[1];
            ((LDSAS float*)(lds + GL_WA + 8192))[tid] = ba[h * 128 + tid] * LOG2E;
        }
        f32x16 S[4];
#pragma unroll
        for (int i = 0; i < 4; ++i) S[i] = (f32x16){};
        f32x4 pf_rf; u32x4 pf_v[4], pf_q[2], pf_k[2];
        float lb[16];
#define GL_MEMBASE(n) ((n) >= 4 ? b * T + 64 * (dr ? 31 - ((n) - 4) : ((n) - 4)) : ML + b * L + 64 * (dr ? 3 - (n) : (n)))
#define GL_PREFETCH_V(n) do { const int mb_ = GL_MEMBASE(n); \
            _Pragma("unroll") for (int k4 = 0; k4 < 4; ++k4) { const int idx = tq + 512 * k4; pf_v[k4] = *(const u32x4*)(P.VG() + (size_t)(mb_ + (idx >> 5)) * 1024 + h * 256 + (idx & 31) * 8); } } while (0)
#define GL_PREFETCH_RQK(n) do { const int mb_ = GL_MEMBASE(n); \
            pf_rf = *(const f32x4*)(P.RF() + (size_t)(mb_ + ((tq & 255) >> 2)) * 32 + dr * 16 + (tq & 3) * 4); \
            _Pragma("unroll") for (int k2 = 0; k2 < 2; ++k2) { const int idx = tq + 512 * k2; pf_k[k2] = *(const u32x4*)(P.KG() + (size_t)(mb_ + (idx >> 4)) * 512 + h * 128 + (idx & 15) * 8); \
                pf_q[k2] = *(const u32x4*)(P.QG() + (size_t)(mb_ + (idx >> 4)) * 512 + h * 128 + (idx & 15) * 8); } } while (0)
#define GL_TOP(lat) do { \
            if (tq < 256) { \
                const unsigned h0 = cvtpk(pf_rf[0], pf_rf[1]), h1 = cvtpk(pf_rf[2], pf_rf[3]); \
                const unsigned l0 = cvtpk(pf_rf[0] - bflo(h0), pf_rf[1] - bfhi(h0)), l1 = cvtpk(pf_rf[2] - bflo(h1), pf_rf[3] - bfhi(h1)); \
                const int off = (dr ? 63 - (tq >> 2) : (tq >> 2)) * 32 + (tq & 3) * 8; \
                *(LDSAS u32x2*)(lds + GL_RF + off) = (u32x2){h0, h1}; *(LDSAS u32x2*)(lds + GL_RF + 2048 + off) = (u32x2){l0, l1}; \
            } \
            _Pragma("unroll") for (int k2 = 0; k2 < 2; ++k2) { const int idx = tq + 512 * k2, im = idx >> 4, ch = idx & 15; const int pr = dr ? 63 - im : im; \
                const int off = pr * 256 + ((ch ^ (4 * (pr & 3))) * 16); \
                *(LDSAS u32x4*)(lds + GL_RK + off) = pf_k[k2]; if (lat) *(LDSAS u32x4*)(lds + GL_RQ + off) = pf_q[k2]; } } while (0)
#define GL_Z() do { \
            const float bav = ((const LDSAS float*)(lds + GL_WA + 8192))[d]; \
            f32x16 z; \
            _Pragma("unroll") for (int r = 0; r < 16; ++r) z[r] = bav; \
            const bf16x8 ah = *(const LDSAS bf16x8*)(lds + GL_RF + (it * 32 + r32) * 32 + hi * 16), al = *(const LDSAS bf16x8*)(lds + GL_RF + 2048 + (it * 32 + r32) * 32 + hi * 16); \
            const bf16x8 bh = *(const LDSAS bf16x8*)(lds + GL_WA + d * 32 + hi * 16), bl = *(const LDSAS bf16x8*)(lds + GL_WA + 4096 + d * 32 + hi * 16); \
            z = __builtin_amdgcn_mfma_f32_32x32x16_bf16(ah, bh, z, 0, 0, 0); \
            z = __builtin_amdgcn_mfma_f32_32x32x16_bf16(al, bh, z, 0, 0, 0); \
            z = __builtin_amdgcn_mfma_f32_32x32x16_bf16(ah, bl, z, 0, 0, 0); \
            float gs[4]; \
            _Pragma("unroll") for (int g = 0; g < 4; ++g) { \
                float run = 0.f; \
                _Pragma("unroll") for (int j = 0; j < 4; ++j) { \
                    const float zz = z[4 * g + j]; \
                    run += (fminf(zz, 0.f) - __builtin_amdgcn_logf(1.0f + __builtin_amdgcn_exp2f(-fabsf(zz)))) * (1.0f / 16.0f); \
                    lb[4 * g + j] = run; \
                } \
                gs[g] = run; \
            } \
            float off = 0.f; \
            _Pragma("unroll") for (int g = 0; g < 4; ++g) {        \
                const auto sw = __builtin_amdgcn_permlane32_swap(__float_as_uint(gs[g]), __float_as_uint(gs[g]), false, false);        \
                const float o2 = off + (hi ? __uint_as_float(sw[0]) : 0.f); \
                _Pragma("unroll") for (int j = 0; j < 4; ++j) lb[4 * g + j] += o2; \
                off += __uint_as_float(sw[0]) + __uint_as_float(sw[1]); \
            } \
            if (hi == 0) ((LDSAS float*)(lds + GL_TOT))[it * 128 + d] = off; } while (0)
        { int tq = tid; asm volatile("" : "+v"(tq)); GL_PREFETCH_RQK(0); GL_PREFETCH_V(0); GL_TOP(false); GL_PREFETCH_RQK(1); }
        __syncthreads();
        GL_Z();
        __syncthreads();
        for (int n = 0; n < 36; ++n) {
            const bool latent = n >= 4;
            const int membase = GL_MEMBASE(n);
            const int nn = n + 1 < 36 ? n + 1 : 35, n2 = n + 2 < 36 ? n + 2 : 35;
            {
                const float t0 = ((const LDSAS float*)(lds + GL_TOT))[d], t1 = ((const LDSAS float*)(lds + GL_TOT))[128 + d];
                const float prefix = it ? t0 : 0.f;
                const float dec = __builtin_amdgcn_exp2f(t0 + t1);
                const int le = lane;
                const int trs = (le & 15) >> 2, trc = dt * 4 + ((le >> 4) & 1) * 2 + ((le & 3) >> 1);
                const int troff = (it * 32 + 4 * (le >> 5) + trs) * 256 + ((trc ^ (4 * trs)) * 16) + (le & 1) * 8;
                u32x2 kr[4], qr[4];
#pragma unroll
                for (int g = 0; g < 4; ++g) { kr[g] = __builtin_bit_cast(u32x2, vtr(lds + GL_RK + troff + g * 2048)); if (latent) qr[g] = __builtin_bit_cast(u32x2, vtr(lds + GL_RQ + troff + g * 2048)); }
                float ktv[16];
                const int dp = ((d & ~15) + pos16(d & 15)) * 2;
#pragma unroll
                for (int r = 0; r < 16; r += 2) {
                    const int i0 = it * 32 + crow(r, hi), i1 = i0 + 1;
                    const float e0 = __builtin_amdgcn_exp2f(prefix + lb[r]), e1 = __builtin_amdgcn_exp2f(prefix + lb[r + 1]);
                    const unsigned kw2 = kr[r >> 2][(r >> 1) & 1];
                    const float kd0 = bflo(kw2) * __builtin_amdgcn_rcpf(e0), kd1 = bfhi(kw2) * __builtin_amdgcn_rcpf(e1);
                    ktv[r] = kd0 * dec; ktv[r + 1] = kd1 * dec;
                    lb[r] = e0; lb[r + 1] = e1;
                    if (latent) {
                        const unsigned kw = cvtpk(kd0, kd1);
                        *(LDSAS bf16_t*)(lds + GL_KD + i0 * 272 + dp) = (bf16_t)kw; *(LDSAS bf16_t*)(lds + GL_KD + i1 * 272 + dp) = (bf16_t)(kw >> 16);
                    }
                }
                if (latent) {
#pragma unroll
                    for (int r = 0; r < 16; r += 2) {
                        const int i0 = it * 32 + crow(r, hi), i1 = i0 + 1;
                        const unsigned qw2 = qr[r >> 2][(r >> 1) & 1];
                        const unsigned qw = cvtpk(bflo(qw2) * lb[r], bfhi(qw2) * lb[r + 1]);
                        *(LDSAS bf16_t*)(lds + GL_QD + i0 * 272 + dp) = (bf16_t)qw; *(LDSAS bf16_t*)(lds + GL_QD + i1 * 272 + dp) = (bf16_t)(qw >> 16);
                    }
                }
                u32x4 w0, w1;
                w0.x = cvtpk(ktv[0], ktv[1]); w0.y = cvtpk(ktv[2], ktv[3]); w0.z = cvtpk(ktv[4], ktv[5]); w0.w = cvtpk(ktv[6], ktv[7]);
                w1.x = cvtpk(ktv[8], ktv[9]); w1.y = cvtpk(ktv[10], ktv[11]); w1.z = cvtpk(ktv[12], ktv[13]); w1.w = cvtpk(ktv[14], ktv[15]);
                *(LDSAS u32x4*)(lds + GL_KT + d * 144 + (2 * it) * 32 + hi * 16) = w0;
                *(LDSAS u32x4*)(lds + GL_KT + d * 144 + (2 * it + 1) * 32 + hi * 16) = w1;
                if (it == 0 && hi == 0) ((LDSAS float*)(lds + GL_DEC))[d] = dec;
            }
            const int tq = tid;
#pragma unroll
            for (int k4 = 0; k4 < 4; ++k4) { const int idx = tq + 512 * k4, im = idx >> 5, ch = idx & 31; *(LDSAS u32x4*)(lds + GL_V + (ch >> 2) * 4096 + (dr ? 63 - im : im) * 64 + (ch & 3) * 16) = pf_v[k4]; }
            __syncthreads();
            GL_TOP(nn >= 4);
            GL_PREFETCH_V(nn);
            GL_PREFETCH_RQK(n2);
            bf16x8 vf[4];
#define GL_LOADV() do { const LDSAS unsigned char* vbp = lds + GL_V + wid * 4096 + (4 * hiq + ((lq & 15) >> 2)) * 64 + ((lq >> 4) & 1) * 32 + (lq & 3) * 8; \
                _Pragma("unroll") for (int js = 0; js < 4; ++js) { const s16x4 lo = vtr(vbp + js * 1024), hh = vtr(vbp + js * 1024 + 512); vf[js] = (bf16x8){lo[0], lo[1], lo[2], lo[3], hh[0], hh[1], hh[2], hh[3]}; } } while (0)
            __builtin_amdgcn_sched_barrier(0);
            const int lq = lane;
            const int r32q = lq & 31, hiq = lq >> 5;
#define GL_SUPDATE() do { _Pragma("unroll") for (int dt2 = 0; dt2 < 4; ++dt2) { __builtin_amdgcn_sched_barrier(0); \
                _Pragma("unroll") for (int g = 0; g < 4; ++g) { const f32x4 dc = *(const LDSAS f32x4*)(lds + GL_DEC + (dt2 * 32 + 8 * g + 4 * hiq) * 4); \
                    S[dt2][4 * g] *= dc[0]; S[dt2][4 * g + 1] *= dc[1]; S[dt2][4 * g + 2] *= dc[2]; S[dt2][4 * g + 3] *= dc[3]; } \
                const LDSAS unsigned char* ktp = lds + GL_KT + (dt2 * 32 + r32q) * 144 + hiq * 16; \
                _Pragma("unroll") for (int is = 0; is < 4; ++is) S[dt2] = __builtin_amdgcn_mfma_f32_32x32x16_bf16(*(const LDSAS bf16x8*)(ktp + is * 32), vf[is], S[dt2], 0, 0, 0); } } while (0)
            GL_LOADV();
            f32x16 o0 = (f32x16){}, o1 = (f32x16){};
            if (latent) {
                if (wid < 3) {
                    f32x16 X = (f32x16){};
                    const LDSAS unsigned char* kb = lds + GL_KD + ((wid == 2 ? 32 : 0) + r32q) * 272 + hiq * 16;
                    const LDSAS unsigned char* qb2 = lds + GL_QD + ((wid >= 1 ? 32 : 0) + r32q) * 272 + hiq * 16;
#pragma unroll
                    for (int s = 0; s < 8; ++s) X = __builtin_amdgcn_mfma_f32_32x32x16_bf16(*(const LDSAS bf16x8*)(kb + s * 32), *(const LDSAS bf16x8*)(qb2 + s * 32), X, 0, 0, 0);
                    if (wid != 1) {
                        const int rq = r32;
#pragma unroll
                        for (int r = 0; r < 16; ++r) X[r] = (crow(r, hi) <= rq) ? X[r] : 0.f;
                    }
                    *(LDSAS bf16x8*)(lds + GL_ATT + wid * 2048 + lq * 16) = pack8(X, 0);
                    *(LDSAS bf16x8*)(lds + GL_ATT + wid * 2048 + 1024 + lq * 16) = pack8(X, 8);
                }
                __builtin_amdgcn_sched_barrier(0);
                const LDSAS unsigned char* qb = lds + GL_QD + r32q * 272 + hiq * 16;
#pragma unroll
                for (int s = 0; s < 8; ++s) {
                    const bf16x8 Sb = pack8(S[s >> 1], (s & 1) * 8);
                    const bf16x8 q0 = *(const LDSAS bf16x8*)(qb + s * 32), q1 = *(const LDSAS bf16x8*)(qb + 32 * 272 + s * 32);
                    o0 = __builtin_amdgcn_mfma_f32_32x32x16_bf16(q0, Sb, o0, 0, 0, 0);
                    o1 = __builtin_amdgcn_mfma_f32_32x32x16_bf16(q1, Sb, o1, 0, 0, 0);
                    if (s & 1) __builtin_amdgcn_sched_barrier(0);
                }
            }
            __syncthreads();
            if (latent) {
                {
                    const LDSAS unsigned char* ab = lds + GL_ATT + lq * 16;
                    o0 = __builtin_amdgcn_mfma_f32_32x32x16_bf16(*(const LDSAS bf16x8*)(ab), vf[0], o0, 0, 0, 0);
                    o0 = __builtin_amdgcn_mfma_f32_32x32x16_bf16(*(const LDSAS bf16x8*)(ab + 1024), vf[1], o0, 0, 0, 0);
                    __builtin_amdgcn_sched_barrier(0);
                    o1 = __builtin_amdgcn_mfma_f32_32x32x16_bf16(*(const LDSAS bf16x8*)(ab + 2048), vf[0], o1, 0, 0, 0);
                    o1 = __builtin_amdgcn_mfma_f32_32x32x16_bf16(*(const LDSAS bf16x8*)(ab + 3072), vf[1], o1, 0, 0, 0);
                    __builtin_amdgcn_sched_barrier(0);
                    o1 = __builtin_amdgcn_mfma_f32_32x32x16_bf16(*(const LDSAS bf16x8*)(ab + 4096), vf[2], o1, 0, 0, 0);
                    o1 = __builtin_amdgcn_mfma_f32_32x32x16_bf16(*(const LDSAS bf16x8*)(ab + 5120), vf[3], o1, 0, 0, 0);
                }
                LDSAS unsigned char* ost = lds + GL_V + wid * 4096;
#pragma unroll
                for (int r = 0; r < 16; r += 2) {
                    const int i0 = crow(r, hi);
                    const unsigned w0 = cvtpk(o0[r], o0[r + 1]), w1 = cvtpk(o1[r], o1[r + 1]);
                    *(LDSAS bf16_t*)(ost + i0 * 64 + r32 * 2) = (bf16_t)w0; *(LDSAS bf16_t*)(ost + (i0 + 1) * 64 + r32 * 2) = (bf16_t)(w0 >> 16);
                    *(LDSAS bf16_t*)(ost + (32 + i0) * 64 + r32 * 2) = (bf16_t)w1; *(LDSAS bf16_t*)(ost + (33 + i0) * 64 + r32 * 2) = (bf16_t)(w1 >> 16);
                }
                bf16_t* od = P.OD() + (size_t)dr * ML * 1024 + h * 256 + wid * 32;
#pragma unroll
                for (int k4 = 0; k4 < 4; ++k4) {
                    const int p = lane + 64 * k4, i = p >> 2, part = p & 3;
                    const u32x4 v = *(const LDSAS u32x4*)(ost + i * 64 + part * 16);
                    *(u32x4*)(od + (size_t)(membase + (dr ? 63 - i : i)) * 1024 + part * 8) = v;
                }
            }
            GL_SUPDATE();
            GL_Z();
            __syncthreads();
#undef GL_LOADV
#undef GL_SUPDATE
        }
#undef GL_PREFETCH_V
#undef GL_PREFETCH_RQK
#undef GL_TOP
#undef GL_Z
#undef GL_MEMBASE
    }
}

__device__ __forceinline__ void phase_rstd1(const Params& P, int vb, int nvb, int g_wave) {
    const int tidx = otid();
    for (int row = vb * 512 + tidx; row < M; row += nvb * 512) {
        float ss = 0.f;
#pragma unroll
        for (int i = 0; i < 16; ++i) ss += P.parts()[(size_t)i * M + row];
        ((float*)(P.ws + OFF_RS))[row] = rsqrtf(ss * (1.0f / 1024.0f) + EPS);
    }
}

__device__ __forceinline__ void phase_finish(const Params& P, int vb, int nvb, int g_wave) {
    const int tidx = otid();
    const int lane = tidx & 63, wpb = blockDim.x >> 6, w = tidx >> 6;
    for (int row = vb * wpb + w; row < ML; row += nvb * wpb) {
        const int c0 = lane * 16;
        float v[16];
        const u32x4* pf = (const u32x4*)(P.OD() + (size_t)row * 1024 + c0);
        const u32x4* pb = (const u32x4*)(P.OD() + ((size_t)ML + row) * 1024 + c0);
        float ss = 0.f;
#pragma unroll
        for (int i = 0; i < 2; ++i) {
            const u32x4 a = pf[i], bq = pb[i];
            v[8 * i] = bflo(a.x) + bflo(bq.x); v[8 * i + 1] = bfhi(a.x) + bfhi(bq.x); v[8 * i + 2] = bflo(a.y) + bflo(bq.y); v[8 * i + 3] = bfhi(a.y) + bfhi(bq.y);
            v[8 * i + 4] = bflo(a.z) + bflo(bq.z); v[8 * i + 5] = bfhi(a.z) + bfhi(bq.z); v[8 * i + 6] = bflo(a.w) + bflo(bq.w); v[8 * i + 7] = bfhi(a.w) + bfhi(bq.w);
        }
#pragma unroll
        for (int i = 0; i < 16; ++i) ss += v[i] * v[i];
        ss = sum_row16(ss);
        const float rn = rsqrtf(ss * (1.0f / 256.0f) + EPS);
        float gn[16];
        { const f32x4* gnp = (const f32x4*)(P.gla_out_norm + (c0 & 255));
#pragma unroll
          for (int i = 0; i < 4; ++i) { const f32x4 t4 = gnp[i]; gn[4 * i] = t4[0]; gn[4 * i + 1] = t4[1]; gn[4 * i + 2] = t4[2]; gn[4 * i + 3] = t4[3]; } }
        const u32x4* gp = (const u32x4*)(P.GG() + (size_t)row * 1024 + c0);
        u32x4* op = (u32x4*)(P.A2() + (size_t)row * 1024 + c0);
        const u32x4 gq[2] = {gp[0], gp[1]};
#pragma unroll
        for (int i = 0; i < 2; ++i) {
            const u32x4 g = gq[i]; u32x4 r;
            r.x = cvtpk(v[8 * i] * rn * gn[8 * i] * bflo(g.x), v[8 * i + 1] * rn * gn[8 * i + 1] * bfhi(g.x));
            r.y = cvtpk(v[8 * i + 2] * rn * gn[8 * i + 2] * bflo(g.y), v[8 * i + 3] * rn * gn[8 * i + 3] * bfhi(g.y));
            r.z = cvtpk(v[8 * i + 4] * rn * gn[8 * i + 4] * bflo(g.z), v[8 * i + 5] * rn * gn[8 * i + 5] * bfhi(g.z));
            r.w = cvtpk(v[8 * i + 6] * rn * gn[8 * i + 6] * bflo(g.w), v[8 * i + 7] * rn * gn[8 * i + 7] * bfhi(g.w));
            op[i] = r;
        }
    }
}

namespace cg = cooperative_groups;
#define XB_TMO      128
#define XB_XCNT(j)  (256  + 64 * (j))
#define XB_XSUB(j)  (1280 + 64 * (j))
#define XB_XGEN(j)  (2304 + 64 * (j))
#define XB_TOP      3328
#define XB_TOPGEN   3392
#define XCD_BAR_WORDS 3456
#define XB_SPIN_CAP (1u << 22)
static_assert(XCD_BAR_WORDS * 4 <= 16384, "barrier words fit their workspace slot");
__device__ __forceinline__ unsigned xb_ld(unsigned* p) { return __hip_atomic_load(p, __ATOMIC_RELAXED, __HIP_MEMORY_SCOPE_AGENT); }
__device__ __forceinline__ unsigned xb_add(unsigned* p, unsigned v) { return __hip_atomic_fetch_add(p, v, __ATOMIC_RELAXED, __HIP_MEMORY_SCOPE_AGENT); }
__device__ __forceinline__ unsigned xb_xcc_id() { return (unsigned)__builtin_amdgcn_s_getreg((3 << 11) | 20) & 0xFu; }
#define XB_SPIN(cond, bar) do { unsigned _sp = 0; while (cond) { __builtin_amdgcn_s_sleep(1); \
    if ((++_sp & 255u) == 0u) { if (xb_ld(&(bar)[XB_TMO])) break; if (_sp > XB_SPIN_CAP) { atomicAdd(&(bar)[XB_TMO], 1u); break; } } } } while (0)
__device__ __forceinline__ void xcd_barrier_complete(unsigned* bar, unsigned x, unsigned G, unsigned& nloc, unsigned& nx) {
    unsigned sum, cnt, mine, sp = 0u;
    for (;;) {
        sum = 0u; cnt = 0u; mine = 0u;
#pragma unroll
        for (unsigned j = 0; j < 16; ++j) { const unsigned c = xb_ld(&bar[XB_XCNT(j)]); sum += c; cnt += (c > 0u) ? 1u : 0u; mine = (j == x) ? c : mine; }
        if (sum == G) break;
        __builtin_amdgcn_s_sleep(1);
        if ((++sp & 255u) == 0u) { if (xb_ld(&bar[XB_TMO])) break; if (sp > XB_SPIN_CAP) { atomicAdd(&bar[XB_TMO], 1u); break; } }
    }
    nloc = mine > 0u ? mine : 1u; nx = cnt > 0u ? cnt : 1u;
}
__device__ __forceinline__ void xcd_barrier(unsigned* bar, volatile LDSAS unsigned* st, unsigned G, int g_wave) {
    asm volatile("s_waitcnt vmcnt(0)" ::: "memory");
    __syncthreads();
    if (g_wave == 0 && lane_id() == 0) {
        const unsigned x = xb_xcc_id();
        __builtin_amdgcn_s_waitcnt(0);
        unsigned nloc = st[0], nx = st[1];
        if (nloc == 0u) { xcd_barrier_complete(bar, x, G, nloc, nx); st[0] = nloc; st[1] = nx; }
        const unsigned old = xb_add(&bar[XB_XSUB(x)], 1u);
        const unsigned gen = old / nloc;
        if (old + 1u == (gen + 1u) * nloc) {
            __builtin_amdgcn_fence(__ATOMIC_RELEASE, "agent");
            asm volatile("s_waitcnt vmcnt(0)" ::: "memory");
            const unsigned og = xb_add(&bar[XB_TOP], 1u);
            const unsigned tg = og / nx;
            if (og + 1u == (tg + 1u) * nx) xb_add(&bar[XB_TOPGEN], 1u);
            else XB_SPIN(xb_ld(&bar[XB_TOPGEN]) == tg, bar);
            __builtin_amdgcn_fence(__ATOMIC_ACQUIRE, "agent");
            xb_add(&bar[XB_XGEN(x)], 1u);
            asm volatile("s_waitcnt vmcnt(0)" ::: "memory");
        } else {
            XB_SPIN(xb_ld(&bar[XB_XGEN(x)]) == gen, bar);
            __builtin_amdgcn_fence(__ATOMIC_ACQUIRE, "agent");
            asm volatile("s_waitcnt vmcnt(0)" ::: "memory");
        }
    }
    __syncthreads();
}

#define GRID_BAR() xcd_barrier((unsigned*)(ldparams().ws + OFF_BAR), (volatile LDSAS unsigned*)(lds + KERNEL_LDS), (unsigned)nvb, g_wave)
#define REPEAT(k, ...) { const Params P = ldparams(); __VA_ARGS__ }
__global__ void __launch_bounds__(512) mega_kernel(Params Pk) {
    __shared__ __attribute__((aligned(16))) unsigned char lds[KERNEL_LDS + 16];
    const int vb = blockIdx.x, nvb = gridDim.x;
    const int g_wave = __builtin_amdgcn_readfirstlane((int)(threadIdx.x >> 6));
    if (threadIdx.x == 0) {
        ((volatile LDSAS unsigned*)(lds + KERNEL_LDS))[0] = 0u; ((volatile LDSAS unsigned*)(lds + KERNEL_LDS))[1] = 0u;
        (void)xb_add(&((unsigned*)(Pk.ws + OFF_BAR))[XB_XCNT(xb_xcc_id())], 1u);
    }
#ifdef PROBE_A
#define STAMP(k) do { if (vb == 0 && g_wave == 0 && lane_id() == 0) ((unsigned long long*)(ldparams().ws + OFF_BAR + 14336))[k] = __builtin_amdgcn_s_memrealtime(); } while (0)
#else
#define STAMP(k) do { } while (0)
#endif
    STAMP(0);
    REPEAT(0, phase_pro0(P, lds, vb, nvb, g_wave);)
    STAMP(1);
    if (ldparams().reps[11] != 0) cg::this_grid().sync();
    GRID_BAR();
    REPEAT(1, phase_bias_a0(P, lds, vb, nvb, g_wave);)
    STAMP(2);
    GRID_BAR();
    REPEAT(2, EpiIn0 E{P.ws, P.a_q_norm, P.a_k_norm, P.b_q_norm, P.b_k_norm};
      pg8::Gemm g{P.A(), P.Wt0(), M, N0, D}; pg8::StaticOrder S; S.init(M, N0, nvb, vb); pg8::gemm_phase<EpiIn0, pg8::StaticOrder, true, true>((LDSAS unsigned char*)lds, g, S, E, g_wave);)
    STAMP(3);
    GRID_BAR();
    REPEAT(3, phase_attnA_mfma(P, (LDSAS unsigned char*)lds, vb, nvb, g_wave);)
    REPEAT(4, phase_attnB_mfma(P, (LDSAS unsigned char*)lds, vb, nvb, g_wave);)
    STAMP(4);
    GRID_BAR();
    REPEAT(5, EpiOut0 E{P.x, P.ctx, P.norm_g + D, P.out, P.ws};
      pg8::Gemm g{P.O(), P.Wo0(), M, D, D}; pg8::StaticOrder S; S.init(M, D, nvb, vb); pg8::gemm_phase<EpiOut0, pg8::StaticOrder, true, true>((LDSAS unsigned char*)lds, g, S, E, g_wave);)
    STAMP(5);
    GRID_BAR();
    { const Params P = ldparams(); phase_rstd1(P, vb, nvb, g_wave); }
    GRID_BAR();
    REPEAT(6, EpiIn1 E{P.ws};
      pg8::Gemm g{P.A(), P.Wt1(), M, N1, D}; OrderIn1 S; S.init(nvb, vb); pg8::gemm_phase<EpiIn1, OrderIn1, true, true>((LDSAS unsigned char*)lds, g, S, E, g_wave);)
    STAMP(6);
    GRID_BAR();
    REPEAT(7, phase_gla_mfma(P, (LDSAS unsigned char*)lds, vb, nvb, g_wave);)
    STAMP(7);
    GRID_BAR();
    REPEAT(8, phase_finish(P, vb, nvb, g_wave);)
    STAMP(8);
    GRID_BAR();
    { const Params P = ldparams();
      EpiOut1 E{P.ws, P.out};
      pg8::Gemm g{P.A2(), P.Wo1(), ML, D, D}; pg8::StaticOrder S; S.init(ML, D, nvb, vb); pg8::gemm_phase<EpiOut1, pg8::StaticOrder, true, true>((LDSAS unsigned char*)lds, g, S, E, g_wave); }
#ifdef PROBE_A
    STAMP(9);
    GRID_BAR();
    if (vb == 0 && g_wave == 0 && lane_id() == 0) {
        const Params P = ldparams(); const unsigned long long* ts = (const unsigned long long*)(P.ws + OFF_BAR + 14336);
        P.out[0] += (float)(ts[PROBE_A + 1] - ts[PROBE_A]) * 0.01f;
        P.out[1] += (float)(ts[PROBE_B + 1] - ts[PROBE_B]) * 0.01f;
    }
#endif
}
}

extern "C" void kernel_launch(void* const* d_in, const int* in_sizes, int n_in, void* d_out, int out_size, void* d_ws, size_t ws_size, hipStream_t stream) {
    Params P{};
    const float* const* in = (const float* const*)d_in;
    P.x = in[0]; P.c = in[1]; P.ctx = in[2]; P.c_ctx = in[3]; P.adaln_w = in[4]; P.adaln_b = in[5]; P.norm_g = in[6]; P.w_out = in[7]; P.ab_w_in = in[8];
    P.a_q_norm = in[9]; P.a_k_norm = in[10]; P.a_sink = in[11]; P.b_q_norm = in[12]; P.b_k_norm = in[13]; P.lq1 = in[14]; P.lk1 = in[15]; P.lq2 = in[16]; P.lk2 = in[17];
    P.b_subln = in[18]; P.gla_w_in = in[19]; P.wa_f = in[20]; P.ba_f = in[21]; P.wa_b = in[22]; P.ba_b = in[23]; P.gla_out_norm = in[24];
    P.out = (float*)d_out;
    P.ws = (unsigned char*)d_ws;
    for (int i = 0; i < 12; ++i) P.reps[i] = 1;
    P.reps[11] = 0;
#ifdef PROBE_PHASE
    P.reps[PROBE_PHASE] = 2;
#endif
    if (WS_NEED > ws_size) { fprintf(stderr, "workspace too small: need %zu have %zu\n", (size_t)WS_NEED, ws_size); return; }
    static int grid_blocks = 0;
    if (!grid_blocks) {
        int dev = 0, cus = 0, per_cu = 0;
        (void)hipGetDevice(&dev);
        (void)hipDeviceGetAttribute(&cus, hipDeviceAttributeMultiprocessorCount, dev);
        (void)hipOccupancyMaxActiveBlocksPerMultiprocessor(&per_cu, mega_kernel, 512, 0);
        if (per_cu > 1) per_cu = 1;
        grid_blocks = cus * per_cu;
    }
    (void)hipMemsetAsync((unsigned char*)d_ws + OFF_BAR, 0, 16384, stream);
    void* args[] = {&P};
    hipError_t e = hipLaunchCooperativeKernel((void*)mega_kernel, dim3(grid_blocks), dim3(512), args, 0, stream);
    if (e != hipSuccess) fprintf(stderr, "cooperative launch failed: %s (grid %d)\n", hipGetErrorString(e), grid_blocks);
}
```

```cpp
#include <hip/hip_runtime.h>
#include <hip/hip_cooperative_groups.h>
#include <cstdint>
#include <cstdio>

namespace {
constexpr int NB = 32, T = 2048, L = 256, D = 1024;
constexpr int ML = NB * T, MC = NB * L, M = ML + MC;
constexpr int N0 = 3328, N1 = 3328, N0R = 3328, N1R = 3104;
constexpr float EPS = 1e-6f;
constexpr float LOG2E = 1.4426950408889634f;
constexpr float QSCALE = 0.125f * LOG2E;
constexpr float LAMBDA_INIT = 0.2f;

typedef unsigned short bf16_t;
typedef short bf16x8 __attribute__((ext_vector_type(8)));
typedef float f32x4 __attribute__((ext_vector_type(4)));
typedef unsigned u32x4 __attribute__((ext_vector_type(4)));
typedef unsigned u32x2 __attribute__((ext_vector_type(2)));

constexpr size_t al256(size_t x) { return (x + 255) & ~(size_t)255; }
constexpr size_t OFF_WT0 = 0;
constexpr size_t OFF_WT1 = OFF_WT0 + al256((size_t)N0 * D * 2);
constexpr size_t OFF_WO0 = OFF_WT1 + al256((size_t)N1 * D * 2);
constexpr size_t OFF_WO1 = OFF_WO0 + al256((size_t)D * D * 2);
constexpr size_t OFF_MOD = OFF_WO1 + al256((size_t)D * D * 2);
constexpr size_t OFF_BIAS0 = OFF_MOD + al256((size_t)2 * 33 * 3072 * 4);
constexpr size_t OFF_BIAS1 = OFF_BIAS0 + al256((size_t)33 * 3328 * 4);
constexpr size_t OFF_ROPE = OFF_BIAS1 + al256((size_t)33 * 3328 * 4);
constexpr size_t OFF_SCAL = OFF_ROPE + al256(64 * 16 * 2 * 4);
constexpr size_t OFF_BAR = OFF_SCAL + 256;
constexpr size_t OFF_RS = OFF_BAR + 16384;
constexpr size_t OFF_PARTS = OFF_RS + al256((size_t)M * 4);
constexpr size_t OFF_A = OFF_PARTS + al256((size_t)16 * M * 4);
constexpr size_t OFF_O = OFF_A + (size_t)M * D * 2;
constexpr size_t OFF_QKV = OFF_O + (size_t)M * D * 2;
constexpr size_t OFF_X1B = OFF_QKV + (size_t)M * 3328 * 2;
constexpr size_t WS_NEED = OFF_X1B + (size_t)ML * D * 2;
constexpr size_t OFF_QA = OFF_QKV, OFF_KA = OFF_QA + (size_t)M * 512 * 2, OFF_VA = OFF_KA + (size_t)M * 128 * 2, OFF_GA = OFF_VA + (size_t)M * 128 * 2;
constexpr size_t OFF_QB = OFF_GA + (size_t)M * 512 * 2, OFF_KB = OFF_QB + (size_t)M * 512 * 2, OFF_VB = OFF_KB + (size_t)M * 512 * 2, OFF_GB = OFF_VB + (size_t)M * 512 * 2;
constexpr size_t OFF_QG = OFF_QKV, OFF_KG = OFF_QG + (size_t)M * 512 * 2, OFF_VG = OFF_KG + (size_t)M * 512 * 2, OFF_GG = OFF_VG + (size_t)M * 1024 * 2, OFF_RF = OFF_GG + (size_t)M * 1024 * 2;
static_assert(OFF_RF + (size_t)M * 32 * 4 <= WS_NEED, "layer-1 projections fit");
static_assert((size_t)2 * ML * 1024 * 2 <= (size_t)2 * M * D * 2, "OD fits over A + O");

struct Params {
    const float *x, *c, *ctx, *c_ctx, *adaln_w, *adaln_b, *norm_g, *w_out, *ab_w_in, *a_q_norm, *a_k_norm, *a_sink, *b_q_norm, *b_k_norm;
    const float *lq1, *lk1, *lq2, *lk2, *b_subln, *gla_w_in, *wa_f, *ba_f, *wa_b, *ba_b, *gla_out_norm;
    float* out;
    unsigned char* ws;
    int reps[12];
#define WSPTR(T, name, off) __device__ __forceinline__ T* name() const { return (T*)(ws + (off)); }
    WSPTR(bf16_t, Wt0, OFF_WT0) WSPTR(bf16_t, Wt1, OFF_WT1) WSPTR(bf16_t, Wo0, OFF_WO0) WSPTR(bf16_t, Wo1, OFF_WO1)
    WSPTR(float, mod, OFF_MOD) WSPTR(float, bias0, OFF_BIAS0) WSPTR(float, bias1, OFF_BIAS1) WSPTR(float, rope, OFF_ROPE) WSPTR(float, scal, OFF_SCAL) WSPTR(float, parts, OFF_PARTS)
    WSPTR(bf16_t, A, OFF_A) WSPTR(bf16_t, O, OFF_O)
    WSPTR(bf16_t, QA, OFF_QA) WSPTR(bf16_t, KA, OFF_KA) WSPTR(bf16_t, VA, OFF_VA) WSPTR(bf16_t, GA, OFF_GA)
    WSPTR(bf16_t, QB, OFF_QB) WSPTR(bf16_t, KB, OFF_KB) WSPTR(bf16_t, VB, OFF_VB) WSPTR(bf16_t, GB, OFF_GB)
    WSPTR(bf16_t, QG, OFF_QG) WSPTR(bf16_t, KG, OFF_KG) WSPTR(bf16_t, VG, OFF_VG) WSPTR(bf16_t, GG, OFF_GG) WSPTR(float, RF, OFF_RF)
    WSPTR(bf16_t, OD, OFF_A) WSPTR(bf16_t, A2, OFF_QKV)
#undef WSPTR
};

__device__ __forceinline__ int lane_id() { int l; asm volatile("v_mbcnt_lo_u32_b32 %0, -1, 0\n\tv_mbcnt_hi_u32_b32 %0, -1, %0" : "=v"(l)); return l; }
#define otid() otid_(g_wave)
__device__ __forceinline__ int otid_(int wave) { int t = wave * 64 + lane_id(); asm volatile("" : "+v"(t)); return t; }
__device__ __forceinline__ unsigned f2bf(float f) { unsigned u = __float_as_uint(f); u += 0x7FFFu + ((u >> 16) & 1u); return u >> 16; }
__device__ __forceinline__ unsigned pack2(float lo, float hi) { return f2bf(lo) | (f2bf(hi) << 16); }
typedef float f32x2_t __attribute__((ext_vector_type(2)));
typedef __bf16 bf16x2_t __attribute__((ext_vector_type(2)));
__device__ __forceinline__ unsigned cvtpk(float lo, float hi) { f32x2_t v = {lo, hi}; bf16x2_t b = __builtin_convertvector(v, bf16x2_t); return __builtin_bit_cast(unsigned, b); }
__device__ __forceinline__ float bf2f(unsigned h) { return __uint_as_float(h << 16); }
__device__ __forceinline__ float bflo(unsigned w) { return __uint_as_float(w << 16); }
__device__ __forceinline__ float bfhi(unsigned w) { return __uint_as_float(w & 0xFFFF0000u); }
__device__ __forceinline__ float sum_xor16(float x) { const auto r = __builtin_amdgcn_permlane16_swap(__float_as_uint(x), __float_as_uint(x), false, false); return __uint_as_float(r[0]) + __uint_as_float(r[1]); }
__device__ __forceinline__ float sum_xor32(float x) { const auto r = __builtin_amdgcn_permlane32_swap(__float_as_uint(x), __float_as_uint(x), false, false); return __uint_as_float(r[0]) + __uint_as_float(r[1]); }
template <int CTRL> __device__ __forceinline__ float dppf(float x) { return __int_as_float(__builtin_amdgcn_mov_dpp(__float_as_int(x), CTRL, 0xF, 0xF, true)); }
__device__ __forceinline__ float sum_row16(float x) { x += dppf<0xB1>(x); x += dppf<0x4E>(x); x += dppf<0x124>(x); x += dppf<0x128>(x); return x; }
__device__ __forceinline__ float siluf(float v) { return v * __builtin_amdgcn_rcpf(1.0f + __builtin_amdgcn_exp2f(-v * LOG2E)); }

__device__ __forceinline__ Params ldparams() {
#if defined(__HIP_DEVICE_COMPILE__)
    const __attribute__((address_space(4))) Params* pp = (const __attribute__((address_space(4))) Params*)__builtin_amdgcn_kernarg_segment_ptr();
    asm volatile("" : "+s"(pp));
    return *pp;
#else
    return Params{};
#endif
}

__device__ __forceinline__ int perm_local(int p, bool ropeType) {
    const int bj = p >> 7, wc = (p >> 5) & 3, low = p & 31;
    if (ropeType) return wc * 64 + bj * 32 + low;
    const int n = (low >> 4) & 1, fq = (low >> 2) & 3, e = low & 3;
    return wc * 64 + bj * 32 + fq * 8 + n * 4 + e;
}
__device__ __forceinline__ int src_col(int which, int np) {
    const int p = np & 255, tile = np >> 8;
    bool rope = false;
    if (which == 0) { const int g = tile * 4 + ((p >> 5) & 3); rope = (g < 10) || (g >= 20 && g < 36); }
    const int c = tile * 256 + perm_local(p, rope);
    const int nreal = which == 0 ? N0R : (which == 1 ? N1R : D);
    return c < nreal ? c : -1;
}

__device__ __forceinline__ int dst_row(int which, int c) {
    const int tile = c >> 8, cl = c & 255, wc = cl >> 6, bj = (cl >> 5) & 1, low = cl & 31;
    bool rope = false;
    if (which == 0) { const int g = tile * 4 + wc; rope = (g < 10) || (g >= 20 && g < 36); }
    int lo5 = low;
    if (!rope) { const int fq = low >> 3, n = (low >> 2) & 1, e = low & 3; lo5 = n * 16 + fq * 4 + e; }
    return tile * 256 + bj * 128 + wc * 32 + lo5;
}

__device__ __forceinline__ void wt_quad(const float* __restrict__ W, int ldw, int nreal, int which, bf16_t* __restrict__ dst, int c0, int k0, unsigned char* lds, int tid) {
    bf16_t* t = (bf16_t*)lds;
    __syncthreads();
    f32x4 v[8];
#pragma unroll
    for (int i = 0; i < 8; ++i) {
        const int idx = tid + 512 * i, r = idx >> 4, c4 = (idx & 15) * 4;
        const bool ok = c0 + c4 < nreal;
        const f32x4 t4 = *(const f32x4*)(W + (size_t)(k0 + r) * ldw + (ok ? c0 + c4 : 0));
        v[i] = ok ? t4 : (f32x4){0.f, 0.f, 0.f, 0.f};
    }
#pragma unroll
    for (int i = 0; i < 8; ++i) {
        const int idx = tid + 512 * i, r = idx >> 4, c4 = (idx & 15) * 4;
#pragma unroll
        for (int j = 0; j < 4; ++j) t[(c4 + j) * 264 + r] = (bf16_t)f2bf(v[i][j]);
    }
    __syncthreads();
    const int c = tid >> 3, kc = tid & 7;
    bf16_t* drow = dst + (size_t)dst_row(which, c0 + c) * D + k0 + kc * 32;
#pragma unroll
    for (int j = 0; j < 4; ++j) *(u32x4*)(drow + j * 8) = *(const u32x4*)(t + c * 264 + kc * 32 + j * 8);
}

template <int MODE>
__device__ __forceinline__ void skinny_unit(const Params& P, int l, int c0, unsigned char* lds, int tid) {
    float* tab = (float*)lds;
    const int lane = tid & 63, w = tid >> 6, cl = lane & 31, kh = lane >> 5;
    const float* W; int ldw, nreal;
    if (MODE == 0) { W = P.adaln_w + (size_t)l * D * 3072; ldw = 3072; nreal = 3072; }
    else { W = l ? P.gla_w_in : P.ab_w_in; ldw = l ? N1R : N0R; nreal = ldw; }
    const bool colok = c0 + cl < nreal;
    float acc[33];
#pragma unroll
    for (int r = 0; r < 33; ++r) acc[r] = 0.f;
    for (int half = 0; half < 2; ++half) {
        __syncthreads();
        for (int r = 0; r < 33; ++r) {
            float v;
            if (MODE == 0) v = siluf(r < 32 ? P.c[r * D + half * 512 + tid] : P.c_ctx[half * 512 + tid]);
            else v = P.mod()[((size_t)l * 33 + r) * 3072 + half * 512 + tid];
            tab[tid * 36 + r] = v;
        }
        __syncthreads();
        const int kb = w * 64 + kh * 32;
        const float* wp = W + (size_t)(half * 512 + kb) * ldw + (colok ? c0 + cl : 0);
        float wn[4];
#pragma unroll
        for (int j = 0; j < 4; ++j) wn[j] = wp[(size_t)j * ldw];
#pragma unroll 1
        for (int kk = 0; kk < 32; kk += 4) {
            float wc[4];
#pragma unroll
            for (int j = 0; j < 4; ++j) wc[j] = colok ? wn[j] : 0.f;
            const int kn = kk + 4 < 32 ? kk + 4 : 28;
#pragma unroll
            for (int j = 0; j < 4; ++j) wn[j] = wp[(size_t)(kn + j) * ldw];
#pragma unroll
            for (int j = 0; j < 4; ++j) {
                const int k = kb + kk + j; const float wv = wc[j];
#pragma unroll
                for (int r4 = 0; r4 < 8; ++r4) { const f32x4 s = *(const f32x4*)(tab + k * 36 + r4 * 4); acc[r4 * 4] += s[0] * wv; acc[r4 * 4 + 1] += s[1] * wv; acc[r4 * 4 + 2] += s[2] * wv; acc[r4 * 4 + 3] += s[3] * wv; }
                acc[32] += tab[k * 36 + 32] * wv;
            }
        }
    }
#pragma unroll
    for (int r = 0; r < 33; ++r) acc[r] = sum_xor32(acc[r]);
    __syncthreads();
    if (kh == 0) {
#pragma unroll
        for (int r = 0; r < 33; ++r) tab[(w * 33 + r) * 32 + cl] = acc[r];
    }
    __syncthreads();
    for (int idx = tid; idx < 33 * 32; idx += 512) {
        const int r = idx >> 5, col = idx & 31;
        float s = 0.f;
#pragma unroll
        for (int ww = 0; ww < 8; ++ww) s += tab[(ww * 33 + r) * 32 + col];
        if (MODE == 0) { const int j = c0 + col; P.mod()[((size_t)l * 33 + r) * 3072 + j] = s + P.adaln_b[l * 3072 + j]; }
        else { const int c = c0 + col; (l ? P.bias1() : P.bias0())[r * 3328 + dst_row(l, c)] = c < nreal ? s : 0.f; }
    }
}

constexpr int TICKET_LDS = 140288 + 8;
#define TICKET_LOOP(ctr, N, ...) { volatile int* sh_ = (volatile int*)(lds + TICKET_LDS); unsigned* ctr_ = (unsigned*)(P.ws + OFF_BAR + 14336) + (ctr) * 16; \
        __syncthreads(); if (tidx == 0) *sh_ = (int)__hip_atomic_fetch_add(ctr_, 1u, __ATOMIC_RELAXED, __HIP_MEMORY_SCOPE_AGENT); __syncthreads(); \
        int item = *sh_; \
        while (item < (N)) { unsigned nx_ = 0; if (tidx == 0) nx_ = __hip_atomic_fetch_add(ctr_, 1u, __ATOMIC_RELAXED, __HIP_MEMORY_SCOPE_AGENT); \
            __VA_ARGS__ \
            __syncthreads(); if (tidx == 0) *sh_ = (int)nx_; __syncthreads(); item = *sh_; } }

__device__ __forceinline__ void phase_pro0(const Params& P, unsigned char* lds, int vb, int nvb, int g_wave) {
    const int tidx = otid();
    TICKET_LOOP(0, 192 + 544,
        if (item < 192) skinny_unit<0>(P, item / 96, (item % 96) * 32, lds, tidx);
        else {
            int t = item - 192; int which; const float* W; bf16_t* dst; int ldw, nreal;
            if (t < 208) { which = 0; W = P.ab_w_in; dst = P.Wt0(); ldw = N0R; nreal = N0R; }
            else if ((t -= 208) < 208) { which = 1; W = P.gla_w_in; dst = P.Wt1(); ldw = N1R; nreal = N1R; }
            else if ((t -= 208) < 64) { which = 2; W = P.w_out; dst = P.Wo0(); ldw = D; nreal = D; }
            else { t -= 64; which = 3; W = P.w_out + (size_t)D * D; dst = P.Wo1(); ldw = D; nreal = D; }
            wt_quad(W, ldw, nreal, which, dst, (t >> 2) * 64, (t & 3) * 256, lds, tidx);
        })
    if (vb == nvb - 1 && tidx < 64) {
        float d1 = P.lq1[tidx] * P.lk1[tidx], d2 = P.lq2[tidx] * P.lk2[tidx];
        d1 = sum_xor32(sum_xor16(sum_row16(d1))); d2 = sum_xor32(sum_xor16(sum_row16(d2)));
        if (tidx == 0) P.scal()[0] = expf(d1) - expf(d2) + LAMBDA_INIT;
    }
}

__device__ __forceinline__ void a0_row(const Params& P, int row, int lane) {
    const float* xin = row < ML ? P.x + (size_t)row * D : P.ctx + (size_t)(row - ML) * D;
    const int r = row < ML ? row >> 11 : 32;
    const float* sc = P.mod() + (size_t)r * 3072 + 1024;
    float ss = 0.f;
    f32x4 a[2], b[2], g0[2], g1[2], s0[2], s1[2];
#pragma unroll
    for (int i = 0; i < 2; ++i) {
        const int c0 = i * 512 + lane * 8;
        a[i] = *(const f32x4*)(xin + c0); b[i] = *(const f32x4*)(xin + c0 + 4);
        g0[i] = *(const f32x4*)(P.norm_g + c0); g1[i] = *(const f32x4*)(P.norm_g + c0 + 4);
        s0[i] = *(const f32x4*)(sc + c0); s1[i] = *(const f32x4*)(sc + c0 + 4);
    }
#pragma unroll
    for (int i = 0; i < 2; ++i) {
        const int c0 = i * 512 + lane * 8;
        ss += a[i][0] * a[i][0] + a[i][1] * a[i][1] + a[i][2] * a[i][2] + a[i][3] * a[i][3] + b[i][0] * b[i][0] + b[i][1] * b[i][1] + b[i][2] * b[i][2] + b[i][3] * b[i][3];
        const f32x4 ya = a[i] * g0[i] * (1.0f + s0[i]), yb = b[i] * g1[i] * (1.0f + s1[i]);
        u32x4 o; o.x = cvtpk(ya[0], ya[1]); o.y = cvtpk(ya[2], ya[3]); o.z = cvtpk(yb[0], yb[1]); o.w = cvtpk(yb[2], yb[3]);
        *(u32x4*)(P.A() + (size_t)row * D + c0) = o;
    }
    ss = sum_row16(ss); ss = sum_xor16(ss); ss = sum_xor32(ss);
    if (lane == 0) ((float*)(P.ws + OFF_RS))[row] = rsqrtf(ss * (1.0f / 1024.0f) + EPS);
}

__device__ __forceinline__ void phase_bias_a0(const Params& P, unsigned char* lds, int vb, int nvb, int g_wave) {
    const int tidx = otid();
    const int lane = tidx & 63, w = tidx >> 6;
    TICKET_LOOP(1, 208 + M / 32,
        if (item < 208) skinny_unit<1>(P, item / 104, (item % 104) * 32, lds, tidx);
        else {
            const int row0 = (item - 208) * 32 + w * 4;
            for (int j = 0; j < 4; ++j) a0_row(P, row0 + j, lane);
        })
}

namespace pg8 {
#define PG8_LAS __attribute__((address_space(3)))
typedef unsigned short bf16_t;
typedef short bf16x8 __attribute__((ext_vector_type(8)));
typedef float f32x4 __attribute__((ext_vector_type(4)));
typedef unsigned u32x4 __attribute__((ext_vector_type(4)));
constexpr int BM = 256, BK = 64, HALF = 128, HTB = HALF * BK * 2  , STAGE_BYTES = 8 * HTB, NXCD = 8, WGM = 8;

__host__ __device__ __forceinline__ int lds_byte(int r, int c) { const int st = (r >> 4) * 2 + (c >> 5), rr = r & 15, cc = c & 31, ob = rr * 64 + cc * 2; return st * 1024 + (ob ^ (((ob >> 9) & 1) << 5)); }
__host__ __device__ __forceinline__ void stage_rc(int b, int& R, int& C) { const int st = b / 1024, sb = b % 1024, swz = sb ^ (((sb >> 9) & 1) << 5); R = (st >> 1) * 16 + swz / 64; C = (st & 1) * 32 + (swz % 64) / 2; }
__host__ __device__ __forceinline__ int perm32(int rho) { const int n = rho >> 4, i = rho & 15; return 8 * (i >> 2) + 4 * n + (i & 3); }

struct Unit { int pm, pn; };
struct Gemm { const bf16_t* A; const bf16_t* Bt; int M, N, K; };

struct StaticOrder {
    int nM, nN, nwg, G, c;
    __host__ __device__ void init(int M, int N, int G_, int c_) { nM = M / BM; nN = N / BM; nwg = nM * nN; G = G_; c = c_; }
    __host__ __device__ bool next(int i, Unit& u) const {
        const long L = (long)i * G + c; if (L >= nwg) return false;
        int wgid = (int)L; { const int q = nwg / NXCD, r = nwg % NXCD, xcd = wgid % NXCD, off = wgid / NXCD; wgid = (xcd < r ? xcd * (q + 1) : r * (q + 1) + (xcd - r) * q) + off; }
        const int nig = WGM * nN, gid = wgid / nig, fm = gid * WGM, gsz = (nM - fm) < WGM ? (nM - fm) : WGM;
        u.pm = fm + ((wgid % nig) % gsz); u.pn = (wgid % nig) / gsz; return true;
    }
    __device__ __forceinline__ void a_ready(const Unit&) const {}
    __device__ __forceinline__ void done(const Unit&) const {}
};
template <class Epi, class Sched, bool ALIGN_EPI = false, bool SP2 = false>
__device__ __forceinline__ void gemm_phase(PG8_LAS unsigned char* lds, const Gemm g, const Sched& S, const Epi& E, int g_wave) {
    const int tid = otid(), wid = __builtin_amdgcn_readfirstlane(tid >> 6), lane = tid & 63, wr = wid >> 2, wc = wid & 3, fr = lane & 15, fq = lane >> 4;
    const int K = g.K, nt = K / BK;
    unsigned voffA[2], voffB[2];
#pragma unroll
    for (int i = 0; i < 2; ++i) { int R, C; stage_rc(tid * 16 + i * 8192, R, C); const int Rb = Epi::PERM ? ((R & ~31) + perm32(R & 31)) : R;
        voffA[i] = (unsigned)(R * K + C) * 2u; voffB[i] = (unsigned)(Rb * K + C) * 2u; }
    const size_t kstep = (size_t)(BK * 2);
    const size_t hstep = (size_t)HALF * K * 2;
    const size_t tstep = 2 * hstep;
    const unsigned ldsw = (unsigned)wid * 1024u;
    const int aoff = lds_byte(wr * 64 + fr, fq * 8), boff = lds_byte(wc * 32 + fr, fq * 8);
#define PG8_SA(b, h) (((b) * 2 + (h)) * HTB)
#define PG8_SB(b, h) ((4 + (b) * 2 + (h)) * HTB)
#define PG8_STAGE(bufoff, gbase, voff) do { _Pragma("unroll") for (int _i = 0; _i < 2; ++_i) \
        __builtin_amdgcn_global_load_lds((const unsigned*)((const char*)(gbase) + (voff)[_i]), (PG8_LAS unsigned*)(lds + (bufoff) + ldsw + _i * 8192), 16, 0, 0); } while (0)
#define PG8_LDA(dst, b, h) do { _Pragma("unroll") for (int m = 0; m < 4; ++m) _Pragma("unroll") for (int k = 0; k < 2; ++k) dst[m][k] = *(const PG8_LAS bf16x8*)(lds + PG8_SA(b, h) + aoff + m * 2048 + k * 1024); } while (0)
#define PG8_LDB(dst, b, h) do { _Pragma("unroll") for (int n = 0; n < 2; ++n) _Pragma("unroll") for (int k = 0; k < 2; ++k) dst[n][k] = *(const PG8_LAS bf16x8*)(lds + PG8_SB(b, h) + boff + n * 2048 + k * 1024); } while (0)
#define PG8_MMA(ai, bj, At, Bt) do { __builtin_amdgcn_s_setprio(1); _Pragma("unroll") for (int m = 0; m < 4; ++m) _Pragma("unroll") for (int n = 0; n < 2; ++n) _Pragma("unroll") for (int k = 0; k < 2; ++k) \
        acc[ai][bj][m][n] = __builtin_amdgcn_mfma_f32_16x16x32_bf16(Bt[n][k], At[m][k], acc[ai][bj][m][n], 0, 0, 0); __builtin_amdgcn_s_setprio(0); } while (0)
#define PG8_WAIT_V(n) asm volatile("s_waitcnt vmcnt(" #n ")" ::: "memory")
#define PG8_WAIT_L(n) asm volatile("s_waitcnt lgkmcnt(" #n ")" ::: "memory")
#define PG8_BAR __builtin_amdgcn_s_barrier()
#define PG8_SCHED __builtin_amdgcn_sched_barrier(0)
    Unit cur, nxt; int ui = 0;
    if (!S.next(0, cur)) return;
    f32x4 acc[2][2][4][2];
#pragma unroll
    for (int a = 0; a < 2; ++a)
#pragma unroll
        for (int b = 0; b < 2; ++b)
#pragma unroll
            for (int m = 0; m < 4; ++m)
#pragma unroll
                for (int n = 0; n < 2; ++n) acc[a][b][m][n] = (f32x4){0.f, 0.f, 0.f, 0.f};
    bf16x8 At[4][2], B0[2][2], B1[2][2];
    const char* cA = (const char*)g.A + (size_t)cur.pm * tstep; const char* cB = (const char*)g.Bt + (size_t)cur.pn * tstep;
    S.a_ready(cur);
    if constexpr (SP2) {
        PG8_STAGE(PG8_SB(0, 0), cB, voffB); PG8_STAGE(PG8_SB(0, 1), cB + hstep, voffB); PG8_STAGE(PG8_SA(0, 0), cA, voffA); PG8_STAGE(PG8_SA(0, 1), cA + hstep, voffA);
        if (wr == 1) PG8_BAR;
        PG8_WAIT_V(2); PG8_BAR;
        PG8_STAGE(PG8_SB(1, 0), cB + kstep, voffB); PG8_STAGE(PG8_SA(1, 0), cA + kstep, voffA); PG8_STAGE(PG8_SB(1, 1), cB + hstep + kstep, voffB);
        PG8_WAIT_V(6); PG8_BAR;
    } else {
        PG8_STAGE(PG8_SB(0, 0), cB, voffB); PG8_STAGE(PG8_SA(0, 0), cA, voffA); PG8_STAGE(PG8_SB(0, 1), cB + hstep, voffB); PG8_STAGE(PG8_SA(0, 1), cA + hstep, voffA);
        if (wr == 1) PG8_BAR;
        PG8_WAIT_V(4); PG8_BAR;
        PG8_STAGE(PG8_SB(1, 0), cB + kstep, voffB); PG8_STAGE(PG8_SA(1, 0), cA + kstep, voffA); PG8_STAGE(PG8_SB(1, 1), cB + hstep + kstep, voffB);
        PG8_WAIT_V(6); PG8_BAR;
    }
    for (;;) {
        const bool has_next = S.next(ui + 1, nxt);
        const char* nA = has_next ? (const char*)g.A + (size_t)nxt.pm * tstep : cA; const char* nB = has_next ? (const char*)g.Bt + (size_t)nxt.pn * tstep : cB;
        for (int t = 0; t < nt; t += 2) {
            const bool last = (t == nt - 2);
            const char* a1 = cA + (size_t)(t + 1) * kstep;
            const char* a2 = last ? nA : cA + (size_t)(t + 2) * kstep; const char* b2 = last ? nB : cB + (size_t)(t + 2) * kstep;
            const char* a3 = a2 + kstep; const char* b3 = b2 + kstep;
            if (last && has_next) S.a_ready(nxt);
            if constexpr (SP2) {
            PG8_LDB(B0, 0, 0); PG8_LDB(B1, 0, 1); PG8_SCHED; PG8_LDA(At, 0, 0); PG8_STAGE(PG8_SA(1, 1), a1 + hstep, voffA);
            PG8_WAIT_V(8); PG8_WAIT_L(0); PG8_BAR; PG8_MMA(0, 0, At, B0); PG8_MMA(0, 1, At, B1); PG8_BAR; PG8_SCHED;
            PG8_LDA(At, 0, 1); PG8_STAGE(PG8_SB(0, 0), b2, voffB); PG8_STAGE(PG8_SB(0, 1), b2 + hstep, voffB); PG8_STAGE(PG8_SA(0, 0), a2, voffA);
            PG8_WAIT_V(8); PG8_WAIT_L(0); PG8_BAR; PG8_MMA(1, 0, At, B0); PG8_MMA(1, 1, At, B1); PG8_BAR; PG8_SCHED;
            PG8_LDB(B0, 1, 0); PG8_LDB(B1, 1, 1); PG8_SCHED; PG8_LDA(At, 1, 0); PG8_STAGE(PG8_SA(0, 1), a2 + hstep, voffA);
            PG8_WAIT_V(8); PG8_WAIT_L(0); PG8_BAR; PG8_MMA(0, 0, At, B0); PG8_MMA(0, 1, At, B1); PG8_BAR; PG8_SCHED;
            PG8_LDA(At, 1, 1); PG8_STAGE(PG8_SB(1, 0), b3, voffB); PG8_STAGE(PG8_SB(1, 1), b3 + hstep, voffB); PG8_STAGE(PG8_SA(1, 0), a3, voffA);
            PG8_WAIT_V(8); PG8_WAIT_L(0); PG8_BAR; PG8_MMA(1, 0, At, B0); PG8_MMA(1, 1, At, B1); PG8_BAR; PG8_SCHED;
            } else {
            PG8_LDB(B0, 0, 0); PG8_SCHED; PG8_LDA(At, 0, 0); PG8_STAGE(PG8_SA(1, 1), a1 + hstep, voffA);
            PG8_WAIT_L(8); PG8_BAR; PG8_WAIT_L(0); PG8_MMA(0, 0, At, B0); PG8_BAR; PG8_SCHED;
            PG8_LDB(B1, 0, 1); PG8_STAGE(PG8_SB(0, 0), b2, voffB);
            PG8_BAR; PG8_WAIT_L(0); PG8_MMA(0, 1, At, B1); PG8_BAR;
            PG8_LDA(At, 0, 1); PG8_STAGE(PG8_SA(0, 0), a2, voffA);
            PG8_BAR; PG8_WAIT_L(0); PG8_MMA(1, 0, At, B0); PG8_BAR; PG8_SCHED;
            PG8_STAGE(PG8_SB(0, 1), b2 + hstep, voffB);
            PG8_WAIT_V(6); PG8_BAR; PG8_MMA(1, 1, At, B1); PG8_BAR;
            PG8_LDB(B0, 1, 0); PG8_SCHED; PG8_LDA(At, 1, 0); PG8_STAGE(PG8_SA(0, 1), a2 + hstep, voffA);
            PG8_WAIT_L(8); PG8_BAR; PG8_WAIT_L(0); PG8_MMA(0, 0, At, B0); PG8_BAR; PG8_SCHED;
            PG8_LDB(B1, 1, 1); PG8_STAGE(PG8_SB(1, 0), b3, voffB);
            PG8_BAR; PG8_WAIT_L(0); PG8_MMA(0, 1, At, B1); PG8_BAR;
            PG8_LDA(At, 1, 1); PG8_STAGE(PG8_SA(1, 0), a3, voffA);
            PG8_BAR; PG8_WAIT_L(0); PG8_MMA(1, 0, At, B0); PG8_BAR; PG8_SCHED;
            PG8_STAGE(PG8_SB(1, 1), b3 + hstep, voffB);
            PG8_WAIT_V(6); PG8_BAR; PG8_MMA(1, 1, At, B1); PG8_BAR;
            }
        }
        if constexpr (ALIGN_EPI) { if (wr == 0) PG8_BAR; }
        if constexpr (!Epi::AFTER_DRAIN) { E(acc, cur, wr, wc, fr, fq); S.done(cur); }
        if (!has_next) break;
#pragma unroll
        for (int a = 0; a < 2; ++a)
#pragma unroll
            for (int b = 0; b < 2; ++b)
#pragma unroll
                for (int m = 0; m < 4; ++m)
#pragma unroll
                    for (int n = 0; n < 2; ++n) acc[a][b][m][n] = (f32x4){0.f, 0.f, 0.f, 0.f};
        cur = nxt; cA = nA; cB = nB; ++ui;
        if constexpr (ALIGN_EPI) { if (wr == 1) PG8_BAR; }
    }
    PG8_WAIT_V(0);
    if constexpr (!ALIGN_EPI) { if (wr == 0) PG8_BAR; }
    PG8_BAR;
    if constexpr (Epi::AFTER_DRAIN) { E.fused(acc, cur, wr, wc, fr, fq, lds, wid, lane); S.done(cur); }
#undef PG8_SA
#undef PG8_SB
#undef PG8_STAGE
#undef PG8_LDA
#undef PG8_LDB
#undef PG8_MMA
#undef PG8_WAIT_V
#undef PG8_WAIT_L
#undef PG8_BAR
#undef PG8_SCHED
}
}

struct OrderIn1 {
    pg8::StaticOrder base; int G, c;
    __device__ void init(int G_, int c_) { base.init(ML, N1, G_, c_); G = G_; c = c_; }
    __device__ bool next(int i, pg8::Unit& u) const {
        const int Lx = i * G + c;
        if (Lx < 256 * 13) return base.next(i, u);
        const int r = Lx - 256 * 13; if (r >= 32 * 7) return false;
        const int j = r >> 5; u.pm = 256 + (r & 31); u.pn = j < 6 ? 2 + j : 12; return true;
    }
    __device__ __forceinline__ void a_ready(const pg8::Unit&) const {}
    __device__ __forceinline__ void done(const pg8::Unit&) const {}
};

struct EpiIn0 {
    unsigned char* ws;
    const float *aqn, *akn, *bqn, *bkn;
    static constexpr bool PERM = false, AFTER_DRAIN = false;
    __device__ __forceinline__ void operator()(const f32x4 (&acc)[2][2][4][2], const pg8::Unit& u, int wr, int wc, int fr, int fq) const { (*this)(acc, u.pm, u.pn, wr, wc, fr, fq); }
    __device__ __forceinline__ void operator()(const f32x4 (&acc)[2][2][4][2], int pm, int pn, int wr, int wc, int fr, int fq) const {
        const int g = 4 * pn + wc;
        const float* rs = (const float*)(ws + OFF_RS);
        size_t doff; int ld, col, type; const float* gain = aqn;
        if (g < 8) { doff = OFF_QA; ld = 512; col = g * 64; type = 2; gain = aqn; }
        else if (g < 10) { doff = OFF_KA; ld = 128; col = (g - 8) * 64; type = 3; gain = akn; }
        else if (g < 12) { doff = OFF_VA; ld = 128; col = (g - 10) * 64; type = 0; }
        else if (g < 20) { doff = OFF_GA; ld = 512; col = (g - 12) * 64; type = 1; }
        else if (g < 28) { doff = OFF_QB; ld = 512; col = (g - 20) * 64; type = 2; gain = bqn; }
        else if (g < 36) { doff = OFF_KB; ld = 512; col = (g - 28) * 64; type = 3; gain = bkn; }
        else if (g < 44) { doff = OFF_VB; ld = 512; col = (g - 36) * 64; type = 0; }
        else { doff = OFF_GB; ld = 512; col = (g - 44) * 64; type = 1; }
        bf16_t* dst = (bf16_t*)(ws + doff);
        const bool lat = pm < 256; const int r = lat ? pm >> 3 : 32;
        const float* bptr = (const float*)(ws + OFF_BIAS0) + (size_t)r * 3328 + pn * 256 + wc * 32 + fq * 4;
        f32x4 bia[2][2], gn[2][2];
        const float qs = type == 2 ? QSCALE : 1.0f;
#pragma unroll
        for (int bj = 0; bj < 2; ++bj)
#pragma unroll
            for (int n = 0; n < 2; ++n) { bia[bj][n] = *(const f32x4*)(bptr + bj * 128 + n * 16); gn[bj][n] = *(const f32x4*)(gain + bj * 32 + n * 16 + fq * 4) * qs; }
        float rsv[2][4];
#pragma unroll
        for (int ai = 0; ai < 2; ++ai)
#pragma unroll
            for (int m = 0; m < 4; ++m) rsv[ai][m] = rs[pm * 256 + ai * 128 + wr * 64 + m * 16 + fr];
        float frq[4];
#pragma unroll
        for (int e = 0; e < 4; ++e) frq[e] = __builtin_amdgcn_exp2f(-(float)(fq * 4 + e) * 0.830482023721841f) * 0.15915494309189535f;
#pragma unroll
        for (int ai = 0; ai < 2; ++ai) {
            const float prow = (float)((pm * 4 + ai * 2 + wr) & 31);
            int fro = fr; asm volatile("" : "+v"(fro));
#pragma unroll
            for (int m = 0; m < 4; ++m) {
                const int row = pm * 256 + ai * 128 + wr * 64 + m * 16 + fr;
                const float rstd = rsv[ai][m];
                f32x4 v[2][2];
#pragma unroll
                for (int bj = 0; bj < 2; ++bj)
#pragma unroll
                    for (int n = 0; n < 2; ++n) v[bj][n] = acc[ai][bj][m][n] * rstd + bia[bj][n];
                if (type >= 2) {
                    float s2 = 0.f;
#pragma unroll
                    for (int bj = 0; bj < 2; ++bj)
#pragma unroll
                        for (int n = 0; n < 2; ++n) s2 += v[bj][n][0] * v[bj][n][0] + v[bj][n][1] * v[bj][n][1] + v[bj][n][2] * v[bj][n][2] + v[bj][n][3] * v[bj][n][3];
                    s2 = sum_xor16(s2); s2 = sum_xor32(s2);
                    const float rn = rsqrtf(s2 * (1.0f / 64.0f) + EPS);
#pragma unroll
                    for (int bj = 0; bj < 2; ++bj)
#pragma unroll
                        for (int n = 0; n < 2; ++n) v[bj][n] = v[bj][n] * rn * gn[bj][n];
                    if (lat) {
                        const float pcol = (float)(m * 16 + fro);
#pragma unroll
                        for (int bj = 0; bj < 2; ++bj) {
                            const float pos = bj ? pcol : prow;
#pragma unroll
                            for (int e = 0; e < 4; ++e) {
                                const float rev = pos * frq[e];
                                const float cc = __builtin_amdgcn_cosf(rev), sn = __builtin_amdgcn_sinf(rev);
                                const float x1 = v[bj][0][e], x2 = v[bj][1][e]; v[bj][0][e] = x1 * cc - x2 * sn; v[bj][1][e] = x2 * cc + x1 * sn;
                            }
                        }
                    }
                } else if (type == 1) {
#pragma unroll
                    for (int bj = 0; bj < 2; ++bj)
#pragma unroll
                        for (int n = 0; n < 2; ++n)
#pragma unroll
                            for (int e = 0; e < 4; ++e) v[bj][n][e] = siluf(v[bj][n][e]);
                }
#pragma unroll
                for (int bj = 0; bj < 2; ++bj) {
                    u32x4 o; o.x = cvtpk(v[bj][0][0], v[bj][0][1]); o.y = cvtpk(v[bj][0][2], v[bj][0][3]); o.z = cvtpk(v[bj][1][0], v[bj][1][1]); o.w = cvtpk(v[bj][1][2], v[bj][1][3]);
                    *(u32x4*)(dst + (size_t)row * ld + col + bj * 32 + fq * 8) = o;
                }
            }
        }
    }
};

struct EpiIn1 {
    unsigned char* ws;
    static constexpr bool PERM = false, AFTER_DRAIN = false;
    __device__ __forceinline__ void operator()(const f32x4 (&acc)[2][2][4][2], const pg8::Unit& u, int wr, int wc, int fr, int fq) const { (*this)(acc, u.pm, u.pn, wr, wc, fr, fq); }
    __device__ __forceinline__ void operator()(const f32x4 (&acc)[2][2][4][2], int pm, int pn, int wr, int wc, int fr, int fq) const {
        const int g = 4 * pn + wc;
        if (g > 48) return;
        const float* rs = (const float*)(ws + OFF_RS); float* RF = (float*)(ws + OFF_RF);
        size_t doff = OFF_QG; int ld = 0, col = 0, type;
        if (g < 8) { doff = OFF_QG; ld = 512; col = g * 64; type = 2; }
        else if (g < 16) { doff = OFF_KG; ld = 512; col = (g - 8) * 64; type = 0; }
        else if (g < 32) { doff = OFF_VG; ld = 1024; col = (g - 16) * 64; type = 0; }
        else if (g < 48) { doff = OFF_GG; ld = 1024; col = (g - 32) * 64; type = 1; }
        else type = 3;
        bf16_t* dst = (bf16_t*)(ws + doff);
        const int r = pm < 256 ? pm >> 3 : 32;
        const float* bptr = (const float*)(ws + OFF_BIAS1) + (size_t)r * 3328 + pn * 256 + wc * 32 + fq * 4;
        f32x4 bia[2][2];
#pragma unroll
        for (int bj = 0; bj < 2; ++bj)
#pragma unroll
            for (int n = 0; n < 2; ++n) bia[bj][n] = *(const f32x4*)(bptr + bj * 128 + n * 16);
        float rsv[2][4];
#pragma unroll
        for (int ai = 0; ai < 2; ++ai)
#pragma unroll
            for (int m = 0; m < 4; ++m) rsv[ai][m] = rs[pm * 256 + ai * 128 + wr * 64 + m * 16 + fr];
        const float sc = type == 2 ? 0.08838834764831845f : 1.0f;
#pragma unroll
        for (int ai = 0; ai < 2; ++ai)
#pragma unroll
            for (int m = 0; m < 4; ++m) {
                const int row = pm * 256 + ai * 128 + wr * 64 + m * 16 + fr;
                const float rstd = rsv[ai][m];
                f32x4 v[2][2];
#pragma unroll
                for (int bj = 0; bj < 2; ++bj)
#pragma unroll
                    for (int n = 0; n < 2; ++n) v[bj][n] = (acc[ai][bj][m][n] * rstd + bia[bj][n]) * sc;
                if (type == 3) {
                    *(f32x4*)(RF + (size_t)row * 32 + fq * 8) = v[0][0];
                    *(f32x4*)(RF + (size_t)row * 32 + fq * 8 + 4) = v[0][1];
                    continue;
                }
                if (type == 1) {
#pragma unroll
                    for (int bj = 0; bj < 2; ++bj)
#pragma unroll
                        for (int n = 0; n < 2; ++n)
#pragma unroll
                            for (int e = 0; e < 4; ++e) v[bj][n][e] = siluf(v[bj][n][e]);
                }
#pragma unroll
                for (int bj = 0; bj < 2; ++bj) {
                    u32x4 o; o.x = cvtpk(v[bj][0][0], v[bj][0][1]); o.y = cvtpk(v[bj][0][2], v[bj][0][3]); o.z = cvtpk(v[bj][1][0], v[bj][1][1]); o.w = cvtpk(v[bj][1][2], v[bj][1][3]);
                    *(u32x4*)(dst + (size_t)row * ld + col + bj * 32 + fq * 8) = o;
                }
            }
    }
};

struct EpiOut0 {
    const float *x, *ctx, *g1; float* out; unsigned char* ws;
    static constexpr bool PERM = false, AFTER_DRAIN = false;
    __device__ __forceinline__ void operator()(const f32x4 (&acc)[2][2][4][2], const pg8::Unit& u, int wr, int wc, int fr, int fq) const { (*this)(acc, u.pm, u.pn, wr, wc, fr, fq); }
    __device__ __forceinline__ void operator()(const f32x4 (&acc)[2][2][4][2], int pm, int pn, int wr, int wc, int fr, int fq) const {
        const float* mod = (const float*)(ws + OFF_MOD); bf16_t* A1 = (bf16_t*)(ws + OFF_A); float* parts = (float*)(ws + OFF_PARTS);
        const bool lat = pm < 256; const int r = lat ? pm >> 3 : 32;
        const int c0 = pn * 256 + wc * 64 + fq * 8;
        const float* gt = mod + (size_t)r * 3072 + 2048 + c0;
        const float* sc = mod + (size_t)(33 + r) * 3072 + 1024 + c0;
        f32x4 gtv[2][2], csv[2][2];
#pragma unroll
        for (int bj = 0; bj < 2; ++bj)
#pragma unroll
            for (int n = 0; n < 2; ++n) { gtv[bj][n] = *(const f32x4*)(gt + bj * 32 + n * 4); csv[bj][n] = *(const f32x4*)(g1 + c0 + bj * 32 + n * 4) * (1.0f + *(const f32x4*)(sc + bj * 32 + n * 4)); }
        const float* xbase = (lat ? x + (size_t)(pm * 256) * D : ctx + (size_t)(pm * 256 - ML) * D) + (size_t)(wr * 64 + fr) * D + c0;
        f32x4 xv[2][2][2];
#define EO0_LOAD(ri) do { const float* xp = xbase + (size_t)(((ri) >> 2) * 128 + ((ri) & 3) * 16) * D; \
            _Pragma("unroll") for (int bj = 0; bj < 2; ++bj) _Pragma("unroll") for (int n = 0; n < 2; ++n) xv[(ri) & 1][bj][n] = *(const f32x4*)(xp + bj * 32 + n * 4); } while (0)
        EO0_LOAD(0);
#pragma unroll
        for (int ri = 0; ri < 8; ++ri) {
            if (ri < 7) EO0_LOAD(ri + 1);
            {
                const int ai = ri >> 2, m = ri & 3;
                const int row = pm * 256 + ai * 128 + wr * 64 + m * 16 + fr;
                float ss = 0.f;
#pragma unroll
                for (int bj = 0; bj < 2; ++bj) {
                    f32x4 y[2], xk[2];
#pragma unroll
                    for (int n = 0; n < 2; ++n) {
                        const f32x4 x1 = xv[ri & 1][bj][n] + gtv[bj][n] * acc[ai][bj][m][n];
                        ss += x1[0] * x1[0] + x1[1] * x1[1] + x1[2] * x1[2] + x1[3] * x1[3];
                        xk[n] = x1;
                        y[n] = x1 * csv[bj][n];
                    }
                    u32x4 o; o.x = cvtpk(y[0][0], y[0][1]); o.y = cvtpk(y[0][2], y[0][3]); o.z = cvtpk(y[1][0], y[1][1]); o.w = cvtpk(y[1][2], y[1][3]);
                    *(u32x4*)(A1 + (size_t)row * D + c0 + bj * 32) = o;
                    if (lat) { u32x4 xb; xb.x = cvtpk(xk[0][0], xk[0][1]); xb.y = cvtpk(xk[0][2], xk[0][3]); xb.z = cvtpk(xk[1][0], xk[1][1]); xb.w = cvtpk(xk[1][2], xk[1][3]);
                        *(u32x4*)((bf16_t*)(ws + OFF_X1B) + (size_t)row * D + c0 + bj * 32) = xb; }
                }
                ss = sum_xor16(ss); ss = sum_xor32(ss);
                if (fq == 0) parts[(size_t)(4 * pn + wc) * M + row] = ss;
            }
            __builtin_amdgcn_sched_barrier(0);
        }
#undef EO0_LOAD
    }
};

struct EpiOut1 {
    unsigned char* ws; float* out;
    static constexpr bool PERM = false, AFTER_DRAIN = false;
    __device__ __forceinline__ void operator()(f32x4 (&acc)[2][2][4][2], const pg8::Unit& u, int wr, int wc, int fr, int fq) const {
        const int pm = u.pm, pn = u.pn;
        const int r = pm >> 3, c0 = pn * 256 + wc * 64 + fq * 8;
        const float* gt = (const float*)(ws + OFF_MOD) + (size_t)(33 + r) * 3072 + 2048 + c0;
        f32x4 gtv[2][2];
#pragma unroll
        for (int bj = 0; bj < 2; ++bj)
#pragma unroll
            for (int n = 0; n < 2; ++n) gtv[bj][n] = *(const f32x4*)(gt + bj * 32 + n * 4);
        const bf16_t* xbase = (const bf16_t*)(ws + OFF_X1B) + (size_t)(pm * 256 + wr * 64 + fr) * D + c0;
        u32x4 xv[4][2];
#define EO1_LOAD(ri) do { const bf16_t* xp = xbase + (size_t)(((ri) >> 2) * 128 + ((ri) & 3) * 16) * D; \
            xv[(ri) & 3][0] = *(const u32x4*)(xp); xv[(ri) & 3][1] = *(const u32x4*)(xp + 32); } while (0)
        EO1_LOAD(0); EO1_LOAD(1); EO1_LOAD(2); EO1_LOAD(3);
#pragma unroll
        for (int ri = 0; ri < 8; ++ri) {
            const int ai = ri >> 2, m = ri & 3;
#pragma unroll
            for (int bj = 0; bj < 2; ++bj) {
                const u32x4 w = xv[ri & 3][bj];
                const f32x4 x0 = (f32x4){bflo(w.x), bfhi(w.x), bflo(w.y), bfhi(w.y)}, x1 = (f32x4){bflo(w.z), bfhi(w.z), bflo(w.w), bfhi(w.w)};
                acc[ai][bj][m][0] = x0 + gtv[bj][0] * acc[ai][bj][m][0];
                acc[ai][bj][m][1] = x1 + gtv[bj][1] * acc[ai][bj][m][1];
            }
            if (ri + 4 < 8) EO1_LOAD(ri + 4);
            __builtin_amdgcn_sched_barrier(0);
        }
#undef EO1_LOAD
        float* obase = out + (size_t)(pm * 256 + wr * 64 + fr) * D + c0;
#pragma unroll
        for (int ri = 0; ri < 8; ++ri) {
            const int ai = ri >> 2, m = ri & 3;
            float* op = obase + (size_t)(ai * 128 + m * 16) * D;
#pragma unroll
            for (int bj = 0; bj < 2; ++bj)
#pragma unroll
                for (int n = 0; n < 2; ++n) *(f32x4*)(op + bj * 32 + n * 4) = acc[ai][bj][m][n];
        }
    }
};

typedef float f32x16 __attribute__((ext_vector_type(16)));
typedef short s16x4 __attribute__((ext_vector_type(4)));
#define LDSAS __attribute__((address_space(3)))
__device__ __forceinline__ int crow(int r, int hi) { return (r & 3) + 8 * (r >> 2) + 4 * hi; }
__device__ __forceinline__ s16x4 vtr(const LDSAS unsigned char* p) { return __builtin_bit_cast(s16x4, __builtin_amdgcn_ds_read_tr16_b64_v4i16((LDSAS s16x4*)p)); }

constexpr int AB_K1 = 0, AB_K2 = 16384, AB_V = 32768, AB_Q = 65536;
static_assert(AB_Q + 65536 <= 134144, "attention B LDS map");
__device__ __forceinline__ float fadd_s(float a, float b) { float r; asm("v_add_f32_e32 %0, %1, %2" : "=v"(r) : "v"(a), "v"(b)); return r; }

__device__ __forceinline__ void attnB_unit(const Params& P, LDSAS unsigned char* lds, int b, int h, int qrow0, int t_begin, int t_end, int g_wave) {
    const int tid = otid(), lane = tid & 63, r32 = lane & 31, hi = lane >> 5;
    const int wid = __builtin_amdgcn_readfirstlane(tid >> 6);
    LDSAS unsigned char* qlds = lds + AB_Q + wid * 8192 + r32 * 256;
    {
        const bf16_t* qg = P.QB() + (size_t)(qrow0 + wid * 32 + r32) * 512 + (2 * h) * 64 + hi * 8;
#pragma unroll
        for (int c2 = 0; c2 < 8; ++c2) {
            const u32x4 v = *(const u32x4*)(qg + (c2 >> 2) * 64 + (c2 & 3) * 16);
            *(LDSAS u32x4*)(qlds + (((2 * c2 + hi) ^ (r32 & 15)) * 16)) = v;
        }
    }
    f32x16 o1[4], o2[4];
#pragma unroll
    for (int i = 0; i < 4; ++i) { o1[i] = (f32x16){}; o2[i] = (f32x16){}; }
    float l1 = 0.f, l2 = 0.f;
    const int krow = tid >> 3, kch = tid & 7, vrow = tid >> 4, vch = tid & 15;
    const int kwoff = krow * 128 + ((kch ^ ((krow >> 1) & 7)) * 16);
    const int vwoff = (vch >> 2) * 4096 + vrow * 64 + (vch & 3) * 16;
    u32x4 rk1, rk2, rv0, rv1;
#define AB_GLOAD(t) do { const int kr0_ = (t) < 32 ? b * 2048 + 64 * (t) : ML + b * 256 + 64 * ((t) - 32); \
        rk1 = *(const u32x4*)(P.KB() + (size_t)(kr0_ + krow) * 512 + (2 * h) * 64 + kch * 8); \
        rk2 = *(const u32x4*)(P.KB() + (size_t)(kr0_ + krow) * 512 + (2 * h + 1) * 64 + kch * 8); \
        rv0 = *(const u32x4*)(P.VB() + (size_t)(kr0_ + vrow) * 512 + h * 128 + vch * 8); \
        rv1 = *(const u32x4*)(P.VB() + (size_t)(kr0_ + vrow + 32) * 512 + h * 128 + vch * 8); } while (0)
#define AB_LWRITE(buf) do { *(LDSAS u32x4*)(lds + AB_K1 + (buf) * 8192 + kwoff) = rk1; *(LDSAS u32x4*)(lds + AB_K2 + (buf) * 8192 + kwoff) = rk2; \
        *(LDSAS u32x4*)(lds + AB_V + (buf) * 16384 + vwoff) = rv0; *(LDSAS u32x4*)(lds + AB_V + (buf) * 16384 + vwoff + 2048) = rv1; } while (0)
#define AB_SCORES(sub, LSUM, PW) do { const LDSAS unsigned char* kb_ = lds + ((sub) ? AB_K2 : AB_K1) + buf * 8192 + r32 * 128; \
        f32x16 p0 = (f32x16){}, p1 = (f32x16){}; \
        _Pragma("unroll") for (int d0 = 0; d0 < 4; ++d0) { const int co = ((2 * d0 + hi) ^ ksw) * 16; \
            const bf16x8 qf = *(const LDSAS bf16x8*)(qlds + (((2 * (4 * (sub) + d0) + hi) ^ (r32 & 15)) * 16)); \
            const bf16x8 k0 = *(const LDSAS bf16x8*)(kb_ + co), k1 = *(const LDSAS bf16x8*)(kb_ + 4096 + co); \
            p0 = __builtin_amdgcn_mfma_f32_32x32x16_bf16(k0, qf, p0, 0, 0, 0); p1 = __builtin_amdgcn_mfma_f32_32x32x16_bf16(k1, qf, p1, 0, 0, 0); } \
        float ls_ = 0.f; \
        _Pragma("unroll") for (int r = 0; r < 16; ++r) { p0[r] = __builtin_amdgcn_exp2f(p0[r]); p1[r] = __builtin_amdgcn_exp2f(p1[r]); ls_ = fadd_s(ls_, p0[r]); ls_ = fadd_s(ls_, p1[r]); } \
        LSUM += ls_; \
        PW[0].x = cvtpk(p0[0], p0[1]); PW[0].y = cvtpk(p0[2], p0[3]); PW[0].z = cvtpk(p0[4], p0[5]); PW[0].w = cvtpk(p0[6], p0[7]); \
        PW[1].x = cvtpk(p0[8], p0[9]); PW[1].y = cvtpk(p0[10], p0[11]); PW[1].z = cvtpk(p0[12], p0[13]); PW[1].w = cvtpk(p0[14], p0[15]); \
        PW[2].x = cvtpk(p1[0], p1[1]); PW[2].y = cvtpk(p1[2], p1[3]); PW[2].z = cvtpk(p1[4], p1[5]); PW[2].w = cvtpk(p1[6], p1[7]); \
        PW[3].x = cvtpk(p1[8], p1[9]); PW[3].y = cvtpk(p1[10], p1[11]); PW[3].z = cvtpk(p1[12], p1[13]); PW[3].w = cvtpk(p1[14], p1[15]); } while (0)
    const int ksw = (r32 >> 1) & 7;
    const int vroff = AB_V + (4 * hi + ((lane & 15) >> 2)) * 64 + ((lane >> 4) & 1) * 32 + (lane & 3) * 8;
    AB_GLOAD(t_begin); AB_LWRITE(0); __syncthreads();
    for (int t = t_begin; t < t_end; ++t) {
        const int buf = (t - t_begin) & 1;
        u32x4 pw1[4], pw2[4];
        AB_SCORES(0, l1, pw1);
        __builtin_amdgcn_sched_barrier(0);
        AB_SCORES(1, l2, pw2);
        __builtin_amdgcn_sched_barrier(0);
        if (t + 1 < t_end) AB_GLOAD(t + 1);
        const LDSAS unsigned char* vb = lds + buf * 16384 + vroff;
        s16x4 vlo[2][4], vhi[2][4];
#define AB_VLOAD(slot, d0) do { _Pragma("unroll") for (int ks = 0; ks < 4; ++ks) { vlo[slot][ks] = vtr(vb + (d0) * 4096 + ks * 1024); vhi[slot][ks] = vtr(vb + (d0) * 4096 + ks * 1024 + 512); } } while (0)
        AB_VLOAD(0, 0);
#pragma unroll
        for (int d0 = 0; d0 < 4; ++d0) {
            if (d0 < 3) AB_VLOAD((d0 + 1) & 1, d0 + 1);
            __builtin_amdgcn_sched_barrier(0);
#pragma unroll
            for (int ks = 0; ks < 4; ++ks) {
                const s16x4 lo = vlo[d0 & 1][ks], hh = vhi[d0 & 1][ks];
                const bf16x8 vf = (bf16x8){lo[0], lo[1], lo[2], lo[3], hh[0], hh[1], hh[2], hh[3]};
                o1[d0] = __builtin_amdgcn_mfma_f32_32x32x16_bf16(__builtin_bit_cast(bf16x8, pw1[ks]), vf, o1[d0], 0, 0, 0);
                o2[d0] = __builtin_amdgcn_mfma_f32_32x32x16_bf16(__builtin_bit_cast(bf16x8, pw2[ks]), vf, o2[d0], 0, 0, 0);
            }
            __builtin_amdgcn_sched_barrier(0);
        }
#undef AB_VLOAD
        if (t + 1 < t_end) AB_LWRITE(buf ^ 1);
        __syncthreads();
    }
#undef AB_GLOAD
#undef AB_LWRITE
#undef AB_SCORES
    l1 = sum_xor32(l1); l2 = sum_xor32(l2);
    LDSAS float* stg = (LDSAS float*)(lds + wid * 8192);
    if (hi == 0) { stg[r32] = 1.0f / l1; stg[32 + r32] = P.scal()[0] / l2; }
    float ss[16];
#pragma unroll
    for (int r = 0; r < 16; ++r) {
        const float a = stg[crow(r, hi)], c = stg[32 + crow(r, hi)];
        float s2 = 0.f;
#pragma unroll
        for (int d0 = 0; d0 < 4; ++d0) { const float v = o1[d0][r] * a - o2[d0][r] * c; o1[d0][r] = v; s2 += v * v; }
        ss[r] = s2;
    }
#pragma unroll
    for (int r = 0; r < 16; ++r) {
        float s2 = ss[r];
        s2 = sum_row16(s2); s2 = sum_xor16(s2);
        ss[r] = rsqrtf(s2 * (1.0f / 128.0f) + EPS) * (1.0f - LAMBDA_INIT);
    }
    const int eq = lane >> 1, eseg = lane & 1;
    const size_t grow = (size_t)(qrow0 + wid * 32 + eq);
#pragma unroll
    for (int half = 0; half < 2; ++half) {
#pragma unroll
        for (int dd = 0; dd < 2; ++dd) {
            const int d0 = half * 2 + dd; const float sl = P.b_subln[d0 * 32 + r32];
#pragma unroll
            for (int r = 0; r < 16; ++r) stg[crow(r, hi) * 64 + ((dd * 32 + r32) ^ ((crow(r, hi) & 7) * 4))] = o1[d0][r] * ss[r] * sl;
        }
        const u32x4* gp = (const u32x4*)(P.GB() + grow * 512 + h * 128 + half * 64 + eseg * 32);
        u32x4* op = (u32x4*)(P.O() + grow * 1024 + 512 + h * 128 + half * 64 + eseg * 32);
        u32x4 gv[4];
#pragma unroll
        for (int i = 0; i < 4; ++i) gv[i] = gp[i];
#pragma unroll
        for (int i = 0; i < 4; ++i) {
            const int c0 = eseg * 32 + i * 8;
            const f32x4 a = *(const LDSAS f32x4*)(stg + eq * 64 + (c0 ^ ((eq & 7) * 4))), c = *(const LDSAS f32x4*)(stg + eq * 64 + ((c0 + 4) ^ ((eq & 7) * 4)));
            const u32x4 g = gv[i]; u32x4 ov;
            ov.x = cvtpk(a[0] * bflo(g.x), a[1] * bfhi(g.x)); ov.y = cvtpk(a[2] * bflo(g.y), a[3] * bfhi(g.y));
            ov.z = cvtpk(c[0] * bflo(g.z), c[1] * bfhi(g.z)); ov.w = cvtpk(c[2] * bflo(g.w), c[3] * bfhi(g.w));
            op[i] = ov;
        }
    }
    __syncthreads();
}

__device__ __forceinline__ void phase_attnB_mfma(const Params& P, LDSAS unsigned char* lds, int vb, int nvb, int g_wave) {
    for (int it = 0; ; ++it) {
        int u;
        if (nvb == 256) { if (it < 4) u = it * 256 + vb; else if (it == 4 && vb >= 128) u = 1024 + (vb - 128); else break; }
        else { u = it * nvb + vb; if (u >= 1024 + 128) break; }
        int pair, qrow0, t0;
        if (u < 1024) {
            int qblk;
            if (nvb == 256) { const int round = u >> 8, i = u & 255, xcd = i & 7, slot = i >> 3; pair = round * 32 + xcd * 4 + (slot >> 3); qblk = slot & 7; }
            else { pair = u >> 3; qblk = u & 7; }
            qrow0 = (pair >> 2) * 2048 + qblk * 256; t0 = 0;
        } else {
            pair = u - 1024;
            qrow0 = ML + (pair >> 2) * 256; t0 = 32;
        }
        attnB_unit(P, lds, pair >> 2, pair & 3, qrow0, t0, 36, g_wave);
    }
}

constexpr int AA_K = 0, AA_V = 32768;
__device__ __forceinline__ void attnA_unit(const Params& P, LDSAS unsigned char* lds, int b, int kvh, int qrow0, int qpos0, int kt0, int nwin, int g_wave) {
    const int tid = otid(), lane = tid & 63, r32 = lane & 31, hi = lane >> 5;
    const int wid = __builtin_amdgcn_readfirstlane(tid >> 6);
    const int head = kvh * 4 + (wid >> 1), qoff = (wid & 1) * 64;
    bf16x8 qf[2][4];
#pragma unroll
    for (int qq = 0; qq < 2; ++qq)
#pragma unroll
        for (int d0 = 0; d0 < 4; ++d0) qf[qq][d0] = *(const bf16x8*)(P.QA() + (size_t)(qrow0 + qoff + qq * 32 + r32) * 512 + head * 64 + d0 * 16 + hi * 8);
    f32x16 o[2][2];
#pragma unroll
    for (int i = 0; i < 2; ++i) { o[i][0] = (f32x16){}; o[i][1] = (f32x16){}; }
    float l[2] = {0.f, 0.f};
    const int krow = tid >> 3, kch = tid & 7;
    const int kwoff = krow * 128 + ((kch ^ ((krow >> 1) & 7)) * 16);
    const int vwoff = (kch >> 2) * 4096 + krow * 64 + (kch & 3) * 16;
    u32x4 rk[2], rv[2];
    const int nt = nwin + 4, npair = (nt + 1) >> 1;
#define AA_KR0(i) ((i) < nwin ? b * 2048 + 64 * (kt0 + (i)) : ML + b * 256 + 64 * ((i) - nwin))
#define AA_GLOAD(pi) do { _Pragma("unroll") for (int sb_ = 0; sb_ < 2; ++sb_) { const int i_ = 2 * (pi) + sb_ < nt ? 2 * (pi) + sb_ : nt - 1; const int kr0_ = AA_KR0(i_); \
        rk[sb_] = *(const u32x4*)(P.KA() + (size_t)(kr0_ + krow) * 128 + kvh * 64 + kch * 8); rv[sb_] = *(const u32x4*)(P.VA() + (size_t)(kr0_ + krow) * 128 + kvh * 64 + kch * 8); } } while (0)
#define AA_LWRITE(buf) do { _Pragma("unroll") for (int sb_ = 0; sb_ < 2; ++sb_) { *(LDSAS u32x4*)(lds + AA_K + ((buf) * 2 + sb_) * 8192 + kwoff) = rk[sb_]; *(LDSAS u32x4*)(lds + AA_V + ((buf) * 2 + sb_) * 8192 + vwoff) = rv[sb_]; } } while (0)
    const int kroff = AA_K + r32 * 128, ksw = (r32 >> 1) & 7;
    const int vroff = AA_V + (4 * hi + ((lane & 15) >> 2)) * 64 + ((lane >> 4) & 1) * 32 + (lane & 3) * 8;
    AA_GLOAD(0); AA_LWRITE(0); __syncthreads();
    for (int pi = 0; pi < npair; ++pi) {
        const int pbuf = pi & 1;
        if (pi + 1 < npair) AA_GLOAD(pi + 1);
      for (int sub = 0; sub < 2; ++sub) {
        const int i = 2 * pi + sub, buf = pbuf * 2 + sub;
        int cls = i < nt ? 1 : 0;
        if (i < nwin) { const int delta = 64 * (kt0 + i) - (qpos0 + qoff); cls = delta == -128 ? 2 : (delta == 128 ? 3 : ((delta >= -64 && delta <= 64) ? 1 : 0)); }
        if (cls != 0) {
            const LDSAS unsigned char* kb = lds + buf * 8192 + kroff;
            u32x4 pw[2][4];
#pragma unroll
            for (int qq = 0; qq < 2; ++qq) {
                f32x16 p0 = (f32x16){}, p1 = (f32x16){};
#pragma unroll
                for (int d0 = 0; d0 < 4; ++d0) {
                    const int co = ((2 * d0 + hi) ^ ksw) * 16;
                    const bf16x8 k0 = *(const LDSAS bf16x8*)(kb + co), k1 = *(const LDSAS bf16x8*)(kb + 4096 + co);
                    p0 = __builtin_amdgcn_mfma_f32_32x32x16_bf16(k0, qf[qq][d0], p0, 0, 0, 0);
                    p1 = __builtin_amdgcn_mfma_f32_32x32x16_bf16(k1, qf[qq][d0], p1, 0, 0, 0);
                }
                float ls = 0.f;
#pragma unroll
                for (int r = 0; r < 16; ++r) { p0[r] = __builtin_amdgcn_exp2f(p0[r]); p1[r] = __builtin_amdgcn_exp2f(p1[r]); }
                if (cls >= 2) {
                    int a = qq * 32 + r32;
                    asm volatile("" : "+v"(a));
#pragma unroll
                    for (int r = 0; r < 16; ++r) {
                        const int c0 = crow(r, hi), c1 = c0 + 32;
                        const bool v0 = cls == 2 ? (c0 >= a) : (c0 <= a), v1 = cls == 2 ? (c1 >= a) : (c1 <= a);
                        p0[r] = v0 ? p0[r] : 0.f; p1[r] = v1 ? p1[r] : 0.f;
                    }
                }
#pragma unroll
                for (int r = 0; r < 16; ++r) ls += p0[r] + p1[r];
                l[qq] += ls;
                pw[qq][0].x = cvtpk(p0[0], p0[1]); pw[qq][0].y = cvtpk(p0[2], p0[3]); pw[qq][0].z = cvtpk(p0[4], p0[5]); pw[qq][0].w = cvtpk(p0[6], p0[7]);
                pw[qq][1].x = cvtpk(p0[8], p0[9]); pw[qq][1].y = cvtpk(p0[10], p0[11]); pw[qq][1].z = cvtpk(p0[12], p0[13]); pw[qq][1].w = cvtpk(p0[14], p0[15]);
                pw[qq][2].x = cvtpk(p1[0], p1[1]); pw[qq][2].y = cvtpk(p1[2], p1[3]); pw[qq][2].z = cvtpk(p1[4], p1[5]); pw[qq][2].w = cvtpk(p1[6], p1[7]);
                pw[qq][3].x = cvtpk(p1[8], p1[9]); pw[qq][3].y = cvtpk(p1[10], p1[11]); pw[qq][3].z = cvtpk(p1[12], p1[13]); pw[qq][3].w = cvtpk(p1[14], p1[15]);
                __builtin_amdgcn_sched_barrier(0);
            }
            const LDSAS unsigned char* vb = lds + buf * 8192 + vroff;
#pragma unroll
            for (int d0 = 0; d0 < 2; ++d0)
#pragma unroll
                for (int ks = 0; ks < 4; ++ks) {
                    const s16x4 lo = vtr(vb + d0 * 4096 + ks * 1024), hh = vtr(vb + d0 * 4096 + ks * 1024 + 512);
                    const bf16x8 vf = (bf16x8){lo[0], lo[1], lo[2], lo[3], hh[0], hh[1], hh[2], hh[3]};
                    o[0][d0] = __builtin_amdgcn_mfma_f32_32x32x16_bf16(__builtin_bit_cast(bf16x8, pw[0][ks]), vf, o[0][d0], 0, 0, 0);
                    o[1][d0] = __builtin_amdgcn_mfma_f32_32x32x16_bf16(__builtin_bit_cast(bf16x8, pw[1][ks]), vf, o[1][d0], 0, 0, 0);
                }
        }
      }
        if (pi + 1 < npair) AA_LWRITE(pbuf ^ 1);
        __syncthreads();
    }
#undef AA_KR0
#undef AA_GLOAD
#undef AA_LWRITE
    const float sinkp = __builtin_amdgcn_exp2f(P.a_sink[head] * LOG2E);
    LDSAS float* stg = (LDSAS float*)(lds + wid * 8704);
    const int eq = lane >> 1, eseg = lane & 1;
#pragma unroll
    for (int qq = 0; qq < 2; ++qq) {
        float lt = sum_xor32(l[qq]);
        if (hi == 0) stg[r32] = 1.0f / (lt + sinkp);
        float rl[16];
#pragma unroll
        for (int r = 0; r < 16; ++r) rl[r] = stg[crow(r, hi)];
#pragma unroll
        for (int d0 = 0; d0 < 2; ++d0)
#pragma unroll
            for (int r = 0; r < 16; ++r) stg[crow(r, hi) * 68 + d0 * 32 + r32] = o[qq][d0][r] * rl[r];
        const size_t grow = (size_t)(qrow0 + qoff + qq * 32 + eq);
        const u32x4* gp = (const u32x4*)(P.GA() + grow * 512 + head * 64 + eseg * 32);
        u32x4* op = (u32x4*)(P.O() + grow * 1024 + head * 64 + eseg * 32);
        u32x4 gv[4];
#pragma unroll
        for (int i = 0; i < 4; ++i) gv[i] = gp[i];
#pragma unroll
        for (int i = 0; i < 4; ++i) {
            const f32x4 a = *(const LDSAS f32x4*)(stg + eq * 68 + eseg * 32 + i * 8), c = *(const LDSAS f32x4*)(stg + eq * 68 + eseg * 32 + i * 8 + 4);
            const u32x4 g = gv[i]; u32x4 ov;
            ov.x = cvtpk(a[0] * bflo(g.x), a[1] * bfhi(g.x)); ov.y = cvtpk(a[2] * bflo(g.y), a[3] * bfhi(g.y));
            ov.z = cvtpk(c[0] * bflo(g.z), c[1] * bfhi(g.z)); ov.w = cvtpk(c[2] * bflo(g.w), c[3] * bfhi(g.w));
            op[i] = ov;
        }
    }
    __syncthreads();
}

__device__ __forceinline__ void phase_attnA_mfma(const Params& P, LDSAS unsigned char* lds, int vb, int nvb, int g_wave) {
    for (int u = vb; u < 1024 + 128; u += nvb) {
        int b, kvh, qrow0, qpos0, kt0, nwin;
        if (u < 1024) {
            int qblk;
            if (nvb == 256) { const int round = u >> 8, i = u & 255; b = round * 8 + (i & 7); kvh = (i >> 3) >> 4; qblk = (i >> 3) & 15; }
            else { qblk = u & 15; kvh = (u >> 4) & 1; b = u >> 5; }
            const int lo = 2 * qblk - 2 < 0 ? 0 : 2 * qblk - 2, hi_ = 2 * qblk + 3 > 31 ? 31 : 2 * qblk + 3;
            qrow0 = b * 2048 + qblk * 128; qpos0 = qblk * 128; kt0 = lo; nwin = hi_ - lo + 1;
        } else {
            const int v = u - 1024, half = v & 1; kvh = (v >> 1) & 1; b = v >> 2;
            qrow0 = ML + b * 256 + half * 128; qpos0 = 0; kt0 = 0; nwin = 0;
        }
        attnA_unit(P, lds, b, kvh, qrow0, qpos0, kt0, nwin, g_wave);
    }
}

constexpr int GL_QD = 0, GL_KD = 17408, GL_KT = 34816, GL_V = 53248, GL_DEC = 86016, GL_RF = 86528, GL_TOT = 90624, GL_WA = 92672, GL_RQ = 101376, GL_RK = 117760, GL_ATT = 134144, GL_END = 140288;
constexpr int KERNEL_LDS = (GL_END > pg8::STAGE_BYTES ? GL_END : pg8::STAGE_BYTES);
static_assert(TICKET_LDS == KERNEL_LDS + 8, "ticket word sits next to the barrier words");
__device__ __forceinline__ int pos16(int x) { return 8 * ((x >> 2) & 1) + (x & 3) + 4 * (x >> 3); }
__device__ __forceinline__ bf16x8 pack8(const f32x16& v, int o) {
    u32x4 w; w.x = cvtpk(v[o], v[o + 1]); w.y = cvtpk(v[o + 2], v[o + 3]); w.z = cvtpk(v[o + 4], v[o + 5]); w.w = cvtpk(v[o + 6], v[o + 7]);
    return __builtin_bit_cast(bf16x8, w);
}

__device__ __forceinline__ void phase_gla_mfma(const Params& P, LDSAS unsigned char* lds, int vb, int nvb, int g_wave) {
    const int tid = otid(), lane = tid & 63, r32 = lane & 31, hi = lane >> 5;
    const int wid = __builtin_amdgcn_readfirstlane(tid >> 6);
    const int it = wid >> 2, dt = wid & 3, d = dt * 32 + r32;
    for (int unit = vb; unit < NB * 8; unit += nvb) {
        const int dr = unit & 1, h = (unit >> 1) & 3, b = unit >> 3;
        const float* wa = dr ? P.wa_b : P.wa_f; const float* ba = dr ? P.ba_b : P.ba_f;
        __syncthreads();
        if (tid < 128) {
            u32x4 whi[2], wlo[2];
#pragma unroll
            for (int j = 0; j < 16; j += 2) {
                const float w0 = wa[j * 512 + h * 128 + tid] * LOG2E, w1 = wa[(j + 1) * 512 + h * 128 + tid] * LOG2E;
                const unsigned ph = cvtpk(w0, w1); const unsigned pl = cvtpk(w0 - bflo(ph), w1 - bfhi(ph));
                whi[j >> 3][(j >> 1) & 3] = ph; wlo[j >> 3][(j >> 1) & 3] = pl;
            }
            *(LDSAS u32x4*)(lds + GL_WA + tid * 32) = whi[0]; *(LDSAS u32x4*)(lds + GL_WA + tid * 32 + 16) = whi[1];
            *(LDSAS u32x4*)(lds + GL_WA + 4096 + tid * 32) = wlo[0]; *(LDSAS u32x4*)(lds + GL_WA + 4096 + tid * 32 + 16) = wlo[1];
            ((LDSAS float*)(lds + GL_WA + 8192))[tid] = ba[h * 128 + tid] * LOG2E;
        }
        f32x16 S[4];
#pragma unroll
        for (int i = 0; i < 4; ++i) S[i] = (f32x16){};
        f32x4 pf_rf; u32x4 pf_v[4], pf_q[2], pf_k[2];
        float lb[16];
#define GL_MEMBASE(n) ((n) >= 4 ? b * T + 64 * (dr ? 31 - ((n) - 4) : ((n) - 4)) : ML + b * L + 64 * (dr ? 3 - (n) : (n)))
#define GL_PREFETCH_V(n) do { const int mb_ = GL_MEMBASE(n); \
            _Pragma("unroll") for (int k4 = 0; k4 < 4; ++k4) { const int idx = tq + 512 * k4; pf_v[k4] = *(const u32x4*)(P.VG() + (size_t)(mb_ + (idx >> 5)) * 1024 + h * 256 + (idx & 31) * 8); } } while (0)
#define GL_PREFETCH_RQK(n) do { const int mb_ = GL_MEMBASE(n); \
            pf_rf = *(const f32x4*)(P.RF() + (size_t)(mb_ + ((tq & 255) >> 2)) * 32 + dr * 16 + (tq & 3) * 4); \
            _Pragma("unroll") for (int k2 = 0; k2 < 2; ++k2) { const int idx = tq + 512 * k2; pf_k[k2] = *(const u32x4*)(P.KG() + (size_t)(mb_ + (idx >> 4)) * 512 + h * 128 + (idx & 15) * 8); \
                pf_q[k2] = *(const u32x4*)(P.QG() + (size_t)(mb_ + (idx >> 4)) * 512 + h * 128 + (idx & 15) * 8); } } while (0)
#define GL_TOP(lat) do { \
            if (tq < 256) { \
                const unsigned h0 = cvtpk(pf_rf[0], pf_rf[1]), h1 = cvtpk(pf_rf[2], pf_rf[3]); \
                const unsigned l0 = cvtpk(pf_rf[0] - bflo(h0), pf_rf[1] - bfhi(h0)), l1 = cvtpk(pf_rf[2] - bflo(h1), pf_rf[3] - bfhi(h1)); \
                const int off = (dr ? 63 - (tq >> 2) : (tq >> 2)) * 32 + (tq & 3) * 8; \
                *(LDSAS u32x2*)(lds + GL_RF + off) = (u32x2){h0, h1}; *(LDSAS u32x2*)(lds + GL_RF + 2048 + off) = (u32x2){l0, l1}; \
            } \
            _Pragma("unroll") for (int k2 = 0; k2 < 2; ++k2) { const int idx = tq + 512 * k2, im = idx >> 4, ch = idx & 15; const int pr = dr ? 63 - im : im; \
                const int off = pr * 256 + ((ch ^ (4 * (pr & 3))) * 16); \
                *(LDSAS u32x4*)(lds + GL_RK + off) = pf_k[k2]; if (lat) *(LDSAS u32x4*)(lds + GL_RQ + off) = pf_q[k2]; } } while (0)
#define GL_Z() do { \
            const float bav = ((const LDSAS float*)(lds + GL_WA + 8192))[d]; \
            f32x16 z; \
            _Pragma("unroll") for (int r = 0; r < 16; ++r) z[r] = bav; \
            const bf16x8 ah = *(const LDSAS bf16x8*)(lds + GL_RF + (it * 32 + r32) * 32 + hi * 16), al = *(const LDSAS bf16x8*)(lds + GL_RF + 2048 + (it * 32 + r32) * 32 + hi * 16); \
            const bf16x8 bh = *(const LDSAS bf16x8*)(lds + GL_WA + d * 32 + hi * 16), bl = *(const LDSAS bf16x8*)(lds + GL_WA + 4096 + d * 32 + hi * 16); \
            z = __builtin_amdgcn_mfma_f32_32x32x16_bf16(ah, bh, z, 0, 0, 0); \
            z = __builtin_amdgcn_mfma_f32_32x32x16_bf16(al, bh, z, 0, 0, 0); \
            z = __builtin_amdgcn_mfma_f32_32x32x16_bf16(ah, bl, z, 0, 0, 0); \
            float gs[4]; \
            _Pragma("unroll") for (int g = 0; g < 4; ++g) { \
                float run = 0.f; \
                _Pragma("unroll") for (int j = 0; j < 4; ++j) { \
                    const float zz = z[4 * g + j]; \
                    run += (fminf(zz, 0.f) - __builtin_amdgcn_logf(1.0f + __builtin_amdgcn_exp2f(-fabsf(zz)))) * (1.0f / 16.0f); \
                    lb[4 * g + j] = run; \
                } \
                gs[g] = run; \
            } \
            float off = 0.f; \
            _Pragma("unroll") for (int g = 0; g < 4; ++g) {        \
                const auto sw = __builtin_amdgcn_permlane32_swap(__float_as_uint(gs[g]), __float_as_uint(gs[g]), false, false);        \
                const float o2 = off + (hi ? __uint_as_float(sw[0]) : 0.f); \
                _Pragma("unroll") for (int j = 0; j < 4; ++j) lb[4 * g + j] += o2; \
                off += __uint_as_float(sw[0]) + __uint_as_float(sw[1]); \
            } \
            if (hi == 0) ((LDSAS float*)(lds + GL_TOT))[it * 128 + d] = off; } while (0)
        { int tq = tid; asm volatile("" : "+v"(tq)); GL_PREFETCH_RQK(0); GL_PREFETCH_V(0); GL_TOP(false); GL_PREFETCH_RQK(1); }
        __syncthreads();
        GL_Z();
        __syncthreads();
        for (int n = 0; n < 36; ++n) {
            const bool latent = n >= 4;
            const int membase = GL_MEMBASE(n);
            const int nn = n + 1 < 36 ? n + 1 : 35, n2 = n + 2 < 36 ? n + 2 : 35;
            {
                const float t0 = ((const LDSAS float*)(lds + GL_TOT))[d], t1 = ((const LDSAS float*)(lds + GL_TOT))[128 + d];
                const float prefix = it ? t0 : 0.f;
                const float dec = __builtin_amdgcn_exp2f(t0 + t1);
                const int le = lane;
                const int trs = (le & 15) >> 2, trc = dt * 4 + ((le >> 4) & 1) * 2 + ((le & 3) >> 1);
                const int troff = (it * 32 + 4 * (le >> 5) + trs) * 256 + ((trc ^ (4 * trs)) * 16) + (le & 1) * 8;
                u32x2 kr[4], qr[4];
#pragma unroll
                for (int g = 0; g < 4; ++g) { kr[g] = __builtin_bit_cast(u32x2, vtr(lds + GL_RK + troff + g * 2048)); if (latent) qr[g] = __builtin_bit_cast(u32x2, vtr(lds + GL_RQ + troff + g * 2048)); }
                float ktv[16];
                const int dp = ((d & ~15) + pos16(d & 15)) * 2;
#pragma unroll
                for (int r = 0; r < 16; r += 2) {
                    const int i0 = it * 32 + crow(r, hi), i1 = i0 + 1;
                    const float e0 = __builtin_amdgcn_exp2f(prefix + lb[r]), e1 = __builtin_amdgcn_exp2f(prefix + lb[r + 1]);
                    const unsigned kw2 = kr[r >> 2][(r >> 1) & 1];
                    const float kd0 = bflo(kw2) * __builtin_amdgcn_rcpf(e0), kd1 = bfhi(kw2) * __builtin_amdgcn_rcpf(e1);
                    ktv[r] = kd0 * dec; ktv[r + 1] = kd1 * dec;
                    lb[r] = e0; lb[r + 1] = e1;
                    if (latent) {
                        const unsigned kw = cvtpk(kd0, kd1);
                        *(LDSAS bf16_t*)(lds + GL_KD + i0 * 272 + dp) = (bf16_t)kw; *(LDSAS bf16_t*)(lds + GL_KD + i1 * 272 + dp) = (bf16_t)(kw >> 16);
                    }
                }
                if (latent) {
#pragma unroll
                    for (int r = 0; r < 16; r += 2) {
                        const int i0 = it * 32 + crow(r, hi), i1 = i0 + 1;
                        const unsigned qw2 = qr[r >> 2][(r >> 1) & 1];
                        const unsigned qw = cvtpk(bflo(qw2) * lb[r], bfhi(qw2) * lb[r + 1]);
                        *(LDSAS bf16_t*)(lds + GL_QD + i0 * 272 + dp) = (bf16_t)qw; *(LDSAS bf16_t*)(lds + GL_QD + i1 * 272 + dp) = (bf16_t)(qw >> 16);
                    }
                }
                u32x4 w0, w1;
                w0.x = cvtpk(ktv[0], ktv[1]); w0.y = cvtpk(ktv[2], ktv[3]); w0.z = cvtpk(ktv[4], ktv[5]); w0.w = cvtpk(ktv[6], ktv[7]);
                w1.x = cvtpk(ktv[8], ktv[9]); w1.y = cvtpk(ktv[10], ktv[11]); w1.z = cvtpk(ktv[12], ktv[13]); w1.w = cvtpk(ktv[14], ktv[15]);
                *(LDSAS u32x4*)(lds + GL_KT + d * 144 + (2 * it) * 32 + hi * 16) = w0;
                *(LDSAS u32x4*)(lds + GL_KT + d * 144 + (2 * it + 1) * 32 + hi * 16) = w1;
                if (it == 0 && hi == 0) ((LDSAS float*)(lds + GL_DEC))[d] = dec;
            }
            const int tq = tid;
#pragma unroll
            for (int k4 = 0; k4 < 4; ++k4) { const int idx = tq + 512 * k4, im = idx >> 5, ch = idx & 31; *(LDSAS u32x4*)(lds + GL_V + (ch >> 2) * 4096 + (dr ? 63 - im : im) * 64 + (ch & 3) * 16) = pf_v[k4]; }
            __syncthreads();
            GL_TOP(nn >= 4);
            GL_PREFETCH_V(nn);
            GL_PREFETCH_RQK(n2);
            bf16x8 vf[4];
#define GL_LOADV() do { const LDSAS unsigned char* vbp = lds + GL_V + wid * 4096 + (4 * hiq + ((lq & 15) >> 2)) * 64 + ((lq >> 4) & 1) * 32 + (lq & 3) * 8; \
                _Pragma("unroll") for (int js = 0; js < 4; ++js) { const s16x4 lo = vtr(vbp + js * 1024), hh = vtr(vbp + js * 1024 + 512); vf[js] = (bf16x8){lo[0], lo[1], lo[2], lo[3], hh[0], hh[1], hh[2], hh[3]}; } } while (0)
            __builtin_amdgcn_sched_barrier(0);
            const int lq = lane;
            const int r32q = lq & 31, hiq = lq >> 5;
#define GL_SUPDATE() do { _Pragma("unroll") for (int dt2 = 0; dt2 < 4; ++dt2) { __builtin_amdgcn_sched_barrier(0); \
                _Pragma("unroll") for (int g = 0; g < 4; ++g) { const f32x4 dc = *(const LDSAS f32x4*)(lds + GL_DEC + (dt2 * 32 + 8 * g + 4 * hiq) * 4); \
                    S[dt2][4 * g] *= dc[0]; S[dt2][4 * g + 1] *= dc[1]; S[dt2][4 * g + 2] *= dc[2]; S[dt2][4 * g + 3] *= dc[3]; } \
                const LDSAS unsigned char* ktp = lds + GL_KT + (dt2 * 32 + r32q) * 144 + hiq * 16; \
                _Pragma("unroll") for (int is = 0; is < 4; ++is) S[dt2] = __builtin_amdgcn_mfma_f32_32x32x16_bf16(*(const LDSAS bf16x8*)(ktp + is * 32), vf[is], S[dt2], 0, 0, 0); } } while (0)
            GL_LOADV();
            f32x16 o0 = (f32x16){}, o1 = (f32x16){};
            if (latent) {
                if (wid < 3) {
                    f32x16 X = (f32x16){};
                    const LDSAS unsigned char* kb = lds + GL_KD + ((wid == 2 ? 32 : 0) + r32q) * 272 + hiq * 16;
                    const LDSAS unsigned char* qb2 = lds + GL_QD + ((wid >= 1 ? 32 : 0) + r32q) * 272 + hiq * 16;
#pragma unroll
                    for (int s = 0; s < 8; ++s) X = __builtin_amdgcn_mfma_f32_32x32x16_bf16(*(const LDSAS bf16x8*)(kb + s * 32), *(const LDSAS bf16x8*)(qb2 + s * 32), X, 0, 0, 0);
                    if (wid != 1) {
                        const int rq = r32;
#pragma unroll
                        for (int r = 0; r < 16; ++r) X[r] = (crow(r, hi) <= rq) ? X[r] : 0.f;
                    }
                    *(LDSAS bf16x8*)(lds + GL_ATT + wid * 2048 + lq * 16) = pack8(X, 0);
                    *(LDSAS bf16x8*)(lds + GL_ATT + wid * 2048 + 1024 + lq * 16) = pack8(X, 8);
                }
                __builtin_amdgcn_sched_barrier(0);
                const LDSAS unsigned char* qb = lds + GL_QD + r32q * 272 + hiq * 16;
#pragma unroll
                for (int s = 0; s < 8; ++s) {
                    const bf16x8 Sb = pack8(S[s >> 1], (s & 1) * 8);
                    const bf16x8 q0 = *(const LDSAS bf16x8*)(qb + s * 32), q1 = *(const LDSAS bf16x8*)(qb + 32 * 272 + s * 32);
                    o0 = __builtin_amdgcn_mfma_f32_32x32x16_bf16(q0, Sb, o0, 0, 0, 0);
                    o1 = __builtin_amdgcn_mfma_f32_32x32x16_bf16(q1, Sb, o1, 0, 0, 0);
                    if (s & 1) __builtin_amdgcn_sched_barrier(0);
                }
            }
            __syncthreads();
            if (latent) {
                {
                    const LDSAS unsigned char* ab = lds + GL_ATT + lq * 16;
                    o0 = __builtin_amdgcn_mfma_f32_32x32x16_bf16(*(const LDSAS bf16x8*)(ab), vf[0], o0, 0, 0, 0);
                    o0 = __builtin_amdgcn_mfma_f32_32x32x16_bf16(*(const LDSAS bf16x8*)(ab + 1024), vf[1], o0, 0, 0, 0);
                    __builtin_amdgcn_sched_barrier(0);
                    o1 = __builtin_amdgcn_mfma_f32_32x32x16_bf16(*(const LDSAS bf16x8*)(ab + 2048), vf[0], o1, 0, 0, 0);
                    o1 = __builtin_amdgcn_mfma_f32_32x32x16_bf16(*(const LDSAS bf16x8*)(ab + 3072), vf[1], o1, 0, 0, 0);
                    __builtin_amdgcn_sched_barrier(0);
                    o1 = __builtin_amdgcn_mfma_f32_32x32x16_bf16(*(const LDSAS bf16x8*)(ab + 4096), vf[2], o1, 0, 0, 0);
                    o1 = __builtin_amdgcn_mfma_f32_32x32x16_bf16(*(const LDSAS bf16x8*)(ab + 5120), vf[3], o1, 0, 0, 0);
                }
                LDSAS unsigned char* ost = lds + GL_V + wid * 4096;
#pragma unroll
                for (int r = 0; r < 16; r += 2) {
                    const int i0 = crow(r, hi);
                    const unsigned w0 = cvtpk(o0[r], o0[r + 1]), w1 = cvtpk(o1[r], o1[r + 1]);
                    *(LDSAS bf16_t*)(ost + i0 * 64 + r32 * 2) = (bf16_t)w0; *(LDSAS bf16_t*)(ost + (i0 + 1) * 64 + r32 * 2) = (bf16_t)(w0 >> 16);
                    *(LDSAS bf16_t*)(ost + (32 + i0) * 64 + r32 * 2) = (bf16_t)w1; *(LDSAS bf16_t*)(ost + (33 + i0) * 64 + r32 * 2) = (bf16_t)(w1 >> 16);
                }
                bf16_t* od = P.OD() + (size_t)dr * ML * 1024 + h * 256 + wid * 32;
#pragma unroll
                for (int k4 = 0; k4 < 4; ++k4) {
                    const int p = lane + 64 * k4, i = p >> 2, part = p & 3;
                    const u32x4 v = *(const LDSAS u32x4*)(ost + i * 64 + part * 16);
                    *(u32x4*)(od + (size_t)(membase + (dr ? 63 - i : i)) * 1024 + part * 8) = v;
                }
            }
            GL_SUPDATE();
            GL_Z();
            __syncthreads();
#undef GL_LOADV
#undef GL_SUPDATE
        }
#undef GL_PREFETCH_V
#undef GL_PREFETCH_RQK
#undef GL_TOP
#undef GL_Z
#undef GL_MEMBASE
    }
}

__device__ __forceinline__ void phase_rstd1(const Params& P, int vb, int nvb, int g_wave) {
    const int tidx = otid();
    for (int row = vb * 512 + tidx; row < M; row += nvb * 512) {
        float ss = 0.f;
#pragma unroll
        for (int i = 0; i < 16; ++i) ss += P.parts()[(size_t)i * M + row];
        ((float*)(P.ws + OFF_RS))[row] = rsqrtf(ss * (1.0f / 1024.0f) + EPS);
    }
}

__device__ __forceinline__ void phase_finish(const Params& P, int vb, int nvb, int g_wave) {
    const int tidx = otid();
    const int lane = tidx & 63, wpb = blockDim.x >> 6, w = tidx >> 6;
    for (int row = vb * wpb + w; row < ML; row += nvb * wpb) {
        const int c0 = lane * 16;
        float v[16];
        const u32x4* pf = (const u32x4*)(P.OD() + (size_t)row * 1024 + c0);
        const u32x4* pb = (const u32x4*)(P.OD() + ((size_t)ML + row) * 1024 + c0);
        float ss = 0.f;
#pragma unroll
        for (int i = 0; i < 2; ++i) {
            const u32x4 a = pf[i], bq = pb[i];
            v[8 * i] = bflo(a.x) + bflo(bq.x); v[8 * i + 1] = bfhi(a.x) + bfhi(bq.x); v[8 * i + 2] = bflo(a.y) + bflo(bq.y); v[8 * i + 3] = bfhi(a.y) + bfhi(bq.y);
            v[8 * i + 4] = bflo(a.z) + bflo(bq.z); v[8 * i + 5] = bfhi(a.z) + bfhi(bq.z); v[8 * i + 6] = bflo(a.w) + bflo(bq.w); v[8 * i + 7] = bfhi(a.w) + bfhi(bq.w);
        }
#pragma unroll
        for (int i = 0; i < 16; ++i) ss += v[i] * v[i];
        ss = sum_row16(ss);
        const float rn = rsqrtf(ss * (1.0f / 256.0f) + EPS);
        float gn[16];
        { const f32x4* gnp = (const f32x4*)(P.gla_out_norm + (c0 & 255));
#pragma unroll
          for (int i = 0; i < 4; ++i) { const f32x4 t4 = gnp[i]; gn[4 * i] = t4[0]; gn[4 * i + 1] = t4[1]; gn[4 * i + 2] = t4[2]; gn[4 * i + 3] = t4[3]; } }
        const u32x4* gp = (const u32x4*)(P.GG() + (size_t)row * 1024 + c0);
        u32x4* op = (u32x4*)(P.A2() + (size_t)row * 1024 + c0);
        const u32x4 gq[2] = {gp[0], gp[1]};
#pragma unroll
        for (int i = 0; i < 2; ++i) {
            const u32x4 g = gq[i]; u32x4 r;
            r.x = cvtpk(v[8 * i] * rn * gn[8 * i] * bflo(g.x), v[8 * i + 1] * rn * gn[8 * i + 1] * bfhi(g.x));
            r.y = cvtpk(v[8 * i + 2] * rn * gn[8 * i + 2] * bflo(g.y), v[8 * i + 3] * rn * gn[8 * i + 3] * bfhi(g.y));
            r.z = cvtpk(v[8 * i + 4] * rn * gn[8 * i + 4] * bflo(g.z), v[8 * i + 5] * rn * gn[8 * i + 5] * bfhi(g.z));
            r.w = cvtpk(v[8 * i + 6] * rn * gn[8 * i + 6] * bflo(g.w), v[8 * i + 7] * rn * gn[8 * i + 7] * bfhi(g.w));
            op[i] = r;
        }
    }
}

namespace cg = cooperative_groups;
#define XB_TMO      128
#define XB_XCNT(j)  (256  + 64 * (j))
#define XB_XSUB(j)  (1280 + 64 * (j))
#define XB_XGEN(j)  (2304 + 64 * (j))
#define XB_TOP      3328
#define XB_TOPGEN   3392
#define XCD_BAR_WORDS 3456
#define XB_SPIN_CAP (1u << 22)
static_assert(XCD_BAR_WORDS * 4 <= 16384, "barrier words fit their workspace slot");
__device__ __forceinline__ unsigned xb_ld(unsigned* p) { return __hip_atomic_load(p, __ATOMIC_RELAXED, __HIP_MEMORY_SCOPE_AGENT); }
__device__ __forceinline__ unsigned xb_add(unsigned* p, unsigned v) { return __hip_atomic_fetch_add(p, v, __ATOMIC_RELAXED, __HIP_MEMORY_SCOPE_AGENT); }
__device__ __forceinline__ unsigned xb_xcc_id() { return (unsigned)__builtin_amdgcn_s_getreg((3 << 11) | 20) & 0xFu; }
#define XB_SPIN(cond, bar) do { unsigned _sp = 0; while (cond) { __builtin_amdgcn_s_sleep(1); \
    if ((++_sp & 255u) == 0u) { if (xb_ld(&(bar)[XB_TMO])) break; if (_sp > XB_SPIN_CAP) { atomicAdd(&(bar)[XB_TMO], 1u); break; } } } } while (0)
__device__ __forceinline__ void xcd_barrier_complete(unsigned* bar, unsigned x, unsigned G, unsigned& nloc, unsigned& nx) {
    unsigned sum, cnt, mine, sp = 0u;
    for (;;) {
        sum = 0u; cnt = 0u; mine = 0u;
#pragma unroll
        for (unsigned j = 0; j < 16; ++j) { const unsigned c = xb_ld(&bar[XB_XCNT(j)]); sum += c; cnt += (c > 0u) ? 1u : 0u; mine = (j == x) ? c : mine; }
        if (sum == G) break;
        __builtin_amdgcn_s_sleep(1);
        if ((++sp & 255u) == 0u) { if (xb_ld(&bar[XB_TMO])) break; if (sp > XB_SPIN_CAP) { atomicAdd(&bar[XB_TMO], 1u); break; } }
    }
    nloc = mine > 0u ? mine : 1u; nx = cnt > 0u ? cnt : 1u;
}
__device__ __forceinline__ void xcd_barrier(unsigned* bar, volatile LDSAS unsigned* st, unsigned G, int g_wave) {
    asm volatile("s_waitcnt vmcnt(0)" ::: "memory");
    __syncthreads();
    if (g_wave == 0 && lane_id() == 0) {
        const unsigned x = xb_xcc_id();
        __builtin_amdgcn_s_waitcnt(0);
        unsigned nloc = st[0], nx = st[1];
        if (nloc == 0u) { xcd_barrier_complete(bar, x, G, nloc, nx); st[0] = nloc; st[1] = nx; }
        const unsigned old = xb_add(&bar[XB_XSUB(x)], 1u);
        const unsigned gen = old / nloc;
        if (old + 1u == (gen + 1u) * nloc) {
            __builtin_amdgcn_fence(__ATOMIC_RELEASE, "agent");
            asm volatile("s_waitcnt vmcnt(0)" ::: "memory");
            const unsigned og = xb_add(&bar[XB_TOP], 1u);
            const unsigned tg = og / nx;
            if (og + 1u == (tg + 1u) * nx) xb_add(&bar[XB_TOPGEN], 1u);
            else XB_SPIN(xb_ld(&bar[XB_TOPGEN]) == tg, bar);
            __builtin_amdgcn_fence(__ATOMIC_ACQUIRE, "agent");
            xb_add(&bar[XB_XGEN(x)], 1u);
            asm volatile("s_waitcnt vmcnt(0)" ::: "memory");
        } else {
            XB_SPIN(xb_ld(&bar[XB_XGEN(x)]) == gen, bar);
            __builtin_amdgcn_fence(__ATOMIC_ACQUIRE, "agent");
            asm volatile("s_waitcnt vmcnt(0)" ::: "memory");
        }
    }
    __syncthreads();
}

#define GRID_BAR() xcd_barrier((unsigned*)(ldparams().ws + OFF_BAR), (volatile LDSAS unsigned*)(lds + KERNEL_LDS), (unsigned)nvb, g_wave)
#define REPEAT(k, ...) { const Params P = ldparams(); __VA_ARGS__ }
__global__ void __launch_bounds__(512) mega_kernel(Params Pk) {
    __shared__ __attribute__((aligned(16))) unsigned char lds[KERNEL_LDS + 16];
    const int vb = blockIdx.x, nvb = gridDim.x;
    const int g_wave = __builtin_amdgcn_readfirstlane((int)(threadIdx.x >> 6));
    if (threadIdx.x == 0) {
        ((volatile LDSAS unsigned*)(lds + KERNEL_LDS))[0] = 0u; ((volatile LDSAS unsigned*)(lds + KERNEL_LDS))[1] = 0u;
        (void)xb_add(&((unsigned*)(Pk.ws + OFF_BAR))[XB_XCNT(xb_xcc_id())], 1u);
    }
#ifdef PROBE_A
#define STAMP(k) do { if (vb == 0 && g_wave == 0 && lane_id() == 0) ((unsigned long long*)(ldparams().ws + OFF_BAR + 14336))[k] = __builtin_amdgcn_s_memrealtime(); } while (0)
#else
#define STAMP(k) do { } while (0)
#endif
    STAMP(0);
    REPEAT(0, phase_pro0(P, lds, vb, nvb, g_wave);)
    STAMP(1);
    if (ldparams().reps[11] != 0) cg::this_grid().sync();
    GRID_BAR();
    REPEAT(1, phase_bias_a0(P, lds, vb, nvb, g_wave);)
    STAMP(2);
    GRID_BAR();
    REPEAT(2, EpiIn0 E{P.ws, P.a_q_norm, P.a_k_norm, P.b_q_norm, P.b_k_norm};
      pg8::Gemm g{P.A(), P.Wt0(), M, N0, D}; pg8::StaticOrder S; S.init(M, N0, nvb, vb); pg8::gemm_phase<EpiIn0, pg8::StaticOrder, true, true>((LDSAS unsigned char*)lds, g, S, E, g_wave);)
    STAMP(3);
    GRID_BAR();
    REPEAT(3, phase_attnA_mfma(P, (LDSAS unsigned char*)lds, vb, nvb, g_wave);)
    REPEAT(4, phase_attnB_mfma(P, (LDSAS unsigned char*)lds, vb, nvb, g_wave);)
    STAMP(4);
    GRID_BAR();
    REPEAT(5, EpiOut0 E{P.x, P.ctx, P.norm_g + D, P.out, P.ws};
      pg8::Gemm g{P.O(), P.Wo0(), M, D, D}; pg8::StaticOrder S; S.init(M, D, nvb, vb); pg8::gemm_phase<EpiOut0, pg8::StaticOrder, true, true>((LDSAS unsigned char*)lds, g, S, E, g_wave);)
    STAMP(5);
    GRID_BAR();
    { const Params P = ldparams(); phase_rstd1(P, vb, nvb, g_wave); }
    GRID_BAR();
    REPEAT(6, EpiIn1 E{P.ws};
      pg8::Gemm g{P.A(), P.Wt1(), M, N1, D}; OrderIn1 S; S.init(nvb, vb); pg8::gemm_phase<EpiIn1, OrderIn1, true, true>((LDSAS unsigned char*)lds, g, S, E, g_wave);)
    STAMP(6);
    GRID_BAR();
    REPEAT(7, phase_gla_mfma(P, (LDSAS unsigned char*)lds, vb, nvb, g_wave);)
    STAMP(7);
    GRID_BAR();
    REPEAT(8, phase_finish(P, vb, nvb, g_wave);)
    STAMP(8);
    GRID_BAR();
    { const Params P = ldparams();
      EpiOut1 E{P.ws, P.out};
      pg8::Gemm g{P.A2(), P.Wo1(), ML, D, D}; pg8::StaticOrder S; S.init(ML, D, nvb, vb); pg8::gemm_phase<EpiOut1, pg8::StaticOrder, true, true>((LDSAS unsigned char*)lds, g, S, E, g_wave); }
#ifdef PROBE_A
    STAMP(9);
    GRID_BAR();
    if (vb == 0 && g_wave == 0 && lane_id() == 0) {
        const Params P = ldparams(); const unsigned long long* ts = (const unsigned long long*)(P.ws + OFF_BAR + 14336);
        P.out[0] += (float)(ts[PROBE_A + 1] - ts[PROBE_A]) * 0.01f;
        P.out[1] += (float)(ts[PROBE_B + 1] - ts[PROBE_B]) * 0.01f;
    }
#endif
}
}

extern "C" void kernel_launch(void* const* d_in, const int* in_sizes, int n_in, void* d_out, int out_size, void* d_ws, size_t ws_size, hipStream_t stream) {
    Params P{};
    const float* const* in = (const float* const*)d_in;
    P.x = in[0]; P.c = in[1]; P.ctx = in[2]; P.c_ctx = in[3]; P.adaln_w = in[4]; P.adaln_b = in[5]; P.norm_g = in[6]; P.w_out = in[7]; P.ab_w_in = in[8];
    P.a_q_norm = in[9]; P.a_k_norm = in[10]; P.a_sink = in[11]; P.b_q_norm = in[12]; P.b_k_norm = in[13]; P.lq1 = in[14]; P.lk1 = in[15]; P.lq2 = in[16]; P.lk2 = in[17];
    P.b_subln = in[18]; P.gla_w_in = in[19]; P.wa_f = in[20]; P.ba_f = in[21]; P.wa_b = in[22]; P.ba_b = in[23]; P.gla_out_norm = in[24];
    P.out = (float*)d_out;
    P.ws = (unsigned char*)d_ws;
    for (int i = 0; i < 12; ++i) P.reps[i] = 1;
    P.reps[11] = 0;
#ifdef PROBE_PHASE
    P.reps[PROBE_PHASE] = 2;
#endif
    if (WS_NEED > ws_size) { fprintf(stderr, "workspace too small: need %zu have %zu\n", (size_t)WS_NEED, ws_size); return; }
    static int grid_blocks = 0;
    if (!grid_blocks) {
        int dev = 0, cus = 0, per_cu = 0;
        (void)hipGetDevice(&dev);
        (void)hipDeviceGetAttribute(&cus, hipDeviceAttributeMultiprocessorCount, dev);
        (void)hipOccupancyMaxActiveBlocksPerMultiprocessor(&per_cu, mega_kernel, 512, 0);
        if (per_cu > 1) per_cu = 1;
        grid_blocks = cus * per_cu;
    }
    (void)hipMemsetAsync((unsigned char*)d_ws + OFF_BAR, 0, 16384, stream);
    void* args[] = {&P};
    hipError_t e = hipLaunchCooperativeKernel((void*)mega_kernel, dim3(grid_blocks), dim3(512), args, 0, stream);
    if (e != hipSuccess) fprintf(stderr, "cooperative launch failed: %s (grid %d)\n", hipGetErrorString(e), grid_blocks);
}
```

```cpp
#include <hip/hip_runtime.h>
#include <hip/hip_cooperative_groups.h>
#include <cstdint>
#include <cstdio>

namespace {
constexpr int NB = 32, T = 2048, L = 256, D = 1024;
constexpr int ML = NB * T, MC = NB * L, M = ML + MC;
constexpr int N0 = 3328, N1 = 3328, N0R = 3328, N1R = 3104;
constexpr float EPS = 1e-6f;
constexpr float LOG2E = 1.4426950408889634f;
constexpr float QSCALE = 0.125f * LOG2E;
constexpr float LAMBDA_INIT = 0.2f;

typedef unsigned short bf16_t;
typedef short bf16x8 __attribute__((ext_vector_type(8)));
typedef float f32x4 __attribute__((ext_vector_type(4)));
typedef unsigned u32x4 __attribute__((ext_vector_type(4)));
typedef unsigned u32x2 __attribute__((ext_vector_type(2)));

constexpr size_t al256(size_t x) { return (x + 255) & ~(size_t)255; }
constexpr size_t OFF_WT0 = 0;
constexpr size_t OFF_WT1 = OFF_WT0 + al256((size_t)N0 * D * 2);
constexpr size_t OFF_WO0 = OFF_WT1 + al256((size_t)N1 * D * 2);
constexpr size_t OFF_WO1 = OFF_WO0 + al256((size_t)D * D * 2);
constexpr size_t OFF_MOD = OFF_WO1 + al256((size_t)D * D * 2);
constexpr size_t OFF_BIAS0 = OFF_MOD + al256((size_t)2 * 33 * 3072 * 4);
constexpr size_t OFF_BIAS1 = OFF_BIAS0 + al256((size_t)33 * 3328 * 4);
constexpr size_t OFF_ROPE = OFF_BIAS1 + al256((size_t)33 * 3328 * 4);
constexpr size_t OFF_SCAL = OFF_ROPE + al256(64 * 16 * 2 * 4);
constexpr size_t OFF_BAR = OFF_SCAL + 256;
constexpr size_t OFF_RS = OFF_BAR + 16384;
constexpr size_t OFF_PARTS = OFF_RS + al256((size_t)M * 4);
constexpr size_t OFF_A = OFF_PARTS + al256((size_t)16 * M * 4);
constexpr size_t OFF_O = OFF_A + (size_t)M * D * 2;
constexpr size_t OFF_QKV = OFF_O + (size_t)M * D * 2;
constexpr size_t OFF_X1B = OFF_QKV + (size_t)M * 3328 * 2;
constexpr size_t WS_NEED = OFF_X1B + (size_t)ML * D * 2;
constexpr size_t OFF_QA = OFF_QKV, OFF_KA = OFF_QA + (size_t)M * 512 * 2, OFF_VA = OFF_KA + (size_t)M * 128 * 2, OFF_GA = OFF_VA + (size_t)M * 128 * 2;
constexpr size_t OFF_QB = OFF_GA + (size_t)M * 512 * 2, OFF_KB = OFF_QB + (size_t)M * 512 * 2, OFF_VB = OFF_KB + (size_t)M * 512 * 2, OFF_GB = OFF_VB + (size_t)M * 512 * 2;
constexpr size_t OFF_QG = OFF_QKV, OFF_KG = OFF_QG + (size_t)M * 512 * 2, OFF_VG = OFF_KG + (size_t)M * 512 * 2, OFF_GG = OFF_VG + (size_t)M * 1024 * 2, OFF_RF = OFF_GG + (size_t)M * 1024 * 2;
static_assert(OFF_RF + (size_t)M * 32 * 4 <= WS_NEED, "layer-1 projections fit");
static_assert((size_t)ML * 1024 * 2 <= (size_t)M * D * 2, "forward scan outputs fit over O");

struct Params {
    const float *x, *c, *ctx, *c_ctx, *adaln_w, *adaln_b, *norm_g, *w_out, *ab_w_in, *a_q_norm, *a_k_norm, *a_sink, *b_q_norm, *b_k_norm;
    const float *lq1, *lk1, *lq2, *lk2, *b_subln, *gla_w_in, *wa_f, *ba_f, *wa_b, *ba_b, *gla_out_norm;
    float* out;
    unsigned char* ws;
    int reps[12];
#define WSPTR(T, name, off) __device__ __forceinline__ T* name() const { return (T*)(ws + (off)); }
    WSPTR(bf16_t, Wt0, OFF_WT0) WSPTR(bf16_t, Wt1, OFF_WT1) WSPTR(bf16_t, Wo0, OFF_WO0) WSPTR(bf16_t, Wo1, OFF_WO1)
    WSPTR(float, mod, OFF_MOD) WSPTR(float, bias0, OFF_BIAS0) WSPTR(float, bias1, OFF_BIAS1) WSPTR(float, rope, OFF_ROPE) WSPTR(float, scal, OFF_SCAL) WSPTR(float, parts, OFF_PARTS)
    WSPTR(bf16_t, A, OFF_A) WSPTR(bf16_t, O, OFF_O)
    WSPTR(bf16_t, QA, OFF_QA) WSPTR(bf16_t, KA, OFF_KA) WSPTR(bf16_t, VA, OFF_VA) WSPTR(bf16_t, GA, OFF_GA)
    WSPTR(bf16_t, QB, OFF_QB) WSPTR(bf16_t, KB, OFF_KB) WSPTR(bf16_t, VB, OFF_VB) WSPTR(bf16_t, GB, OFF_GB)
    WSPTR(bf16_t, QG, OFF_QG) WSPTR(bf16_t, KG, OFF_KG) WSPTR(bf16_t, VG, OFF_VG) WSPTR(bf16_t, GG, OFF_GG) WSPTR(float, RF, OFF_RF)
    WSPTR(bf16_t, ODF, OFF_O) WSPTR(bf16_t, ODB, OFF_X1B) WSPTR(bf16_t, A2, OFF_QKV)
#undef WSPTR
};

__device__ __forceinline__ int lane_id() { int l; asm volatile("v_mbcnt_lo_u32_b32 %0, -1, 0\n\tv_mbcnt_hi_u32_b32 %0, -1, %0" : "=v"(l)); return l; }
#define otid() otid_(g_wave)
__device__ __forceinline__ int otid_(int wave) { int t = wave * 64 + lane_id(); asm volatile("" : "+v"(t)); return t; }
__device__ __forceinline__ unsigned f2bf(float f) { unsigned u = __float_as_uint(f); u += 0x7FFFu + ((u >> 16) & 1u); return u >> 16; }
__device__ __forceinline__ unsigned pack2(float lo, float hi) { return f2bf(lo) | (f2bf(hi) << 16); }
typedef float f32x2_t __attribute__((ext_vector_type(2)));
typedef __bf16 bf16x2_t __attribute__((ext_vector_type(2)));
__device__ __forceinline__ unsigned cvtpk(float lo, float hi) { f32x2_t v = {lo, hi}; bf16x2_t b = __builtin_convertvector(v, bf16x2_t); return __builtin_bit_cast(unsigned, b); }
__device__ __forceinline__ float bf2f(unsigned h) { return __uint_as_float(h << 16); }
__device__ __forceinline__ float bflo(unsigned w) { return __uint_as_float(w << 16); }
__device__ __forceinline__ float bfhi(unsigned w) { return __uint_as_float(w & 0xFFFF0000u); }
__device__ __forceinline__ float sum_xor16(float x) { const auto r = __builtin_amdgcn_permlane16_swap(__float_as_uint(x), __float_as_uint(x), false, false); return __uint_as_float(r[0]) + __uint_as_float(r[1]); }
__device__ __forceinline__ float sum_xor32(float x) { const auto r = __builtin_amdgcn_permlane32_swap(__float_as_uint(x), __float_as_uint(x), false, false); return __uint_as_float(r[0]) + __uint_as_float(r[1]); }
template <int CTRL> __device__ __forceinline__ float dppf(float x) { return __int_as_float(__builtin_amdgcn_mov_dpp(__float_as_int(x), CTRL, 0xF, 0xF, true)); }
__device__ __forceinline__ float sum_row16(float x) { x += dppf<0xB1>(x); x += dppf<0x4E>(x); x += dppf<0x124>(x); x += dppf<0x128>(x); return x; }
__device__ __forceinline__ f32x4 clamp_scale(f32x4 s) {
#pragma unroll
    for (int e = 0; e < 4; ++e) s[e] = fabsf(s[e]) >= 1e-6f ? s[e] : (s[e] < 0.f ? -1e-6f : 1e-6f);
    return s;
}
__device__ __forceinline__ void load32(const void* base32, int lane, u32x4& lo, u32x4& hi2) {
    const unsigned char* p = (const unsigned char*)base32 + (lane & 31) * 32 + (lane >> 5) * 16;
    u32x4 a = *(const u32x4*)p, b = *(const u32x4*)(p + 1024);
#pragma unroll
    for (int e = 0; e < 4; ++e) { const auto sw = __builtin_amdgcn_permlane32_swap(a[e], b[e], false, false); a[e] = sw[0]; b[e] = sw[1]; }
    lo = a; hi2 = b;
}
__device__ __forceinline__ float siluf(float v) { return v * __builtin_amdgcn_rcpf(1.0f + __builtin_amdgcn_exp2f(-v * LOG2E)); }

__device__ __forceinline__ Params ldparams() {
#if defined(__HIP_DEVICE_COMPILE__)
    const __attribute__((address_space(4))) Params* pp = (const __attribute__((address_space(4))) Params*)__builtin_amdgcn_kernarg_segment_ptr();
    asm volatile("" : "+s"(pp));
    return *pp;
#else
    return Params{};
#endif
}

__device__ __forceinline__ int perm_local(int p, bool ropeType) {
    const int bj = p >> 7, wc = (p >> 5) & 3, low = p & 31;
    if (ropeType) return wc * 64 + bj * 32 + low;
    const int n = (low >> 4) & 1, fq = (low >> 2) & 3, e = low & 3;
    return wc * 64 + bj * 32 + fq * 8 + n * 4 + e;
}
__device__ __forceinline__ int src_col(int which, int np) {
    const int p = np & 255, tile = np >> 8;
    bool rope = false;
    if (which == 0) { const int g = tile * 4 + ((p >> 5) & 3); rope = (g < 10) || (g >= 20 && g < 36); }
    const int c = tile * 256 + perm_local(p, rope);
    const int nreal = which == 0 ? N0R : (which == 1 ? N1R : D);
    return c < nreal ? c : -1;
}

__device__ __forceinline__ int dst_row(int which, int c) {
    const int tile = c >> 8, cl = c & 255, wc = cl >> 6, bj = (cl >> 5) & 1, low = cl & 31;
    bool rope = false;
    if (which == 0) { const int g = tile * 4 + wc; rope = (g < 10) || (g >= 20 && g < 36); }
    int lo5 = low;
    if (!rope) { const int fq = low >> 3, n = (low >> 2) & 1, e = low & 3; lo5 = n * 16 + fq * 4 + e; }
    return tile * 256 + bj * 128 + wc * 32 + lo5;
}

__device__ __forceinline__ void wt_quad(const float* __restrict__ W, int ldw, int nreal, int which, bf16_t* __restrict__ dst, int c0, int k0, unsigned char* lds, int tid) {
    bf16_t* t = (bf16_t*)lds;
    __syncthreads();
    f32x4 v[8];
#pragma unroll
    for (int i = 0; i < 8; ++i) {
        const int idx = tid + 512 * i, r = idx >> 4, c4 = (idx & 15) * 4;
        const bool ok = c0 + c4 < nreal;
        const f32x4 t4 = *(const f32x4*)(W + (size_t)(k0 + r) * ldw + (ok ? c0 + c4 : 0));
        v[i] = ok ? t4 : (f32x4){0.f, 0.f, 0.f, 0.f};
    }
#pragma unroll
    for (int i = 0; i < 8; ++i) {
        const int idx = tid + 512 * i, r = idx >> 4, c4 = (idx & 15) * 4;
#pragma unroll
        for (int j = 0; j < 4; ++j) t[(c4 + j) * 264 + r] = (bf16_t)f2bf(v[i][j]);
    }
    __syncthreads();
    const int c = tid >> 3, kc = tid & 7;
    bf16_t* drow = dst + (size_t)dst_row(which, c0 + c) * D + k0 + kc * 32;
#pragma unroll
    for (int j = 0; j < 4; ++j) *(u32x4*)(drow + j * 8) = *(const u32x4*)(t + c * 264 + kc * 32 + j * 8);
}

template <int MODE>
__device__ __forceinline__ void skinny_unit(const Params& P, int l, int c0, unsigned char* lds, int tid) {
    float* tab = (float*)lds;
    asm volatile("" : "+v"(tid));
    const int lane = tid & 63, w = tid >> 6, cl = lane & 31, kh = lane >> 5;
    const float* W; int ldw, nreal;
    if (MODE == 0) { W = P.adaln_w + (size_t)l * D * 3072; ldw = 3072; nreal = 3072; }
    else { W = l ? P.gla_w_in : P.ab_w_in; ldw = l ? N1R : N0R; nreal = ldw; }
    const bool colok = c0 + cl < nreal;
    const int kb = w * 64 + kh * 32;
    float xv[2][33], wv[2][32];
#pragma unroll
    for (int half = 0; half < 2; ++half) {
#pragma unroll
        for (int r = 0; r < 33; ++r) {
            if (MODE == 0) xv[half][r] = (r < 32 ? P.c + (size_t)r * D : P.c_ctx)[half * 512 + tid];
            else xv[half][r] = P.mod()[((size_t)l * 33 + r) * 3072 + half * 512 + tid];
        }
        const float* wp = W + (size_t)(half * 512 + kb) * ldw + (colok ? c0 + cl : 0);
#pragma unroll
        for (int j = 0; j < 32; ++j) wv[half][j] = wp[(size_t)j * ldw];
    }
    float acc[33];
#pragma unroll
    for (int r = 0; r < 33; ++r) acc[r] = 0.f;
#pragma unroll
    for (int half = 0; half < 2; ++half) {
        __syncthreads();
#pragma unroll
        for (int r = 0; r < 33; ++r) tab[tid * 36 + r] = MODE == 0 ? siluf(xv[half][r]) : xv[half][r];
        __syncthreads();
#pragma unroll
        for (int j = 0; j < 32; ++j) {
            const int k = kb + j; const float wq = colok ? wv[half][j] : 0.f;
#pragma unroll
            for (int r4 = 0; r4 < 8; ++r4) { const f32x4 s = *(const f32x4*)(tab + k * 36 + r4 * 4); acc[r4 * 4] += s[0] * wq; acc[r4 * 4 + 1] += s[1] * wq; acc[r4 * 4 + 2] += s[2] * wq; acc[r4 * 4 + 3] += s[3] * wq; }
            acc[32] += tab[k * 36 + 32] * wq;
            if ((j & 1) == 1) __builtin_amdgcn_sched_barrier(0);
        }
    }
#pragma unroll
    for (int r = 0; r < 33; ++r) acc[r] = sum_xor32(acc[r]);
    __syncthreads();
    if (kh == 0) {
#pragma unroll
        for (int r = 0; r < 33; ++r) tab[(w * 33 + r) * 32 + cl] = acc[r];
    }
    __syncthreads();
    for (int idx = tid; idx < 33 * 32; idx += 512) {
        const int r = idx >> 5, col = idx & 31;
        float s = 0.f;
#pragma unroll
        for (int ww = 0; ww < 8; ++ww) s += tab[(ww * 33 + r) * 32 + col];
        if (MODE == 0) { const int j = c0 + col; P.mod()[((size_t)l * 33 + r) * 3072 + j] = s + P.adaln_b[l * 3072 + j]; }
        else { const int c = c0 + col; (l ? P.bias1() : P.bias0())[r * 3328 + dst_row(l, c)] = c < nreal ? s : 0.f; }
    }
}

constexpr int TICKET_LDS = 140288 + 8;
#define TICKET_LOOP(ctr, N, ...) { volatile int* sh_ = (volatile int*)(lds + TICKET_LDS); unsigned* ctr_ = (unsigned*)(P.ws + OFF_BAR + 14336) + (ctr) * 16; \
        __syncthreads(); if (tidx == 0) *sh_ = (int)__hip_atomic_fetch_add(ctr_, 1u, __ATOMIC_RELAXED, __HIP_MEMORY_SCOPE_AGENT); __syncthreads(); \
        int item = *sh_; \
        while (item < (N)) { unsigned nx_ = 0; if (tidx == 0) nx_ = __hip_atomic_fetch_add(ctr_, 1u, __ATOMIC_RELAXED, __HIP_MEMORY_SCOPE_AGENT); \
            __VA_ARGS__ \
            __syncthreads(); if (tidx == 0) *sh_ = (int)nx_; __syncthreads(); item = *sh_; } }

__device__ __forceinline__ void phase_pro0(const Params& P, unsigned char* lds, int vb, int nvb, int g_wave) {
    const int tidx = otid();
    TICKET_LOOP(0, 192 + 544,
        if (item < 192) skinny_unit<0>(P, item / 96, (item % 96) * 32, lds, tidx);
        else {
            int t = item - 192; int which; const float* W; bf16_t* dst; int ldw, nreal;
            if (t < 208) { which = 0; W = P.ab_w_in; dst = P.Wt0(); ldw = N0R; nreal = N0R; }
            else if ((t -= 208) < 208) { which = 1; W = P.gla_w_in; dst = P.Wt1(); ldw = N1R; nreal = N1R; }
            else if ((t -= 208) < 64) { which = 2; W = P.w_out; dst = P.Wo0(); ldw = D; nreal = D; }
            else { t -= 64; which = 3; W = P.w_out + (size_t)D * D; dst = P.Wo1(); ldw = D; nreal = D; }
            wt_quad(W, ldw, nreal, which, dst, (t >> 2) * 64, (t & 3) * 256, lds, tidx);
        })
    if (vb == nvb - 1 && tidx < 64) {
        float d1 = P.lq1[tidx] * P.lk1[tidx], d2 = P.lq2[tidx] * P.lk2[tidx];
        d1 = sum_xor32(sum_xor16(sum_row16(d1))); d2 = sum_xor32(sum_xor16(sum_row16(d2)));
        if (tidx == 0) P.scal()[0] = expf(d1) - expf(d2) + LAMBDA_INIT;
    }
}

__device__ __forceinline__ void a0_row2(const Params& P, int row0, int lane) {
    const int r = row0 < ML ? row0 >> 11 : 32;
    const float* sc = P.mod() + (size_t)r * 3072 + 1024;
    f32x4 a[2][2], b[2][2], sa[2], sb[2];
#pragma unroll
    for (int q = 0; q < 2; ++q) {
        const int row = row0 + q;
        const float* xin = row < ML ? P.x + (size_t)row * D : P.ctx + (size_t)(row - ML) * D;
#pragma unroll
        for (int i = 0; i < 2; ++i) { u32x4 t0, t1; load32(xin + i * 512, lane, t0, t1); a[q][i] = __builtin_bit_cast(f32x4, t0); b[q][i] = __builtin_bit_cast(f32x4, t1); }
    }
#pragma unroll
    for (int i = 0; i < 2; ++i) {
        u32x4 t0, t1, u0, u1;
        load32(P.norm_g + i * 512, lane, t0, t1); load32(sc + i * 512, lane, u0, u1);
        sa[i] = clamp_scale(__builtin_bit_cast(f32x4, t0) * (1.0f + __builtin_bit_cast(f32x4, u0)));
        sb[i] = clamp_scale(__builtin_bit_cast(f32x4, t1) * (1.0f + __builtin_bit_cast(f32x4, u1)));
    }
#pragma unroll
    for (int q = 0; q < 2; ++q) {
        const int row = row0 + q;
        float ss = 0.f;
#pragma unroll
        for (int i = 0; i < 2; ++i) {
            const int c0 = i * 512 + lane * 8;
            const f32x4 av = a[q][i], bv = b[q][i];
            ss += av[0] * av[0] + av[1] * av[1] + av[2] * av[2] + av[3] * av[3] + bv[0] * bv[0] + bv[1] * bv[1] + bv[2] * bv[2] + bv[3] * bv[3];
            const f32x4 ya = av * sa[i], yb = bv * sb[i];
            u32x4 o; o.x = cvtpk(ya[0], ya[1]); o.y = cvtpk(ya[2], ya[3]); o.z = cvtpk(yb[0], yb[1]); o.w = cvtpk(yb[2], yb[3]);
            *(u32x4*)(P.A() + (size_t)row * D + c0) = o;
        }
        ss = sum_row16(ss); ss = sum_xor16(ss); ss = sum_xor32(ss);
        if (lane == 0) ((float*)(P.ws + OFF_RS))[row] = rsqrtf(ss * (1.0f / 1024.0f) + EPS);
    }
}

__device__ __forceinline__ void phase_bias_a0(const Params& P, unsigned char* lds, int vb, int nvb, int g_wave) {
    const int tidx = otid();
    const int lane = tidx & 63, w = tidx >> 6;
    TICKET_LOOP(1, 208 + M / 32,
        if (item < 208) skinny_unit<1>(P, item / 104, (item % 104) * 32, lds, tidx);
        else {
            const int row0 = (item - 208) * 32 + w * 4;
            for (int j = 0; j < 4; j += 2) a0_row2(P, row0 + j, lane);
        })
}

namespace pg8 {
#define PG8_LAS __attribute__((address_space(3)))
typedef unsigned short bf16_t;
typedef short bf16x8 __attribute__((ext_vector_type(8)));
typedef float f32x4 __attribute__((ext_vector_type(4)));
typedef unsigned u32x4 __attribute__((ext_vector_type(4)));
constexpr int BM = 256, BK = 64, HALF = 128, HTB = HALF * BK * 2  , STAGE_BYTES = 8 * HTB, NXCD = 8, WGM = 8;

__host__ __device__ __forceinline__ int lds_byte(int r, int c) { const int st = (r >> 4) * 2 + (c >> 5), rr = r & 15, cc = c & 31, ob = rr * 64 + cc * 2; return st * 1024 + (ob ^ (((ob >> 9) & 1) << 5)); }
__host__ __device__ __forceinline__ void stage_rc(int b, int& R, int& C) { const int st = b / 1024, sb = b % 1024, swz = sb ^ (((sb >> 9) & 1) << 5); R = (st >> 1) * 16 + swz / 64; C = (st & 1) * 32 + (swz % 64) / 2; }
__host__ __device__ __forceinline__ int perm32(int rho) { const int n = rho >> 4, i = rho & 15; return 8 * (i >> 2) + 4 * n + (i & 3); }

struct Unit { int pm, pn; };
struct Gemm { const bf16_t* A; const bf16_t* Bt; int M, N, K; };

struct StaticOrder {
    int nM, nN, nwg, G, c;
    __host__ __device__ void init(int M, int N, int G_, int c_) { nM = M / BM; nN = N / BM; nwg = nM * nN; G = G_; c = c_; }
    __host__ __device__ bool next(int i, Unit& u) const {
        const long L = (long)i * G + c; if (L >= nwg) return false;
        int wgid = (int)L; { const int q = nwg / NXCD, r = nwg % NXCD, xcd = wgid % NXCD, off = wgid / NXCD; wgid = (xcd < r ? xcd * (q + 1) : r * (q + 1) + (xcd - r) * q) + off; }
        const int nig = WGM * nN, gid = wgid / nig, fm = gid * WGM, gsz = (nM - fm) < WGM ? (nM - fm) : WGM;
        u.pm = fm + ((wgid % nig) % gsz); u.pn = (wgid % nig) / gsz; return true;
    }
    __device__ __forceinline__ void a_ready(const Unit&) const {}
    __device__ __forceinline__ void done(const Unit&) const {}
};
template <class Epi, class Sched, bool ALIGN_EPI = false, bool SP2 = false>
__device__ __forceinline__ void gemm_phase(PG8_LAS unsigned char* lds, const Gemm g, const Sched& S, const Epi& E, int g_wave) {
    const int tid = otid(), wid = __builtin_amdgcn_readfirstlane(tid >> 6), lane = tid & 63, wr = wid >> 2, wc = wid & 3, fr = lane & 15, fq = lane >> 4;
    const int K = g.K, nt = K / BK;
    unsigned voffA[2], voffB[2];
#pragma unroll
    for (int i = 0; i < 2; ++i) { int R, C; stage_rc(tid * 16 + i * 8192, R, C); const int Rb = Epi::PERM ? ((R & ~31) + perm32(R & 31)) : R;
        voffA[i] = (unsigned)(R * K + C) * 2u; voffB[i] = (unsigned)(Rb * K + C) * 2u; }
    const size_t kstep = (size_t)(BK * 2);
    const size_t hstep = (size_t)HALF * K * 2;
    const size_t tstep = 2 * hstep;
    const unsigned ldsw = (unsigned)wid * 1024u;
    const int aoff = lds_byte(wr * 64 + fr, fq * 8), boff = lds_byte(wc * 32 + fr, fq * 8);
#define PG8_SA(b, h) (((b) * 2 + (h)) * HTB)
#define PG8_SB(b, h) ((4 + (b) * 2 + (h)) * HTB)
#define PG8_STAGE(bufoff, gbase, voff) do { _Pragma("unroll") for (int _i = 0; _i < 2; ++_i) \
        __builtin_amdgcn_global_load_lds((const unsigned*)((const char*)(gbase) + (voff)[_i]), (PG8_LAS unsigned*)(lds + (bufoff) + ldsw + _i * 8192), 16, 0, 0); } while (0)
#define PG8_LDA(dst, b, h) do { _Pragma("unroll") for (int m = 0; m < 4; ++m) _Pragma("unroll") for (int k = 0; k < 2; ++k) dst[m][k] = *(const PG8_LAS bf16x8*)(lds + PG8_SA(b, h) + aoff + m * 2048 + k * 1024); } while (0)
#define PG8_LDB(dst, b, h) do { _Pragma("unroll") for (int n = 0; n < 2; ++n) _Pragma("unroll") for (int k = 0; k < 2; ++k) dst[n][k] = *(const PG8_LAS bf16x8*)(lds + PG8_SB(b, h) + boff + n * 2048 + k * 1024); } while (0)
#define PG8_MMA(ai, bj, At, Bt) do { __builtin_amdgcn_s_setprio(1); _Pragma("unroll") for (int m = 0; m < 4; ++m) _Pragma("unroll") for (int n = 0; n < 2; ++n) _Pragma("unroll") for (int k = 0; k < 2; ++k) \
        acc[ai][bj][m][n] = __builtin_amdgcn_mfma_f32_16x16x32_bf16(Bt[n][k], At[m][k], acc[ai][bj][m][n], 0, 0, 0); __builtin_amdgcn_s_setprio(0); } while (0)
#define PG8_WAIT_V(n) asm volatile("s_waitcnt vmcnt(" #n ")" ::: "memory")
#define PG8_WAIT_L(n) asm volatile("s_waitcnt lgkmcnt(" #n ")" ::: "memory")
#define PG8_BAR __builtin_amdgcn_s_barrier()
#define PG8_SCHED __builtin_amdgcn_sched_barrier(0)
    Unit cur, nxt; int ui = 0;
    if (!S.next(0, cur)) return;
    f32x4 acc[2][2][4][2];
#pragma unroll
    for (int a = 0; a < 2; ++a)
#pragma unroll
        for (int b = 0; b < 2; ++b)
#pragma unroll
            for (int m = 0; m < 4; ++m)
#pragma unroll
                for (int n = 0; n < 2; ++n) acc[a][b][m][n] = (f32x4){0.f, 0.f, 0.f, 0.f};
    bf16x8 At[4][2], B0[2][2], B1[2][2];
    const char* cA = (const char*)g.A + (size_t)cur.pm * tstep; const char* cB = (const char*)g.Bt + (size_t)cur.pn * tstep;
    S.a_ready(cur);
    if constexpr (SP2) {
        PG8_STAGE(PG8_SB(0, 0), cB, voffB); PG8_STAGE(PG8_SB(0, 1), cB + hstep, voffB); PG8_STAGE(PG8_SA(0, 0), cA, voffA); PG8_STAGE(PG8_SA(0, 1), cA + hstep, voffA);
        if (wr == 1) PG8_BAR;
        PG8_WAIT_V(2); PG8_BAR;
        PG8_STAGE(PG8_SB(1, 0), cB + kstep, voffB); PG8_STAGE(PG8_SA(1, 0), cA + kstep, voffA); PG8_STAGE(PG8_SB(1, 1), cB + hstep + kstep, voffB);
        PG8_WAIT_V(6); PG8_BAR;
    } else {
        PG8_STAGE(PG8_SB(0, 0), cB, voffB); PG8_STAGE(PG8_SA(0, 0), cA, voffA); PG8_STAGE(PG8_SB(0, 1), cB + hstep, voffB); PG8_STAGE(PG8_SA(0, 1), cA + hstep, voffA);
        if (wr == 1) PG8_BAR;
        PG8_WAIT_V(4); PG8_BAR;
        PG8_STAGE(PG8_SB(1, 0), cB + kstep, voffB); PG8_STAGE(PG8_SA(1, 0), cA + kstep, voffA); PG8_STAGE(PG8_SB(1, 1), cB + hstep + kstep, voffB);
        PG8_WAIT_V(6); PG8_BAR;
    }
    for (;;) {
        const bool has_next = S.next(ui + 1, nxt);
        const char* nA = has_next ? (const char*)g.A + (size_t)nxt.pm * tstep : cA; const char* nB = has_next ? (const char*)g.Bt + (size_t)nxt.pn * tstep : cB;
        for (int t = 0; t < nt; t += 2) {
            const bool last = (t == nt - 2);
            const char* a1 = cA + (size_t)(t + 1) * kstep;
            const char* a2 = last ? nA : cA + (size_t)(t + 2) * kstep; const char* b2 = last ? nB : cB + (size_t)(t + 2) * kstep;
            const char* a3 = a2 + kstep; const char* b3 = b2 + kstep;
            if (last && has_next) S.a_ready(nxt);
            if constexpr (SP2) {
            PG8_LDB(B0, 0, 0); PG8_LDB(B1, 0, 1); PG8_SCHED; PG8_LDA(At, 0, 0); PG8_STAGE(PG8_SA(1, 1), a1 + hstep, voffA);
            PG8_WAIT_V(8); PG8_WAIT_L(0); PG8_BAR; PG8_MMA(0, 0, At, B0); PG8_MMA(0, 1, At, B1); PG8_BAR; PG8_SCHED;
            PG8_LDA(At, 0, 1); PG8_STAGE(PG8_SB(0, 0), b2, voffB); PG8_STAGE(PG8_SB(0, 1), b2 + hstep, voffB); PG8_STAGE(PG8_SA(0, 0), a2, voffA);
            PG8_WAIT_V(8); PG8_WAIT_L(0); PG8_BAR; PG8_MMA(1, 0, At, B0); PG8_MMA(1, 1, At, B1); PG8_BAR; PG8_SCHED;
            PG8_LDB(B0, 1, 0); PG8_LDB(B1, 1, 1); PG8_SCHED; PG8_LDA(At, 1, 0); PG8_STAGE(PG8_SA(0, 1), a2 + hstep, voffA);
            PG8_WAIT_V(8); PG8_WAIT_L(0); PG8_BAR; PG8_MMA(0, 0, At, B0); PG8_MMA(0, 1, At, B1); PG8_BAR; PG8_SCHED;
            PG8_LDA(At, 1, 1); PG8_STAGE(PG8_SB(1, 0), b3, voffB); PG8_STAGE(PG8_SB(1, 1), b3 + hstep, voffB); PG8_STAGE(PG8_SA(1, 0), a3, voffA);
            PG8_WAIT_V(8); PG8_WAIT_L(0); PG8_BAR; PG8_MMA(1, 0, At, B0); PG8_MMA(1, 1, At, B1); PG8_BAR; PG8_SCHED;
            } else {
            PG8_LDB(B0, 0, 0); PG8_SCHED; PG8_LDA(At, 0, 0); PG8_STAGE(PG8_SA(1, 1), a1 + hstep, voffA);
            PG8_WAIT_L(8); PG8_BAR; PG8_WAIT_L(0); PG8_MMA(0, 0, At, B0); PG8_BAR; PG8_SCHED;
            PG8_LDB(B1, 0, 1); PG8_STAGE(PG8_SB(0, 0), b2, voffB);
            PG8_BAR; PG8_WAIT_L(0); PG8_MMA(0, 1, At, B1); PG8_BAR;
            PG8_LDA(At, 0, 1); PG8_STAGE(PG8_SA(0, 0), a2, voffA);
            PG8_BAR; PG8_WAIT_L(0); PG8_MMA(1, 0, At, B0); PG8_BAR; PG8_SCHED;
            PG8_STAGE(PG8_SB(0, 1), b2 + hstep, voffB);
            PG8_WAIT_V(6); PG8_BAR; PG8_MMA(1, 1, At, B1); PG8_BAR;
            PG8_LDB(B0, 1, 0); PG8_SCHED; PG8_LDA(At, 1, 0); PG8_STAGE(PG8_SA(0, 1), a2 + hstep, voffA);
            PG8_WAIT_L(8); PG8_BAR; PG8_WAIT_L(0); PG8_MMA(0, 0, At, B0); PG8_BAR; PG8_SCHED;
            PG8_LDB(B1, 1, 1); PG8_STAGE(PG8_SB(1, 0), b3, voffB);
            PG8_BAR; PG8_WAIT_L(0); PG8_MMA(0, 1, At, B1); PG8_BAR;
            PG8_LDA(At, 1, 1); PG8_STAGE(PG8_SA(1, 0), a3, voffA);
            PG8_BAR; PG8_WAIT_L(0); PG8_MMA(1, 0, At, B0); PG8_BAR; PG8_SCHED;
            PG8_STAGE(PG8_SB(1, 1), b3 + hstep, voffB);
            PG8_WAIT_V(6); PG8_BAR; PG8_MMA(1, 1, At, B1); PG8_BAR;
            }
        }
        if constexpr (ALIGN_EPI) { if (wr == 0) PG8_BAR; }
        if constexpr (!Epi::AFTER_DRAIN) { E(acc, cur, wr, wc, fr, fq); S.done(cur); }
        if (!has_next) break;
#pragma unroll
        for (int a = 0; a < 2; ++a)
#pragma unroll
            for (int b = 0; b < 2; ++b)
#pragma unroll
                for (int m = 0; m < 4; ++m)
#pragma unroll
                    for (int n = 0; n < 2; ++n) acc[a][b][m][n] = (f32x4){0.f, 0.f, 0.f, 0.f};
        cur = nxt; cA = nA; cB = nB; ++ui;
        if constexpr (ALIGN_EPI) { if (wr == 1) PG8_BAR; }
    }
    PG8_WAIT_V(0);
    if constexpr (!ALIGN_EPI) { if (wr == 0) PG8_BAR; }
    PG8_BAR;
    if constexpr (Epi::AFTER_DRAIN) { E.fused(acc, cur, wr, wc, fr, fq, lds, wid, lane); S.done(cur); }
#undef PG8_SA
#undef PG8_SB
#undef PG8_STAGE
#undef PG8_LDA
#undef PG8_LDB
#undef PG8_MMA
#undef PG8_WAIT_V
#undef PG8_WAIT_L
#undef PG8_BAR
#undef PG8_SCHED
}
}

struct OrderIn1 {
    pg8::StaticOrder base; int G, c;
    __device__ void init(int G_, int c_) { base.init(ML, N1, G_, c_); G = G_; c = c_; }
    __device__ bool next(int i, pg8::Unit& u) const {
        const int Lx = i * G + c;
        if (Lx < 256 * 13) return base.next(i, u);
        const int r = Lx - 256 * 13; if (r >= 32 * 7) return false;
        const int j = r >> 5; u.pm = 256 + (r & 31); u.pn = j < 6 ? 2 + j : 12; return true;
    }
    __device__ __forceinline__ void a_ready(const pg8::Unit&) const {}
    __device__ __forceinline__ void done(const pg8::Unit&) const {}
};

struct EpiIn0 {
    unsigned char* ws;
    const float *aqn, *akn, *bqn, *bkn;
    static constexpr bool PERM = false, AFTER_DRAIN = false;
    __device__ __forceinline__ void operator()(const f32x4 (&acc)[2][2][4][2], const pg8::Unit& u, int wr, int wc, int fr, int fq) const { (*this)(acc, u.pm, u.pn, wr, wc, fr, fq); }
    __device__ __forceinline__ void operator()(const f32x4 (&acc)[2][2][4][2], int pm, int pn, int wr, int wc, int fr, int fq) const {
        const int g = 4 * pn + wc;
        const float* rs = (const float*)(ws + OFF_RS);
        size_t doff; int ld, col, type; const float* gain = aqn;
        if (g < 8) { doff = OFF_QA; ld = 512; col = g * 64; type = 2; gain = aqn; }
        else if (g < 10) { doff = OFF_KA; ld = 128; col = (g - 8) * 64; type = 3; gain = akn; }
        else if (g < 12) { doff = OFF_VA; ld = 128; col = (g - 10) * 64; type = 0; }
        else if (g < 20) { doff = OFF_GA; ld = 512; col = (g - 12) * 64; type = 1; }
        else if (g < 28) { doff = OFF_QB; ld = 512; col = (g - 20) * 64; type = 2; gain = bqn; }
        else if (g < 36) { doff = OFF_KB; ld = 512; col = (g - 28) * 64; type = 3; gain = bkn; }
        else if (g < 44) { doff = OFF_VB; ld = 512; col = (g - 36) * 64; type = 0; }
        else { doff = OFF_GB; ld = 512; col = (g - 44) * 64; type = 1; }
        bf16_t* dst = (bf16_t*)(ws + doff);
        const bool lat = pm < 256; const int r = lat ? pm >> 3 : 32;
        const float* bptr = (const float*)(ws + OFF_BIAS0) + (size_t)r * 3328 + pn * 256 + wc * 32 + fq * 4;
        f32x4 bia[2][2], gn[2][2];
        const float qs = type == 2 ? QSCALE : 1.0f;
#pragma unroll
        for (int bj = 0; bj < 2; ++bj)
#pragma unroll
            for (int n = 0; n < 2; ++n) { bia[bj][n] = *(const f32x4*)(bptr + bj * 128 + n * 16); gn[bj][n] = *(const f32x4*)(gain + bj * 32 + n * 16 + fq * 4) * qs; }
        float rsv[2][4];
#pragma unroll
        for (int ai = 0; ai < 2; ++ai)
#pragma unroll
            for (int m = 0; m < 4; ++m) rsv[ai][m] = rs[pm * 256 + ai * 128 + wr * 64 + m * 16 + fr];
        float frq[4];
#pragma unroll
        for (int e = 0; e < 4; ++e) frq[e] = __builtin_amdgcn_exp2f(-(float)(fq * 4 + e) * 0.830482023721841f) * 0.15915494309189535f;
#pragma unroll
        for (int ai = 0; ai < 2; ++ai) {
            const float prow = (float)((pm * 4 + ai * 2 + wr) & 31);
            int fro = fr; asm volatile("" : "+v"(fro));
#pragma unroll
            for (int m = 0; m < 4; ++m) {
                const int row = pm * 256 + ai * 128 + wr * 64 + m * 16 + fr;
                const float rstd = rsv[ai][m];
                f32x4 v[2][2];
#pragma unroll
                for (int bj = 0; bj < 2; ++bj)
#pragma unroll
                    for (int n = 0; n < 2; ++n) v[bj][n] = acc[ai][bj][m][n] * rstd + bia[bj][n];
                if (type >= 2) {
                    float s2 = 0.f;
#pragma unroll
                    for (int bj = 0; bj < 2; ++bj)
#pragma unroll
                        for (int n = 0; n < 2; ++n) s2 += v[bj][n][0] * v[bj][n][0] + v[bj][n][1] * v[bj][n][1] + v[bj][n][2] * v[bj][n][2] + v[bj][n][3] * v[bj][n][3];
                    s2 = sum_xor16(s2); s2 = sum_xor32(s2);
                    const float rn = rsqrtf(s2 * (1.0f / 64.0f) + EPS);
#pragma unroll
                    for (int bj = 0; bj < 2; ++bj)
#pragma unroll
                        for (int n = 0; n < 2; ++n) v[bj][n] = v[bj][n] * rn * gn[bj][n];
                    if (lat) {
                        const float pcol = (float)(m * 16 + fro);
#pragma unroll
                        for (int bj = 0; bj < 2; ++bj) {
                            const float pos = bj ? pcol : prow;
#pragma unroll
                            for (int e = 0; e < 4; ++e) {
                                const float rev = pos * frq[e];
                                const float cc = __builtin_amdgcn_cosf(rev), sn = __builtin_amdgcn_sinf(rev);
                                const float x1 = v[bj][0][e], x2 = v[bj][1][e]; v[bj][0][e] = x1 * cc - x2 * sn; v[bj][1][e] = x2 * cc + x1 * sn;
                            }
                        }
                    }
                } else if (type == 1) {
#pragma unroll
                    for (int bj = 0; bj < 2; ++bj)
#pragma unroll
                        for (int n = 0; n < 2; ++n)
#pragma unroll
                            for (int e = 0; e < 4; ++e) v[bj][n][e] = siluf(v[bj][n][e]);
                }
#pragma unroll
                for (int bj = 0; bj < 2; ++bj) {
                    u32x4 o; o.x = cvtpk(v[bj][0][0], v[bj][0][1]); o.y = cvtpk(v[bj][0][2], v[bj][0][3]); o.z = cvtpk(v[bj][1][0], v[bj][1][1]); o.w = cvtpk(v[bj][1][2], v[bj][1][3]);
                    *(u32x4*)(dst + (size_t)row * ld + col + bj * 32 + fq * 8) = o;
                }
            }
        }
    }
};

struct EpiIn1 {
    unsigned char* ws;
    static constexpr bool PERM = false, AFTER_DRAIN = false;
    __device__ __forceinline__ void operator()(const f32x4 (&acc)[2][2][4][2], const pg8::Unit& u, int wr, int wc, int fr, int fq) const { (*this)(acc, u.pm, u.pn, wr, wc, fr, fq); }
    __device__ __forceinline__ void operator()(const f32x4 (&acc)[2][2][4][2], int pm, int pn, int wr, int wc, int fr, int fq) const {
        const int g = 4 * pn + wc;
        if (g > 48) return;
        const float* rs = (const float*)(ws + OFF_RS); float* RF = (float*)(ws + OFF_RF);
        size_t doff = OFF_QG; int ld = 0, col = 0, type;
        if (g < 8) { doff = OFF_QG; ld = 512; col = g * 64; type = 2; }
        else if (g < 16) { doff = OFF_KG; ld = 512; col = (g - 8) * 64; type = 0; }
        else if (g < 32) { doff = OFF_VG; ld = 1024; col = (g - 16) * 64; type = 0; }
        else if (g < 48) { doff = OFF_GG; ld = 1024; col = (g - 32) * 64; type = 1; }
        else type = 3;
        bf16_t* dst = (bf16_t*)(ws + doff);
        const int r = pm < 256 ? pm >> 3 : 32;
        const float* bptr = (const float*)(ws + OFF_BIAS1) + (size_t)r * 3328 + pn * 256 + wc * 32 + fq * 4;
        f32x4 bia[2][2];
#pragma unroll
        for (int bj = 0; bj < 2; ++bj)
#pragma unroll
            for (int n = 0; n < 2; ++n) bia[bj][n] = *(const f32x4*)(bptr + bj * 128 + n * 16);
        float rsv[2][4];
#pragma unroll
        for (int ai = 0; ai < 2; ++ai)
#pragma unroll
            for (int m = 0; m < 4; ++m) rsv[ai][m] = rs[pm * 256 + ai * 128 + wr * 64 + m * 16 + fr];
        const float sc = type == 2 ? 0.08838834764831845f : 1.0f;
#pragma unroll
        for (int ai = 0; ai < 2; ++ai)
#pragma unroll
            for (int m = 0; m < 4; ++m) {
                const int row = pm * 256 + ai * 128 + wr * 64 + m * 16 + fr;
                const float rstd = rsv[ai][m];
                f32x4 v[2][2];
#pragma unroll
                for (int bj = 0; bj < 2; ++bj)
#pragma unroll
                    for (int n = 0; n < 2; ++n) v[bj][n] = (acc[ai][bj][m][n] * rstd + bia[bj][n]) * sc;
                if (type == 3) {
                    *(f32x4*)(RF + (size_t)row * 32 + fq * 8) = v[0][0];
                    *(f32x4*)(RF + (size_t)row * 32 + fq * 8 + 4) = v[0][1];
                    continue;
                }
                if (type == 1) {
#pragma unroll
                    for (int bj = 0; bj < 2; ++bj)
#pragma unroll
                        for (int n = 0; n < 2; ++n)
#pragma unroll
                            for (int e = 0; e < 4; ++e) v[bj][n][e] = siluf(v[bj][n][e]);
                }
#pragma unroll
                for (int bj = 0; bj < 2; ++bj) {
                    u32x4 o; o.x = cvtpk(v[bj][0][0], v[bj][0][1]); o.y = cvtpk(v[bj][0][2], v[bj][0][3]); o.z = cvtpk(v[bj][1][0], v[bj][1][1]); o.w = cvtpk(v[bj][1][2], v[bj][1][3]);
                    *(u32x4*)(dst + (size_t)row * ld + col + bj * 32 + fq * 8) = o;
                }
            }
    }
};

struct EpiOut0 {
    const float *x, *ctx, *g1; float* out; unsigned char* ws; const float* g0;
    static constexpr bool PERM = false, AFTER_DRAIN = false;
    __device__ __forceinline__ void operator()(const f32x4 (&acc)[2][2][4][2], const pg8::Unit& u, int wr, int wc, int fr, int fq) const { (*this)(acc, u.pm, u.pn, wr, wc, fr, fq); }
    __device__ __forceinline__ void operator()(const f32x4 (&acc)[2][2][4][2], int pm, int pn, int wr, int wc, int fr, int fq) const {
        asm volatile("" : "+v"(fr), "+v"(fq));
        const float* mod = (const float*)(ws + OFF_MOD); bf16_t* A1 = (bf16_t*)(ws + OFF_A); float* parts = (float*)(ws + OFF_PARTS);
        const bool lat = pm < 256; const int r = lat ? pm >> 3 : 32;
        const int c0 = pn * 256 + wc * 64 + fq * 8;
        const float* gt = mod + (size_t)r * 3072 + 2048 + c0;
        const float* sc = mod + (size_t)(33 + r) * 3072 + 1024 + c0;
        const float* s0p = mod + (size_t)r * 3072 + 1024 + c0;
        f32x4 gtv[2][2], csv[2][2], inv[2][2];
#pragma unroll
        for (int bj = 0; bj < 2; ++bj)
#pragma unroll
            for (int n = 0; n < 2; ++n) {
                gtv[bj][n] = *(const f32x4*)(gt + bj * 32 + n * 4); csv[bj][n] = clamp_scale(*(const f32x4*)(g1 + c0 + bj * 32 + n * 4) * (1.0f + *(const f32x4*)(sc + bj * 32 + n * 4)));
                const f32x4 s0 = clamp_scale(*(const f32x4*)(g0 + c0 + bj * 32 + n * 4) * (1.0f + *(const f32x4*)(s0p + bj * 32 + n * 4)));
#pragma unroll
                for (int e = 0; e < 4; ++e) inv[bj][n][e] = __builtin_amdgcn_rcpf(s0[e]);
            }
        const bf16_t* abase = A1 + (size_t)(pm * 256 + wr * 64 + fr) * D + c0;
        u32x4 av[2][2];
#define EO0_LOAD(ri) do { const bf16_t* ap = abase + (size_t)(((ri) >> 2) * 128 + ((ri) & 3) * 16) * D; \
            _Pragma("unroll") for (int bj = 0; bj < 2; ++bj) av[(ri) & 1][bj] = *(const u32x4*)(ap + bj * 32); } while (0)
        EO0_LOAD(0);
        float ssv[8];
#pragma unroll
        for (int ri = 0; ri < 8; ++ri) {
            if (ri < 7) EO0_LOAD(ri + 1);
            {
                const int ai = ri >> 2, m = ri & 3;
                const int row = pm * 256 + ai * 128 + wr * 64 + m * 16 + fr;
                float ss = 0.f;
#pragma unroll
                for (int bj = 0; bj < 2; ++bj) {
                    const u32x4 a = av[ri & 1][bj];
                    f32x4 xr[2];
                    xr[0] = (f32x4){bflo(a.x), bfhi(a.x), bflo(a.y), bfhi(a.y)} * inv[bj][0];
                    xr[1] = (f32x4){bflo(a.z), bfhi(a.z), bflo(a.w), bfhi(a.w)} * inv[bj][1];
                    f32x4 y[2];
#pragma unroll
                    for (int n = 0; n < 2; ++n) {
                        const f32x4 x1 = xr[n] + gtv[bj][n] * acc[ai][bj][m][n];
                        ss += x1[0] * x1[0] + x1[1] * x1[1] + x1[2] * x1[2] + x1[3] * x1[3];
                        y[n] = x1 * csv[bj][n];
                    }
                    u32x4 o; o.x = cvtpk(y[0][0], y[0][1]); o.y = cvtpk(y[0][2], y[0][3]); o.z = cvtpk(y[1][0], y[1][1]); o.w = cvtpk(y[1][2], y[1][3]);
                    *(u32x4*)(A1 + (size_t)row * D + c0 + bj * 32) = o;
                }
                ss = sum_xor16(ss); ss = sum_xor32(ss);
                ssv[ri] = ss;
            }
            __builtin_amdgcn_sched_barrier(0);
        }
#undef EO0_LOAD
        if (fq < 2) {
            const f32x4 v4 = fq == 0 ? (f32x4){ssv[0], ssv[1], ssv[2], ssv[3]} : (f32x4){ssv[4], ssv[5], ssv[6], ssv[7]};
            *(f32x4*)(parts + ((((size_t)(4 * pn + wc) * (M / 256) + pm) * 2 + wr) * 16 + fr) * 8 + fq * 4) = v4;
        }
    }
};

struct EpiOut1 {
    unsigned char* ws; float* out; const float* g1;
    static constexpr bool PERM = false, AFTER_DRAIN = false;
    __device__ __forceinline__ void operator()(f32x4 (&acc)[2][2][4][2], const pg8::Unit& u, int wr, int wc, int fr, int fq) const {
        const int pm = u.pm, pn = u.pn;
        const int r = pm >> 3, c0 = pn * 256 + wc * 64 + fq * 8;
        const float* gt = (const float*)(ws + OFF_MOD) + (size_t)(33 + r) * 3072 + 2048 + c0;
        const float* sc = (const float*)(ws + OFF_MOD) + (size_t)(33 + r) * 3072 + 1024 + c0;
        f32x4 gtv[2][2], inv[2][2];
#pragma unroll
        for (int bj = 0; bj < 2; ++bj)
#pragma unroll
            for (int n = 0; n < 2; ++n) {
                gtv[bj][n] = *(const f32x4*)(gt + bj * 32 + n * 4);
                const f32x4 s1 = clamp_scale(*(const f32x4*)(g1 + c0 + bj * 32 + n * 4) * (1.0f + *(const f32x4*)(sc + bj * 32 + n * 4)));
#pragma unroll
                for (int e = 0; e < 4; ++e) inv[bj][n][e] = __builtin_amdgcn_rcpf(s1[e]);
            }
        const bf16_t* xbase = (const bf16_t*)(ws + OFF_A) + (size_t)(pm * 256 + wr * 64 + fr) * D + c0;
        u32x4 xv[4][2];
#define EO1_LOAD(ri) do { const bf16_t* xp = xbase + (size_t)(((ri) >> 2) * 128 + ((ri) & 3) * 16) * D; \
            xv[(ri) & 3][0] = *(const u32x4*)(xp); xv[(ri) & 3][1] = *(const u32x4*)(xp + 32); } while (0)
        EO1_LOAD(0); EO1_LOAD(1); EO1_LOAD(2); EO1_LOAD(3);
#pragma unroll
        for (int ri = 0; ri < 8; ++ri) {
            const int ai = ri >> 2, m = ri & 3;
#pragma unroll
            for (int bj = 0; bj < 2; ++bj) {
                const u32x4 w = xv[ri & 3][bj];
                const f32x4 x0 = (f32x4){bflo(w.x), bfhi(w.x), bflo(w.y), bfhi(w.y)}, x1 = (f32x4){bflo(w.z), bfhi(w.z), bflo(w.w), bfhi(w.w)};
                acc[ai][bj][m][0] = x0 * inv[bj][0] + gtv[bj][0] * acc[ai][bj][m][0];
                acc[ai][bj][m][1] = x1 * inv[bj][1] + gtv[bj][1] * acc[ai][bj][m][1];
            }
            if (ri + 4 < 8) EO1_LOAD(ri + 4);
            __builtin_amdgcn_sched_barrier(0);
        }
#undef EO1_LOAD
        float* obase = out + (size_t)(pm * 256 + wr * 64 + fr) * D + pn * 256 + wc * 64 + (fq & 1) * 8 + (fq >> 1) * 4;
#pragma unroll
        for (int ri = 0; ri < 8; ++ri) {
            const int ai = ri >> 2, m = ri & 3;
            float* op = obase + (size_t)(ai * 128 + m * 16) * D;
#pragma unroll
            for (int bj = 0; bj < 2; ++bj) {
                f32x4 lo = acc[ai][bj][m][0], hi2 = acc[ai][bj][m][1];
#pragma unroll
                for (int e = 0; e < 4; ++e) {
                    const auto sw = __builtin_amdgcn_permlane32_swap(__float_as_uint(lo[e]), __float_as_uint(hi2[e]), false, false);
                    lo[e] = __uint_as_float(sw[0]); hi2[e] = __uint_as_float(sw[1]);
                }
                *(f32x4*)(op + bj * 32) = lo; *(f32x4*)(op + bj * 32 + 16) = hi2;
            }
        }
    }
};

typedef float f32x16 __attribute__((ext_vector_type(16)));
typedef short s16x4 __attribute__((ext_vector_type(4)));
#define LDSAS __attribute__((address_space(3)))
__device__ __forceinline__ int crow(int r, int hi) { return (r & 3) + 8 * (r >> 2) + 4 * hi; }
__device__ __forceinline__ s16x4 vtr(const LDSAS unsigned char* p) { return __builtin_bit_cast(s16x4, __builtin_amdgcn_ds_read_tr16_b64_v4i16((LDSAS s16x4*)p)); }

constexpr int AB_K1 = 0, AB_K2 = 16384, AB_V = 32768, AB_Q = 65536;
static_assert(AB_Q + 65536 <= 134144, "attention B LDS map");
__device__ __forceinline__ float fadd_s(float a, float b) { float r; asm("v_add_f32_e32 %0, %1, %2" : "=v"(r) : "v"(a), "v"(b)); return r; }

__device__ __forceinline__ void attnB_unit(const Params& P, LDSAS unsigned char* lds, int b, int h, int qrow0, int t_begin, int t_end, int g_wave) {
    const int tid = otid(), lane = tid & 63, r32 = lane & 31, hi = lane >> 5;
    const int wid = __builtin_amdgcn_readfirstlane(tid >> 6);
    LDSAS unsigned char* qlds = lds + AB_Q + wid * 8192 + r32 * 256;
    {
        const bf16_t* qg = P.QB() + (size_t)(qrow0 + wid * 32 + r32) * 512 + (2 * h) * 64 + hi * 8;
#pragma unroll
        for (int c2 = 0; c2 < 8; ++c2) {
            const u32x4 v = *(const u32x4*)(qg + (c2 >> 2) * 64 + (c2 & 3) * 16);
            *(LDSAS u32x4*)(qlds + (((2 * c2 + hi) ^ (r32 & 15)) * 16)) = v;
        }
    }
    f32x16 o1[4], o2[4];
#pragma unroll
    for (int i = 0; i < 4; ++i) { o1[i] = (f32x16){}; o2[i] = (f32x16){}; }
    float l1 = 0.f, l2 = 0.f;
    const int krow = tid >> 3, kch = tid & 7, vrow = tid >> 4, vch = tid & 15;
    const int kwoff = krow * 128 + ((kch ^ ((krow >> 1) & 7)) * 16);
    const int vwoff = (vch >> 2) * 4096 + vrow * 64 + (vch & 3) * 16;
    u32x4 rk1, rk2, rv0, rv1;
#define AB_GLOAD(t) do { const int kr0_ = (t) < 32 ? b * 2048 + 64 * (t) : ML + b * 256 + 64 * ((t) - 32); \
        rk1 = *(const u32x4*)(P.KB() + (size_t)(kr0_ + krow) * 512 + (2 * h) * 64 + kch * 8); \
        rk2 = *(const u32x4*)(P.KB() + (size_t)(kr0_ + krow) * 512 + (2 * h + 1) * 64 + kch * 8); \
        rv0 = *(const u32x4*)(P.VB() + (size_t)(kr0_ + vrow) * 512 + h * 128 + vch * 8); \
        rv1 = *(const u32x4*)(P.VB() + (size_t)(kr0_ + vrow + 32) * 512 + h * 128 + vch * 8); } while (0)
#define AB_LWRITE(buf) do { *(LDSAS u32x4*)(lds + AB_K1 + (buf) * 8192 + kwoff) = rk1; *(LDSAS u32x4*)(lds + AB_K2 + (buf) * 8192 + kwoff) = rk2; \
        *(LDSAS u32x4*)(lds + AB_V + (buf) * 16384 + vwoff) = rv0; *(LDSAS u32x4*)(lds + AB_V + (buf) * 16384 + vwoff + 2048) = rv1; } while (0)
#define AB_SCORES(sub, LSUM, PW) do { const LDSAS unsigned char* kb_ = lds + ((sub) ? AB_K2 : AB_K1) + buf * 8192 + r32 * 128; \
        f32x16 p0 = (f32x16){}, p1 = (f32x16){}; \
        _Pragma("unroll") for (int d0 = 0; d0 < 4; ++d0) { const int co = ((2 * d0 + hi) ^ ksw) * 16; \
            const bf16x8 qf = *(const LDSAS bf16x8*)(qlds + (((2 * (4 * (sub) + d0) + hi) ^ (r32 & 15)) * 16)); \
            const bf16x8 k0 = *(const LDSAS bf16x8*)(kb_ + co), k1 = *(const LDSAS bf16x8*)(kb_ + 4096 + co); \
            p0 = __builtin_amdgcn_mfma_f32_32x32x16_bf16(k0, qf, p0, 0, 0, 0); p1 = __builtin_amdgcn_mfma_f32_32x32x16_bf16(k1, qf, p1, 0, 0, 0); } \
        float ls_ = 0.f; \
        _Pragma("unroll") for (int r = 0; r < 16; ++r) { p0[r] = __builtin_amdgcn_exp2f(p0[r]); p1[r] = __builtin_amdgcn_exp2f(p1[r]); ls_ = fadd_s(ls_, p0[r]); ls_ = fadd_s(ls_, p1[r]); } \
        LSUM += ls_; \
        PW[0].x = cvtpk(p0[0], p0[1]); PW[0].y = cvtpk(p0[2], p0[3]); PW[0].z = cvtpk(p0[4], p0[5]); PW[0].w = cvtpk(p0[6], p0[7]); \
        PW[1].x = cvtpk(p0[8], p0[9]); PW[1].y = cvtpk(p0[10], p0[11]); PW[1].z = cvtpk(p0[12], p0[13]); PW[1].w = cvtpk(p0[14], p0[15]); \
        PW[2].x = cvtpk(p1[0], p1[1]); PW[2].y = cvtpk(p1[2], p1[3]); PW[2].z = cvtpk(p1[4], p1[5]); PW[2].w = cvtpk(p1[6], p1[7]); \
        PW[3].x = cvtpk(p1[8], p1[9]); PW[3].y = cvtpk(p1[10], p1[11]); PW[3].z = cvtpk(p1[12], p1[13]); PW[3].w = cvtpk(p1[14], p1[15]); } while (0)
    const int ksw = (r32 >> 1) & 7;
    const int vroff = AB_V + (4 * hi + ((lane & 15) >> 2)) * 64 + ((lane >> 4) & 1) * 32 + (lane & 3) * 8;
    AB_GLOAD(t_begin); AB_LWRITE(0); __syncthreads();
    for (int t = t_begin; t < t_end; ++t) {
        const int buf = (t - t_begin) & 1;
        u32x4 pw1[4], pw2[4];
        AB_SCORES(0, l1, pw1);
        __builtin_amdgcn_sched_barrier(0);
        AB_SCORES(1, l2, pw2);
        __builtin_amdgcn_sched_barrier(0);
        if (t + 1 < t_end) AB_GLOAD(t + 1);
        const LDSAS unsigned char* vb = lds + buf * 16384 + vroff;
        s16x4 vlo[2][4], vhi[2][4];
#define AB_VLOAD(slot, d0) do { _Pragma("unroll") for (int ks = 0; ks < 4; ++ks) { vlo[slot][ks] = vtr(vb + (d0) * 4096 + ks * 1024); vhi[slot][ks] = vtr(vb + (d0) * 4096 + ks * 1024 + 512); } } while (0)
        AB_VLOAD(0, 0);
#pragma unroll
        for (int d0 = 0; d0 < 4; ++d0) {
            if (d0 < 3) AB_VLOAD((d0 + 1) & 1, d0 + 1);
            __builtin_amdgcn_sched_barrier(0);
#pragma unroll
            for (int ks = 0; ks < 4; ++ks) {
                const s16x4 lo = vlo[d0 & 1][ks], hh = vhi[d0 & 1][ks];
                const bf16x8 vf = (bf16x8){lo[0], lo[1], lo[2], lo[3], hh[0], hh[1], hh[2], hh[3]};
                o1[d0] = __builtin_amdgcn_mfma_f32_32x32x16_bf16(__builtin_bit_cast(bf16x8, pw1[ks]), vf, o1[d0], 0, 0, 0);
                o2[d0] = __builtin_amdgcn_mfma_f32_32x32x16_bf16(__builtin_bit_cast(bf16x8, pw2[ks]), vf, o2[d0], 0, 0, 0);
            }
            __builtin_amdgcn_sched_barrier(0);
        }
#undef AB_VLOAD
        if (t + 1 < t_end) AB_LWRITE(buf ^ 1);
        __syncthreads();
    }
#undef AB_GLOAD
#undef AB_LWRITE
#undef AB_SCORES
    l1 = sum_xor32(l1); l2 = sum_xor32(l2);
    LDSAS float* stg = (LDSAS float*)(lds + wid * 8192);
    if (hi == 0) { stg[r32] = 1.0f / l1; stg[32 + r32] = P.scal()[0] / l2; }
    float ss[16];
#pragma unroll
    for (int r = 0; r < 16; ++r) {
        const float a = stg[crow(r, hi)], c = stg[32 + crow(r, hi)];
        float s2 = 0.f;
#pragma unroll
        for (int d0 = 0; d0 < 4; ++d0) { const float v = o1[d0][r] * a - o2[d0][r] * c; o1[d0][r] = v; s2 += v * v; }
        ss[r] = s2;
    }
#pragma unroll
    for (int r = 0; r < 16; ++r) {
        float s2 = ss[r];
        s2 = sum_row16(s2); s2 = sum_xor16(s2);
        ss[r] = rsqrtf(s2 * (1.0f / 128.0f) + EPS) * (1.0f - LAMBDA_INIT);
    }
    const int eq = lane >> 1, eseg = lane & 1;
    const size_t grow = (size_t)(qrow0 + wid * 32 + eq);
#pragma unroll
    for (int half = 0; half < 2; ++half) {
#pragma unroll
        for (int dd = 0; dd < 2; ++dd) {
            const int d0 = half * 2 + dd; const float sl = P.b_subln[d0 * 32 + r32];
#pragma unroll
            for (int r = 0; r < 16; ++r) stg[crow(r, hi) * 64 + ((dd * 32 + r32) ^ ((crow(r, hi) & 7) * 4))] = o1[d0][r] * ss[r] * sl;
        }
        const u32x4* gp = (const u32x4*)(P.GB() + grow * 512 + h * 128 + half * 64 + eseg * 32);
        u32x4 gv[4], ovs[4];
#pragma unroll
        for (int i = 0; i < 4; ++i) gv[i] = gp[i];
#pragma unroll
        for (int i = 0; i < 4; ++i) {
            const int c0 = eseg * 32 + i * 8;
            const f32x4 a = *(const LDSAS f32x4*)(stg + eq * 64 + (c0 ^ ((eq & 7) * 4))), c = *(const LDSAS f32x4*)(stg + eq * 64 + ((c0 + 4) ^ ((eq & 7) * 4)));
            const u32x4 g = gv[i]; u32x4 ov;
            ov.x = cvtpk(a[0] * bflo(g.x), a[1] * bfhi(g.x)); ov.y = cvtpk(a[2] * bflo(g.y), a[3] * bfhi(g.y));
            ov.z = cvtpk(c[0] * bflo(g.z), c[1] * bfhi(g.z)); ov.w = cvtpk(c[2] * bflo(g.w), c[3] * bfhi(g.w));
            ovs[i] = ov;
        }
#pragma unroll
        for (int e = 0; e < 4; ++e) {
            const auto s01 = __builtin_amdgcn_permlane32_swap(ovs[0][e], ovs[1][e], false, false); ovs[0][e] = s01[0]; ovs[1][e] = s01[1];
            const auto s23 = __builtin_amdgcn_permlane32_swap(ovs[2][e], ovs[3][e], false, false); ovs[2][e] = s23[0]; ovs[3][e] = s23[1];
        }
        bf16_t* oa = P.O() + (size_t)(qrow0 + wid * 32 + ((lane & 31) >> 1)) * 1024 + 512 + h * 128 + half * 64 + eseg * 32 + (lane >> 5) * 8;
        *(u32x4*)(oa) = ovs[0]; *(u32x4*)(oa + (size_t)16 * 1024) = ovs[1]; *(u32x4*)(oa + 16) = ovs[2]; *(u32x4*)(oa + (size_t)16 * 1024 + 16) = ovs[3];
    }
    __syncthreads();
}

__device__ __forceinline__ void phase_attnB_mfma(const Params& P, LDSAS unsigned char* lds, int vb, int nvb, int g_wave) {
    for (int it = 0; ; ++it) {
        int u;
        if (nvb == 256) { if (it < 4) u = it * 256 + vb; else if (it == 4 && vb >= 128) u = 1024 + (vb - 128); else break; }
        else { u = it * nvb + vb; if (u >= 1024 + 128) break; }
        int pair, qrow0, t0;
        if (u < 1024) {
            int qblk;
            if (nvb == 256) { const int round = u >> 8, i = u & 255, xcd = i & 7, slot = i >> 3; pair = round * 32 + xcd * 4 + (slot >> 3); qblk = slot & 7; }
            else { pair = u >> 3; qblk = u & 7; }
            qrow0 = (pair >> 2) * 2048 + qblk * 256; t0 = 0;
        } else {
            pair = u - 1024;
            qrow0 = ML + (pair >> 2) * 256; t0 = 32;
        }
        attnB_unit(P, lds, pair >> 2, pair & 3, qrow0, t0, 36, g_wave);
    }
}

constexpr int AA_K = 0, AA_V = 32768;
__device__ __forceinline__ void attnA_unit(const Params& P, LDSAS unsigned char* lds, int b, int kvh, int qrow0, int qpos0, int kt0, int nwin, int g_wave) {
    const int tid = otid(), lane = tid & 63, r32 = lane & 31, hi = lane >> 5;
    const int wid = __builtin_amdgcn_readfirstlane(tid >> 6);
    const int head = kvh * 4 + (wid >> 1), qoff = (wid & 1) * 64;
    bf16x8 qf[2][4];
#pragma unroll
    for (int qq = 0; qq < 2; ++qq)
#pragma unroll
        for (int d0 = 0; d0 < 4; ++d0) qf[qq][d0] = *(const bf16x8*)(P.QA() + (size_t)(qrow0 + qoff + qq * 32 + r32) * 512 + head * 64 + d0 * 16 + hi * 8);
    f32x16 o[2][2];
#pragma unroll
    for (int i = 0; i < 2; ++i) { o[i][0] = (f32x16){}; o[i][1] = (f32x16){}; }
    float l[2] = {0.f, 0.f};
    const int krow = tid >> 3, kch = tid & 7;
    const int kwoff = krow * 128 + ((kch ^ ((krow >> 1) & 7)) * 16);
    const int vwoff = (kch >> 2) * 4096 + krow * 64 + (kch & 3) * 16;
    u32x4 rk[2], rv[2];
    const int nt = nwin + 4, npair = (nt + 1) >> 1;
#define AA_KR0(i) ((i) < nwin ? b * 2048 + 64 * (kt0 + (i)) : ML + b * 256 + 64 * ((i) - nwin))
#define AA_GLOAD(pi) do { _Pragma("unroll") for (int sb_ = 0; sb_ < 2; ++sb_) { const int i_ = 2 * (pi) + sb_ < nt ? 2 * (pi) + sb_ : nt - 1; const int kr0_ = AA_KR0(i_); \
        rk[sb_] = *(const u32x4*)(P.KA() + (size_t)(kr0_ + krow) * 128 + kvh * 64 + kch * 8); rv[sb_] = *(const u32x4*)(P.VA() + (size_t)(kr0_ + krow) * 128 + kvh * 64 + kch * 8); } } while (0)
#define AA_LWRITE(buf) do { _Pragma("unroll") for (int sb_ = 0; sb_ < 2; ++sb_) { *(LDSAS u32x4*)(lds + AA_K + ((buf) * 2 + sb_) * 8192 + kwoff) = rk[sb_]; *(LDSAS u32x4*)(lds + AA_V + ((buf) * 2 + sb_) * 8192 + vwoff) = rv[sb_]; } } while (0)
    const int kroff = AA_K + r32 * 128, ksw = (r32 >> 1) & 7;
    const int vroff = AA_V + (4 * hi + ((lane & 15) >> 2)) * 64 + ((lane >> 4) & 1) * 32 + (lane & 3) * 8;
    AA_GLOAD(0); AA_LWRITE(0); __syncthreads();
    for (int pi = 0; pi < npair; ++pi) {
        const int pbuf = pi & 1;
        if (pi + 1 < npair) AA_GLOAD(pi + 1);
      for (int sub = 0; sub < 2; ++sub) {
        const int i = 2 * pi + sub, buf = pbuf * 2 + sub;
        int cls = i < nt ? 1 : 0;
        if (i < nwin) { const int delta = 64 * (kt0 + i) - (qpos0 + qoff); cls = delta == -128 ? 2 : (delta == 128 ? 3 : ((delta >= -64 && delta <= 64) ? 1 : 0)); }
        if (cls != 0) {
            const LDSAS unsigned char* kb = lds + buf * 8192 + kroff;
            u32x4 pw[2][4];
#pragma unroll
            for (int qq = 0; qq < 2; ++qq) {
                f32x16 p0 = (f32x16){}, p1 = (f32x16){};
#pragma unroll
                for (int d0 = 0; d0 < 4; ++d0) {
                    const int co = ((2 * d0 + hi) ^ ksw) * 16;
                    const bf16x8 k0 = *(const LDSAS bf16x8*)(kb + co), k1 = *(const LDSAS bf16x8*)(kb + 4096 + co);
                    p0 = __builtin_amdgcn_mfma_f32_32x32x16_bf16(k0, qf[qq][d0], p0, 0, 0, 0);
                    p1 = __builtin_amdgcn_mfma_f32_32x32x16_bf16(k1, qf[qq][d0], p1, 0, 0, 0);
                }
                float ls = 0.f;
#pragma unroll
                for (int r = 0; r < 16; ++r) { p0[r] = __builtin_amdgcn_exp2f(p0[r]); p1[r] = __builtin_amdgcn_exp2f(p1[r]); }
                if (cls >= 2) {
                    int a = qq * 32 + r32;
                    asm volatile("" : "+v"(a));
#pragma unroll
                    for (int r = 0; r < 16; ++r) {
                        const int c0 = crow(r, hi), c1 = c0 + 32;
                        const bool v0 = cls == 2 ? (c0 >= a) : (c0 <= a), v1 = cls == 2 ? (c1 >= a) : (c1 <= a);
                        p0[r] = v0 ? p0[r] : 0.f; p1[r] = v1 ? p1[r] : 0.f;
                    }
                }
#pragma unroll
                for (int r = 0; r < 16; ++r) ls += p0[r] + p1[r];
                l[qq] += ls;
                pw[qq][0].x = cvtpk(p0[0], p0[1]); pw[qq][0].y = cvtpk(p0[2], p0[3]); pw[qq][0].z = cvtpk(p0[4], p0[5]); pw[qq][0].w = cvtpk(p0[6], p0[7]);
                pw[qq][1].x = cvtpk(p0[8], p0[9]); pw[qq][1].y = cvtpk(p0[10], p0[11]); pw[qq][1].z = cvtpk(p0[12], p0[13]); pw[qq][1].w = cvtpk(p0[14], p0[15]);
                pw[qq][2].x = cvtpk(p1[0], p1[1]); pw[qq][2].y = cvtpk(p1[2], p1[3]); pw[qq][2].z = cvtpk(p1[4], p1[5]); pw[qq][2].w = cvtpk(p1[6], p1[7]);
                pw[qq][3].x = cvtpk(p1[8], p1[9]); pw[qq][3].y = cvtpk(p1[10], p1[11]); pw[qq][3].z = cvtpk(p1[12], p1[13]); pw[qq][3].w = cvtpk(p1[14], p1[15]);
                __builtin_amdgcn_sched_barrier(0);
            }
            const LDSAS unsigned char* vb = lds + buf * 8192 + vroff;
#pragma unroll
            for (int d0 = 0; d0 < 2; ++d0)
#pragma unroll
                for (int ks = 0; ks < 4; ++ks) {
                    const s16x4 lo = vtr(vb + d0 * 4096 + ks * 1024), hh = vtr(vb + d0 * 4096 + ks * 1024 + 512);
                    const bf16x8 vf = (bf16x8){lo[0], lo[1], lo[2], lo[3], hh[0], hh[1], hh[2], hh[3]};
                    o[0][d0] = __builtin_amdgcn_mfma_f32_32x32x16_bf16(__builtin_bit_cast(bf16x8, pw[0][ks]), vf, o[0][d0], 0, 0, 0);
                    o[1][d0] = __builtin_amdgcn_mfma_f32_32x32x16_bf16(__builtin_bit_cast(bf16x8, pw[1][ks]), vf, o[1][d0], 0, 0, 0);
                }
        }
      }
        if (pi + 1 < npair) AA_LWRITE(pbuf ^ 1);
        __syncthreads();
    }
#undef AA_KR0
#undef AA_GLOAD
#undef AA_LWRITE
    const float sinkp = __builtin_amdgcn_exp2f(P.a_sink[head] * LOG2E);
    LDSAS float* stg = (LDSAS float*)(lds + wid * 8704);
    const int ep_row = lane >> 3, ep_pc = lane & 7;
#pragma unroll
    for (int qq = 0; qq < 2; ++qq) {
        float lt = sum_xor32(l[qq]);
        if (hi == 0) stg[r32] = 1.0f / (lt + sinkp);
        float rl[16];
#pragma unroll
        for (int r = 0; r < 16; ++r) rl[r] = stg[crow(r, hi)];
#pragma unroll
        for (int d0 = 0; d0 < 2; ++d0)
#pragma unroll
            for (int r = 0; r < 16; ++r) stg[crow(r, hi) * 68 + d0 * 32 + r32] = o[qq][d0][r] * rl[r];
        const size_t grow = (size_t)(qrow0 + qoff + qq * 32 + ep_row);
        const bf16_t* gp = P.GA() + grow * 512 + head * 64 + ep_pc * 8;
        bf16_t* op = P.O() + grow * 1024 + head * 64 + ep_pc * 8;
        u32x4 gv[4];
#pragma unroll
        for (int i = 0; i < 4; ++i) gv[i] = *(const u32x4*)(gp + (size_t)(8 * i) * 512);
#pragma unroll
        for (int i = 0; i < 4; ++i) {
            const f32x4 a = *(const LDSAS f32x4*)(stg + (8 * i + ep_row) * 68 + ep_pc * 8), c = *(const LDSAS f32x4*)(stg + (8 * i + ep_row) * 68 + ep_pc * 8 + 4);
            const u32x4 g = gv[i]; u32x4 ov;
            ov.x = cvtpk(a[0] * bflo(g.x), a[1] * bfhi(g.x)); ov.y = cvtpk(a[2] * bflo(g.y), a[3] * bfhi(g.y));
            ov.z = cvtpk(c[0] * bflo(g.z), c[1] * bfhi(g.z)); ov.w = cvtpk(c[2] * bflo(g.w), c[3] * bfhi(g.w));
            *(u32x4*)(op + (size_t)(8 * i) * 1024) = ov;
        }
    }
    __syncthreads();
}

__device__ __forceinline__ void phase_attnA_mfma(const Params& P, LDSAS unsigned char* lds, int vb, int nvb, int g_wave) {
    for (int u = vb; u < 1024 + 128; u += nvb) {
        int b, kvh, qrow0, qpos0, kt0, nwin;
        if (u < 1024) {
            int qblk;
            if (nvb == 256) { const int round = u >> 8, i = u & 255; b = round * 8 + (i & 7); kvh = (i >> 3) >> 4; qblk = (i >> 3) & 15; }
            else { qblk = u & 15; kvh = (u >> 4) & 1; b = u >> 5; }
            const int lo = 2 * qblk - 2 < 0 ? 0 : 2 * qblk - 2, hi_ = 2 * qblk + 3 > 31 ? 31 : 2 * qblk + 3;
            qrow0 = b * 2048 + qblk * 128; qpos0 = qblk * 128; kt0 = lo; nwin = hi_ - lo + 1;
        } else {
            const int v = u - 1024, half = v & 1; kvh = (v >> 1) & 1; b = v >> 2;
            qrow0 = ML + b * 256 + half * 128; qpos0 = 0; kt0 = 0; nwin = 0;
        }
        attnA_unit(P, lds, b, kvh, qrow0, qpos0, kt0, nwin, g_wave);
    }
}

constexpr int GL_QD = 0, GL_KD = 17408, GL_KT = 34816, GL_V = 53248, GL_DEC = 86016, GL_RF = 86528, GL_TOT = 90624, GL_WA = 92672, GL_RQ = 101376, GL_RK = 117760, GL_ATT = 134144, GL_END = 140288;
constexpr int KERNEL_LDS = (GL_END > pg8::STAGE_BYTES ? GL_END : pg8::STAGE_BYTES);
static_assert(TICKET_LDS == KERNEL_LDS + 8, "ticket word sits next to the barrier words");
__device__ __forceinline__ int pos16(int x) { return 8 * ((x >> 2) & 1) + (x & 3) + 4 * (x >> 3); }
__device__ __forceinline__ bf16x8 pack8(const f32x16& v, int o) {
    u32x4 w; w.x = cvtpk(v[o], v[o + 1]); w.y = cvtpk(v[o + 2], v[o + 3]); w.z = cvtpk(v[o + 4], v[o + 5]); w.w = cvtpk(v[o + 6], v[o + 7]);
    return __builtin_bit_cast(bf16x8, w);
}

__device__ __forceinline__ void phase_gla_mfma(const Params& P, LDSAS unsigned char* lds, int vb, int nvb, int g_wave) {
    const int tid = otid(), lane = tid & 63, r32 = lane & 31, hi = lane >> 5;
    const int wid = __builtin_amdgcn_readfirstlane(tid >> 6);
    const int it = wid >> 2, dt = wid & 3, d = dt * 32 + r32;
    for (int unit = vb; unit < NB * 8; unit += nvb) {
        const int dr = unit & 1, h = (unit >> 1) & 3, b = unit >> 3;
        const float* wa = dr ? P.wa_b : P.wa_f; const float* ba = dr ? P.ba_b : P.ba_f;
        __syncthreads();
        if (tid < 128) {
            u32x4 whi[2], wlo[2];
#pragma unroll
            for (int j = 0; j < 16; j += 2) {
                const float w0 = wa[j * 512 + h * 128 + tid] * LOG2E, w1 = wa[(j + 1) * 512 + h * 128 + tid] * LOG2E;
                const unsigned ph = cvtpk(w0, w1); const unsigned pl = cvtpk(w0 - bflo(ph), w1 - bfhi(ph));
                whi[j >> 3][(j >> 1) & 3] = ph; wlo[j >> 3][(j >> 1) & 3] = pl;
            }
            *(LDSAS u32x4*)(lds + GL_WA + tid * 32) = whi[0]; *(LDSAS u32x4*)(lds + GL_WA + tid * 32 + 16) = whi[1];
            *(LDSAS u32x4*)(lds + GL_WA + 4096 + tid * 32) = wlo[0]; *(LDSAS u32x4*)(lds + GL_WA + 4096 + tid * 32 + 16) = wlo[1];
            ((LDSAS float*)(lds + GL_WA + 8192))[tid] = ba[h * 128 + tid] * LOG2E;
        }
        f32x16 S[4];
#pragma unroll
        for (int i = 0; i < 4; ++i) S[i] = (f32x16){};
        f32x4 pf_rf; u32x4 pf_v[4], pf_q[2], pf_k[2];
        float lb[16];
#define GL_MEMBASE(n) ((n) >= 4 ? b * T + 64 * (dr ? 31 - ((n) - 4) : ((n) - 4)) : ML + b * L + 64 * (dr ? 3 - (n) : (n)))
#define GL_PREFETCH_V(n) do { const int mb_ = GL_MEMBASE(n); \
            _Pragma("unroll") for (int k4 = 0; k4 < 4; ++k4) { const int idx = tq + 512 * k4; pf_v[k4] = *(const u32x4*)(P.VG() + (size_t)(mb_ + (idx >> 5)) * 1024 + h * 256 + (idx & 31) * 8); } } while (0)
#define GL_PREFETCH_RQK(n) do { const int mb_ = GL_MEMBASE(n); \
            pf_rf = *(const f32x4*)(P.RF() + (size_t)(mb_ + ((tq & 255) >> 2)) * 32 + dr * 16 + (tq & 3) * 4); \
            _Pragma("unroll") for (int k2 = 0; k2 < 2; ++k2) { const int idx = tq + 512 * k2; pf_k[k2] = *(const u32x4*)(P.KG() + (size_t)(mb_ + (idx >> 4)) * 512 + h * 128 + (idx & 15) * 8); \
                pf_q[k2] = *(const u32x4*)(P.QG() + (size_t)(mb_ + (idx >> 4)) * 512 + h * 128 + (idx & 15) * 8); } } while (0)
#define GL_TOP(lat) do { \
            if (tq < 256) { \
                const unsigned h0 = cvtpk(pf_rf[0], pf_rf[1]), h1 = cvtpk(pf_rf[2], pf_rf[3]); \
                const unsigned l0 = cvtpk(pf_rf[0] - bflo(h0), pf_rf[1] - bfhi(h0)), l1 = cvtpk(pf_rf[2] - bflo(h1), pf_rf[3] - bfhi(h1)); \
                const int off = (dr ? 63 - (tq >> 2) : (tq >> 2)) * 32 + (tq & 3) * 8; \
                *(LDSAS u32x2*)(lds + GL_RF + off) = (u32x2){h0, h1}; *(LDSAS u32x2*)(lds + GL_RF + 2048 + off) = (u32x2){l0, l1}; \
            } \
            _Pragma("unroll") for (int k2 = 0; k2 < 2; ++k2) { const int idx = tq + 512 * k2, im = idx >> 4, ch = idx & 15; const int pr = dr ? 63 - im : im; \
                const int off = pr * 256 + ((ch ^ (4 * (pr & 3))) * 16); \
                *(LDSAS u32x4*)(lds + GL_RK + off) = pf_k[k2]; if (lat) *(LDSAS u32x4*)(lds + GL_RQ + off) = pf_q[k2]; } } while (0)
#define GL_Z() do { \
            const float bav = ((const LDSAS float*)(lds + GL_WA + 8192))[d]; \
            f32x16 z; \
            _Pragma("unroll") for (int r = 0; r < 16; ++r) z[r] = bav; \
            const bf16x8 ah = *(const LDSAS bf16x8*)(lds + GL_RF + (it * 32 + r32) * 32 + hi * 16), al = *(const LDSAS bf16x8*)(lds + GL_RF + 2048 + (it * 32 + r32) * 32 + hi * 16); \
            const bf16x8 bh = *(const LDSAS bf16x8*)(lds + GL_WA + d * 32 + hi * 16), bl = *(const LDSAS bf16x8*)(lds + GL_WA + 4096 + d * 32 + hi * 16); \
            z = __builtin_amdgcn_mfma_f32_32x32x16_bf16(ah, bh, z, 0, 0, 0); \
            z = __builtin_amdgcn_mfma_f32_32x32x16_bf16(al, bh, z, 0, 0, 0); \
            z = __builtin_amdgcn_mfma_f32_32x32x16_bf16(ah, bl, z, 0, 0, 0); \
            float gs[4]; \
            _Pragma("unroll") for (int g = 0; g < 4; ++g) { \
                float run = 0.f; \
                _Pragma("unroll") for (int j = 0; j < 4; ++j) { \
                    const float zz = z[4 * g + j]; \
                    run += (fminf(zz, 0.f) - __builtin_amdgcn_logf(1.0f + __builtin_amdgcn_exp2f(-fabsf(zz)))) * (1.0f / 16.0f); \
                    lb[4 * g + j] = run; \
                } \
                gs[g] = run; \
            } \
            float off = 0.f; \
            _Pragma("unroll") for (int g = 0; g < 4; ++g) {        \
                const auto sw = __builtin_amdgcn_permlane32_swap(__float_as_uint(gs[g]), __float_as_uint(gs[g]), false, false);        \
                const float o2 = off + (hi ? __uint_as_float(sw[0]) : 0.f); \
                _Pragma("unroll") for (int j = 0; j < 4; ++j) lb[4 * g + j] += o2; \
                off += __uint_as_float(sw[0]) + __uint_as_float(sw[1]); \
            } \
            if (hi == 0) ((LDSAS float*)(lds + GL_TOT))[it * 128 + d] = off; } while (0)
        { int tq = tid; asm volatile("" : "+v"(tq)); GL_PREFETCH_RQK(0); GL_PREFETCH_V(0); GL_TOP(false); GL_PREFETCH_RQK(1); }
        __syncthreads();
        GL_Z();
        __syncthreads();
        for (int n = 0; n < 36; ++n) {
            const bool latent = n >= 4;
            const int membase = GL_MEMBASE(n);
            const int nn = n + 1 < 36 ? n + 1 : 35, n2 = n + 2 < 36 ? n + 2 : 35;
            {
                const float t0 = ((const LDSAS float*)(lds + GL_TOT))[d], t1 = ((const LDSAS float*)(lds + GL_TOT))[128 + d];
                const float prefix = it ? t0 : 0.f;
                const float dec = __builtin_amdgcn_exp2f(t0 + t1);
                const int le = lane;
                const int trs = (le & 15) >> 2, trc = dt * 4 + ((le >> 4) & 1) * 2 + ((le & 3) >> 1);
                const int troff = (it * 32 + 4 * (le >> 5) + trs) * 256 + ((trc ^ (4 * trs)) * 16) + (le & 1) * 8;
                u32x2 kr[4], qr[4];
#pragma unroll
                for (int g = 0; g < 4; ++g) { kr[g] = __builtin_bit_cast(u32x2, vtr(lds + GL_RK + troff + g * 2048)); if (latent) qr[g] = __builtin_bit_cast(u32x2, vtr(lds + GL_RQ + troff + g * 2048)); }
                float ktv[16];
                const int dp = ((d & ~15) + pos16(d & 15)) * 2;
#pragma unroll
                for (int r = 0; r < 16; r += 2) {
                    const int i0 = it * 32 + crow(r, hi), i1 = i0 + 1;
                    const float e0 = __builtin_amdgcn_exp2f(prefix + lb[r]), e1 = __builtin_amdgcn_exp2f(prefix + lb[r + 1]);
                    const unsigned kw2 = kr[r >> 2][(r >> 1) & 1];
                    const float kd0 = bflo(kw2) * __builtin_amdgcn_rcpf(e0), kd1 = bfhi(kw2) * __builtin_amdgcn_rcpf(e1);
                    ktv[r] = kd0 * dec; ktv[r + 1] = kd1 * dec;
                    lb[r] = e0; lb[r + 1] = e1;
                    if (latent) {
                        const unsigned kw = cvtpk(kd0, kd1);
                        *(LDSAS bf16_t*)(lds + GL_KD + i0 * 272 + dp) = (bf16_t)kw; *(LDSAS bf16_t*)(lds + GL_KD + i1 * 272 + dp) = (bf16_t)(kw >> 16);
                    }
                }
                if (latent) {
#pragma unroll
                    for (int r = 0; r < 16; r += 2) {
                        const int i0 = it * 32 + crow(r, hi), i1 = i0 + 1;
                        const unsigned qw2 = qr[r >> 2][(r >> 1) & 1];
                        const unsigned qw = cvtpk(bflo(qw2) * lb[r], bfhi(qw2) * lb[r + 1]);
                        *(LDSAS bf16_t*)(lds + GL_QD + i0 * 272 + dp) = (bf16_t)qw; *(LDSAS bf16_t*)(lds + GL_QD + i1 * 272 + dp) = (bf16_t)(qw >> 16);
                    }
                }
                u32x4 w0, w1;
                w0.x = cvtpk(ktv[0], ktv[1]); w0.y = cvtpk(ktv[2], ktv[3]); w0.z = cvtpk(ktv[4], ktv[5]); w0.w = cvtpk(ktv[6], ktv[7]);
                w1.x = cvtpk(ktv[8], ktv[9]); w1.y = cvtpk(ktv[10], ktv[11]); w1.z = cvtpk(ktv[12], ktv[13]); w1.w = cvtpk(ktv[14], ktv[15]);
                *(LDSAS u32x4*)(lds + GL_KT + d * 144 + (2 * it) * 32 + hi * 16) = w0;
                *(LDSAS u32x4*)(lds + GL_KT + d * 144 + (2 * it + 1) * 32 + hi * 16) = w1;
                if (it == 0 && hi == 0) ((LDSAS float*)(lds + GL_DEC))[d] = dec;
            }
            const int tq = tid;
#pragma unroll
            for (int k4 = 0; k4 < 4; ++k4) { const int idx = tq + 512 * k4, im = idx >> 5, ch = idx & 31; *(LDSAS u32x4*)(lds + GL_V + (ch >> 2) * 4096 + (dr ? 63 - im : im) * 64 + (ch & 3) * 16) = pf_v[k4]; }
            __syncthreads();
            GL_TOP(nn >= 4);
            GL_PREFETCH_V(nn);
            GL_PREFETCH_RQK(n2);
            bf16x8 vf[4];
#define GL_LOADV() do { const LDSAS unsigned char* vbp = lds + GL_V + wid * 4096 + (4 * hiq + ((lq & 15) >> 2)) * 64 + ((lq >> 4) & 1) * 32 + (lq & 3) * 8; \
                _Pragma("unroll") for (int js = 0; js < 4; ++js) { const s16x4 lo = vtr(vbp + js * 1024), hh = vtr(vbp + js * 1024 + 512); vf[js] = (bf16x8){lo[0], lo[1], lo[2], lo[3], hh[0], hh[1], hh[2], hh[3]}; } } while (0)
            __builtin_amdgcn_sched_barrier(0);
            const int lq = lane;
            const int r32q = lq & 31, hiq = lq >> 5;
#define GL_SUPDATE() do { _Pragma("unroll") for (int dt2 = 0; dt2 < 4; ++dt2) { __builtin_amdgcn_sched_barrier(0); \
                _Pragma("unroll") for (int g = 0; g < 4; ++g) { const f32x4 dc = *(const LDSAS f32x4*)(lds + GL_DEC + (dt2 * 32 + 8 * g + 4 * hiq) * 4); \
                    S[dt2][4 * g] *= dc[0]; S[dt2][4 * g + 1] *= dc[1]; S[dt2][4 * g + 2] *= dc[2]; S[dt2][4 * g + 3] *= dc[3]; } \
                const LDSAS unsigned char* ktp = lds + GL_KT + (dt2 * 32 + r32q) * 144 + hiq * 16; \
                _Pragma("unroll") for (int is = 0; is < 4; ++is) S[dt2] = __builtin_amdgcn_mfma_f32_32x32x16_bf16(*(const LDSAS bf16x8*)(ktp + is * 32), vf[is], S[dt2], 0, 0, 0); } } while (0)
            GL_LOADV();
            f32x16 o0 = (f32x16){}, o1 = (f32x16){};
            if (latent) {
                if (wid < 3) {
                    f32x16 X = (f32x16){};
                    const LDSAS unsigned char* kb = lds + GL_KD + ((wid == 2 ? 32 : 0) + r32q) * 272 + hiq * 16;
                    const LDSAS unsigned char* qb2 = lds + GL_QD + ((wid >= 1 ? 32 : 0) + r32q) * 272 + hiq * 16;
#pragma unroll
                    for (int s = 0; s < 8; ++s) X = __builtin_amdgcn_mfma_f32_32x32x16_bf16(*(const LDSAS bf16x8*)(kb + s * 32), *(const LDSAS bf16x8*)(qb2 + s * 32), X, 0, 0, 0);
                    if (wid != 1) {
                        const int rq = r32;
#pragma unroll
                        for (int r = 0; r < 16; ++r) X[r] = (crow(r, hi) <= rq) ? X[r] : 0.f;
                    }
                    *(LDSAS bf16x8*)(lds + GL_ATT + wid * 2048 + lq * 16) = pack8(X, 0);
                    *(LDSAS bf16x8*)(lds + GL_ATT + wid * 2048 + 1024 + lq * 16) = pack8(X, 8);
                }
                __builtin_amdgcn_sched_barrier(0);
                const LDSAS unsigned char* qb = lds + GL_QD + r32q * 272 + hiq * 16;
#pragma unroll
                for (int s = 0; s < 8; ++s) {
                    const bf16x8 Sb = pack8(S[s >> 1], (s & 1) * 8);
                    const bf16x8 q0 = *(const LDSAS bf16x8*)(qb + s * 32), q1 = *(const LDSAS bf16x8*)(qb + 32 * 272 + s * 32);
                    o0 = __builtin_amdgcn_mfma_f32_32x32x16_bf16(q0, Sb, o0, 0, 0, 0);
                    o1 = __builtin_amdgcn_mfma_f32_32x32x16_bf16(q1, Sb, o1, 0, 0, 0);
                    if (s & 1) __builtin_amdgcn_sched_barrier(0);
                }
            }
            __syncthreads();
            if (latent) {
                {
                    const LDSAS unsigned char* ab = lds + GL_ATT + lq * 16;
                    o0 = __builtin_amdgcn_mfma_f32_32x32x16_bf16(*(const LDSAS bf16x8*)(ab), vf[0], o0, 0, 0, 0);
                    o0 = __builtin_amdgcn_mfma_f32_32x32x16_bf16(*(const LDSAS bf16x8*)(ab + 1024), vf[1], o0, 0, 0, 0);
                    __builtin_amdgcn_sched_barrier(0);
                    o1 = __builtin_amdgcn_mfma_f32_32x32x16_bf16(*(const LDSAS bf16x8*)(ab + 2048), vf[0], o1, 0, 0, 0);
                    o1 = __builtin_amdgcn_mfma_f32_32x32x16_bf16(*(const LDSAS bf16x8*)(ab + 3072), vf[1], o1, 0, 0, 0);
                    __builtin_amdgcn_sched_barrier(0);
                    o1 = __builtin_amdgcn_mfma_f32_32x32x16_bf16(*(const LDSAS bf16x8*)(ab + 4096), vf[2], o1, 0, 0, 0);
                    o1 = __builtin_amdgcn_mfma_f32_32x32x16_bf16(*(const LDSAS bf16x8*)(ab + 5120), vf[3], o1, 0, 0, 0);
                }
                LDSAS unsigned char* ost = lds + GL_V + wid * 4096;
#pragma unroll
                for (int r = 0; r < 16; r += 2) {
                    const int i0 = crow(r, hi);
                    const unsigned w0 = cvtpk(o0[r], o0[r + 1]), w1 = cvtpk(o1[r], o1[r + 1]);
                    *(LDSAS bf16_t*)(ost + i0 * 64 + r32 * 2) = (bf16_t)w0; *(LDSAS bf16_t*)(ost + (i0 + 1) * 64 + r32 * 2) = (bf16_t)(w0 >> 16);
                    *(LDSAS bf16_t*)(ost + (32 + i0) * 64 + r32 * 2) = (bf16_t)w1; *(LDSAS bf16_t*)(ost + (33 + i0) * 64 + r32 * 2) = (bf16_t)(w1 >> 16);
                }
                bf16_t* od = (dr ? P.ODB() : P.ODF()) + h * 256 + wid * 32;
#pragma unroll
                for (int k4 = 0; k4 < 4; ++k4) {
                    const int p = lane + 64 * k4, i = p >> 2, part = p & 3;
                    const u32x4 v = *(const LDSAS u32x4*)(ost + i * 64 + part * 16);
                    *(u32x4*)(od + (size_t)(membase + (dr ? 63 - i : i)) * 1024 + part * 8) = v;
                }
            }
            GL_SUPDATE();
            GL_Z();
            __syncthreads();
#undef GL_LOADV
#undef GL_SUPDATE
        }
#undef GL_PREFETCH_V
#undef GL_PREFETCH_RQK
#undef GL_TOP
#undef GL_Z
#undef GL_MEMBASE
    }
}

__device__ __forceinline__ void phase_rstd1(const Params& P, int vb, int nvb, int g_wave) {
    const int tidx = otid();
    for (int row = vb * 512 + tidx; row < M; row += nvb * 512) {
        float ss = 0.f;
#pragma unroll
        for (int i = 0; i < 16; ++i) ss += P.parts()[((((size_t)i * (M / 256) + (row >> 8)) * 2 + ((row >> 6) & 1)) * 16 + (row & 15)) * 8 + ((row >> 7) & 1) * 4 + ((row >> 4) & 3)];
        ((float*)(P.ws + OFF_RS))[row] = rsqrtf(ss * (1.0f / 1024.0f) + EPS);
    }
}

__device__ __forceinline__ void phase_finish(const Params& P, int vb, int nvb, int g_wave) {
    const int tidx = otid();
    const int lane = tidx & 63, wpb = blockDim.x >> 6, w = tidx >> 6;
    for (int row = vb * wpb + w; row < ML; row += nvb * wpb) {
        const int c0 = lane * 16;
        float v[16];
        u32x4 pfv[2], pbv[2], gq[2];
        load32(P.ODF() + (size_t)row * 1024, lane, pfv[0], pfv[1]);
        load32(P.ODB() + (size_t)row * 1024, lane, pbv[0], pbv[1]);
        load32(P.GG() + (size_t)row * 1024, lane, gq[0], gq[1]);
        float ss = 0.f;
#pragma unroll
        for (int i = 0; i < 2; ++i) {
            const u32x4 a = pfv[i], bq = pbv[i];
            v[8 * i] = bflo(a.x) + bflo(bq.x); v[8 * i + 1] = bfhi(a.x) + bfhi(bq.x); v[8 * i + 2] = bflo(a.y) + bflo(bq.y); v[8 * i + 3] = bfhi(a.y) + bfhi(bq.y);
            v[8 * i + 4] = bflo(a.z) + bflo(bq.z); v[8 * i + 5] = bfhi(a.z) + bfhi(bq.z); v[8 * i + 6] = bflo(a.w) + bflo(bq.w); v[8 * i + 7] = bfhi(a.w) + bfhi(bq.w);
        }
#pragma unroll
        for (int i = 0; i < 16; ++i) ss += v[i] * v[i];
        ss = sum_row16(ss);
        const float rn = rsqrtf(ss * (1.0f / 256.0f) + EPS);
        float gn[16];
        { const f32x4* gnp = (const f32x4*)(P.gla_out_norm + (c0 & 255));
#pragma unroll
          for (int i = 0; i < 4; ++i) { const f32x4 t4 = gnp[i]; gn[4 * i] = t4[0]; gn[4 * i + 1] = t4[1]; gn[4 * i + 2] = t4[2]; gn[4 * i + 3] = t4[3]; } }
        u32x4 rr[2];
#pragma unroll
        for (int i = 0; i < 2; ++i) {
            const u32x4 g = gq[i]; u32x4 r;
            r.x = cvtpk(v[8 * i] * rn * gn[8 * i] * bflo(g.x), v[8 * i + 1] * rn * gn[8 * i + 1] * bfhi(g.x));
            r.y = cvtpk(v[8 * i + 2] * rn * gn[8 * i + 2] * bflo(g.y), v[8 * i + 3] * rn * gn[8 * i + 3] * bfhi(g.y));
            r.z = cvtpk(v[8 * i + 4] * rn * gn[8 * i + 4] * bflo(g.z), v[8 * i + 5] * rn * gn[8 * i + 5] * bfhi(g.z));
            r.w = cvtpk(v[8 * i + 6] * rn * gn[8 * i + 6] * bflo(g.w), v[8 * i + 7] * rn * gn[8 * i + 7] * bfhi(g.w));
            rr[i] = r;
        }
#pragma unroll
        for (int e = 0; e < 4; ++e) { const auto sw = __builtin_amdgcn_permlane32_swap(rr[0][e], rr[1][e], false, false); rr[0][e] = sw[0]; rr[1][e] = sw[1]; }
        unsigned char* op = (unsigned char*)(P.A2() + (size_t)row * 1024) + (lane & 31) * 32 + (lane >> 5) * 16;
        *(u32x4*)(op) = rr[0]; *(u32x4*)(op + 1024) = rr[1];
    }
}

namespace cg = cooperative_groups;
#define XB_TMO      128
#define XB_XCNT(j)  (256  + 64 * (j))
#define XB_XSUB(j)  (1280 + 64 * (j))
#define XB_XGEN(j)  (2304 + 64 * (j))
#define XB_TOP      3328
#define XB_TOPGEN   3392
#define XCD_BAR_WORDS 3456
#define XB_SPIN_CAP (1u << 22)
static_assert(XCD_BAR_WORDS * 4 <= 16384, "barrier words fit their workspace slot");
__device__ __forceinline__ unsigned xb_ld(unsigned* p) { return __hip_atomic_load(p, __ATOMIC_RELAXED, __HIP_MEMORY_SCOPE_AGENT); }
__device__ __forceinline__ unsigned xb_add(unsigned* p, unsigned v) { return __hip_atomic_fetch_add(p, v, __ATOMIC_RELAXED, __HIP_MEMORY_SCOPE_AGENT); }
__device__ __forceinline__ unsigned xb_xcc_id() { return (unsigned)__builtin_amdgcn_s_getreg((3 << 11) | 20) & 0xFu; }
#define XB_SPIN(cond, bar) do { unsigned _sp = 0; while (cond) { __builtin_amdgcn_s_sleep(1); \
    if ((++_sp & 255u) == 0u) { if (xb_ld(&(bar)[XB_TMO])) break; if (_sp > XB_SPIN_CAP) { atomicAdd(&(bar)[XB_TMO], 1u); break; } } } } while (0)
__device__ __forceinline__ void xcd_barrier_complete(unsigned* bar, unsigned x, unsigned G, unsigned& nloc, unsigned& nx) {
    unsigned sum, cnt, mine, sp = 0u;
    for (;;) {
        sum = 0u; cnt = 0u; mine = 0u;
#pragma unroll
        for (unsigned j = 0; j < 16; ++j) { const unsigned c = xb_ld(&bar[XB_XCNT(j)]); sum += c; cnt += (c > 0u) ? 1u : 0u; mine = (j == x) ? c : mine; }
        if (sum == G) break;
        __builtin_amdgcn_s_sleep(1);
        if ((++sp & 255u) == 0u) { if (xb_ld(&bar[XB_TMO])) break; if (sp > XB_SPIN_CAP) { atomicAdd(&bar[XB_TMO], 1u); break; } }
    }
    nloc = mine > 0u ? mine : 1u; nx = cnt > 0u ? cnt : 1u;
}
__device__ __forceinline__ void xcd_barrier(unsigned* bar, volatile LDSAS unsigned* st, unsigned G, int g_wave) {
    asm volatile("s_waitcnt vmcnt(0)" ::: "memory");
    __syncthreads();
    if (g_wave == 0 && lane_id() == 0) {
        const unsigned x = xb_xcc_id();
        __builtin_amdgcn_s_waitcnt(0);
        unsigned nloc = st[0], nx = st[1];
        if (nloc == 0u) { xcd_barrier_complete(bar, x, G, nloc, nx); st[0] = nloc; st[1] = nx; }
        const unsigned old = xb_add(&bar[XB_XSUB(x)], 1u);
        const unsigned gen = old / nloc;
        if (old + 1u == (gen + 1u) * nloc) {
            __builtin_amdgcn_fence(__ATOMIC_RELEASE, "agent");
            asm volatile("s_waitcnt vmcnt(0)" ::: "memory");
            const unsigned og = xb_add(&bar[XB_TOP], 1u);
            const unsigned tg = og / nx;
            if (og + 1u == (tg + 1u) * nx) xb_add(&bar[XB_TOPGEN], 1u);
            else XB_SPIN(xb_ld(&bar[XB_TOPGEN]) == tg, bar);
            __builtin_amdgcn_fence(__ATOMIC_ACQUIRE, "agent");
            xb_add(&bar[XB_XGEN(x)], 1u);
            asm volatile("s_waitcnt vmcnt(0)" ::: "memory");
        } else {
            XB_SPIN(xb_ld(&bar[XB_XGEN(x)]) == gen, bar);
            __builtin_amdgcn_fence(__ATOMIC_ACQUIRE, "agent");
            asm volatile("s_waitcnt vmcnt(0)" ::: "memory");
        }
    }
    __syncthreads();
}

#define GRID_BAR() xcd_barrier((unsigned*)(ldparams().ws + OFF_BAR), (volatile LDSAS unsigned*)(lds + KERNEL_LDS), (unsigned)nvb, g_wave)
#define REPEAT(k, ...) { const Params P = ldparams(); __VA_ARGS__ }
__global__ void __launch_bounds__(512) mega_kernel(Params Pk) {
    __shared__ __attribute__((aligned(16))) unsigned char lds[KERNEL_LDS + 16];
    const int vb = blockIdx.x, nvb = gridDim.x;
    const int g_wave = __builtin_amdgcn_readfirstlane((int)(threadIdx.x >> 6));
    if (threadIdx.x == 0) {
        ((volatile LDSAS unsigned*)(lds + KERNEL_LDS))[0] = 0u; ((volatile LDSAS unsigned*)(lds + KERNEL_LDS))[1] = 0u;
        (void)xb_add(&((unsigned*)(Pk.ws + OFF_BAR))[XB_XCNT(xb_xcc_id())], 1u);
    }
#ifdef PROBE_A
#define STAMP(k) do { if (vb == 0 && g_wave == 0 && lane_id() == 0) ((unsigned long long*)(ldparams().ws + OFF_BAR + 14336))[k] = __builtin_amdgcn_s_memrealtime(); } while (0)
#else
#define STAMP(k) do { } while (0)
#endif
    STAMP(0);
    REPEAT(0, phase_pro0(P, lds, vb, nvb, g_wave);)
    STAMP(1);
    if (ldparams().reps[11] != 0) cg::this_grid().sync();
    GRID_BAR();
    REPEAT(1, phase_bias_a0(P, lds, vb, nvb, g_wave);)
    STAMP(2);
    GRID_BAR();
    REPEAT(2, EpiIn0 E{P.ws, P.a_q_norm, P.a_k_norm, P.b_q_norm, P.b_k_norm};
      pg8::Gemm g{P.A(), P.Wt0(), M, N0, D}; pg8::StaticOrder S; S.init(M, N0, nvb, vb); pg8::gemm_phase<EpiIn0, pg8::StaticOrder, true, true>((LDSAS unsigned char*)lds, g, S, E, g_wave);)
    STAMP(3);
    GRID_BAR();
    REPEAT(3, phase_attnA_mfma(P, (LDSAS unsigned char*)lds, vb, nvb, g_wave);)
    REPEAT(4, phase_attnB_mfma(P, (LDSAS unsigned char*)lds, vb, nvb, g_wave);)
    STAMP(4);
    GRID_BAR();
    REPEAT(5, EpiOut0 E{P.x, P.ctx, P.norm_g + D, P.out, P.ws, P.norm_g};
      pg8::Gemm g{P.O(), P.Wo0(), M, D, D}; pg8::StaticOrder S; S.init(M, D, nvb, vb); pg8::gemm_phase<EpiOut0, pg8::StaticOrder, true, true>((LDSAS unsigned char*)lds, g, S, E, g_wave);)
    STAMP(5);
    GRID_BAR();
    { const Params P = ldparams(); phase_rstd1(P, vb, nvb, g_wave); }
    GRID_BAR();
    REPEAT(6, EpiIn1 E{P.ws};
      pg8::Gemm g{P.A(), P.Wt1(), M, N1, D}; OrderIn1 S; S.init(nvb, vb); pg8::gemm_phase<EpiIn1, OrderIn1, true, true>((LDSAS unsigned char*)lds, g, S, E, g_wave);)
    STAMP(6);
    GRID_BAR();
    REPEAT(7, phase_gla_mfma(P, (LDSAS unsigned char*)lds, vb, nvb, g_wave);)
    STAMP(7);
    GRID_BAR();
    REPEAT(8, phase_finish(P, vb, nvb, g_wave);)
    STAMP(8);
    GRID_BAR();
    { const Params P = ldparams();
      EpiOut1 E{P.ws, P.out, P.norm_g + D};
      pg8::Gemm g{P.A2(), P.Wo1(), ML, D, D}; pg8::StaticOrder S; S.init(ML, D, nvb, vb); pg8::gemm_phase<EpiOut1, pg8::StaticOrder, true, true>((LDSAS unsigned char*)lds, g, S, E, g_wave); }
#ifdef PROBE_A
    STAMP(9);
    GRID_BAR();
    if (vb == 0 && g_wave == 0 && lane_id() == 0) {
        const Params P = ldparams(); const unsigned long long* ts = (const unsigned long long*)(P.ws + OFF_BAR + 14336);
        P.out[0] += (float)(ts[PROBE_A + 1] - ts[PROBE_A]) * 0.01f;
        P.out[1] += (float)(ts[PROBE_B + 1] - ts[PROBE_B]) * 0.01f;
    }
#endif
}
}

extern "C" void kernel_launch(void* const* d_in, const int* in_sizes, int n_in, void* d_out, int out_size, void* d_ws, size_t ws_size, hipStream_t stream) {
    Params P{};
    const float* const* in = (const float* const*)d_in;
    P.x = in[0]; P.c = in[1]; P.ctx = in[2]; P.c_ctx = in[3]; P.adaln_w = in[4]; P.adaln_b = in[5]; P.norm_g = in[6]; P.w_out = in[7]; P.ab_w_in = in[8];
    P.a_q_norm = in[9]; P.a_k_norm = in[10]; P.a_sink = in[11]; P.b_q_norm = in[12]; P.b_k_norm = in[13]; P.lq1 = in[14]; P.lk1 = in[15]; P.lq2 = in[16]; P.lk2 = in[17];
    P.b_subln = in[18]; P.gla_w_in = in[19]; P.wa_f = in[20]; P.ba_f = in[21]; P.wa_b = in[22]; P.ba_b = in[23]; P.gla_out_norm = in[24];
    P.out = (float*)d_out;
    P.ws = (unsigned char*)d_ws;
    for (int i = 0; i < 12; ++i) P.reps[i] = 1;
    P.reps[11] = 0;
#ifdef PROBE_PHASE
    P.reps[PROBE_PHASE] = 2;
#endif
    if (WS_NEED > ws_size) { fprintf(stderr, "workspace too small: need %zu have %zu\n", (size_t)WS_NEED, ws_size); return; }
    static int grid_blocks = 0;
    if (!grid_blocks) {
        int dev = 0, cus = 0, per_cu = 0;
        (void)hipGetDevice(&dev);
        (void)hipDeviceGetAttribute(&cus, hipDeviceAttributeMultiprocessorCount, dev);
        (void)hipOccupancyMaxActiveBlocksPerMultiprocessor(&per_cu, mega_kernel, 512, 0);
        if (per_cu > 1) per_cu = 1;
        grid_blocks = cus * per_cu;
    }
    (void)hipMemsetAsync((unsigned char*)d_ws + OFF_BAR, 0, 16384, stream);
    void* args[] = {&P};
    hipError_t e = hipLaunchCooperativeKernel((void*)mega_kernel, dim3(grid_blocks), dim3(512), args, 0, stream);
    if (e != hipSuccess) fprintf(stderr, "cooperative launch failed: %s (grid %d)\n", hipGetErrorString(e), grid_blocks);
}
```
